# Optimizing an MI355X kernel written in HIP

```python
import math
import jax
import jax.numpy as jnp
from jax import lax
import numpy as np

D_MODEL = 1024
BATCH = 16
SEQ = 256
DEPTH = 4
DEC_BATCH = 4
DEC_SEQ = 1024
PAST_LEN = 512

GRID_W = 64
N_MIXERS = 3
N_ATTN = len(range(0, DEPTH, N_MIXERS))
N_REC = len(range(1, DEPTH, N_MIXERS))
N_FOUR = len(range(2, DEPTH, N_MIXERS))

ATTN_HEADS = 8
ATTN_DH = D_MODEL // ATTN_HEADS // 2
ATTN_DV = 2 * ATTN_DH
ROPE_THETA = 10000.0
Q_BLOCK = 128

REC_HEADS = 8
REC_DK = D_MODEL // REC_HEADS
REC_DV = D_MODEL // REC_HEADS
REC_CHUNK = 16

FOUR_GROUPS = 4
FOUR_DG = D_MODEL // FOUR_GROUPS

D_FF = ((8 * D_MODEL // 3 + 255) // 256) * 256
N_MOD = 6
EPS = 1e-6

kernel_name = 'hybrid_diffattn_hgrn2_fnet_prefix_dit_step'

F32 = jnp.float32


def rmsnorm(x, g):
    xf = x.astype(F32)
    y = xf * lax.rsqrt(jnp.mean(xf * xf, axis=-1, keepdims=True) + EPS)
    return (y * g.astype(F32)).astype(x.dtype)


def modulation(cond, w, b):
    m = jax.nn.silu(cond.reshape(-1, D_MODEL)) @ w + b
    return [t[:, None, :] for t in jnp.split(m, N_MOD, axis=-1)]


def adanorm(x, g, shift, scale):
    return rmsnorm(x, g) * (1.0 + scale) + shift


def grid_positions(n_tokens):
    rows = n_tokens // GRID_W
    row = jnp.repeat(jnp.arange(rows), GRID_W)
    col = jnp.tile(jnp.arange(GRID_W), rows)
    return row, col


def rope_axis(x, pos):
    half = x.shape[-1] // 2
    inv = ROPE_THETA ** (-jnp.arange(half, dtype=F32) / half)
    ang = pos.astype(F32)[:, None] * inv
    cos = jnp.cos(ang)[None, :, None, None, :]
    sin = jnp.sin(ang)[None, :, None, None, :]
    x1, x2 = x[..., :half], x[..., half:]
    return jnp.concatenate([x1 * cos - x2 * sin, x2 * cos + x1 * sin], axis=-1)


def rope_2d(x, row, col):
    xf = x.astype(F32)
    n = ATTN_DH // 2
    out = jnp.concatenate([rope_axis(xf[..., :n], row), rope_axis(xf[..., n:], col)], axis=-1)
    return out.astype(x.dtype)


def diff_attn_core(q, k, v, lam):
    bsz, lq = q.shape[0], q.shape[1]
    nb = lq // Q_BLOCK
    qb = q.reshape(bsz, nb, Q_BLOCK, ATTN_HEADS, 2, ATTN_DH).swapaxes(0, 1)
    scale = ATTN_DH ** -0.5
    vf = v.astype(F32)

    def one_block(qi):
        s = jnp.einsum('bqhcd,bkhcd->bhcqk', qi, k).astype(F32) * scale
        p = jax.nn.softmax(s, axis=-1)
        pd = p[:, :, 0] - lam * p[:, :, 1]
        return jnp.einsum('bhqk,bkhe->bqhe', pd, vf)

    o = lax.map(one_block, qb)
    return o.swapaxes(0, 1).reshape(bsz, lq, ATTN_HEADS, ATTN_DV)


def attn_project(h, w_qkv):
    bsz, n = h.shape[0], h.shape[1]
    q, k, v = jnp.split(h @ w_qkv, 3, axis=-1)
    q = q.reshape(bsz, n, ATTN_HEADS, 2, ATTN_DH)
    k = k.reshape(bsz, n, ATTN_HEADS, 2, ATTN_DH)
    v = v.reshape(bsz, n, ATTN_HEADS, ATTN_DV)
    return q, k, v


def attn_output(o, g_subln, lam_init, w_o, dtype):
    bsz, n = o.shape[0], o.shape[1]
    o = rmsnorm(o, g_subln) * (1.0 - lam_init)
    return o.reshape(bsz, n, D_MODEL).astype(dtype) @ w_o


def chunk_gla(q, k, v, lf, s0):
    bsz, n, nh, dk = q.shape
    dv = v.shape[-1]
    c = REC_CHUNK
    nc = n // c
    q = q.reshape(bsz, nc, c, nh, dk)
    k = k.reshape(bsz, nc, c, nh, dk)
    v = v.reshape(bsz, nc, c, nh, dv)
    b = jnp.cumsum(lf.reshape(bsz, nc, c, nh, dk), axis=2)
    mask = jnp.tril(jnp.ones((c, c), dtype=bool))[:, :, None, None]
    diff = b[:, :, :, None] - b[:, :, None, :]
    dec = jnp.where(mask, jnp.exp(jnp.where(mask, diff, 0.0)), 0.0)
    a = jnp.sum(q[:, :, :, None] * k[:, :, None, :] * dec, axis=-1)
    o_intra = jnp.einsum('bntsh,bnshv->bnthv', a, v)
    b_last = b[:, :, -1]
    kv = jnp.einsum('bnshk,bnshv->bnhkv', k * jnp.exp(b_last[:, :, None] - b), v)

    def step(s, inp):
        d, kv_c = inp
        return d[..., None] * s + kv_c, s

    s_fin, s_start = lax.scan(step, s0, (jnp.exp(b_last).swapaxes(0, 1), kv.swapaxes(0, 1)))
    o_inter = jnp.einsum('bnthk,nbhkv->bnthv', q * jnp.exp(b), s_start)
    return (o_intra + o_inter).reshape(bsz, n, nh, dv), s_fin


def hgrn_lower_bounds(lb_logits, layer):
    s = jax.nn.softmax(lb_logits.astype(F32), axis=1)
    lb = jnp.cumsum(s, axis=1) - s[:, :1]
    return lb[:, layer]


def hgrn_project(h, w_in, lb):
    bsz, n = h.shape[0], h.shape[1]
    q, vi, g, zf, zb = jnp.split(h @ w_in, 5, axis=-1)
    q = jax.nn.silu(q.astype(F32)).reshape(bsz, n, REC_HEADS, REC_DK)
    vi = vi.astype(F32).reshape(bsz, n, REC_HEADS, REC_DV)

    def gates(z, lbd):
        f = lbd + (1.0 - lbd) * jax.nn.sigmoid(z.astype(F32))
        return (1.0 - f).reshape(bsz, n, REC_HEADS, REC_DK), jnp.log(f).reshape(bsz, n, REC_HEADS, REC_DK)

    kf, lff = gates(zf, lb[0])
    kb, lfb = gates(zb, lb[1])
    return q, vi, g, kf, lff, kb, lfb


def hgrn_mix(q, vi, kf, lff, kb, lfb, s0f, s0b):
    of, sf = chunk_gla(q, kf, vi, lff, s0f)
    ob, sb = chunk_gla(q[:, ::-1], kb[:, ::-1], vi[:, ::-1], lfb[:, ::-1], s0b)
    return of + ob[:, ::-1], jnp.stack([sf, sb], axis=1)


def hgrn_output(o, g, g_out, w_o, dtype):
    bsz, n = o.shape[0], o.shape[1]
    gate = jax.nn.silu(g.astype(F32)).reshape(bsz, n, REC_HEADS, REC_DV)
    o = rmsnorm(o, g_out) * gate
    return o.reshape(bsz, n, D_MODEL).astype(dtype) @ w_o


def fourier_mix(h, w):
    bsz, n = h.shape[0], h.shape[1]
    hg = h.astype(F32).reshape(bsz, n, FOUR_GROUPS, FOUR_DG)
    f = jnp.fft.fftn(hg, axes=(1, 3), norm='ortho').real
    return f.reshape(bsz, n, D_MODEL).astype(h.dtype) @ w


def swiglu(h, w_in, w_out):
    gt, up = jnp.split(h @ w_in, 2, axis=-1)
    return (jax.nn.silu(gt) * up) @ w_out


def setup_inputs(seed: int = 0) -> dict:
    key = jax.random.key(seed)
    ks = jax.random.split(key, 24)
    nrm = jax.random.normal
    d = D_MODEL
    return {
        'x_prompt': nrm(ks[0], (BATCH, SEQ, d), F32),
        'x_sample': nrm(ks[1], (DEC_BATCH, DEC_SEQ, d), F32),
        'cache_attn_k': nrm(ks[2], (DEC_BATCH, N_ATTN, PAST_LEN, ATTN_HEADS, 2, ATTN_DH), F32),
        'cache_attn_v': nrm(ks[3], (DEC_BATCH, N_ATTN, PAST_LEN, ATTN_HEADS, ATTN_DV), F32),
        'state_hgrn': 0.5 * nrm(ks[4], (DEC_BATCH, N_REC, 2, REC_HEADS, REC_DK, REC_DV), F32),
        'c': nrm(ks[5], (DEC_BATCH, d), F32),
        'c_ctx': nrm(ks[6], (d,), F32),
        'w_ada': nrm(ks[7], (DEPTH, d, N_MOD * d), F32) * d ** -0.5,
        'b_ada': 0.02 * nrm(ks[8], (DEPTH, N_MOD * d), F32),
        'g_norm_mix': 1.0 + 0.02 * nrm(ks[9], (DEPTH, d), F32),
        'g_norm_ffn': 1.0 + 0.02 * nrm(ks[10], (DEPTH, d), F32),
        'w_qkv_attn': nrm(ks[11], (N_ATTN, d, 3 * d), F32) * d ** -0.5,
        'lam_attn': 0.1 * nrm(ks[12], (N_ATTN, 4, ATTN_DH), F32),
        'g_subln_attn': 1.0 + 0.02 * nrm(ks[13], (N_ATTN, ATTN_DV), F32),
        'w_o_attn': nrm(ks[14], (N_ATTN, d, d), F32) * d ** -0.5,
        'w_in_rec': nrm(ks[15], (N_REC, d, 5 * d), F32) * d ** -0.5,
        'lb_logits_rec': 0.5 * nrm(ks[16], (2, DEPTH, REC_HEADS * REC_DK), F32),
        'g_out_rec': 1.0 + 0.02 * nrm(ks[17], (N_REC, REC_DV), F32),
        'w_o_rec': nrm(ks[18], (N_REC, d, d), F32) * d ** -0.5,
        'w_four': nrm(ks[19], (N_FOUR, d, d), F32) * d ** -0.5,
        'w_ffn_in': nrm(ks[20], (DEPTH, d, 2 * D_FF), F32) * d ** -0.5,
        'w_ffn_out': nrm(ks[21], (DEPTH, D_FF, d), F32) * D_FF ** -0.5,
        'g_final': 1.0 + 0.02 * nrm(ks[22], (d,), F32),
    }


def reference(x_prompt, x_sample, cache_attn_k, cache_attn_v, state_hgrn, c, c_ctx,
              w_ada, b_ada, g_norm_mix, g_norm_ffn, w_qkv_attn, lam_attn, g_subln_attn, w_o_attn,
              w_in_rec, lb_logits_rec, g_out_rec, w_o_rec, w_four, w_ffn_in, w_ffn_out, g_final):
    n_lat = x_sample.shape[1]
    row, col = grid_positions(n_lat)
    xp, xs = x_prompt, x_sample
    new_k, new_v, new_s = [], [], []
    for i in range(DEPTH):
        kind, j = i % N_MIXERS, i // N_MIXERS
        mp = modulation(c_ctx, w_ada[i], b_ada[i])
        ms = modulation(c, w_ada[i], b_ada[i])
        hp = adanorm(xp, g_norm_mix[i], mp[0], mp[1])
        hs = adanorm(xs, g_norm_mix[i], ms[0], ms[1])
        if kind == 0:
            lam_init = 0.8 - 0.6 * math.exp(-0.3 * i)
            lp = lam_attn[j].astype(F32)
            lam = jnp.exp(jnp.sum(lp[0] * lp[1])) - jnp.exp(jnp.sum(lp[2] * lp[3])) + lam_init
            qp, kp, vp = attn_project(hp, w_qkv_attn[j])
            op = attn_output(diff_attn_core(qp, kp, vp, lam), g_subln_attn[j], lam_init, w_o_attn[j], xp.dtype)
            new_k.append(kp)
            new_v.append(vp)
            qs, ks_, vs = attn_project(hs, w_qkv_attn[j])
            qs, ks_ = rope_2d(qs, row, col), rope_2d(ks_, row, col)
            k_all = jnp.concatenate([cache_attn_k[:, j].astype(ks_.dtype), ks_], axis=1)
            v_all = jnp.concatenate([cache_attn_v[:, j].astype(vs.dtype), vs], axis=1)
            os_ = attn_output(diff_attn_core(qs, k_all, v_all, lam), g_subln_attn[j], lam_init, w_o_attn[j], xs.dtype)
        elif kind == 1:
            lb = hgrn_lower_bounds(lb_logits_rec, i)
            q, vi, g, kf, lff, kb, lfb = hgrn_project(hp, w_in_rec[j], lb)
            zero = jnp.zeros((xp.shape[0], REC_HEADS, REC_DK, REC_DV), F32)
            o, s_ctx = hgrn_mix(q, vi, kf, lff, kb, lfb, zero, zero)
            op = hgrn_output(o, g, g_out_rec[j], w_o_rec[j], xp.dtype)
            new_s.append(s_ctx.astype(xp.dtype))
            q, vi, g, kf, lff, kb, lfb = hgrn_project(hs, w_in_rec[j], lb)
            st = state_hgrn[:, j].astype(F32)
            o, _ = hgrn_mix(q, vi, kf, lff, kb, lfb, st[:, 0], st[:, 1])
            os_ = hgrn_output(o, g, g_out_rec[j], w_o_rec[j], xs.dtype)
        else:
            op = fourier_mix(hp, w_four[j])
            os_ = fourier_mix(hs, w_four[j])
        xp = xp + mp[2] * op
        xs = xs + ms[2] * os_
        xp = xp + mp[5] * swiglu(adanorm(xp, g_norm_ffn[i], mp[3], mp[4]), w_ffn_in[i], w_ffn_out[i])
        xs = xs + ms[5] * swiglu(adanorm(xs, g_norm_ffn[i], ms[3], ms[4]), w_ffn_in[i], w_ffn_out[i])
    y_prompt = rmsnorm(xp, g_final)
    y_sample = rmsnorm(xs, g_final)
    return (y_prompt, y_sample, jnp.stack(new_k, axis=1), jnp.stack(new_v, axis=1), jnp.stack(new_s, axis=1))
```

```cpp
#include <hip/hip_runtime.h>
#include <cstdio>
#include <cstdint>

#define LAS __attribute__((address_space(3)))
#define GAS __attribute__((address_space(1)))
typedef unsigned short bf16_t;
typedef short bf16x8 __attribute__((ext_vector_type(8)));
typedef short s16x4 __attribute__((ext_vector_type(4)));
typedef float f32x2 __attribute__((ext_vector_type(2)));
typedef float f32x4 __attribute__((ext_vector_type(4)));
typedef float f32x8 __attribute__((ext_vector_type(8)));
typedef float f32x16 __attribute__((ext_vector_type(16)));
typedef unsigned u32x2 __attribute__((ext_vector_type(2)));
typedef unsigned u32x4 __attribute__((ext_vector_type(4)));

constexpr int DM = 1024, MTOK = 8192, NCTX = 4096, DFF = 2816, NKV = 4096 + 4 * 1536;
constexpr float EPS = 1e-6f;
constexpr int NWAVES = 8, NTHREADS = 512;

constexpr size_t al256(size_t x) { return (x + 255) / 256 * 256; }
constexpr size_t WS_CTL = 0, CTL_BYTES = 65536;
constexpr size_t WS_MOD = WS_CTL + CTL_BYTES;
constexpr size_t WS_ROPE = WS_MOD + al256(4 * 5 * 6144 * 4);
constexpr size_t WS_LBV = WS_ROPE + 8192;
constexpr size_t WS_LAM = WS_LBV + 8192;
constexpr size_t WS_AN = WS_LAM + 256;
constexpr size_t WS_SW = WS_AN + 8 * 5 * 1024 * 4;
constexpr size_t WS_SSP = WS_SW + al256(35840 * 5 * 4);
constexpr int SSPN = 32;
constexpr size_t WS_TC = WS_SSP + 9ull * 8192 * SSPN * 4;
constexpr size_t WS_CS256 = WS_TC + 256 * 1024 * 2;
constexpr size_t WS_CS1024 = WS_CS256 + 256 * 2048 * 2;
constexpr size_t WS_WQKV = WS_CS1024 + 1024 * 2048 * 2;
constexpr size_t WS_WOA = WS_WQKV + 2ull * 3072 * 1024 * 2;
constexpr size_t WS_WINR = WS_WOA + 2ull * 1024 * 1024 * 2;
constexpr size_t WS_WOR = WS_WINR + 5120ull * 1024 * 2;
constexpr size_t WS_WFO = WS_WOR + 1024ull * 1024 * 2;
constexpr size_t WS_WCS = WS_WFO + 1024ull * 1024 * 2;
constexpr size_t WS_WFI = WS_WCS + 2048ull * 1024 * 2;
constexpr size_t WS_WFOUT = WS_WFI + 4ull * 5632 * 1024 * 2;
constexpr size_t WS_X = WS_WFOUT + 4ull * 1024 * 2816 * 2;
constexpr size_t WS_H = WS_X + 8192ull * 1024 * 4;
constexpr size_t WS_O = WS_H + 8192ull * 1024 * 2;
constexpr size_t WS_SCR = WS_O + 8192ull * 1024 * 2;
constexpr size_t SZ_TOK = 8192ull * 1024 * 2;
constexpr size_t WS_Q = WS_SCR, WS_KB = WS_Q + SZ_TOK, WS_VB = WS_KB + (size_t)NKV * 1024 * 2;
constexpr size_t WS_GH = WS_SCR, WS_QTF = WS_GH + SZ_TOK, WS_KTF = WS_QTF + SZ_TOK, WS_QTB = WS_KTF + SZ_TOK, WS_KTB = WS_QTB + SZ_TOK, WS_KHTF = WS_KTB + SZ_TOK, WS_KHTB = WS_KHTF + SZ_TOK,
                 WS_VT = WS_KHTB + SZ_TOK, WS_OF = WS_VT + SZ_TOK, WS_OB = WS_OF + SZ_TOK, WS_DDF = WS_OB + SZ_TOK, WS_DDB = WS_DDF + 512ull * 8 * 128 * 4;
constexpr size_t WS_ZT = WS_SCR;
constexpr size_t WS_ACT = WS_SCR;
constexpr size_t WS_END = WS_DDB + 512ull * 8 * 128 * 4;
constexpr size_t WS_END2 = WS_END;
__host__ __device__ constexpr int sw_n(int nidx) { return nidx == 0 || nidx == 6 ? 3072 : nidx == 2 ? 5120 : nidx == 4 ? 2048 : 5632; }
__host__ __device__ constexpr int sw_off(int nidx) { int o = 0; for (int i = 0; i < nidx; ++i) o += 5 * sw_n(i); return o; }

constexpr size_t OUT_YP = 0, OUT_YS = 4194304, OUT_NK = 8388608, OUT_NV = 16777216, OUT_NS = 25165824;

constexpr int RING_BYTES = 131072;
constexpr int LDSCTL_OFF = RING_BYTES, MISC_OFF = LDSCTL_OFF + 320, RSTD_OFF = LDSCTL_OFF + 1024;
constexpr int LDS_BYTES = 147456;

typedef __bf16 bf16x2_t __attribute__((ext_vector_type(2)));
__device__ __forceinline__ unsigned cvt_pk_bf16(float lo, float hi) { f32x2 v = {lo, hi}; bf16x2_t b = __builtin_convertvector(v, bf16x2_t); return __builtin_bit_cast(unsigned, b); }
__device__ __forceinline__ float bf2f(unsigned short b) { return __uint_as_float((unsigned)b << 16); }
__device__ __forceinline__ float bflo(unsigned w) { return __uint_as_float(w << 16); }
__device__ __forceinline__ float bfhi(unsigned w) { return __uint_as_float(w & 0xffff0000u); }
__device__ __forceinline__ float fast_rcp(float x) { return __builtin_amdgcn_rcpf(x); }
__device__ __forceinline__ float silu_f(float x) { return x * fast_rcp(1.f + __expf(-x)); }
__device__ __forceinline__ float sigmoid_f(float x) { return fast_rcp(1.f + __expf(-x)); }
__device__ __forceinline__ float wave_sum(float v) {
#pragma unroll
    for (int o = 1; o < 64; o <<= 1) v += __shfl_xor(v, o);
    return v;
}
__device__ __forceinline__ int tid_opaque() { int t = threadIdx.x; asm volatile("" : "+v"(t)); return t; }
__device__ __forceinline__ int cond_of_row(int r) { return r < NCTX ? 0 : 1 + ((r - NCTX) >> 10); }
#define LDS_WAIT() asm volatile("s_waitcnt lgkmcnt(0)" ::: "memory")
#define VM_WAIT() asm volatile("s_waitcnt vmcnt(0)" ::: "memory")

#define XB_TMO      128
#define XB_XCNT(j)  (256  + 64 * (j))
#define XB_XSUB(j)  (1280 + 64 * (j))
#define XB_XGEN(j)  (2304 + 64 * (j))
#define XB_TOP      3328
#define XB_TOPGEN   3392
#define XCD_BAR_WORDS 3456
#define XB_SPIN_CAP (1u << 22)
__device__ __forceinline__ unsigned xb_ld(unsigned* p)              { return __hip_atomic_load(p, __ATOMIC_RELAXED, __HIP_MEMORY_SCOPE_AGENT); }
__device__ __forceinline__ unsigned xb_add(unsigned* p, unsigned v) { return __hip_atomic_fetch_add(p, v, __ATOMIC_RELAXED, __HIP_MEMORY_SCOPE_AGENT); }
__device__ __forceinline__ unsigned xb_xcc_id() { return (unsigned)__builtin_amdgcn_s_getreg((3 << 11) | 20) & 0xFu; }
#define XB_SPIN(cond, bar) do { unsigned _sp = 0; while (cond) { __builtin_amdgcn_s_sleep(1); \
    if ((++_sp & 255u) == 0u) { if (xb_ld(&(bar)[XB_TMO])) break; if (_sp > XB_SPIN_CAP) { atomicAdd(&(bar)[XB_TMO], 1u); break; } } } } while (0)
struct XcdBarrier { unsigned* bar; unsigned x; volatile LAS unsigned* st; };
__device__ __forceinline__ XcdBarrier xcd_barrier_post(unsigned* bar, volatile LAS unsigned* st) {
    XcdBarrier b; b.bar = bar; b.x = xb_xcc_id(); b.st = st;
    if (threadIdx.x == 0) (void)xb_add(&bar[XB_XCNT(b.x)], 1u);
    return b;
}
__device__ __forceinline__ void xcd_barrier_complete(unsigned* bar, unsigned x, unsigned& nloc, unsigned& nx) {
    const unsigned G = gridDim.x * gridDim.y * gridDim.z;
    unsigned sum, cnt, mine, sp = 0u;
    for (;;) {
        sum = 0u; cnt = 0u; mine = 0u;
#pragma unroll
        for (unsigned j = 0; j < 16; ++j) { const unsigned c = xb_ld(&bar[XB_XCNT(j)]); sum += c; cnt += (c > 0u) ? 1u : 0u; mine = (j == x) ? c : mine; }
        if (sum == G) break;
        __builtin_amdgcn_s_sleep(1);
        if ((++sp & 255u) == 0u) { if (xb_ld(&bar[XB_TMO])) break; if (sp > XB_SPIN_CAP) { atomicAdd(&bar[XB_TMO], 1u); break; } }
    }
    nloc = mine > 0u ? mine : 1u; nx = cnt > 0u ? cnt : 1u;
}
__device__ __forceinline__ void xcd_barrier(const XcdBarrier& b) {
    asm volatile("s_waitcnt vmcnt(0)" ::: "memory");
    __syncthreads();
    if (threadIdx.x == 0) {
        unsigned* bar = b.bar;
        __builtin_amdgcn_s_waitcnt(0);
        unsigned nloc = b.st[0], nx = b.st[1];
        if (nloc == 0u) { xcd_barrier_complete(bar, b.x, nloc, nx); b.st[0] = nloc; b.st[1] = nx; }
        const unsigned old = xb_add(&bar[XB_XSUB(b.x)], 1u);
        const unsigned gen = old / nloc;
        if (old + 1u == (gen + 1u) * nloc) {
            __builtin_amdgcn_fence(__ATOMIC_RELEASE, "agent");
            asm volatile("s_waitcnt vmcnt(0)" ::: "memory");
            const unsigned og = xb_add(&bar[XB_TOP], 1u);
            const unsigned tg = og / nx;
            if (og + 1u == (tg + 1u) * nx) xb_add(&bar[XB_TOPGEN], 1u);
            else XB_SPIN(xb_ld(&bar[XB_TOPGEN]) == tg, bar);
            __builtin_amdgcn_fence(__ATOMIC_ACQUIRE, "agent");
            xb_add(&bar[XB_XGEN(b.x)], 1u);
            asm volatile("s_waitcnt vmcnt(0)" ::: "memory");
        } else {
            XB_SPIN(xb_ld(&bar[XB_XGEN(b.x)]) == gen, bar);
            __builtin_amdgcn_fence(__ATOMIC_ACQUIRE, "agent");
            asm volatile("s_waitcnt vmcnt(0)" ::: "memory");
        }
    }
    __syncthreads();
}

namespace pg8 {
constexpr int BM = 256, BK = 64, HALF = 128, HTB = HALF * BK * 2, NXCD = 8, WGM = 8;
__host__ __device__ __forceinline__ int lds_byte(int r, int c) { const int st = (r >> 4) * 2 + (c >> 5), rr = r & 15, cc = c & 31, ob = rr * 64 + cc * 2; return st * 1024 + (ob ^ (((ob >> 9) & 1) << 5)); }
__host__ __device__ __forceinline__ int perm32(int rho) { const int n = rho >> 4, i = rho & 15; return 8 * (i >> 2) + 4 * n + (i & 3); }
__host__ __device__ __forceinline__ void stage_rc(int b, int& R, int& C) { const int st = b / 1024, sb = b % 1024, swz = sb ^ (((sb >> 9) & 1) << 5); R = (st >> 1) * 16 + swz / 64; C = (st & 1) * 32 + (swz % 64) / 2; }

struct GUnit { const char* A; const char* B; int nt; int row0; int col0; int aux; };

template <class Epi, class Sched>
__device__ __forceinline__ void gemm_phase(LAS unsigned char* lds, const int lda, const int ldb, const Sched& S, const Epi& E) {
    const int tid = tid_opaque(), wid = __builtin_amdgcn_readfirstlane(tid >> 6), lane = tid & 63, wr = wid >> 2, wc = wid & 3, fr = lane & 15, fq = lane >> 4;
    unsigned voffA[2], voffB[2];
#pragma unroll
    for (int i = 0; i < 2; ++i) { int R, C; stage_rc(tid * 16 + i * 8192, R, C); const int Rb = Epi::PERM ? ((R & ~31) + perm32(R & 31)) : R; voffA[i] = (unsigned)(R * lda + C) * 2u; voffB[i] = (unsigned)(Rb * ldb + C) * 2u; }
    const size_t kstep = (size_t)(BK * 2);
    const size_t hstepA = (size_t)HALF * lda * 2, hstepB = (size_t)HALF * ldb * 2;
    const unsigned ldsw = (unsigned)wid * 1024u;
    const int aoff = lds_byte(wr * 64 + fr, fq * 8), boff = lds_byte(wc * 32 + fr, fq * 8);
#define PG8_SA(b, h) (((b) * 2 + (h)) * HTB)
#define PG8_SB(b, h) ((4 + (b) * 2 + (h)) * HTB)
#define PG8_STAGE(bufoff, gbase, voff) do { _Pragma("unroll") for (int _i = 0; _i < 2; ++_i) \
        __builtin_amdgcn_global_load_lds((const unsigned*)((const char*)(gbase) + (voff)[_i]), (LAS unsigned*)(lds + (bufoff) + ldsw + _i * 8192), 16, 0, 0); } while (0)
#define PG8_LDA(dst, b, h) do { _Pragma("unroll") for (int m = 0; m < 4; ++m) _Pragma("unroll") for (int k = 0; k < 2; ++k) dst[m][k] = *(const LAS bf16x8*)(lds + PG8_SA(b, h) + aoff + m * 2048 + k * 1024); } while (0)
#define PG8_LDB(dst, b, h) do { _Pragma("unroll") for (int n = 0; n < 2; ++n) _Pragma("unroll") for (int k = 0; k < 2; ++k) dst[n][k] = *(const LAS bf16x8*)(lds + PG8_SB(b, h) + boff + n * 2048 + k * 1024); } while (0)
#define PG8_MMA(ai, bj, At, Bt) do { __builtin_amdgcn_s_setprio(1); _Pragma("unroll") for (int m = 0; m < 4; ++m) _Pragma("unroll") for (int n = 0; n < 2; ++n) _Pragma("unroll") for (int k = 0; k < 2; ++k) \
        acc[ai][bj][m][n] = __builtin_amdgcn_mfma_f32_16x16x32_bf16(Bt[n][k], At[m][k], acc[ai][bj][m][n], 0, 0, 0); __builtin_amdgcn_s_setprio(0); } while (0)
#define PG8_WAIT_V(n) asm volatile("s_waitcnt vmcnt(" #n ")" ::: "memory")
#define PG8_WAIT_L(n) asm volatile("s_waitcnt lgkmcnt(" #n ")" ::: "memory")
#define PG8_BAR __builtin_amdgcn_s_barrier()
#define PG8_SCHED __builtin_amdgcn_sched_barrier(0)
    GUnit cur, nxt; int ui = 0;
    if (!S.next(0, cur)) return;
    E.prepare(S, lds, tid);
    f32x4 acc[2][2][4][2];
#pragma unroll
    for (int a = 0; a < 2; ++a)
#pragma unroll
        for (int b = 0; b < 2; ++b)
#pragma unroll
            for (int m = 0; m < 4; ++m)
#pragma unroll
                for (int n = 0; n < 2; ++n) acc[a][b][m][n] = (f32x4){0.f, 0.f, 0.f, 0.f};
    bf16x8 At[4][2], B0[2][2], B1[2][2];
    const char* cA = cur.A; const char* cB = cur.B;
    PG8_STAGE(PG8_SB(0, 0), cB, voffB); PG8_STAGE(PG8_SB(0, 1), cB + hstepB, voffB); PG8_STAGE(PG8_SA(0, 0), cA, voffA); PG8_STAGE(PG8_SA(0, 1), cA + hstepA, voffA);
    if (wr == 1) PG8_BAR;
    PG8_WAIT_V(2); PG8_BAR;
    PG8_STAGE(PG8_SB(1, 0), cB + kstep, voffB); PG8_STAGE(PG8_SA(1, 0), cA + kstep, voffA); PG8_STAGE(PG8_SB(1, 1), cB + hstepB + kstep, voffB);
    PG8_WAIT_V(6); PG8_BAR;
    for (;;) {
        const bool has_next = S.next(ui + 1, nxt);
        const char* nA = has_next ? nxt.A : cA; const char* nB = has_next ? nxt.B : cB;
        const int nt = cur.nt;
        for (int t = 0; t < nt; t += 2) {
            const bool last = (t == nt - 2);
            const char* a1 = cA + (size_t)(t + 1) * kstep;
            const char* a2 = last ? nA : cA + (size_t)(t + 2) * kstep; const char* b2 = last ? nB : cB + (size_t)(t + 2) * kstep;
            const char* a3 = a2 + kstep; const char* b3 = b2 + kstep;
            PG8_LDB(B0, 0, 0); PG8_LDB(B1, 0, 1); PG8_SCHED; PG8_LDA(At, 0, 0); PG8_STAGE(PG8_SA(1, 1), a1 + hstepA, voffA);
            PG8_WAIT_V(8); PG8_WAIT_L(0); PG8_BAR; PG8_MMA(0, 0, At, B0); PG8_MMA(0, 1, At, B1); PG8_BAR; PG8_SCHED;
            PG8_LDA(At, 0, 1); PG8_STAGE(PG8_SB(0, 0), b2, voffB); PG8_STAGE(PG8_SB(0, 1), b2 + hstepB, voffB); PG8_STAGE(PG8_SA(0, 0), a2, voffA);
            PG8_WAIT_V(8); PG8_WAIT_L(0); PG8_BAR; PG8_MMA(1, 0, At, B0); PG8_MMA(1, 1, At, B1); PG8_BAR; PG8_SCHED;
            PG8_LDB(B0, 1, 0); PG8_LDB(B1, 1, 1); PG8_SCHED; PG8_LDA(At, 1, 0); PG8_STAGE(PG8_SA(0, 1), a2 + hstepA, voffA);
            PG8_WAIT_V(8); PG8_WAIT_L(0); PG8_BAR; PG8_MMA(0, 0, At, B0); PG8_MMA(0, 1, At, B1); PG8_BAR; PG8_SCHED;
            PG8_LDA(At, 1, 1); PG8_STAGE(PG8_SB(1, 0), b3, voffB); PG8_STAGE(PG8_SB(1, 1), b3 + hstepB, voffB); PG8_STAGE(PG8_SA(1, 0), a3, voffA);
            PG8_WAIT_V(8); PG8_WAIT_L(0); PG8_BAR; PG8_MMA(1, 0, At, B0); PG8_MMA(1, 1, At, B1); PG8_BAR; PG8_SCHED;
        }
        if (wr == 0) PG8_BAR;
        E(acc, cur, ui, wr, wc, fr, fq);
        if (!has_next) break;
#pragma unroll
        for (int a = 0; a < 2; ++a)
#pragma unroll
            for (int b = 0; b < 2; ++b)
#pragma unroll
                for (int m = 0; m < 4; ++m)
#pragma unroll
                    for (int n = 0; n < 2; ++n) acc[a][b][m][n] = (f32x4){0.f, 0.f, 0.f, 0.f};
        cur = nxt; cA = nA; cB = nB; ++ui;
        if (wr == 1) PG8_BAR;
    }
    PG8_WAIT_V(0);
    PG8_BAR;
#undef PG8_SA
#undef PG8_SB
#undef PG8_STAGE
#undef PG8_LDA
#undef PG8_LDB
#undef PG8_MMA
#undef PG8_WAIT_V
#undef PG8_WAIT_L
#undef PG8_BAR
#undef PG8_SCHED
}

template <class Epi, class Sched>
__device__ __forceinline__ void gemm_phase_n128(LAS unsigned char* lds, const int lda, const int ldb, const Sched& S, const Epi& E) {
    const int tid = tid_opaque(), wid = __builtin_amdgcn_readfirstlane(tid >> 6), lane = tid & 63, wr = wid >> 2, wc = wid & 3, fr = lane & 15, fq = lane >> 4;
    unsigned voffA[2], voffB[2];
#pragma unroll
    for (int i = 0; i < 2; ++i) { int R, C; stage_rc(tid * 16 + i * 8192, R, C); const int Rb = Epi::PERM ? ((R & ~31) + perm32(R & 31)) : R; voffA[i] = (unsigned)(R * lda + C) * 2u; voffB[i] = (unsigned)(Rb * ldb + C) * 2u; }
    const size_t kstep = (size_t)(BK * 2);
    const size_t hstepA = (size_t)HALF * lda * 2;
    const unsigned ldsw = (unsigned)wid * 1024u;
    const int aoff = lds_byte(wr * 64 + fr, fq * 8), boff = lds_byte(wc * 32 + fr, fq * 8);
#define N1_SA(b, h) (((b) * 2 + (h)) * HTB)
#define N1_SB(b) ((4 + (b)) * HTB)
#define N1_STAGE(bufoff, gbase, voff) do { _Pragma("unroll") for (int _i = 0; _i < 2; ++_i) \
        __builtin_amdgcn_global_load_lds((const unsigned*)((const char*)(gbase) + (voff)[_i]), (LAS unsigned*)(lds + (bufoff) + ldsw + _i * 8192), 16, 0, 0); } while (0)
#define N1_LDA(dst, b, h) do { _Pragma("unroll") for (int m = 0; m < 4; ++m) _Pragma("unroll") for (int k = 0; k < 2; ++k) dst[m][k] = *(const LAS bf16x8*)(lds + N1_SA(b, h) + aoff + m * 2048 + k * 1024); } while (0)
#define N1_LDB(dst, b) do { _Pragma("unroll") for (int n = 0; n < 2; ++n) _Pragma("unroll") for (int k = 0; k < 2; ++k) dst[n][k] = *(const LAS bf16x8*)(lds + N1_SB(b) + boff + n * 2048 + k * 1024); } while (0)
#define N1_MMA(ai, At, Bt) do { __builtin_amdgcn_s_setprio(1); _Pragma("unroll") for (int m = 0; m < 4; ++m) _Pragma("unroll") for (int n = 0; n < 2; ++n) _Pragma("unroll") for (int k = 0; k < 2; ++k) \
        acc[ai][m][n] = __builtin_amdgcn_mfma_f32_16x16x32_bf16(Bt[n][k], At[m][k], acc[ai][m][n], 0, 0, 0); __builtin_amdgcn_s_setprio(0); } while (0)
#define N1_WAIT_V(n) asm volatile("s_waitcnt vmcnt(" #n ")" ::: "memory")
#define N1_WAIT_L(n) asm volatile("s_waitcnt lgkmcnt(" #n ")" ::: "memory")
#define N1_BAR __builtin_amdgcn_s_barrier()
#define N1_SCHED __builtin_amdgcn_sched_barrier(0)
    GUnit cur, nxt; int ui = 0;
    if (!S.next(0, cur)) return;
    E.prepare(S, lds, tid);
    f32x4 acc[2][4][2];
#pragma unroll
    for (int x = 0; x < 2; ++x)
#pragma unroll
        for (int m = 0; m < 4; ++m)
#pragma unroll
            for (int n = 0; n < 2; ++n) acc[x][m][n] = (f32x4){0.f, 0.f, 0.f, 0.f};
    bf16x8 At[4][2], B0[2][2];
    const char* cA = cur.A; const char* cB = cur.B;
    N1_STAGE(N1_SB(0), cB, voffB); N1_STAGE(N1_SA(0, 0), cA, voffA); N1_STAGE(N1_SA(0, 1), cA + hstepA, voffA);
    if (wr == 1) N1_BAR;
    N1_WAIT_V(0); N1_BAR;
    N1_STAGE(N1_SB(1), cB + kstep, voffB); N1_STAGE(N1_SA(1, 0), cA + kstep, voffA);
    N1_BAR;
    for (;;) {
        const bool has_next = S.next(ui + 1, nxt);
        const char* nA = has_next ? nxt.A : cA; const char* nB = has_next ? nxt.B : cB;
        const int nt = cur.nt;
        for (int t = 0; t < nt; t += 2) {
            const bool last = (t == nt - 2);
            const char* a1 = cA + (size_t)(t + 1) * kstep;
            const char* a2 = last ? nA : cA + (size_t)(t + 2) * kstep; const char* b2 = last ? nB : cB + (size_t)(t + 2) * kstep;
            const char* a3 = a2 + kstep; const char* b3 = b2 + kstep;
            N1_LDB(B0, 0); N1_SCHED; N1_LDA(At, 0, 0); N1_STAGE(N1_SA(1, 1), a1 + hstepA, voffA);
            N1_WAIT_V(6); N1_WAIT_L(0); N1_BAR; N1_MMA(0, At, B0); N1_BAR; N1_SCHED;
            N1_LDA(At, 0, 1); N1_STAGE(N1_SA(0, 0), a2, voffA); N1_STAGE(N1_SB(0), b2, voffB);
            N1_WAIT_V(6); N1_WAIT_L(0); N1_BAR; N1_MMA(1, At, B0); N1_BAR; N1_SCHED;
            N1_LDB(B0, 1); N1_SCHED; N1_LDA(At, 1, 0); N1_STAGE(N1_SA(0, 1), a2 + hstepA, voffA);
            N1_WAIT_V(6); N1_WAIT_L(0); N1_BAR; N1_MMA(0, At, B0); N1_BAR; N1_SCHED;
            N1_LDA(At, 1, 1); N1_STAGE(N1_SA(1, 0), a3, voffA); N1_STAGE(N1_SB(1), b3, voffB);
            N1_WAIT_V(6); N1_WAIT_L(0); N1_BAR; N1_MMA(1, At, B0); N1_BAR; N1_SCHED;
        }
        if (wr == 0) N1_BAR;
        E(acc, cur, ui, wr, wc, fr, fq);
        if (!has_next) break;
#pragma unroll
        for (int x = 0; x < 2; ++x)
#pragma unroll
            for (int m = 0; m < 4; ++m)
#pragma unroll
                for (int n = 0; n < 2; ++n) acc[x][m][n] = (f32x4){0.f, 0.f, 0.f, 0.f};
        cur = nxt; cA = nA; cB = nB; ++ui;
        if (wr == 1) N1_BAR;
    }
    N1_WAIT_V(0);
    N1_BAR;
#undef N1_SA
#undef N1_SB
#undef N1_STAGE
#undef N1_LDA
#undef N1_LDB
#undef N1_MMA
#undef N1_WAIT_V
#undef N1_WAIT_L
#undef N1_BAR
#undef N1_SCHED
}
}
using pg8::GUnit;
typedef f32x4 AccT[2][2][4][2];
typedef f32x4 AccH[2][4][2];

template <class Sched> __device__ __forceinline__ void prep_rstd(LAS unsigned char* lds, const float* ssp, const Sched& S, bool cols, int tid) {
    LAS float* R = (LAS float*)(lds + RSTD_OFF);
    GUnit u;
    for (int i = 0; i < 8 && S.next(i, u); ++i) {
        if (tid < 256) { const f32x4* p = (const f32x4*)(ssp + (size_t)((cols ? u.col0 : u.row0) + tid) * SSPN); const f32x4 s4 = ((p[0] + p[1]) + (p[2] + p[3])) + ((p[4] + p[5]) + (p[6] + p[7]));
            R[i * 256 + tid] = rsqrtf(((s4[0] + s4[1]) + (s4[2] + s4[3])) * (1.f / 1024.f) + EPS); }
    }
    LDS_WAIT(); __builtin_amdgcn_s_barrier(); asm volatile("" ::: "memory");
}
struct EpiQKV {
    bf16_t* Q; bf16_t* KB; bf16_t* VB; float* nk; float* nv; const float* ropec; const float* ropes; const float* ssp; const float* sw; LAS unsigned char* lds;
    static constexpr bool PERM = false;
    template <class Sched> __device__ __forceinline__ void prepare(const Sched& S, LAS unsigned char* l, int tid) const { prep_rstd(l, ssp, S, false, tid); }
    __device__ __forceinline__ void operator()(const AccT& acc, const GUnit& u, int ui, int wr, int wc, int fr, int fq) const {
        const LAS float* R = (const LAS float*)(lds + RSTD_OFF) + ui * 256;
        const int sec = u.col0 >> 10;
        const bool lat = u.row0 >= NCTX;
        const int cbase = (u.col0 & 1023) + wc * 32 + 4 * fq;
        const float* swc = sw + cond_of_row(u.row0) * 3072 + u.col0 + wc * 32 + 4 * fq;
        f32x4 sv[2][2];
#pragma unroll
        for (int bj = 0; bj < 2; ++bj)
#pragma unroll
            for (int n = 0; n < 2; ++n) sv[bj][n] = *(const f32x4*)(swc + bj * 128 + n * 16);
#pragma unroll
        for (int ai = 0; ai < 2; ++ai)
#pragma unroll
            for (int m = 0; m < 4; ++m) {
                const int rl = ai * 128 + wr * 64 + m * 16 + fr, r = u.row0 + rl;
                const float rs = R[rl];
                int t = 0, kvrow = r; size_t orow = 0;
                if (lat) { const int rr = r - NCTX; t = rr & 1023; kvrow = NCTX + (rr >> 10) * 1536 + 512 + t; }
                else { const int b = r >> 8; orow = ((size_t)(b * 2) * 256 + (r & 255)) * 1024; }
                f32x4 cs = {1.f, 1.f, 1.f, 1.f}, sn = {0.f, 0.f, 0.f, 0.f};
                if (lat && sec < 2) { const int pos = (wc & 1) ? (t & 63) : (t >> 6); cs = *(const f32x4*)(ropec + pos * 16 + 4 * fq); sn = *(const f32x4*)(ropes + pos * 16 + 4 * fq); }
#pragma unroll
                for (int bj = 0; bj < 2; ++bj) {
                    f32x4 x1 = acc[ai][bj][m][0] * rs + sv[bj][0], x2 = acc[ai][bj][m][1] * rs + sv[bj][1];
                    const int c = cbase + bj * 128;
                    if (sec < 2) { const f32x4 y1 = x1 * cs - x2 * sn, y2 = x2 * cs + x1 * sn; x1 = y1; x2 = y2; }
                    u32x4 w; w.x = cvt_pk_bf16(x1[0], x1[1]); w.y = cvt_pk_bf16(x1[2], x1[3]); w.z = cvt_pk_bf16(x2[0], x2[1]); w.w = cvt_pk_bf16(x2[2], x2[3]);
                    const int c8 = c + 4 * fq;
                    if (sec == 0) *(u32x4*)(Q + (size_t)r * 1024 + c8) = w;
                    else {
                        *(u32x4*)((sec == 1 ? KB : VB) + (size_t)kvrow * 1024 + c8) = w;
                        if (!lat) { if (sec == 1) { float* o = nk + orow + c; *(f32x4*)o = x1; *(f32x4*)(o + 16) = x2; }
                                    else { float* o = nv + orow + c8; *(f32x4*)o = x1; *(f32x4*)(o + 4) = x2; } }
                    }
                }
            }
    }
};
struct EpiQKV128 {
    bf16_t* Q; bf16_t* KB; bf16_t* VB; float* nk; float* nv; const float* ropec; const float* ropes; const float* ssp; const float* sw; LAS unsigned char* lds;
    static constexpr bool PERM = false;
    template <class Sched> __device__ __forceinline__ void prepare(const Sched& S, LAS unsigned char* l, int tid) const { prep_rstd(l, ssp, S, false, tid); }
    __device__ __forceinline__ void operator()(const AccH& acc, const GUnit& u, int ui, int wr, int wc, int fr, int fq) const {
        const LAS float* R = (const LAS float*)(lds + RSTD_OFF) + ui * 256;
        const int sec = u.col0 >> 10;
        const bool lat = u.row0 >= NCTX;
        const int c = (u.col0 & 1023) + wc * 32 + 4 * fq;
        const float* swc = sw + cond_of_row(u.row0) * 3072 + u.col0 + wc * 32 + 4 * fq;
        const f32x4 sv0 = *(const f32x4*)swc, sv1 = *(const f32x4*)(swc + 16);
#pragma unroll
        for (int ai = 0; ai < 2; ++ai)
#pragma unroll
            for (int m = 0; m < 4; ++m) {
                const int rl = ai * 128 + wr * 64 + m * 16 + fr, r = u.row0 + rl;
                const float rs = R[rl];
                int t = 0, kvrow = r; size_t orow = 0;
                if (lat) { const int rr = r - NCTX; t = rr & 1023; kvrow = NCTX + (rr >> 10) * 1536 + 512 + t; }
                else { const int b = r >> 8; orow = ((size_t)(b * 2) * 256 + (r & 255)) * 1024; }
                f32x4 cs = {1.f, 1.f, 1.f, 1.f}, sn = {0.f, 0.f, 0.f, 0.f};
                if (lat && sec < 2) { const int pos = (wc & 1) ? (t & 63) : (t >> 6); cs = *(const f32x4*)(ropec + pos * 16 + 4 * fq); sn = *(const f32x4*)(ropes + pos * 16 + 4 * fq); }
                f32x4 x1 = acc[ai][m][0] * rs + sv0, x2 = acc[ai][m][1] * rs + sv1;
                if (sec < 2) { const f32x4 y1 = x1 * cs - x2 * sn, y2 = x2 * cs + x1 * sn; x1 = y1; x2 = y2; }
                u32x4 w; w.x = cvt_pk_bf16(x1[0], x1[1]); w.y = cvt_pk_bf16(x1[2], x1[3]); w.z = cvt_pk_bf16(x2[0], x2[1]); w.w = cvt_pk_bf16(x2[2], x2[3]);
                const int c8 = c + 4 * fq;
                if (sec == 0) *(u32x4*)(Q + (size_t)r * 1024 + c8) = w;
                else {
                    *(u32x4*)((sec == 1 ? KB : VB) + (size_t)kvrow * 1024 + c8) = w;
                    if (!lat) { if (sec == 1) { float* o = nk + orow + c; *(f32x4*)o = x1; *(f32x4*)(o + 16) = x2; }
                                else { float* o = nv + orow + c8; *(f32x4*)o = x1; *(f32x4*)(o + 4) = x2; } }
                }
            }
    }
};
struct EpiResid {
    float* X; const float* gate; const float* an; bf16_t* XA; float* ssp;
    static constexpr bool PERM = true;
    template <class Sched> __device__ __forceinline__ void prepare(const Sched&, LAS unsigned char*, int) const {}
    __device__ __forceinline__ void operator()(const AccT& acc, const GUnit& u, int ui, int wr, int wc, int fr, int fq) const {
        const int cbase = u.col0 + wc * 32 + 8 * fq;
        const int cnd = cond_of_row(u.row0);
        const float* g = gate + cnd * 6144;
        f32x4 gv[2][2];
#pragma unroll
        for (int bj = 0; bj < 2; ++bj)
#pragma unroll
            for (int n = 0; n < 2; ++n) gv[bj][n] = *(const f32x4*)(g + cbase + bj * 128 + n * 4);
        const float* anc = an + cnd * 1024 + cbase;
        const int slot = (u.col0 >> 8) * 4 + wc;
#pragma unroll
        for (int ai = 0; ai < 2; ++ai) {
#pragma unroll
            for (int mp = 0; mp < 2; ++mp) {
            f32x4 xo[2][2][2];
#pragma unroll
            for (int m2 = 0; m2 < 2; ++m2)
#pragma unroll
                for (int bj = 0; bj < 2; ++bj)
#pragma unroll
                    for (int n = 0; n < 2; ++n) xo[m2][bj][n] = *(const f32x4*)(X + (size_t)(u.row0 + ai * 128 + wr * 64 + (mp * 2 + m2) * 16 + fr) * 1024 + cbase + bj * 128 + n * 4);
#pragma unroll
            for (int m2 = 0; m2 < 2; ++m2) {
                const int m = mp * 2 + m2;
                const size_t ro = (size_t)(u.row0 + ai * 128 + wr * 64 + m * 16 + fr);
                float ss = 0.f;
#pragma unroll
                for (int bj = 0; bj < 2; ++bj) {
                    const f32x4 x0 = xo[m2][bj][0] + gv[bj][0] * acc[ai][bj][m][0], x1 = xo[m2][bj][1] + gv[bj][1] * acc[ai][bj][m][1];
                    *(f32x4*)(X + ro * 1024 + cbase + bj * 128) = x0; *(f32x4*)(X + ro * 1024 + cbase + bj * 128 + 4) = x1;
                    ss += ((x0[0] * x0[0] + x0[1] * x0[1]) + (x0[2] * x0[2] + x0[3] * x0[3])) + ((x1[0] * x1[0] + x1[1] * x1[1]) + (x1[2] * x1[2] + x1[3] * x1[3]));
                    if (an) { const f32x4 y0 = x0 * *(const f32x4*)(anc + bj * 128), y1 = x1 * *(const f32x4*)(anc + bj * 128 + 4); u32x4 w; w.x = cvt_pk_bf16(y0[0], y0[1]); w.y = cvt_pk_bf16(y0[2], y0[3]); w.z = cvt_pk_bf16(y1[0], y1[1]); w.w = cvt_pk_bf16(y1[2], y1[3]);
                        *(u32x4*)(XA + ro * 1024 + cbase + bj * 128) = w; }
                }
                ss += __shfl_xor(ss, 16); ss += __shfl_xor(ss, 32);
                if (fq == 0) ssp[ro * SSPN + slot] = ss;
            }
            }
            asm volatile("" ::: "memory");
        }
    }
};
struct EpiResid128 {
    bf16_t* X; const float* gate; const float* an; bf16_t* XA; float* ssp;
    static constexpr bool PERM = true;
    template <class Sched> __device__ __forceinline__ void prepare(const Sched&, LAS unsigned char*, int) const {}
    __device__ __forceinline__ void operator()(const AccH& acc, const GUnit& u, int ui, int wr, int wc, int fr, int fq) const {
        const int cbase = u.col0 + wc * 32 + 8 * fq;
        const int cnd = cond_of_row(u.row0);
        const float* g = gate + cnd * 6144;
        const f32x4 gv0 = *(const f32x4*)(g + cbase), gv1 = *(const f32x4*)(g + cbase + 4);
        f32x4 av0 = {0.f, 0.f, 0.f, 0.f}, av1 = av0;
        if (an) { av0 = *(const f32x4*)(an + cnd * 1024 + cbase); av1 = *(const f32x4*)(an + cnd * 1024 + cbase + 4); }
        const int slot = (u.col0 >> 7) * 4 + wc;
        u32x4 xo[2][4];
#pragma unroll
        for (int ai = 0; ai < 2; ++ai)
#pragma unroll
            for (int m = 0; m < 4; ++m) xo[ai][m] = *(const u32x4*)(X + (size_t)(u.row0 + ai * 128 + wr * 64 + m * 16 + fr) * 1024 + cbase);
#pragma unroll
        for (int ai = 0; ai < 2; ++ai)
#pragma unroll
            for (int m = 0; m < 4; ++m) {
                const size_t ro = (size_t)(u.row0 + ai * 128 + wr * 64 + m * 16 + fr);
                const u32x4 xw = xo[ai][m];
                const f32x4 xa = {bflo(xw.x), bfhi(xw.x), bflo(xw.y), bfhi(xw.y)}, xb = {bflo(xw.z), bfhi(xw.z), bflo(xw.w), bfhi(xw.w)};
                const f32x4 x0 = xa + gv0 * acc[ai][m][0], x1 = xb + gv1 * acc[ai][m][1];
                { u32x4 w; w.x = cvt_pk_bf16(x0[0], x0[1]); w.y = cvt_pk_bf16(x0[2], x0[3]); w.z = cvt_pk_bf16(x1[0], x1[1]); w.w = cvt_pk_bf16(x1[2], x1[3]); *(u32x4*)(X + ro * 1024 + cbase) = w; }
                float ss = ((x0[0] * x0[0] + x0[1] * x0[1]) + (x0[2] * x0[2] + x0[3] * x0[3])) + ((x1[0] * x1[0] + x1[1] * x1[1]) + (x1[2] * x1[2] + x1[3] * x1[3]));
                if (an) { const f32x4 y0 = x0 * av0, y1 = x1 * av1; u32x4 w; w.x = cvt_pk_bf16(y0[0], y0[1]); w.y = cvt_pk_bf16(y0[2], y0[3]); w.z = cvt_pk_bf16(y1[0], y1[1]); w.w = cvt_pk_bf16(y1[2], y1[3]);
                    *(u32x4*)(XA + ro * 1024 + cbase) = w; }
                ss += __shfl_xor(ss, 16); ss += __shfl_xor(ss, 32);
                if (fq == 0) ssp[ro * SSPN + slot] = ss;
            }
    }
};
struct EpiG128 {
    bf16_t* GH; const float* ssp; const float* sw; LAS unsigned char* lds;
    static constexpr bool PERM = true;
    template <class Sched> __device__ __forceinline__ void prepare(const Sched& S, LAS unsigned char* l, int tid) const { prep_rstd(l, ssp, S, false, tid); }
    __device__ __forceinline__ void operator()(const AccH& acc, const GUnit& u, int ui, int wr, int wc, int fr, int fq) const {
        const LAS float* R = (const LAS float*)(lds + RSTD_OFF) + ui * 256;
        const float* swc = sw + cond_of_row(u.row0) * 5120 + u.col0 + wc * 32 + 8 * fq;
        const f32x4 sv0 = *(const f32x4*)swc, sv1 = *(const f32x4*)(swc + 4);
        const int cbase = (u.col0 - 4096) + wc * 32 + 8 * fq;
#pragma unroll
        for (int ai = 0; ai < 2; ++ai)
#pragma unroll
            for (int m = 0; m < 4; ++m) {
                const int rl = ai * 128 + wr * 64 + m * 16 + fr; const float rs = R[rl];
                const f32x4 v0 = acc[ai][m][0] * rs + sv0, v1 = acc[ai][m][1] * rs + sv1;
                u32x4 w; w.x = cvt_pk_bf16(silu_f(v0[0]), silu_f(v0[1])); w.y = cvt_pk_bf16(silu_f(v0[2]), silu_f(v0[3])); w.z = cvt_pk_bf16(silu_f(v1[0]), silu_f(v1[1])); w.w = cvt_pk_bf16(silu_f(v1[2]), silu_f(v1[3]));
                *(u32x4*)(GH + (size_t)(u.row0 + rl) * 1024 + cbase) = w;
            }
    }
};
struct EpiFFN {
    bf16_t* ACT; const float* ssp; const float* sw; LAS unsigned char* lds;
    static constexpr bool PERM = true;
    template <class Sched> __device__ __forceinline__ void prepare(const Sched& S, LAS unsigned char* l, int tid) const { prep_rstd(l, ssp, S, false, tid); }
    __device__ __forceinline__ void operator()(const AccT& acc, const GUnit& u, int ui, int wr, int wc, int fr, int fq) const {
        const LAS float* R = (const LAS float*)(lds + RSTD_OFF) + ui * 256;
        const int abase = (u.col0 >> 1) + wc * 32 + 8 * fq;
        const float* swc = sw + cond_of_row(u.row0) * 5632 + u.col0 + wc * 32 + 8 * fq;
        f32x4 sv[2][2];
#pragma unroll
        for (int bj = 0; bj < 2; ++bj)
#pragma unroll
            for (int n = 0; n < 2; ++n) sv[bj][n] = *(const f32x4*)(swc + bj * 128 + n * 4);
#pragma unroll
        for (int ai = 0; ai < 2; ++ai)
#pragma unroll
            for (int m = 0; m < 4; ++m) {
                const int rl = ai * 128 + wr * 64 + m * 16 + fr;
                const float rs = R[rl];
                u32x4 w;
#pragma unroll
                for (int n = 0; n < 2; ++n) {
                    const f32x4 g = acc[ai][0][m][n] * rs + sv[0][n], up = acc[ai][1][m][n] * rs + sv[1][n];
                    w[2 * n] = cvt_pk_bf16(silu_f(g[0]) * up[0], silu_f(g[1]) * up[1]); w[2 * n + 1] = cvt_pk_bf16(silu_f(g[2]) * up[2], silu_f(g[3]) * up[3]);
                }
                *(u32x4*)(ACT + (size_t)(u.row0 + rl) * DFF + abase) = w;
            }
    }
};
__device__ __forceinline__ void quad_transpose(f32x4& v, int qi) {
#define QT_X1(x) __int_as_float(__builtin_amdgcn_update_dpp(0, __float_as_int(x), 0xB1, 0xF, 0xF, true))
#define QT_X2(x) __int_as_float(__builtin_amdgcn_update_dpp(0, __float_as_int(x), 0x4E, 0xF, 0xF, true))
    const bool o1 = qi & 1, o2 = qi & 2;
    { const float t0 = o1 ? v[0] : v[1], t1 = o1 ? v[2] : v[3]; const float r0 = QT_X1(t0), r1 = QT_X1(t1);
      if (o1) { v[0] = r0; v[2] = r1; } else { v[1] = r0; v[3] = r1; } }
    { const float t0 = o2 ? v[0] : v[2], t1 = o2 ? v[1] : v[3]; const float r0 = QT_X2(t0), r1 = QT_X2(t1);
      if (o2) { v[0] = r0; v[1] = r1; } else { v[2] = r0; v[3] = r1; } }
#undef QT_X1
#undef QT_X2
}
#define DPP_SHR(x, N) __int_as_float(__builtin_amdgcn_update_dpp(0, __float_as_int(x), 0x110 + (N), 0xF, 0xF, true))
#define DPP_SHL(x, N) __int_as_float(__builtin_amdgcn_update_dpp(0, __float_as_int(x), 0x100 + (N), 0xF, 0xF, true))
struct EpiHgrn {
    bf16_t* GH; bf16_t* QTF; bf16_t* KTF; bf16_t* QTB; bf16_t* KTB; bf16_t* KHTF; bf16_t* KHTB; bf16_t* VT; float* DDF; float* DDB; const float* lbv; const float* ssp; const float* sw; LAS unsigned char* lds;
    static constexpr bool PERM = false;
    template <class Sched> __device__ __forceinline__ void prepare(const Sched& S, LAS unsigned char* l, int tid) const { prep_rstd(l, ssp, S, false, tid); }
    __device__ __forceinline__ void operator()(const AccT& acc, const GUnit& u, int ui, int wr, int wc, int fr, int fq) const {
        const LAS float* R = (const LAS float*)(lds + RSTD_OFF) + ui * 256;
        const int t = u.col0 >> 8;
        const float* swc = sw + cond_of_row(u.row0) * 5120 + u.col0 + wc * 32 + 4 * fq;
        f32x4 sv[2][2];
#pragma unroll
        for (int bj = 0; bj < 2; ++bj)
#pragma unroll
            for (int n = 0; n < 2; ++n) sv[bj][n] = *(const f32x4*)(swc + bj * 128 + n * 16);
        if (t >= 16) {
            const int cbase = (u.col0 - 4096) + wc * 32 + 4 * fq;
#pragma unroll
            for (int ai = 0; ai < 2; ++ai)
#pragma unroll
                for (int m = 0; m < 4; ++m) {
                    const int rl = ai * 128 + wr * 64 + m * 16 + fr; const float rs = R[rl];
#pragma unroll
                    for (int bj = 0; bj < 2; ++bj)
#pragma unroll
                        for (int n = 0; n < 2; ++n) { const f32x4 v = acc[ai][bj][m][n] * rs + sv[bj][n];
                            u32x2 w; w.x = cvt_pk_bf16(silu_f(v[0]), silu_f(v[1])); w.y = cvt_pk_bf16(silu_f(v[2]), silu_f(v[3]));
                            *(u32x2*)(GH + (size_t)(u.row0 + rl) * 1024 + cbase + bj * 128 + n * 16) = w; }
                }
            return;
        }
        const int h = t >> 1, kk = (t & 1) * 64 + wc * 16 + 4 * fq, chg = t * 64 + wc * 16 + 4 * fq;
        const f32x4 lb0 = *(const f32x4*)(lbv + chg), lb1 = *(const f32x4*)(lbv + 1024 + chg);
        const int lane = fq * 16 + fr;
#pragma unroll 1
        for (int am = 0; am < 8; ++am) {
            const int ai = am >> 2, m = am & 3;
            f32x4 aq, av, azf, azb;
            switch (am) {
#define HG_CASE(I) case I: aq = acc[(I) >> 2][0][(I) & 3][0]; av = acc[(I) >> 2][0][(I) & 3][1]; azf = acc[(I) >> 2][1][(I) & 3][0]; azb = acc[(I) >> 2][1][(I) & 3][1]; break;
                HG_CASE(0) HG_CASE(1) HG_CASE(2) HG_CASE(3) HG_CASE(4) HG_CASE(5) HG_CASE(6) default: aq = acc[1][0][3][0]; av = acc[1][0][3][1]; azf = acc[1][1][3][0]; azb = acc[1][1][3][1]; break;
#undef HG_CASE
            }
            const int rl = ai * 128 + wr * 64 + m * 16 + fr; const float rs = R[rl];
            const int tok = u.row0 + rl; const size_t cg = (size_t)((tok >> 4) * 8 + h);
            const f32x4 q4 = aq * rs + sv[0][0], v4 = av * rs + sv[0][1], zf = azf * rs + sv[1][0], zb = azb * rs + sv[1][1];
            f32x4 q, kf, kb, bf, bb;
#pragma unroll
            for (int j = 0; j < 4; ++j) { q[j] = silu_f(q4[j]);
                const float ff = lb0[j] + (1.f - lb0[j]) * sigmoid_f(zf[j]), fb = lb1[j] + (1.f - lb1[j]) * sigmoid_f(zb[j]);
                kf[j] = 1.f - ff; kb[j] = 1.f - fb; bf[j] = __logf(ff); bb[j] = __logf(fb); }
#pragma unroll
            for (int j = 0; j < 4; ++j) {
                float x = bf[j]; x += DPP_SHR(x, 1); x += DPP_SHR(x, 2); x += DPP_SHR(x, 4); x += DPP_SHR(x, 8); bf[j] = x;
                float y = bb[j]; y += DPP_SHL(y, 1); y += DPP_SHL(y, 2); y += DPP_SHL(y, 4); y += DPP_SHL(y, 8); bb[j] = y; }
            f32x4 qtf, ktf, khf, ddf, qtb, ktb, khb, ddb;
#pragma unroll
            for (int j = 0; j < 4; ++j) {
                const float ef = __expf(bf[j]), eif = __expf(-bf[j]), eb = __expf(bb[j]), eib = __expf(-bb[j]);
                ddf[j] = __shfl(ef, lane | 15); ddb[j] = __shfl(eb, lane & ~15);
                qtf[j] = q[j] * ef; ktf[j] = kf[j] * eif; khf[j] = ktf[j] * ddf[j];
                qtb[j] = q[j] * eb; ktb[j] = kb[j] * eib; khb[j] = ktb[j] * ddb[j]; }
            const size_t ro = (size_t)tok * 1024 + h * 128 + kk;
            { u32x2 w; w.x = cvt_pk_bf16(qtf[0], qtf[1]); w.y = cvt_pk_bf16(qtf[2], qtf[3]); *(u32x2*)(QTF + ro) = w; }
            { u32x2 w; w.x = cvt_pk_bf16(ktf[0], ktf[1]); w.y = cvt_pk_bf16(ktf[2], ktf[3]); *(u32x2*)(KTF + ro) = w; }
            { u32x2 w; w.x = cvt_pk_bf16(qtb[0], qtb[1]); w.y = cvt_pk_bf16(qtb[2], qtb[3]); *(u32x2*)(QTB + ro) = w; }
            { u32x2 w; w.x = cvt_pk_bf16(ktb[0], ktb[1]); w.y = cvt_pk_bf16(ktb[2], ktb[3]); *(u32x2*)(KTB + ro) = w; }
            f32x4 vt = v4;
            quad_transpose(khf, fr & 3); quad_transpose(khb, fr & 3); quad_transpose(vt, fr & 3);
            const size_t to = (cg * 128 + kk + (fr & 3)) * 16 + (fr & ~3);
            { u32x2 w; w.x = cvt_pk_bf16(khf[0], khf[1]); w.y = cvt_pk_bf16(khf[2], khf[3]); *(u32x2*)(KHTF + to) = w; }
            { u32x2 w; w.x = cvt_pk_bf16(khb[0], khb[1]); w.y = cvt_pk_bf16(khb[2], khb[3]); *(u32x2*)(KHTB + to) = w; }
            { u32x2 w; w.x = cvt_pk_bf16(vt[0], vt[1]); w.y = cvt_pk_bf16(vt[2], vt[3]); *(u32x2*)(VT + to) = w; }
            if (fr == 15) *(f32x4*)(DDF + cg * 128 + kk) = ddf;
            if (fr == 0) *(f32x4*)(DDB + cg * 128 + kk) = ddb;
        }
    }
};
struct EpiFour1 {
    bf16_t* ZT; const float* ssp; const float* sw; LAS unsigned char* lds;
    static constexpr bool PERM = true;
    template <class Sched> __device__ __forceinline__ void prepare(const Sched& S, LAS unsigned char* l, int tid) const { prep_rstd(l, ssp, S, true, tid); }
    __device__ __forceinline__ void operator()(const AccT& acc, const GUnit& u, int ui, int wr, int wc, int fr, int fq) const {
        const LAS float* R = (const LAS float*)(lds + RSTD_OFF) + ui * 256;
        const int cs = u.row0 >> 10;
        const float* swc = sw + cond_of_row(u.col0) * 2048 + u.row0 + wr * 64 + fr;
#pragma unroll
        for (int bj = 0; bj < 2; ++bj) {
            const int tl = bj * 128 + wc * 32 + 8 * fq, tok = u.col0 + tl;
            const f32x4 rs0 = *(const LAS f32x4*)(R + tl), rs1 = *(const LAS f32x4*)(R + tl + 4);
            int off;
            if (tok < NCTX) off = (tok >> 8) * 512 + cs * 256 + (tok & 255);
            else { const int tt = tok - NCTX; off = 8192 + (tt >> 10) * 2048 + cs * 1024 + (tt & 1023); }
#pragma unroll
            for (int ai = 0; ai < 2; ++ai)
#pragma unroll
                for (int m = 0; m < 4; ++m) {
                    const int nrow = (u.row0 & 1023) + ai * 128 + wr * 64 + m * 16 + fr;
                    const float sh = swc[ai * 128 + m * 16];
                    const f32x4 v0 = acc[ai][bj][m][0] * rs0 + sh, v1 = acc[ai][bj][m][1] * rs1 + sh;
                    u32x4 w; w.x = cvt_pk_bf16(v0[0], v0[1]); w.y = cvt_pk_bf16(v0[2], v0[3]); w.z = cvt_pk_bf16(v1[0], v1[1]); w.w = cvt_pk_bf16(v1[2], v1[3]);
                    *(u32x4*)(ZT + (size_t)nrow * 16384 + off) = w;
                }
        }
    }
};
struct EpiBf16 {
    bf16_t* O; int ldc;
    static constexpr bool PERM = false;
    template <class Sched> __device__ __forceinline__ void prepare(const Sched&, LAS unsigned char*, int) const {}
    __device__ __forceinline__ void operator()(const AccT& acc, const GUnit& u, int ui, int wr, int wc, int fr, int fq) const {
        bf16_t* base = O + (size_t)u.aux;
        const int cbase = u.col0 + wc * 32 + 4 * fq;
#pragma unroll
        for (int ai = 0; ai < 2; ++ai)
#pragma unroll
            for (int m = 0; m < 4; ++m) {
                bf16_t* pr = base + (size_t)(u.row0 + ai * 128 + wr * 64 + m * 16 + fr) * ldc + cbase;
#pragma unroll
                for (int bj = 0; bj < 2; ++bj)
#pragma unroll
                    for (int n = 0; n < 2; ++n) { const f32x4 v = acc[ai][bj][m][n]; u32x2 w; w.x = cvt_pk_bf16(v[0], v[1]); w.y = cvt_pk_bf16(v[2], v[3]); *(u32x2*)(pr + bj * 128 + n * 16) = w; }
            }
    }
};
struct GenSched {
    const char* A; const char* A2; const char* B; int lda, ldb, nM, nN, nwg, G, c, nt, mode;
    __device__ __forceinline__ void init(int mode_, const void* A_, const void* A2_, int lda_, const void* B_, int ldb_, int M, int N, int K, int G_, int c_) {
        mode = mode_; A = (const char*)A_; A2 = (const char*)A2_; B = (const char*)B_; lda = lda_; ldb = ldb_; nM = M / 256; nN = N / 256; nwg = (mode_ == 0 || mode_ == 7 || mode_ == 8) ? nM * nN : mode_ == 1 ? 128 : mode_ == 2 ? 32 : mode_ == 5 ? 512 : 256; G = G_; c = c_; nt = K / 64; }
    __device__ __forceinline__ bool next(int i, GUnit& u) const {
        const int L = i * G + c; if (L >= nwg) return false;
        u.aux = 0;
        if (mode == 0 || mode == 7 || mode == 8) {
            if (mode == 7 && i > 0) return false;
            int half = 0; int wgid = L; if (mode == 8) { if (i > 0) return false; half = L & 1; wgid = 256 + (L >> 1); if (wgid >= nM * nN) return false; } { const int q = nwg / 8, r = nwg % 8, xcd = wgid % 8, off = wgid / 8; wgid = (xcd < r ? xcd * (q + 1) : r * (q + 1) + (xcd - r) * q) + off; }
            const int nig = 8 * nN, gid = wgid / nig, fm = gid * 8, gsz = (nM - fm) < 8 ? (nM - fm) : 8;
            const int pm = fm + ((wgid % nig) % gsz), pn = (wgid % nig) / gsz;
            u.A = A + (size_t)pm * 256 * lda * 2; u.B = B + (size_t)(pn * 256 + half * 128) * ldb * 2; u.nt = nt; u.row0 = pm * 256; u.col0 = pn * 256 + half * 128;
        } else if (mode == 1) {
            if (L < 64) { const int b = L >> 4, pm = (L >> 2) & 3, pn = L & 3;
                u.A = A + (size_t)pm * 256 * 2048 * 2; u.B = B + ((size_t)pn * 256 * 16384 + 8192 + b * 2048) * 2; u.nt = 32; u.row0 = NCTX + b * 1024 + pm * 256; u.col0 = pn * 256; }
            else { const int l = L - 64, b = l >> 2, pn = l & 3;
                u.A = A2; u.B = B + ((size_t)pn * 256 * 16384 + b * 512) * 2; u.nt = 8; u.row0 = b * 256; u.col0 = pn * 256; }
        } else if (mode == 5) {
            int wgid = L; { const int xcd = wgid % 8, off = wgid / 8; wgid = xcd * 64 + off; }
            const int gid = wgid >> 7, r = wgid & 127, pm = gid * 8 + (r & 7), pn = r >> 3;
            u.A = A + (size_t)pm * 256 * lda * 2; u.B = B + (size_t)pn * 256 * ldb * 2; u.nt = nt; u.row0 = pm * 256; u.col0 = pn * 256;
        } else if (mode == 6) {
            const int wgid = (L & 7) * 32 + (L >> 3), pm = wgid >> 3, pn = wgid & 7;
            u.A = A + (size_t)pm * 256 * lda * 2; u.B = B + (size_t)(4096 + pn * 128) * ldb * 2; u.nt = nt; u.row0 = pm * 256; u.col0 = 4096 + pn * 128;
        } else if (mode == 3) {
            const int wgid = (L & 7) * 32 + (L >> 3), pm = wgid >> 3, pn = wgid & 7;
            u.A = A + (size_t)pm * 256 * lda * 2; u.B = B + (size_t)pn * 128 * ldb * 2; u.nt = nt; u.row0 = pm * 256; u.col0 = pn * 128;
        } else if (mode == 4) {
            if (L < 128) { const int b = L >> 5, pm = (L >> 3) & 3, pn = L & 7;
                u.A = A + (size_t)pm * 256 * 2048 * 2; u.B = B + ((size_t)pn * 128 * 16384 + 8192 + b * 2048) * 2; u.nt = 32; u.row0 = NCTX + b * 1024 + pm * 256; u.col0 = pn * 128; }
            else { const int l = L - 128, b = l >> 3, pn = l & 7;
                u.A = A2; u.B = B + ((size_t)pn * 128 * 16384 + b * 512) * 2; u.nt = 8; u.row0 = b * 256; u.col0 = pn * 128; }
        } else {
            const int g = L >> 3, cs = (L >> 2) & 1, pm = L & 3;
            u.A = A + ((size_t)pm * 256 * 1024 + g * 256) * 2; u.B = B + (size_t)cs * 256 * 2; u.nt = nt;
            u.row0 = pm * 256; u.col0 = 0; u.aux = cs * 1024 * 1024 + g * 256;
        }
        return true;
    }
};
struct Args {
    const float* in[23];
    float* out; unsigned char* ws;
    int ph_lo, ph_hi; float lam_init0, lam_init1; int pad0, pad1;
};
typedef const __attribute__((address_space(4))) Args* ArgP;
enum { I_XP = 0, I_XS, I_CK, I_CV, I_ST, I_C, I_CCTX, I_WADA, I_BADA, I_GMIX, I_GFFN, I_WQKV, I_LAM, I_GSUB, I_WOA, I_WINR, I_LBL, I_GOUT, I_WOR, I_WFOUR, I_WFI, I_WFO, I_GFIN };

template <class RowMap>
__device__ __forceinline__ void transpose_item(const float* W, int K, int N, bf16_t* WT, const RowMap& rowmap, LAS float* scr, int item, int lane) {
    const int nblk = N / 32, kb = item / nblk, nb = item % nblk, k0 = 64 * kb, n0 = 32 * nb;
#pragma unroll
    for (int i = 0; i < 8; ++i) { const int kk = 8 * i + (lane >> 3), c4 = (lane & 7) * 4; const f32x4 v = __builtin_nontemporal_load((const f32x4*)(W + (size_t)(k0 + kk) * N + n0 + c4));
        LAS float* d = scr + kk * 33 + c4; d[0] = v[0]; d[1] = v[1]; d[2] = v[2]; d[3] = v[3]; }
    LDS_WAIT(); asm volatile("" ::: "memory");
    const int c = lane & 7;
#pragma unroll
    for (int j = 0; j < 4; ++j) { const int n = (lane >> 3) + 8 * j; const LAS float* s = scr + (8 * c) * 33 + n;
        u32x4 o; o.x = cvt_pk_bf16(s[0 * 33], s[1 * 33]); o.y = cvt_pk_bf16(s[2 * 33], s[3 * 33]); o.z = cvt_pk_bf16(s[4 * 33], s[5 * 33]); o.w = cvt_pk_bf16(s[6 * 33], s[7 * 33]);
        *(u32x4*)(WT + (size_t)rowmap(n0 + n) * K + k0 + 8 * c) = o; }
    LDS_WAIT(); asm volatile("" ::: "memory");
}
struct RowHin { __device__ __forceinline__ int operator()(int s) const { const int sec = s >> 10, ch = s & 1023; if (sec == 2) return 4096 + ch;
    const int t = ch >> 6, cl = ch & 63, bj = sec >= 3 ? 1 : 0, n = (sec == 1 || sec == 4) ? 1 : 0; return 256 * t + 128 * bj + 32 * (cl >> 4) + 16 * n + (cl & 15); } };
struct RowQKV { __device__ __forceinline__ int operator()(int s) const { if (s < 2048) return s; const int p = s & 31; return (s & ~31) + 16 * ((p >> 2) & 1) + 4 * (p >> 3) + (p & 3); } };
struct RowId { __device__ __forceinline__ int operator()(int n) const { return n; } };
struct RowFFN { __device__ __forceinline__ int operator()(int s) const { const int n = s >= DFF ? 1 : 0, a = s - n * DFF; return 256 * (a >> 7) + 128 * n + (a & 127); } };

__device__ __forceinline__ void cache_convert(ArgP a, int j, int gw, int ngw, int lane) {
    bf16_t* KB = (bf16_t*)(a->ws + WS_KB); bf16_t* VB = (bf16_t*)(a->ws + WS_VB);
    for (int it = gw; it < 2 * 4 * 512; it += ngw) {
        const int kv = it >> 11, r = it & 2047, b = r >> 9, s = r & 511;
        const float* src = a->in[kv ? I_CV : I_CK] + ((size_t)(b * 2 + j) * 512 + s) * 1024;
        bf16_t* dst = (kv ? VB : KB) + (size_t)(NCTX + b * 1536 + s) * 1024;
#pragma unroll
        for (int q = 0; q < 2; ++q) { const f32x8 v = *(const f32x8*)(src + q * 512 + lane * 8);
            u32x4 w; w.x = cvt_pk_bf16(v[0], v[1]); w.y = cvt_pk_bf16(v[2], v[3]); w.z = cvt_pk_bf16(v[4], v[5]); w.w = cvt_pk_bf16(v[6], v[7]);
            if (kv) *(u32x4*)(dst + q * 512 + lane * 8) = w;
            else { const int d0 = q * 512 + lane * 8, p0 = d0 & 31, n = p0 >> 4, f0 = (p0 & 15) >> 2;
                bf16_t* g = dst + (d0 & ~31);
                u32x2 lo, hi; lo.x = w.x; lo.y = w.y; hi.x = w.z; hi.y = w.w;
                *(u32x2*)(g + 8 * f0 + 4 * n) = lo; *(u32x2*)(g + 8 * (f0 + 1) + 4 * n) = hi; } }
    }
}

__device__ __forceinline__ void phase_prologue(ArgP a, LAS unsigned char* lds, int G, int bid) {
    const int tid = tid_opaque(), lane = tid & 63, wave = __builtin_amdgcn_readfirstlane(tid >> 6);
    const int gw = bid * NWAVES + wave, ngw = G * NWAVES, gt = bid * NTHREADS + tid, ngt = G * NTHREADS;
    {
        LAS float* SC = (LAS float*)lds;
        LAS float* RED = (LAS float*)(lds + 20480);
        for (int i = tid; i < 5 * 1024; i += NTHREADS) { const int cnd = i >> 10, k = i & 1023; const float x = cnd == 0 ? a->in[I_CCTX][k] : a->in[I_C][(cnd - 1) * 1024 + k]; SC[i] = silu_f(x); }
        __syncthreads();
        float* mod = (float*)(a->ws + WS_MOD);
        for (int it = bid; it < 4 * 48; it += G) {
            const int l = it / 48, cg = it % 48;
            const float* w = a->in[I_WADA] + (size_t)l * 1024 * 6144 + (size_t)(wave * 128) * 6144 + cg * 128 + lane * 2;
            float acc[5][2];
#pragma unroll
            for (int c = 0; c < 5; ++c) { acc[c][0] = 0.f; acc[c][1] = 0.f; }
            for (int k0 = 0; k0 < 128; k0 += 8) {
                f32x2 wv[8];
#pragma unroll
                for (int kk = 0; kk < 8; ++kk) wv[kk] = *(const f32x2*)(w + (size_t)(k0 + kk) * 6144);
#pragma unroll
                for (int kk = 0; kk < 8; ++kk)
#pragma unroll
                    for (int c = 0; c < 5; ++c) { const float s = SC[c * 1024 + wave * 128 + k0 + kk]; acc[c][0] += s * wv[kk].x; acc[c][1] += s * wv[kk].y; }
            }
#pragma unroll
            for (int c = 0; c < 5; ++c) { RED[(wave * 5 + c) * 128 + lane * 2] = acc[c][0]; RED[(wave * 5 + c) * 128 + lane * 2 + 1] = acc[c][1]; }
            __syncthreads();
            for (int i = tid; i < 5 * 128; i += NTHREADS) { const int c = i >> 7, col = i & 127; float s = 0.f;
#pragma unroll
                for (int wv2 = 0; wv2 < 8; ++wv2) s += RED[(wv2 * 5 + c) * 128 + col];
                mod[(size_t)(l * 5 + c) * 6144 + cg * 128 + col] = s + a->in[I_BADA][l * 6144 + cg * 128 + col]; }
            __syncthreads();
        }
    }
    {
        LAS float* scr = (LAS float*)(lds + wave * 16384);
        constexpr int I_Q = 16 * 96, I_O = 16 * 32, I_R = 16 * 160, I_FI = 16 * 176, I_FO = 44 * 32;
        constexpr int NIT = 2 * I_Q + 2 * I_O + I_R + I_O + I_O + 4 * I_FI + 4 * I_FO;
        for (int it = gw; it < NIT; it += ngw) {
            int r = it;
            if (r < 2 * I_Q) { const int j = r / I_Q; transpose_item(a->in[I_WQKV] + (size_t)j * 1024 * 3072, 1024, 3072, (bf16_t*)(a->ws + WS_WQKV) + (size_t)j * 3072 * 1024, RowQKV(), scr, r % I_Q, lane); continue; } r -= 2 * I_Q;
            if (r < 2 * I_O) { const int j = r / I_O; transpose_item(a->in[I_WOA] + (size_t)j * 1024 * 1024, 1024, 1024, (bf16_t*)(a->ws + WS_WOA) + (size_t)j * 1024 * 1024, RowId(), scr, r % I_O, lane); continue; } r -= 2 * I_O;
            if (r < I_R) { transpose_item(a->in[I_WINR], 1024, 5120, (bf16_t*)(a->ws + WS_WINR), RowHin(), scr, r, lane); continue; } r -= I_R;
            if (r < I_O) { transpose_item(a->in[I_WOR], 1024, 1024, (bf16_t*)(a->ws + WS_WOR), RowId(), scr, r, lane); continue; } r -= I_O;
            if (r < I_O) { transpose_item(a->in[I_WFOUR], 1024, 1024, (bf16_t*)(a->ws + WS_WFO), RowId(), scr, r, lane); continue; } r -= I_O;
            if (r < 4 * I_FI) { const int l = r / I_FI; transpose_item(a->in[I_WFI] + (size_t)l * 1024 * 5632, 1024, 5632, (bf16_t*)(a->ws + WS_WFI) + (size_t)l * 5632 * 1024, RowFFN(), scr, r % I_FI, lane); continue; } r -= 4 * I_FI;
            { const int l = r / I_FO; transpose_item(a->in[I_WFO] + (size_t)l * DFF * 1024, DFF, 1024, (bf16_t*)(a->ws + WS_WFOUT) + (size_t)l * 1024 * DFF, RowId(), scr, r % I_FO, lane); }
        }
    }
    {
        float* ropec = (float*)(a->ws + WS_ROPE); float* ropes = ropec + 1024;
        for (int i = gt; i < 1024; i += ngt) { const int pos = i >> 4, q = i & 15;
            float inv = (q & 3) == 0 ? 1.f : (q & 3) == 1 ? 0.56234132519f : (q & 3) == 2 ? 0.31622776602f : 0.17782794100f;
            inv *= (q >> 2) == 0 ? 1.f : (q >> 2) == 1 ? 0.1f : (q >> 2) == 2 ? 0.01f : 0.001f;
            const float ap = (float)pos * inv * 0.31830988618f;
            ropec[i] = cospif(ap); ropes[i] = sinpif(ap); }
        bf16_t* TC = (bf16_t*)(a->ws + WS_TC);
        for (int i = gt; i < 256 * 512; i += ngt) { const int c = i >> 9, k = i & 511, d = k & 255; const float ang = (float)((c * d) & 255) * (1.f / 128.f);
            const float v = (k < 256 ? cospif(ang) : sinpif(ang)) * 0.0625f; TC[c * 1024 + k] = (bf16_t)(cvt_pk_bf16(v, 0.f) & 0xffff); }
        bf16_t* C2 = (bf16_t*)(a->ws + WS_CS256);
        for (int i = gt; i < 256 * 512; i += ngt) { const int p = i >> 9, k = i & 511, t = k & 255; const float ang = (float)((p * t) & 255) * (1.f / 128.f);
            const float v = (k < 256 ? cospif(ang) : -sinpif(ang)) * 0.0625f; C2[p * 2048 + k] = (bf16_t)(cvt_pk_bf16(v, 0.f) & 0xffff); }
        bf16_t* C1 = (bf16_t*)(a->ws + WS_CS1024);
        for (int i = gt; i < 1024 * 2048; i += ngt) { const int p = i >> 11, k = i & 2047, t = k & 1023; const float ang = (float)((p * t) & 1023) * (1.f / 512.f);
            const float v = (k < 1024 ? cospif(ang) : -sinpif(ang)) * 0.03125f; C1[i] = (bf16_t)(cvt_pk_bf16(v, 0.f) & 0xffff); }
        float* lbv = (float*)(a->ws + WS_LBV);
        for (int i = gt; i < 2048; i += ngt) { const int d = i >> 10, k = i & 1023; const float* lg = a->in[I_LBL] + (size_t)d * 4096 + k;
            const float l0 = lg[0], l1 = lg[1024], l2 = lg[2048], l3 = lg[3072]; const float mx = fmaxf(fmaxf(l0, l1), fmaxf(l2, l3));
            const float e0 = __expf(l0 - mx), e1 = __expf(l1 - mx), e2 = __expf(l2 - mx), e3 = __expf(l3 - mx); lbv[i] = e1 / (e0 + e1 + e2 + e3); }
        if (gw < 2) { const int j = gw; const float* lp = a->in[I_LAM] + j * 256;
            float s1 = wave_sum(lp[lane] * lp[64 + lane]), s2 = wave_sum(lp[128 + lane] * lp[192 + lane]);
            if (lane == 0) ((float*)(a->ws + WS_LAM))[j] = __expf(s1) - __expf(s2) + (j == 0 ? a->lam_init0 : a->lam_init1); }
    }
    cache_convert(a, 0, gw, ngw, lane);
}

__device__ __forceinline__ void phase_first_norm(ArgP a, int gw, int ngw, int lane) {
    bf16_t* X = (bf16_t*)(a->ws + WS_X); bf16_t* XA = (bf16_t*)(a->ws + WS_H); float* ssp = (float*)(a->ws + WS_SSP);
    const float* an = (const float*)(a->ws + WS_AN);
    for (int r = gw; r < MTOK; r += ngw) {
        const float* xr = r < NCTX ? a->in[I_XP] + (size_t)r * 1024 : a->in[I_XS] + (size_t)(r - NCTX) * 1024;
        const float* ac = an + cond_of_row(r) * 1024;
        float s = 0.f;
#pragma unroll
        for (int j = 0; j < 4; ++j) {
            const int c = j * 256 + lane * 4;
            const f32x4 v = *(const f32x4*)(xr + c); s += (v.x * v.x + v.y * v.y) + (v.z * v.z + v.w * v.w);
            const f32x4 y = v * *(const f32x4*)(ac + c);
            u32x2 w; w.x = cvt_pk_bf16(y[0], y[1]); w.y = cvt_pk_bf16(y[2], y[3]);
            *(u32x2*)(XA + (size_t)r * 1024 + c) = w; { u32x2 xw; xw.x = cvt_pk_bf16(v[0], v[1]); xw.y = cvt_pk_bf16(v[2], v[3]); *(u32x2*)(X + (size_t)r * 1024 + c) = xw; }
        }
        s = wave_sum(s);
        if (lane < SSPN) ssp[(size_t)r * SSPN + lane] = lane == 0 ? s : 0.f;
    }
}
__device__ __forceinline__ void phase_final(ArgP a, int gw, int ngw, int lane) {
    const bf16_t* X = (const bf16_t*)(a->ws + WS_X); const float* g = a->in[I_GFIN]; const float* ssp = (const float*)(a->ws + WS_SSP) + 8ull * 8192 * SSPN;
    for (int r = gw; r < MTOK; r += ngw) {
        const bf16_t* xr = X + (size_t)r * 1024;
        float s = lane < SSPN ? ssp[(size_t)r * SSPN + lane] : 0.f;
        const float rstd = rsqrtf(wave_sum(s) * (1.f / 1024.f) + EPS);
#pragma unroll
        for (int j = 0; j < 4; ++j) { const int c = j * 256 + lane * 4; const u32x2 xw = *(const u32x2*)(xr + c); const f32x4 xv = {bflo(xw.x), bfhi(xw.x), bflo(xw.y), bfhi(xw.y)};
            *(f32x4*)(a->out + (size_t)r * 1024 + c) = xv * rstd * *(const f32x4*)(g + c); }
    }
}
__device__ __forceinline__ void phase_an(ArgP a, int gt, int ngt) {
    float* an = (float*)(a->ws + WS_AN); const float* mod = (const float*)(a->ws + WS_MOD);
    for (int i = gt; i < 8 * 5 * 1024; i += ngt) { const int nidx = i / 5120, c = (i / 1024) % 5, k = i & 1023, l = nidx >> 1, wh = nidx & 1;
        an[i] = a->in[wh ? I_GFFN : I_GMIX][l * 1024 + k] * (1.f + mod[(size_t)(l * 5 + c) * 6144 + (wh ? 4 : 1) * 1024 + k]); }
}
__device__ __forceinline__ void phase_sw(ArgP a, LAS unsigned char* lds, unsigned mask, int gw, int ngw, int tid, int lane) {
    LAS float* SH = (LAS float*)lds;
    const float* mod = (const float*)(a->ws + WS_MOD); float* swb = (float*)(a->ws + WS_SW);
    for (int nidx = 0; nidx < 8; ++nidx) {
        if (!((mask >> nidx) & 1)) continue;
        const int l = nidx >> 1, wh = nidx & 1, N = sw_n(nidx);
        const bf16_t* W = nidx == 0 ? (const bf16_t*)(a->ws + WS_WQKV) : nidx == 6 ? (const bf16_t*)(a->ws + WS_WQKV) + 3072ull * 1024 : nidx == 2 ? (const bf16_t*)(a->ws + WS_WINR)
                        : nidx == 4 ? (const bf16_t*)(a->ws + WS_WCS) : (const bf16_t*)(a->ws + WS_WFI) + (size_t)l * 5632 * 1024;
        __syncthreads();
        for (int i = tid; i < 5 * 1024; i += NTHREADS) SH[i] = mod[(size_t)(l * 5 + (i >> 10)) * 6144 + (wh ? 3 : 0) * 1024 + (i & 1023)];
        __syncthreads();
        float* sw = swb + sw_off(nidx);
        for (int n = gw; n < N; n += ngw) {
            const u32x4 w0 = *(const u32x4*)(W + (size_t)n * 1024 + lane * 8), w1 = *(const u32x4*)(W + (size_t)n * 1024 + 512 + lane * 8);
            float wf[16];
#pragma unroll
            for (int i = 0; i < 4; ++i) { wf[2 * i] = bflo(w0[i]); wf[2 * i + 1] = bfhi(w0[i]); wf[8 + 2 * i] = bflo(w1[i]); wf[8 + 2 * i + 1] = bfhi(w1[i]); }
            float acc[5];
#pragma unroll
            for (int c = 0; c < 5; ++c) {
                const f32x4 s0 = *(const LAS f32x4*)(SH + c * 1024 + lane * 8), s1 = *(const LAS f32x4*)(SH + c * 1024 + lane * 8 + 4);
                const f32x4 s2 = *(const LAS f32x4*)(SH + c * 1024 + 512 + lane * 8), s3 = *(const LAS f32x4*)(SH + c * 1024 + 512 + lane * 8 + 4);
                float t = 0.f;
#pragma unroll
                for (int i = 0; i < 4; ++i) t += wf[i] * s0[i] + wf[4 + i] * s1[i] + wf[8 + i] * s2[i] + wf[12 + i] * s3[i];
                acc[c] = wave_sum(t);
            }
            if (lane < 5) sw[(size_t)lane * N + n] = lane == 0 ? acc[0] : lane == 1 ? acc[1] : lane == 2 ? acc[2] : lane == 3 ? acc[3] : acc[4];
        }
    }
    __syncthreads();
}
__device__ __forceinline__ void phase_hgrn_final(ArgP a, int gw, int ngw, int lane) {
    const bf16_t* OF = (const bf16_t*)(a->ws + WS_OF); const bf16_t* OB = (const bf16_t*)(a->ws + WS_OB); const bf16_t* GH = (const bf16_t*)(a->ws + WS_GH);
    bf16_t* O = (bf16_t*)(a->ws + WS_O); const float* go = a->in[I_GOUT];
    for (int r = gw; r < MTOK; r += ngw) {
        const size_t off = (size_t)r * 1024 + lane * 16;
        u32x4 f0 = *(const u32x4*)(OF + off), f1 = *(const u32x4*)(OF + off + 8), b0 = *(const u32x4*)(OB + off), b1 = *(const u32x4*)(OB + off + 8);
        u32x4 g0 = *(const u32x4*)(GH + off), g1 = *(const u32x4*)(GH + off + 8);
        float o[16], gt[16];
#pragma unroll
        for (int i = 0; i < 4; ++i) { o[2 * i] = bflo(f0[i]) + bflo(b0[i]); o[2 * i + 1] = bfhi(f0[i]) + bfhi(b0[i]); o[8 + 2 * i] = bflo(f1[i]) + bflo(b1[i]); o[8 + 2 * i + 1] = bfhi(f1[i]) + bfhi(b1[i]);
            gt[2 * i] = bflo(g0[i]); gt[2 * i + 1] = bfhi(g0[i]); gt[8 + 2 * i] = bflo(g1[i]); gt[8 + 2 * i + 1] = bfhi(g1[i]); }
        float s = 0.f;
#pragma unroll
        for (int i = 0; i < 16; ++i) s += o[i] * o[i];
        s += __shfl_xor(s, 1); s += __shfl_xor(s, 2); s += __shfl_xor(s, 4);
        const float rstd = rsqrtf(s * (1.f / 128.f) + EPS);
        const int vc = (lane & 7) * 16;
        u32x4 w0, w1;
#pragma unroll
        for (int i = 0; i < 4; ++i) {
            w0[i] = cvt_pk_bf16(o[2 * i] * rstd * go[vc + 2 * i] * gt[2 * i], o[2 * i + 1] * rstd * go[vc + 2 * i + 1] * gt[2 * i + 1]);
            w1[i] = cvt_pk_bf16(o[8 + 2 * i] * rstd * go[vc + 8 + 2 * i] * gt[8 + 2 * i], o[8 + 2 * i + 1] * rstd * go[vc + 8 + 2 * i + 1] * gt[8 + 2 * i + 1]); }
        *(u32x4*)(O + off) = w0; *(u32x4*)(O + off + 8) = w1;
    }
}

namespace att {
constexpr int KVBLK = 64, LDQ = 1024;
constexpr float SCALE = 0.125f, THR = 8.f;
constexpr size_t SHM_V = KVBLK * 128 * 2, SHM_K = KVBLK * 128 * 2;
#define KSWZ(row, colB) ((row) * 256 + ((colB) ^ (((row) & 7) << 4)))
#define SBAR() __builtin_amdgcn_sched_barrier(0)
__device__ __forceinline__ int crow(int r, int hi) { return (r & 3) + 8 * (r >> 2) + 4 * hi; }
__device__ __forceinline__ unsigned cvtpk(float lo, float hi) { unsigned r; asm volatile("v_cvt_pk_bf16_f32 %0, %1, %2" : "=v"(r) : "v"(lo), "v"(hi)); return r; }
__device__ __forceinline__ void partialSM(f32x16& p0, f32x16& p1, float& m_reg, float& mn, float& alpha) {
  constexpr float C = SCALE * 1.4426950408889634f;
  float pmax = p0[0];
#pragma unroll
  for (int r = 1; r < 16; ++r) pmax = fmaxf(pmax, p0[r]);
#pragma unroll
  for (int r = 0; r < 16; ++r) pmax = fmaxf(pmax, p1[r]);
  { auto rr = __builtin_amdgcn_permlane32_swap(__float_as_uint(pmax), __float_as_uint(pmax), false, false);
    pmax = fmaxf(__uint_as_float(rr[0]), __uint_as_float(rr[1])); }
  if (__builtin_expect(__all(pmax - m_reg <= THR / SCALE), 1)) { mn = m_reg; alpha = 1.f; }
  else { mn = fmaxf(m_reg, pmax); alpha = __builtin_amdgcn_exp2f((m_reg - mn) * C); m_reg = mn; }
  float mnC = -mn * C;
#pragma unroll
  for (int r = 0; r < 16; ++r) p0[r] = fmaf(p0[r], C, mnC);
#pragma unroll
  for (int r = 0; r < 16; ++r) p1[r] = fmaf(p1[r], C, mnC);
#pragma unroll
  for (int r = 0; r < 16; ++r) p0[r] = __builtin_amdgcn_exp2f(p0[r]);
}
__device__ __forceinline__ void finishSM(f32x16& p0, f32x16& p1, float alpha, float& l_reg, bf16x8& pa0, bf16x8& pa1, bf16x8& pa2, bf16x8& pa3) {
#pragma unroll
  for (int r = 0; r < 16; ++r) p1[r] = __builtin_amdgcn_exp2f(p1[r]);
  float ps = 0;
#pragma unroll
  for (int r = 0; r < 16; ++r) ps += p0[r];
#pragma unroll
  for (int r = 0; r < 16; ++r) ps += p1[r];
  { auto rr = __builtin_amdgcn_permlane32_swap(__float_as_uint(ps), __float_as_uint(ps), false, false);
    ps = __uint_as_float(rr[0]) + __uint_as_float(rr[1]); }
  l_reg = l_reg * alpha + ps;
#define PK4(P, BASE, OUT) do { unsigned a0 = cvtpk(P[BASE + 0], P[BASE + 1]), a1 = cvtpk(P[BASE + 2], P[BASE + 3]);   \
    unsigned b0 = cvtpk(P[BASE + 4], P[BASE + 5]), b1 = cvtpk(P[BASE + 6], P[BASE + 7]);                              \
    auto r0 = __builtin_amdgcn_permlane32_swap(a0, b0, false, false); auto r1 = __builtin_amdgcn_permlane32_swap(a1, b1, false, false); \
    u32x4 w = {r0[0], r1[0], r0[1], r1[1]}; OUT = *reinterpret_cast<bf16x8*>(&w); } while (0)
  PK4(p0, 0, pa0); PK4(p0, 8, pa1); PK4(p1, 0, pa2); PK4(p1, 8, pa3);
#undef PK4
}
__device__ __forceinline__ void qkt(f32x16& p0, f32x16& p1, const bf16_t* Ks, const bf16x8* qr, int r32, int hi, int cc) {
  p0 = f32x16{}; p1 = f32x16{};
#pragma unroll
  for (int d0 = 0; d0 < 4; ++d0) { int cb = (cc * 64 + d0 * 16 + hi * 8) * 2;
    bf16x8 b0 = *reinterpret_cast<const bf16x8*>((const char*)Ks + KSWZ(r32, cb));
    bf16x8 b1 = *reinterpret_cast<const bf16x8*>((const char*)Ks + KSWZ(32 + r32, cb));
    p0 = __builtin_amdgcn_mfma_f32_32x32x16_bf16(b0, qr[d0], p0, 0, 0, 0);
    p1 = __builtin_amdgcn_mfma_f32_32x32x16_bf16(b1, qr[d0], p1, 0, 0, 0); }
}
__device__ __forceinline__ int v_st(int k, int c) { const int kk = (k & ~0xC) | ((k & 4) << 1) | ((k & 8) >> 1); return ((kk >> 3) * 4 + (c >> 5)) * 512 + ((kk & 7) * 32 + (c & 31)) * 2; }
__device__ __forceinline__ int v_rd_base(int lane) { return ((lane & 3) << 3) | (((lane >> 2) & 3) << 6) | (((lane >> 4) & 1) << 5) | (((lane >> 5) & 1) << 8); }
constexpr int v_rd_off(int d0, int ks, int half) { return d0 * 512 + ks * 4096 + half * 2048; }
template <int OFF> __device__ __forceinline__ s16x4 tr_read(int vb) {
  s16x4 r; asm volatile("ds_read_b64_tr_b16 %0, %1 offset:%2" : "=&v"(r) : "v"(vb), "i"(OFF) : "memory"); return r;
}
template <int D0> __device__ __forceinline__ void pv_one(f32x16& od, int vb, bf16x8 pa0, bf16x8 pa1, bf16x8 pa2, bf16x8 pa3) {
  const s16x4 l0 = tr_read<v_rd_off(D0, 0, 0)>(vb), h0 = tr_read<v_rd_off(D0, 0, 1)>(vb), l1 = tr_read<v_rd_off(D0, 1, 0)>(vb), h1 = tr_read<v_rd_off(D0, 1, 1)>(vb);
  const s16x4 l2 = tr_read<v_rd_off(D0, 2, 0)>(vb), h2 = tr_read<v_rd_off(D0, 2, 1)>(vb), l3 = tr_read<v_rd_off(D0, 3, 0)>(vb), h3 = tr_read<v_rd_off(D0, 3, 1)>(vb);
  asm volatile("s_waitcnt lgkmcnt(0)" ::: "memory"); SBAR();
#define PK(L, H) (bf16x8){L[0], L[1], L[2], L[3], H[0], H[1], H[2], H[3]}
  od = __builtin_amdgcn_mfma_f32_32x32x16_bf16(pa0, PK(l0, h0), od, 0, 0, 0);
  od = __builtin_amdgcn_mfma_f32_32x32x16_bf16(pa1, PK(l1, h1), od, 0, 0, 0);
  od = __builtin_amdgcn_mfma_f32_32x32x16_bf16(pa2, PK(l2, h2), od, 0, 0, 0);
  od = __builtin_amdgcn_mfma_f32_32x32x16_bf16(pa3, PK(l3, h3), od, 0, 0, 0);
#undef PK
}
__device__ __forceinline__ void pv_d0(f32x16* o, int vb, bf16x8 pa0, bf16x8 pa1, bf16x8 pa2, bf16x8 pa3) {
  pv_one<0>(o[0], vb, pa0, pa1, pa2, pa3); pv_one<1>(o[1], vb, pa0, pa1, pa2, pa3); pv_one<2>(o[2], vb, pa0, pa1, pa2, pa3); pv_one<3>(o[3], vb, pa0, pa1, pa2, pa3);
}
__device__ __forceinline__ void diff_attn_unit(const bf16_t* __restrict__ Qb, const bf16_t* __restrict__ Kh, const bf16_t* __restrict__ Vh, bf16_t* __restrict__ Ob,
                                               int seq, char* lds, float lam, const float* __restrict__ gsub, float oscale) {
  const int tid = tid_opaque(), wid = tid >> 6, lane = tid & 63, r32 = lane & 31, hi = lane >> 5;
  const int qblk = wid >> 1, cc = wid & 1;
  bf16_t* V_lds = (bf16_t*)lds; bf16_t* K_lds = (bf16_t*)(lds + 2 * SHM_V);
  float* ws = (float*)(lds + 2 * SHM_V + 2 * SHM_K) + wid * 64; float* li_l = ws; float* al_l = ws + 32;
  float m_reg = -1e30f, l_reg = 0; f32x16 o[4] = {}; bf16x8 qr[4];
  const bf16_t* Qw = Qb + (long)(qblk * 32 + r32) * LDQ + cc * 64 + hi * 8;
#pragma unroll
  for (int d0 = 0; d0 < 4; ++d0) qr[d0] = *reinterpret_cast<const bf16x8*>(Qw + d0 * 16);
  const int sr = tid >> 4, sc = (tid & 15) * 8, vst0 = v_st(sr, sc), vst1 = v_st(32 + sr, sc);
  const int vb0 = (int)(uintptr_t)V_lds + v_rd_base(lane);
  struct { bf16x8 vs0, vs1, ks0, ks1; } sr_[2];
#define SLOAD(i, k0) do { sr_[i].vs0 = *reinterpret_cast<const bf16x8*>(&Vh[(long)((k0) + sr) * LDQ + sc]); sr_[i].vs1 = *reinterpret_cast<const bf16x8*>(&Vh[(long)((k0) + 32 + sr) * LDQ + sc]); \
    sr_[i].ks0 = *reinterpret_cast<const bf16x8*>(&Kh[(long)((k0) + sr) * LDQ + sc]); sr_[i].ks1 = *reinterpret_cast<const bf16x8*>(&Kh[(long)((k0) + 32 + sr) * LDQ + sc]); } while (0)
#define SWRITE(b, i) do { *(bf16x8*)((char*)V_lds + (b) * SHM_V + vst0) = sr_[i].vs0;          \
    *(bf16x8*)((char*)V_lds + (b) * SHM_V + vst1) = sr_[i].vs1; int kc = sc * 2;               \
    *(bf16x8*)((char*)K_lds + (b) * SHM_K + KSWZ(sr, kc)) = sr_[i].ks0;                       \
    *(bf16x8*)((char*)K_lds + (b) * SHM_K + KSWZ(32 + sr, kc)) = sr_[i].ks1; } while (0)
#define SWAIT() asm volatile("s_waitcnt vmcnt(4)" ::: "memory")
#define RESC(a) do { if (__any((a) < 1.f)) { if (hi == 0) al_l[r32] = (a); asm volatile("s_waitcnt lgkmcnt(0)" ::: "memory"); \
    _Pragma("unroll") for (int d = 0; d < 4; ++d) _Pragma("unroll") for (int r = 0; r < 16; ++r) o[d][r] *= al_l[crow(r, hi)]; } } while (0)
  f32x16 pA0, pA1, pB0, pB1; float mnA, mnB, alA, alB; bf16x8 pa0, pa1, pa2, pa3; const int NT = seq / KVBLK;
  constexpr int SE = 0, SO = 1;
  SLOAD(SE, 0); asm volatile("s_waitcnt vmcnt(0)" ::: "memory"); SWRITE(0, SE); __syncthreads();
  qkt(pA0, pA1, K_lds, qr, r32, hi, cc); partialSM(pA0, pA1, m_reg, mnA, alA);
  SLOAD(SO, KVBLK); if (2 < NT) SLOAD(SE, 2 * KVBLK);
  SWAIT(); SWRITE(1, SO); __syncthreads();
  for (int j = 1; j + 1 < NT; j += 2) {
    SBAR(); qkt(pB0, pB1, (bf16_t*)((char*)K_lds + SHM_K), qr, r32, hi, cc);
    finishSM(pA0, pA1, alA, l_reg, pa0, pa1, pa2, pa3); SBAR();
    SLOAD(SO, (j + 2) * KVBLK); SBAR();
    pv_d0(o, vb0, pa0, pa1, pa2, pa3); partialSM(pB0, pB1, m_reg, mnB, alB);
    __syncthreads(); SWAIT(); SWRITE(0, SE);
    RESC(alB); __syncthreads();
    SBAR(); qkt(pA0, pA1, K_lds, qr, r32, hi, cc);
    finishSM(pB0, pB1, alB, l_reg, pa0, pa1, pa2, pa3); SBAR();
    if (j + 3 < NT) SLOAD(SE, (j + 3) * KVBLK); SBAR();
    pv_d0(o, vb0 + (int)SHM_V, pa0, pa1, pa2, pa3); partialSM(pA0, pA1, m_reg, mnA, alA);
    __syncthreads(); SWAIT(); SWRITE(1, SO);
    RESC(alA); __syncthreads();
  }
  SBAR(); qkt(pB0, pB1, (bf16_t*)((char*)K_lds + SHM_K), qr, r32, hi, cc);
  finishSM(pA0, pA1, alA, l_reg, pa0, pa1, pa2, pa3); SBAR();
  pv_d0(o, vb0, pa0, pa1, pa2, pa3); partialSM(pB0, pB1, m_reg, mnB, alB);
  __syncthreads(); RESC(alB);
  finishSM(pB0, pB1, alB, l_reg, pa0, pa1, pa2, pa3); SBAR();
  pv_d0(o, vb0 + (int)SHM_V, pa0, pa1, pa2, pa3);
  if (hi == 0) li_l[r32] = l_reg; asm volatile("s_waitcnt lgkmcnt(0)" ::: "memory");
  float rli[16];
#pragma unroll
  for (int r = 0; r < 16; ++r) rli[r] = __builtin_amdgcn_rcpf(li_l[crow(r, hi)]);
  __syncthreads();
  float* xch = (float*)lds + qblk * (32 * 128);
  if (cc == 1) {
#pragma unroll
    for (int r = 0; r < 16; ++r)
#pragma unroll
      for (int d0 = 0; d0 < 4; ++d0) xch[crow(r, hi) * 128 + d0 * 32 + r32] = lam * o[d0][r] * rli[r];
  }
  __syncthreads();
  if (cc == 0) {
    float gs[4];
#pragma unroll
    for (int d0 = 0; d0 < 4; ++d0) gs[d0] = gsub[d0 * 32 + r32] * oscale;
#pragma unroll
    for (int r = 0; r < 16; ++r) {
      float ss = 0.f;
#pragma unroll
      for (int d0 = 0; d0 < 4; ++d0) { const float v = o[d0][r] * rli[r] - xch[crow(r, hi) * 128 + d0 * 32 + r32]; o[d0][r] = v; ss += v * v; }
      ss += __shfl_xor(ss, 1); ss += __shfl_xor(ss, 2); ss += __shfl_xor(ss, 4); ss += __shfl_xor(ss, 8); ss += __shfl_xor(ss, 16);
      const float rs = rsqrtf(ss * (1.f / 128.f) + EPS);
      bf16_t* orow = Ob + (long)(qblk * 32 + crow(r, hi)) * LDQ;
#pragma unroll
      for (int d0 = 0; d0 < 4; ++d0) orow[d0 * 32 + r32] = (bf16_t)(cvtpk(o[d0][r] * rs * gs[d0], 0.f) & 0xffff);
    }
  }
  __syncthreads();
#undef SLOAD
#undef SWRITE
#undef SWAIT
#undef RESC
}
#undef KSWZ
#undef SBAR
constexpr int LDS_NEED = 2 * SHM_V + 2 * SHM_K + 8 * 64 * 4;
}

__device__ __forceinline__ void phase_attn(ArgP a, int j, char* lds, int G, int bid) {
    const bf16_t* Q = (const bf16_t*)(a->ws + WS_Q); const bf16_t* KB = (const bf16_t*)(a->ws + WS_KB); const bf16_t* VB = (const bf16_t*)(a->ws + WS_VB);
    bf16_t* O = (bf16_t*)(a->ws + WS_O);
    const float lam = ((const float*)(a->ws + WS_LAM))[j];
    const float oscale = 1.f - (j == 0 ? a->lam_init0 : a->lam_init1);
    const float* gsub = a->in[I_GSUB] + j * 128;
    for (int u = bid; u < 512; u += G) {
        int qrow, krow, seq, h;
        if (u < 256) { const int b = u >> 6; h = (u >> 3) & 7; const int qb = u & 7; qrow = NCTX + b * 1024 + qb * 128; krow = NCTX + b * 1536; seq = 1536; }
        else { const int v = u - 256, b = v >> 4; h = (v >> 1) & 7; const int qb = v & 1; qrow = b * 256 + qb * 128; krow = b * 256; seq = 256; }
        att::diff_attn_unit(Q + (size_t)qrow * 1024 + h * 128, KB + (size_t)krow * 1024 + h * 128, VB + (size_t)krow * 1024 + h * 128, O + (size_t)qrow * 1024 + h * 128,
                            seq, lds, lam, gsub, oscale);
    }
}

namespace hg {
constexpr int QT_OFF = 0, KT_OFF = 64 * 272, KHT_OFF = 2 * 64 * 272, VT_OFF = KHT_OFF + 128 * 144, DD_OFF = VT_OFF + 128 * 144, LDS_NEED = DD_OFF + 4 * 128 * 4;
__device__ __forceinline__ s16x4 pk4(f32x4 v) { u32x2 w; w.x = cvt_pk_bf16(v[0], v[1]); w.y = cvt_pk_bf16(v[2], v[3]); return __builtin_bit_cast(s16x4, w); }
struct Stage { u32x4 q[2], k[2], kh[2], v[2], d; };
__device__ __forceinline__ void scan_unit(int tok0, int n, int h, int dir, int vbase, int nwv, const bf16_t* __restrict__ QT, const bf16_t* __restrict__ KT, const bf16_t* __restrict__ KHT, const bf16_t* __restrict__ VT,
                                          const float* __restrict__ DD, const float* __restrict__ s0, float* __restrict__ sout, bf16_t* __restrict__ Od, LAS unsigned char* lds) {
    const int tid = tid_opaque(), lane = tid & 63, wv = __builtin_amdgcn_readfirstlane(tid >> 6), l15 = lane & 15, g = lane >> 4;
    const bool act = wv < nwv;
    const int vc = vbase + 16 * wv + l15;
    f32x4 S[8];
#pragma unroll
    for (int i = 0; i < 8; ++i) {
        if (s0 && act) {
#pragma unroll
            for (int r = 0; r < 4; ++r) S[i][r] = s0[(size_t)(16 * i + 4 * g + r) * 128 + vc]; }
        else S[i] = (f32x4){0.f, 0.f, 0.f, 0.f};
    }
    const int nms = n >> 6;
    Stage st;
#define HG_LOAD(msn) do { const int tb_ = tok0 + (msn) * 64; \
        _Pragma("unroll") for (int i_ = 0; i_ < 2; ++i_) { const int p_ = tid + 512 * i_; \
            const size_t so_ = (size_t)(tb_ + (p_ >> 4)) * 1024 + h * 128 + (p_ & 15) * 8; st.q[i_] = *(const u32x4*)(QT + so_); st.k[i_] = *(const u32x4*)(KT + so_); \
            const size_t to_ = ((size_t)(((tb_ >> 4) + (p_ >> 8)) * 8 + h) * 128 + ((p_ & 255) >> 1)) * 16 + (p_ & 1) * 8; st.kh[i_] = *(const u32x4*)(KHT + to_); st.v[i_] = *(const u32x4*)(VT + to_); } \
        if (tid < 128) st.d = *(const u32x4*)(DD + (size_t)(((tb_ >> 4) + (tid >> 5)) * 8 + h) * 128 + (tid & 31) * 4); } while (0)
#define HG_STORE() do { \
        _Pragma("unroll") for (int i_ = 0; i_ < 2; ++i_) { const int p_ = tid + 512 * i_; \
            *(LAS u32x4*)(lds + QT_OFF + (p_ >> 4) * 272 + (p_ & 15) * 16) = st.q[i_]; *(LAS u32x4*)(lds + KT_OFF + (p_ >> 4) * 272 + (p_ & 15) * 16) = st.k[i_]; \
            const int lo_ = ((p_ & 255) >> 1) * 144 + ((p_ >> 8) * 16 + (p_ & 1) * 8) * 2; *(LAS u32x4*)(lds + KHT_OFF + lo_) = st.kh[i_]; *(LAS u32x4*)(lds + VT_OFF + lo_) = st.v[i_]; } \
        if (tid < 128) *(LAS u32x4*)(lds + DD_OFF + ((tid >> 5) * 128 + (tid & 31) * 4) * 4) = st.d; } while (0)
    HG_LOAD(dir ? nms - 1 : 0);
    HG_STORE();
    __syncthreads();
    for (int ms = 0; ms < nms; ++ms) {
        const int msn = dir ? nms - 1 - ms : ms;
        if (ms + 1 < nms) HG_LOAD(dir ? msn - 1 : msn + 1);
        __builtin_amdgcn_sched_barrier(0);
        if (act) {
        s16x4 xb[4];
#pragma unroll
        for (int cp = 0; cp < 4; cp += 2) {
            bf16x8 ka[2][4], qb[2][4];
#pragma unroll
            for (int q = 0; q < 2; ++q)
#pragma unroll
                for (int kk = 0; kk < 4; ++kk) {
                    ka[q][kk] = *(const LAS bf16x8*)(lds + KT_OFF + ((cp + q) * 16 + l15) * 272 + kk * 64 + g * 16);
                    qb[q][kk] = *(const LAS bf16x8*)(lds + QT_OFF + ((cp + q) * 16 + l15) * 272 + kk * 64 + g * 16); }
            __builtin_amdgcn_sched_barrier(0);
            f32x4 X0 = {0.f, 0.f, 0.f, 0.f}, X1 = {0.f, 0.f, 0.f, 0.f};
#pragma unroll
            for (int kk = 0; kk < 4; ++kk) { X0 = __builtin_amdgcn_mfma_f32_16x16x32_bf16(ka[0][kk], qb[0][kk], X0, 0, 0, 0); X1 = __builtin_amdgcn_mfma_f32_16x16x32_bf16(ka[1][kk], qb[1][kk], X1, 0, 0, 0); }
#pragma unroll
            for (int r = 0; r < 4; ++r) if (dir ? (4 * g + r < l15) : (4 * g + r > l15)) { X0[r] = 0.f; X1[r] = 0.f; }
            xb[cp] = pk4(X0); xb[cp + 1] = pk4(X1);
            __builtin_amdgcn_sched_barrier(0);
        }
        f32x4 dvA[8]; s16x4 kaA[8], qaA[8], vbA;
#define HG_OPS(c_, DV, KA, QA, VB) do { VB = *(const LAS s16x4*)(lds + VT_OFF + vc * 144 + ((c_) * 16 + 4 * g) * 2); \
            _Pragma("unroll") for (int i_ = 0; i_ < 8; ++i_) { DV[i_] = *(const LAS f32x4*)(lds + DD_OFF + ((c_) * 128 + 16 * i_ + 4 * g) * 4); \
                KA[i_] = *(const LAS s16x4*)(lds + KHT_OFF + (16 * i_ + l15) * 144 + ((c_) * 16 + 4 * g) * 2); \
                QA[i_] = *(const LAS s16x4*)(lds + QT_OFF + ((c_) * 16 + l15) * 272 + (16 * i_ + 4 * g) * 2); } } while (0)
#define HG_CHUNK(c_, XB, DV, KA, QA, VB) do { \
            f32x4 o0_ = {0.f, 0.f, 0.f, 0.f}, o1_ = {0.f, 0.f, 0.f, 0.f}; s16x4 sb_[8]; \
            _Pragma("unroll") for (int i_ = 0; i_ < 8; ++i_) sb_[i_] = pk4(S[i_]); \
            _Pragma("unroll") for (int i_ = 0; i_ < 8; ++i_) S[i_] = __builtin_amdgcn_mfma_f32_16x16x16bf16_1k(KA[i_], VB, S[i_] * DV[i_], 0, 0, 0); \
            _Pragma("unroll") for (int i_ = 0; i_ < 8; i_ += 2) { o0_ = __builtin_amdgcn_mfma_f32_16x16x16bf16_1k(QA[i_], sb_[i_], o0_, 0, 0, 0); o1_ = __builtin_amdgcn_mfma_f32_16x16x16bf16_1k(QA[i_ + 1], sb_[i_ + 1], o1_, 0, 0, 0); } \
            o0_ = __builtin_amdgcn_mfma_f32_16x16x16bf16_1k(XB, VB, o0_, 0, 0, 0); \
            const f32x4 o_ = o0_ + o1_; \
            _Pragma("unroll") for (int r_ = 0; r_ < 4; ++r_) Od[(size_t)(tok0 + msn * 64 + (c_) * 16 + 4 * g + r_) * 1024 + h * 128 + vc] = (bf16_t)(cvt_pk_bf16(o_[r_], 0.f) & 0xffff); } while (0)
#pragma unroll 1
        for (int cc = 0; cc < 4; ++cc) {
            const int c = dir ? 3 - cc : cc;
            const s16x4 xbc = c == 0 ? xb[0] : c == 1 ? xb[1] : c == 2 ? xb[2] : xb[3];
            HG_OPS(c, dvA, kaA, qaA, vbA); __builtin_amdgcn_sched_barrier(0);
            HG_CHUNK(c, xbc, dvA, kaA, qaA, vbA); __builtin_amdgcn_sched_barrier(0);
        }
#undef HG_OPS
#undef HG_CHUNK
        }
        __syncthreads();
        if (ms + 1 < nms) { HG_STORE(); }
        __syncthreads();
    }
#undef HG_LOAD
#undef HG_STORE
    if (sout && act) {
#pragma unroll
        for (int i = 0; i < 8; ++i)
#pragma unroll
            for (int r = 0; r < 4; ++r) sout[(size_t)(16 * i + 4 * g + r) * 128 + vc] = S[i][r];
    }
}
}

__device__ __forceinline__ void phase_scan(ArgP a, LAS unsigned char* lds, int G, int bid) {
    for (int i = 0;; ++i) {
        const int u = i * G + ((i & 1) ? (G - 1 - bid) : bid);
        if (u >= 384) break;
        int tok0, n, h, dir, vbase = 0, nwv = 8; const float* s0 = nullptr; float* sout = nullptr;
        if (u < 128) { const int b = u >> 5; h = (u >> 2) & 7; dir = (u >> 1) & 1; vbase = (u & 1) * 64; nwv = 4; tok0 = NCTX + b * 1024; n = 1024; s0 = a->in[I_ST] + ((size_t)(b * 2 + dir) * 8 + h) * 16384; }
        else { const int v = u - 128, b = v >> 4; h = (v >> 1) & 7; dir = v & 1; tok0 = b * 256; n = 256; sout = a->out + OUT_NS + ((size_t)(b * 2 + dir) * 8 + h) * 16384; }
        hg::scan_unit(tok0, n, h, dir, vbase, nwv, (const bf16_t*)(a->ws + (dir ? WS_QTB : WS_QTF)), (const bf16_t*)(a->ws + (dir ? WS_KTB : WS_KTF)), (const bf16_t*)(a->ws + (dir ? WS_KHTB : WS_KHTF)),
                      (const bf16_t*)(a->ws + WS_VT), (const float*)(a->ws + (dir ? WS_DDB : WS_DDF)), s0, sout, (bf16_t*)(a->ws + (dir ? WS_OB : WS_OF)), lds);
    }
}

#ifndef PHMASK
#define PHMASK 0xFFFF
#endif
#ifndef REPMASK
#define REPMASK 0
#endif
#ifndef XBAR
#define XBAR 0
#endif
enum PhType { T_PRO = 0, T_NORM, T_QKV, T_ATTN, T_RES, T_FFN, T_HIN, T_SCAN, T_HFIN, T_F1, T_FINAL, T_FOLD };
struct PhDesc { int type, layer, sub; };
constexpr int NPH = 24;
__device__ __forceinline__ PhDesc phase_desc(int p) {
    switch (p) {
        case 0: return {T_PRO, 0, 0};
        case 1: return {T_FOLD, 0, 0};
        case 2: return {T_NORM, 0, 0};
        case 3: return {T_QKV, 0, 0}; case 4: return {T_ATTN, 0, 0}; case 5: return {T_RES, 0, 0}; case 6: return {T_FFN, 0, 0}; case 7: return {T_RES, 0, 2};
        case 8: return {T_HIN, 1, 0}; case 9: return {T_SCAN, 1, 0}; case 10: return {T_HFIN, 1, 0}; case 11: return {T_RES, 1, 1}; case 12: return {T_FFN, 1, 0}; case 13: return {T_RES, 1, 2};
        case 14: return {T_F1, 2, 0}; case 15: return {T_RES, 2, 3}; case 16: return {T_FFN, 2, 0}; case 17: return {T_RES, 2, 2};
        case 18: return {T_QKV, 3, 1}; case 19: return {T_ATTN, 3, 1}; case 20: return {T_RES, 3, 0}; case 21: return {T_FFN, 3, 0}; case 22: return {T_RES, 3, 2};
        default: return {T_FINAL, 0, 0};
    }
}

__global__ void __launch_bounds__(NTHREADS, 2) fwd_megakernel(Args a_unused) {
    extern __shared__ __attribute__((aligned(16))) unsigned char lds_raw[];
    LAS unsigned char* lds = (LAS unsigned char*)lds_raw;
    constexpr int G = 256; const int bid = blockIdx.x;
    ArgP a = (ArgP)__builtin_amdgcn_kernarg_segment_ptr();
    for (int u = threadIdx.x; u < (LDS_BYTES - LDSCTL_OFF) / 4; u += NTHREADS) ((LAS unsigned*)(lds + LDSCTL_OFF))[u] = 0u;
    __syncthreads();
    volatile LAS unsigned* MISC = (volatile LAS unsigned*)(lds + MISC_OFF);
    XcdBarrier bar = xcd_barrier_post((unsigned*)(a->ws + WS_CTL), MISC + 8);

    const int nrun = a->ph_hi < NPH ? a->ph_hi + 1 : NPH;
#if REPMASK
    for (int pj = 2 * a->ph_lo; pj < 2 * nrun; ++pj) {
        const int pi = pj >> 1, rep = pj & 1;
        const int ph = pi < a->ph_hi ? pi : NPH - 1;
        const PhDesc d = phase_desc(ph);
        if (rep && !((REPMASK >> d.type) & 1)) continue;
        if (pj > 2 * a->ph_lo) xcd_barrier(bar);
#else
    for (int pi = a->ph_lo; pi < nrun; ++pi) {
        const int rep = 0;
        const int ph = pi < a->ph_hi ? pi : NPH - 1;
        const PhDesc d = phase_desc(ph);
        if (pi > a->ph_lo) xcd_barrier(bar);
#endif
        for (int xb = 0; xb < XBAR; ++xb) xcd_barrier(bar);
#define PH_TID const int tid = tid_opaque(), lane = tid & 63, wave = __builtin_amdgcn_readfirstlane(tid >> 6), gw = bid * NWAVES + wave, ngw = G * NWAVES; (void)lane; (void)gw; (void)ngw
        asm volatile("" : "+s"(a));
        const int L = d.layer;
        switch (d.type) {
#if (PHMASK >> 0) & 1
        case T_PRO: phase_prologue(a, lds, G, bid);
            if (a->ph_hi < NPH) { PH_TID; for (size_t i = (size_t)bid * NTHREADS + tid; i < 29360128 / 4; i += (size_t)G * NTHREADS) ((f32x4*)a->out)[i] = (f32x4){0.f, 0.f, 0.f, 0.f}; }
            break;
#endif
#if (PHMASK >> 1) & 1
        case T_FOLD: {
            GenSched S; S.init(2, a->ws + WS_WFO, nullptr, 1024, a->ws + WS_TC, 1024, 1024, 256, a->ph_hi > 0 ? 256 : 320, G, bid);
            EpiBf16 E{(bf16_t*)(a->ws + WS_WCS), 1024};
            pg8::gemm_phase(lds, 1024, 1024, S, E);
            PH_TID;
            phase_an(a, bid * NTHREADS + tid, G * NTHREADS);
            phase_sw(a, lds, 0xEF, gw, ngw, tid, lane);
        } break;
#endif
#if (PHMASK >> 2) & 1
        case T_NORM: {
            PH_TID;
            phase_first_norm(a, gw, ngw, lane);
            phase_sw(a, lds, 0x10, gw, ngw, tid, lane);
        } break;
#endif
#if (PHMASK >> 3) & 1
        case T_QKV: {
            const int j = d.sub, nidx = 2 * L;
            if (j == 1) { PH_TID; cache_convert(a, 1, gw, ngw, lane); }
            const float* sspn = (const float*)(a->ws + WS_SSP) + (size_t)nidx * 8192 * SSPN; const float* swn = (const float*)(a->ws + WS_SW) + sw_off(nidx);
            { GenSched S; S.init(7, a->ws + WS_H, nullptr, 1024, a->ws + WS_WQKV + (size_t)j * 3072 * 1024 * 2, 1024, MTOK, 3072, 1024, G, bid);
              EpiQKV E{(bf16_t*)(a->ws + WS_Q), (bf16_t*)(a->ws + WS_KB), (bf16_t*)(a->ws + WS_VB), a->out + OUT_NK + (size_t)j * 256 * 1024, a->out + OUT_NV + (size_t)j * 256 * 1024,
                       (const float*)(a->ws + WS_ROPE), (const float*)(a->ws + WS_ROPE) + 1024, sspn, swn, lds};
              pg8::gemm_phase(lds, 1024, 1024, S, E); }
            { GenSched S; S.init(8, a->ws + WS_H, nullptr, 1024, a->ws + WS_WQKV + (size_t)j * 3072 * 1024 * 2, 1024, MTOK, 3072, 1024, G, bid);
              EpiQKV128 E{(bf16_t*)(a->ws + WS_Q), (bf16_t*)(a->ws + WS_KB), (bf16_t*)(a->ws + WS_VB), a->out + OUT_NK + (size_t)j * 256 * 1024, a->out + OUT_NV + (size_t)j * 256 * 1024,
                          (const float*)(a->ws + WS_ROPE), (const float*)(a->ws + WS_ROPE) + 1024, sspn, swn, lds};
              pg8::gemm_phase_n128(lds, 1024, 1024, S, E); }
        } break;
#endif
#if (PHMASK >> 4) & 1
        case T_ATTN: phase_attn(a, d.sub, (char*)lds_raw, G, bid); break;
#endif
#if (PHMASK >> 5) & 1
        case T_RES: {
            const int nn = d.sub == 2 ? 2 * L + 2 : 2 * L + 1;
            EpiResid128 E{(bf16_t*)(a->ws + WS_X), (float*)(a->ws + WS_MOD) + (size_t)L * 5 * 6144 + (d.sub == 2 ? 5 : 2) * 1024,
                          nn < 8 ? (const float*)(a->ws + WS_AN) + nn * 5120 : nullptr, (bf16_t*)(a->ws + WS_H), (float*)(a->ws + WS_SSP) + (size_t)nn * 8192 * SSPN};
            GenSched S; int lda, ldb;
            if (d.sub == 3) { lda = 2048; ldb = 16384; S.init(4, a->ws + WS_CS1024, a->ws + WS_CS256, lda, a->ws + WS_ZT, ldb, 0, 0, 2048, G, bid); }
            else if (d.sub == 2) { lda = DFF; ldb = DFF; S.init(3, a->ws + WS_ACT, nullptr, lda, a->ws + WS_WFOUT + (size_t)L * 1024 * DFF * 2, ldb, MTOK, 1024, DFF, G, bid); }
            else { lda = 1024; ldb = 1024; const unsigned char* w = d.sub == 0 ? a->ws + WS_WOA + (size_t)(L == 0 ? 0 : 1) * 1024 * 1024 * 2 : a->ws + WS_WOR;
                S.init(3, a->ws + WS_O, nullptr, lda, w, ldb, MTOK, 1024, 1024, G, bid); }
            pg8::gemm_phase_n128(lds, lda, ldb, S, E);
        } break;
#endif
#if (PHMASK >> 6) & 1
        case T_FFN: {
            const int nidx = 2 * L + 1;
            GenSched S; S.init(0, a->ws + WS_H, nullptr, 1024, a->ws + WS_WFI + (size_t)L * 5632 * 1024 * 2, 1024, MTOK, 5632, 1024, G, bid);
            EpiFFN E{(bf16_t*)(a->ws + WS_ACT), (const float*)(a->ws + WS_SSP) + (size_t)nidx * 8192 * SSPN, (const float*)(a->ws + WS_SW) + sw_off(nidx), lds};
            pg8::gemm_phase(lds, 1024, 1024, S, E);
        } break;
#endif
#if (PHMASK >> 7) & 1
        case T_HIN: {
            { GenSched S; S.init(5, a->ws + WS_H, nullptr, 1024, a->ws + WS_WINR, 1024, MTOK, 4096, 1024, G, bid);
              EpiHgrn E{(bf16_t*)(a->ws + WS_GH), (bf16_t*)(a->ws + WS_QTF), (bf16_t*)(a->ws + WS_KTF), (bf16_t*)(a->ws + WS_QTB), (bf16_t*)(a->ws + WS_KTB), (bf16_t*)(a->ws + WS_KHTF), (bf16_t*)(a->ws + WS_KHTB),
                        (bf16_t*)(a->ws + WS_VT), (float*)(a->ws + WS_DDF), (float*)(a->ws + WS_DDB), (const float*)(a->ws + WS_LBV), (const float*)(a->ws + WS_SSP) + 2ull * 8192 * SSPN, (const float*)(a->ws + WS_SW) + sw_off(2), lds};
              pg8::gemm_phase(lds, 1024, 1024, S, E); }
            { GenSched S; S.init(6, a->ws + WS_H, nullptr, 1024, a->ws + WS_WINR, 1024, MTOK, 1024, 1024, G, bid);
              EpiG128 E{(bf16_t*)(a->ws + WS_GH), (const float*)(a->ws + WS_SSP) + 2ull * 8192 * SSPN, (const float*)(a->ws + WS_SW) + sw_off(2), lds};
              pg8::gemm_phase_n128(lds, 1024, 1024, S, E); }
        } break;
#endif
#if (PHMASK >> 8) & 1
        case T_SCAN: phase_scan(a, lds, G, bid); break;
#endif
#if (PHMASK >> 9) & 1
        case T_HFIN: { PH_TID; phase_hgrn_final(a, gw, ngw, lane); } break;
#endif
#if (PHMASK >> 10) & 1
        case T_F1: {
            GenSched S; S.init(0, a->ws + WS_WCS, nullptr, 1024, a->ws + WS_H, 1024, 2048, MTOK, 1024, G, bid);
            EpiFour1 E{(bf16_t*)(a->ws + WS_ZT), (const float*)(a->ws + WS_SSP) + 4ull * 8192 * SSPN, (const float*)(a->ws + WS_SW) + sw_off(4), lds};
            pg8::gemm_phase(lds, 1024, 1024, S, E);
        } break;
#endif
        default: { PH_TID; phase_final(a, gw, ngw, lane); } break;
        }
    }
}

extern "C" void kernel_launch(void* const* d_in, const int* in_sizes, int n_in, void* d_out, int out_size, void* d_ws, size_t ws_size, hipStream_t stream) {
    static int grid = 0;
    if (grid == 0) {
        if (n_in != 23 || out_size != 29360128 || ws_size < WS_END2) {
            fprintf(stderr, "kernel_launch: unexpected shapes: n_in %d out %d ws %zu (need >= %zu); nothing launched\n", n_in, out_size, ws_size, (size_t)WS_END); grid = -1; return; }
        int dev = 0, cus = 0, per_cu = 0;
        if (hipGetDevice(&dev) != hipSuccess || hipDeviceGetAttribute(&cus, hipDeviceAttributeMultiprocessorCount, dev) != hipSuccess) { fprintf(stderr, "kernel_launch: device query failed\n"); grid = -1; return; }
        if (hipFuncSetAttribute((const void*)fwd_megakernel, hipFuncAttributeMaxDynamicSharedMemorySize, LDS_BYTES) != hipSuccess) { fprintf(stderr, "kernel_launch: hipFuncSetAttribute failed\n"); grid = -1; return; }
        if (hipOccupancyMaxActiveBlocksPerMultiprocessor(&per_cu, (const void*)fwd_megakernel, NTHREADS, LDS_BYTES) != hipSuccess || per_cu < 1) {
            fprintf(stderr, "kernel_launch: occupancy query reports %d workgroups per CU; nothing launched\n", per_cu); (void)hipGetLastError(); grid = -1; return; }
        if (cus < 256) { fprintf(stderr, "kernel_launch: needs >= 256 CUs (have %d); nothing launched\n", cus); grid = -1; return; }
        grid = 256;
    }
    if (grid < 0) return;
    (void)hipMemsetAsync((char*)d_ws + WS_CTL, 0, CTL_BYTES, stream);
    Args a{};
    for (int i = 0; i < 23; ++i) a.in[i] = (const float*)d_in[i];
    a.out = (float*)d_out; a.ws = (unsigned char*)d_ws;
    a.lam_init0 = 0.2f; a.lam_init1 = (float)(0.8 - 0.6 * 0.40656965974059917);
    a.ph_lo = 0; a.ph_hi = NPH;
    hipLaunchKernelGGL(fwd_megakernel, dim3(grid), dim3(NTHREADS), LDS_BYTES, stream, a);
    const hipError_t le = hipPeekAtLastError();
    if (le != hipSuccess) fprintf(stderr, "kernel_launch: launch failed: %s\n", hipGetErrorName(le));
}
```

```cpp
#include <hip/hip_runtime.h>
#include <cstdio>
#include <cstdint>

#define LAS __attribute__((address_space(3)))
#define GAS __attribute__((address_space(1)))
typedef unsigned short bf16_t;
typedef short bf16x8 __attribute__((ext_vector_type(8)));
typedef short s16x4 __attribute__((ext_vector_type(4)));
typedef float f32x2 __attribute__((ext_vector_type(2)));
typedef float f32x4 __attribute__((ext_vector_type(4)));
typedef float f32x8 __attribute__((ext_vector_type(8)));
typedef float f32x16 __attribute__((ext_vector_type(16)));
typedef unsigned u32x2 __attribute__((ext_vector_type(2)));
typedef unsigned u32x4 __attribute__((ext_vector_type(4)));

constexpr int DM = 1024, MTOK = 8192, NCTX = 4096, DFF = 2816, NKV = 4096 + 4 * 1536;
constexpr float EPS = 1e-6f;
constexpr int NWAVES = 8, NTHREADS = 512;

constexpr size_t al256(size_t x) { return (x + 255) / 256 * 256; }
constexpr size_t WS_CTL = 0, CTL_BYTES = 65536;
constexpr size_t WS_MOD = WS_CTL + CTL_BYTES;
constexpr size_t WS_ROPE = WS_MOD + al256(4 * 5 * 6144 * 4);
constexpr size_t WS_LBV = WS_ROPE + 8192;
constexpr size_t WS_LAM = WS_LBV + 8192;
constexpr size_t WS_AN = WS_LAM + 256;
constexpr size_t WS_SW = WS_AN + 8 * 5 * 1024 * 4;
constexpr size_t WS_SSP = WS_SW + al256(35840 * 5 * 4);
constexpr int SSPN = 32;
constexpr size_t WS_TC = WS_SSP + 9ull * 8192 * SSPN * 4;
constexpr size_t WS_CS256 = WS_TC + 256 * 1024 * 2;
constexpr size_t WS_CS1024 = WS_CS256 + 256 * 2048 * 2;
constexpr size_t WS_WQKV = WS_CS1024 + 1024 * 2048 * 2;
constexpr size_t WS_WOA = WS_WQKV + 2ull * 3072 * 1024 * 2;
constexpr size_t WS_WINR = WS_WOA + 2ull * 1024 * 1024 * 2;
constexpr size_t WS_WOR = WS_WINR + 5120ull * 1024 * 2;
constexpr size_t WS_WFO = WS_WOR + 1024ull * 1024 * 2;
constexpr size_t WS_WCS = WS_WFO + 1024ull * 1024 * 2;
constexpr size_t WS_WFI = WS_WCS + 2048ull * 1024 * 2;
constexpr size_t WS_WFOUT = WS_WFI + 4ull * 5632 * 1024 * 2;
constexpr size_t WS_X = WS_WFOUT + 4ull * 1024 * 2816 * 2;
constexpr size_t WS_H = WS_X + 8192ull * 1024 * 4;
constexpr size_t WS_O = WS_H + 8192ull * 1024 * 2;
constexpr size_t WS_SCR = WS_O + 8192ull * 1024 * 2;
constexpr size_t SZ_TOK = 8192ull * 1024 * 2;
constexpr size_t WS_Q = WS_SCR, WS_KB = WS_Q + SZ_TOK, WS_VB = WS_KB + (size_t)NKV * 1024 * 2;
constexpr size_t WS_GH = WS_SCR, WS_QTF = WS_GH + SZ_TOK, WS_KTF = WS_QTF + SZ_TOK, WS_QTB = WS_KTF + SZ_TOK, WS_KTB = WS_QTB + SZ_TOK, WS_KHTF = WS_KTB + SZ_TOK, WS_KHTB = WS_KHTF + SZ_TOK,
                 WS_VT = WS_KHTB + SZ_TOK, WS_OF = WS_VT + SZ_TOK, WS_OB = WS_OF + SZ_TOK, WS_DDF = WS_OB + SZ_TOK, WS_DDB = WS_DDF + 512ull * 8 * 128 * 4;
constexpr size_t WS_ZT = WS_SCR;
constexpr size_t WS_ACT = WS_SCR;
constexpr size_t WS_END = WS_DDB + 512ull * 8 * 128 * 4;
constexpr size_t WS_END2 = WS_END;
__host__ __device__ constexpr int sw_n(int nidx) { return nidx == 0 || nidx == 6 ? 3072 : nidx == 2 ? 5120 : nidx == 4 ? 2048 : 5632; }
__host__ __device__ constexpr int sw_off(int nidx) { int o = 0; for (int i = 0; i < nidx; ++i) o += 5 * sw_n(i); return o; }

constexpr size_t OUT_YP = 0, OUT_YS = 4194304, OUT_NK = 8388608, OUT_NV = 16777216, OUT_NS = 25165824;

constexpr int RING_BYTES = 131072;
constexpr int LDSCTL_OFF = RING_BYTES, MISC_OFF = LDSCTL_OFF + 320, RSTD_OFF = LDSCTL_OFF + 1024;
constexpr int LDS_BYTES = 147456;

typedef __bf16 bf16x2_t __attribute__((ext_vector_type(2)));
__device__ __forceinline__ unsigned cvt_pk_bf16(float lo, float hi) { f32x2 v = {lo, hi}; bf16x2_t b = __builtin_convertvector(v, bf16x2_t); return __builtin_bit_cast(unsigned, b); }
__device__ __forceinline__ float bf2f(unsigned short b) { return __uint_as_float((unsigned)b << 16); }
__device__ __forceinline__ float bflo(unsigned w) { return __uint_as_float(w << 16); }
__device__ __forceinline__ float bfhi(unsigned w) { return __uint_as_float(w & 0xffff0000u); }
__device__ __forceinline__ float fast_rcp(float x) { return __builtin_amdgcn_rcpf(x); }
__device__ __forceinline__ float silu_f(float x) { return x * fast_rcp(1.f + __expf(-x)); }
__device__ __forceinline__ float sigmoid_f(float x) { return fast_rcp(1.f + __expf(-x)); }
__device__ __forceinline__ float wave_sum(float v) {
#pragma unroll
    for (int o = 1; o < 64; o <<= 1) v += __shfl_xor(v, o);
    return v;
}
__device__ __forceinline__ int tid_opaque() { int t = threadIdx.x; asm volatile("" : "+v"(t)); return t; }
__device__ __forceinline__ int cond_of_row(int r) { return r < NCTX ? 0 : 1 + ((r - NCTX) >> 10); }
#define LDS_WAIT() asm volatile("s_waitcnt lgkmcnt(0)" ::: "memory")
#define VM_WAIT() asm volatile("s_waitcnt vmcnt(0)" ::: "memory")

#define XB_TMO      128
#define XB_XCNT(j)  (256  + 64 * (j))
#define XB_XSUB(j)  (1280 + 64 * (j))
#define XB_XGEN(j)  (2304 + 64 * (j))
#define XB_TOP      3328
#define XB_TOPGEN   3392
#define XCD_BAR_WORDS 3456
#define XB_SPIN_CAP (1u << 22)
__device__ __forceinline__ unsigned xb_ld(unsigned* p)              { return __hip_atomic_load(p, __ATOMIC_RELAXED, __HIP_MEMORY_SCOPE_AGENT); }
__device__ __forceinline__ unsigned xb_add(unsigned* p, unsigned v) { return __hip_atomic_fetch_add(p, v, __ATOMIC_RELAXED, __HIP_MEMORY_SCOPE_AGENT); }
__device__ __forceinline__ unsigned xb_xcc_id() { return (unsigned)__builtin_amdgcn_s_getreg((3 << 11) | 20) & 0xFu; }
#define XB_SPIN(cond, bar) do { unsigned _sp = 0; while (cond) { __builtin_amdgcn_s_sleep(1); \
    if ((++_sp & 255u) == 0u) { if (xb_ld(&(bar)[XB_TMO])) break; if (_sp > XB_SPIN_CAP) { atomicAdd(&(bar)[XB_TMO], 1u); break; } } } } while (0)
struct XcdBarrier { unsigned* bar; unsigned x; volatile LAS unsigned* st; };
__device__ __forceinline__ XcdBarrier xcd_barrier_post(unsigned* bar, volatile LAS unsigned* st) {
    XcdBarrier b; b.bar = bar; b.x = xb_xcc_id(); b.st = st;
    if (threadIdx.x == 0) (void)xb_add(&bar[XB_XCNT(b.x)], 1u);
    return b;
}
__device__ __forceinline__ void xcd_barrier_complete(unsigned* bar, unsigned x, unsigned& nloc, unsigned& nx) {
    const unsigned G = gridDim.x * gridDim.y * gridDim.z;
    unsigned sum, cnt, mine, sp = 0u;
    for (;;) {
        sum = 0u; cnt = 0u; mine = 0u;
#pragma unroll
        for (unsigned j = 0; j < 16; ++j) { const unsigned c = xb_ld(&bar[XB_XCNT(j)]); sum += c; cnt += (c > 0u) ? 1u : 0u; mine = (j == x) ? c : mine; }
        if (sum == G) break;
        __builtin_amdgcn_s_sleep(1);
        if ((++sp & 255u) == 0u) { if (xb_ld(&bar[XB_TMO])) break; if (sp > XB_SPIN_CAP) { atomicAdd(&bar[XB_TMO], 1u); break; } }
    }
    nloc = mine > 0u ? mine : 1u; nx = cnt > 0u ? cnt : 1u;
}
__device__ __forceinline__ void xcd_barrier(const XcdBarrier& b) {
    asm volatile("s_waitcnt vmcnt(0)" ::: "memory");
    __syncthreads();
    if (threadIdx.x == 0) {
        unsigned* bar = b.bar;
        __builtin_amdgcn_s_waitcnt(0);
        unsigned nloc = b.st[0], nx = b.st[1];
        if (nloc == 0u) { xcd_barrier_complete(bar, b.x, nloc, nx); b.st[0] = nloc; b.st[1] = nx; }
        const unsigned old = xb_add(&bar[XB_XSUB(b.x)], 1u);
        const unsigned gen = old / nloc;
        if (old + 1u == (gen + 1u) * nloc) {
            __builtin_amdgcn_fence(__ATOMIC_RELEASE, "agent");
            asm volatile("s_waitcnt vmcnt(0)" ::: "memory");
            const unsigned og = xb_add(&bar[XB_TOP], 1u);
            const unsigned tg = og / nx;
            if (og + 1u == (tg + 1u) * nx) xb_add(&bar[XB_TOPGEN], 1u);
            else XB_SPIN(xb_ld(&bar[XB_TOPGEN]) == tg, bar);
            __builtin_amdgcn_fence(__ATOMIC_ACQUIRE, "agent");
            xb_add(&bar[XB_XGEN(b.x)], 1u);
            asm volatile("s_waitcnt vmcnt(0)" ::: "memory");
        } else {
            XB_SPIN(xb_ld(&bar[XB_XGEN(b.x)]) == gen, bar);
            __builtin_amdgcn_fence(__ATOMIC_ACQUIRE, "agent");
            asm volatile("s_waitcnt vmcnt(0)" ::: "memory");
        }
    }
    __syncthreads();
}

namespace pg8 {
constexpr int BM = 256, BK = 64, HALF = 128, HTB = HALF * BK * 2, NXCD = 8, WGM = 8;
__host__ __device__ __forceinline__ int lds_byte(int r, int c) { const int st = (r >> 4) * 2 + (c >> 5), rr = r & 15, cc = c & 31, ob = rr * 64 + cc * 2; return st * 1024 + (ob ^ (((ob >> 9) & 1) << 5)); }
__host__ __device__ __forceinline__ int perm32(int rho) { const int n = rho >> 4, i = rho & 15; return 8 * (i >> 2) + 4 * n + (i & 3); }
__host__ __device__ __forceinline__ void stage_rc(int b, int& R, int& C) { const int st = b / 1024, sb = b % 1024, swz = sb ^ (((sb >> 9) & 1) << 5); R = (st >> 1) * 16 + swz / 64; C = (st & 1) * 32 + (swz % 64) / 2; }

struct GUnit { const char* A; const char* B; int nt; int row0; int col0; int aux; };

template <class Epi, class Sched>
__device__ __forceinline__ void gemm_phase(LAS unsigned char* lds, const int lda, const int ldb, const Sched& S, const Epi& E) {
    const int tid = tid_opaque(), wid = __builtin_amdgcn_readfirstlane(tid >> 6), lane = tid & 63, wr = wid >> 2, wc = wid & 3, fr = lane & 15, fq = lane >> 4;
    unsigned voffA[2], voffB[2];
#pragma unroll
    for (int i = 0; i < 2; ++i) { int R, C; stage_rc(tid * 16 + i * 8192, R, C); const int Rb = Epi::PERM ? ((R & ~31) + perm32(R & 31)) : R; voffA[i] = (unsigned)(R * lda + C) * 2u; voffB[i] = (unsigned)(Rb * ldb + C) * 2u; }
    const size_t kstep = (size_t)(BK * 2);
    const size_t hstepA = (size_t)HALF * lda * 2, hstepB = (size_t)HALF * ldb * 2;
    const unsigned ldsw = (unsigned)wid * 1024u;
    const int aoff = lds_byte(wr * 64 + fr, fq * 8), boff = lds_byte(wc * 32 + fr, fq * 8);
#define PG8_SA(b, h) (((b) * 2 + (h)) * HTB)
#define PG8_SB(b, h) ((4 + (b) * 2 + (h)) * HTB)
#define PG8_STAGE(bufoff, gbase, voff) do { _Pragma("unroll") for (int _i = 0; _i < 2; ++_i) \
        __builtin_amdgcn_global_load_lds((const unsigned*)((const char*)(gbase) + (voff)[_i]), (LAS unsigned*)(lds + (bufoff) + ldsw + _i * 8192), 16, 0, 0); } while (0)
#define PG8_LDA(dst, b, h) do { _Pragma("unroll") for (int m = 0; m < 4; ++m) _Pragma("unroll") for (int k = 0; k < 2; ++k) dst[m][k] = *(const LAS bf16x8*)(lds + PG8_SA(b, h) + aoff + m * 2048 + k * 1024); } while (0)
#define PG8_LDB(dst, b, h) do { _Pragma("unroll") for (int n = 0; n < 2; ++n) _Pragma("unroll") for (int k = 0; k < 2; ++k) dst[n][k] = *(const LAS bf16x8*)(lds + PG8_SB(b, h) + boff + n * 2048 + k * 1024); } while (0)
#define PG8_MMA(ai, bj, At, Bt) do { __builtin_amdgcn_s_setprio(1); _Pragma("unroll") for (int m = 0; m < 4; ++m) _Pragma("unroll") for (int n = 0; n < 2; ++n) _Pragma("unroll") for (int k = 0; k < 2; ++k) \
        acc[ai][bj][m][n] = __builtin_amdgcn_mfma_f32_16x16x32_bf16(Bt[n][k], At[m][k], acc[ai][bj][m][n], 0, 0, 0); __builtin_amdgcn_s_setprio(0); } while (0)
#define PG8_WAIT_V(n) asm volatile("s_waitcnt vmcnt(" #n ")" ::: "memory")
#define PG8_WAIT_L(n) asm volatile("s_waitcnt lgkmcnt(" #n ")" ::: "memory")
#define PG8_BAR __builtin_amdgcn_s_barrier()
#define PG8_SCHED __builtin_amdgcn_sched_barrier(0)
    GUnit cur, nxt; int ui = 0;
    if (!S.next(0, cur)) return;
    E.prepare(S, lds, tid);
    f32x4 acc[2][2][4][2];
#pragma unroll
    for (int a = 0; a < 2; ++a)
#pragma unroll
        for (int b = 0; b < 2; ++b)
#pragma unroll
            for (int m = 0; m < 4; ++m)
#pragma unroll
                for (int n = 0; n < 2; ++n) acc[a][b][m][n] = (f32x4){0.f, 0.f, 0.f, 0.f};
    bf16x8 At[4][2], B0[2][2], B1[2][2];
    const char* cA = cur.A; const char* cB = cur.B;
    PG8_STAGE(PG8_SB(0, 0), cB, voffB); PG8_STAGE(PG8_SB(0, 1), cB + hstepB, voffB); PG8_STAGE(PG8_SA(0, 0), cA, voffA); PG8_STAGE(PG8_SA(0, 1), cA + hstepA, voffA);
    if (wr == 1) PG8_BAR;
    PG8_WAIT_V(2); PG8_BAR;
    PG8_STAGE(PG8_SB(1, 0), cB + kstep, voffB); PG8_STAGE(PG8_SA(1, 0), cA + kstep, voffA); PG8_STAGE(PG8_SB(1, 1), cB + hstepB + kstep, voffB);
    PG8_WAIT_V(6); PG8_BAR;
    for (;;) {
        const bool has_next = S.next(ui + 1, nxt);
        const char* nA = has_next ? nxt.A : cA; const char* nB = has_next ? nxt.B : cB;
        const int nt = cur.nt;
        for (int t = 0; t < nt; t += 2) {
            const bool last = (t == nt - 2);
            const char* a1 = cA + (size_t)(t + 1) * kstep;
            const char* a2 = last ? nA : cA + (size_t)(t + 2) * kstep; const char* b2 = last ? nB : cB + (size_t)(t + 2) * kstep;
            const char* a3 = a2 + kstep; const char* b3 = b2 + kstep;
            PG8_LDB(B0, 0, 0); PG8_LDB(B1, 0, 1); PG8_SCHED; PG8_LDA(At, 0, 0); PG8_STAGE(PG8_SA(1, 1), a1 + hstepA, voffA);
            PG8_WAIT_V(8); PG8_WAIT_L(0); PG8_BAR; PG8_MMA(0, 0, At, B0); PG8_MMA(0, 1, At, B1); PG8_BAR; PG8_SCHED;
            PG8_LDA(At, 0, 1); PG8_STAGE(PG8_SB(0, 0), b2, voffB); PG8_STAGE(PG8_SB(0, 1), b2 + hstepB, voffB); PG8_STAGE(PG8_SA(0, 0), a2, voffA);
            PG8_WAIT_V(8); PG8_WAIT_L(0); PG8_BAR; PG8_MMA(1, 0, At, B0); PG8_MMA(1, 1, At, B1); PG8_BAR; PG8_SCHED;
            PG8_LDB(B0, 1, 0); PG8_LDB(B1, 1, 1); PG8_SCHED; PG8_LDA(At, 1, 0); PG8_STAGE(PG8_SA(0, 1), a2 + hstepA, voffA);
            PG8_WAIT_V(8); PG8_WAIT_L(0); PG8_BAR; PG8_MMA(0, 0, At, B0); PG8_MMA(0, 1, At, B1); PG8_BAR; PG8_SCHED;
            PG8_LDA(At, 1, 1); PG8_STAGE(PG8_SB(1, 0), b3, voffB); PG8_STAGE(PG8_SB(1, 1), b3 + hstepB, voffB); PG8_STAGE(PG8_SA(1, 0), a3, voffA);
            PG8_WAIT_V(8); PG8_WAIT_L(0); PG8_BAR; PG8_MMA(1, 0, At, B0); PG8_MMA(1, 1, At, B1); PG8_BAR; PG8_SCHED;
        }
        if (wr == 0) PG8_BAR;
        E(acc, cur, ui, wr, wc, fr, fq);
        if (!has_next) break;
#pragma unroll
        for (int a = 0; a < 2; ++a)
#pragma unroll
            for (int b = 0; b < 2; ++b)
#pragma unroll
                for (int m = 0; m < 4; ++m)
#pragma unroll
                    for (int n = 0; n < 2; ++n) acc[a][b][m][n] = (f32x4){0.f, 0.f, 0.f, 0.f};
        cur = nxt; cA = nA; cB = nB; ++ui;
        if (wr == 1) PG8_BAR;
    }
    PG8_WAIT_V(0);
    PG8_BAR;
#undef PG8_SA
#undef PG8_SB
#undef PG8_STAGE
#undef PG8_LDA
#undef PG8_LDB
#undef PG8_MMA
#undef PG8_WAIT_V
#undef PG8_WAIT_L
#undef PG8_BAR
#undef PG8_SCHED
}

template <class Epi, class Sched>
__device__ __forceinline__ void gemm_phase_n128(LAS unsigned char* lds, const int lda, const int ldb, const Sched& S, const Epi& E) {
    const int tid = tid_opaque(), wid = __builtin_amdgcn_readfirstlane(tid >> 6), lane = tid & 63, wr = wid >> 2, wc = wid & 3, fr = lane & 15, fq = lane >> 4;
    unsigned voffA[2], voffB[2];
#pragma unroll
    for (int i = 0; i < 2; ++i) { int R, C; stage_rc(tid * 16 + i * 8192, R, C); const int Rb = Epi::PERM ? ((R & ~31) + perm32(R & 31)) : R; voffA[i] = (unsigned)(R * lda + C) * 2u; voffB[i] = (unsigned)(Rb * ldb + C) * 2u; }
    const size_t kstep = (size_t)(BK * 2);
    const size_t hstepA = (size_t)HALF * lda * 2;
    const unsigned ldsw = (unsigned)wid * 1024u;
    const int aoff = lds_byte(wr * 64 + fr, fq * 8), boff = lds_byte(wc * 32 + fr, fq * 8);
#define N1_SA(b, h) (((b) * 2 + (h)) * HTB)
#define N1_SB(b) ((4 + (b)) * HTB)
#define N1_STAGE(bufoff, gbase, voff) do { _Pragma("unroll") for (int _i = 0; _i < 2; ++_i) \
        __builtin_amdgcn_global_load_lds((const unsigned*)((const char*)(gbase) + (voff)[_i]), (LAS unsigned*)(lds + (bufoff) + ldsw + _i * 8192), 16, 0, 0); } while (0)
#define N1_LDA(dst, b, h) do { _Pragma("unroll") for (int m = 0; m < 4; ++m) _Pragma("unroll") for (int k = 0; k < 2; ++k) dst[m][k] = *(const LAS bf16x8*)(lds + N1_SA(b, h) + aoff + m * 2048 + k * 1024); } while (0)
#define N1_LDB(dst, b) do { _Pragma("unroll") for (int n = 0; n < 2; ++n) _Pragma("unroll") for (int k = 0; k < 2; ++k) dst[n][k] = *(const LAS bf16x8*)(lds + N1_SB(b) + boff + n * 2048 + k * 1024); } while (0)
#define N1_MMA(ai, At, Bt) do { __builtin_amdgcn_s_setprio(1); _Pragma("unroll") for (int m = 0; m < 4; ++m) _Pragma("unroll") for (int n = 0; n < 2; ++n) _Pragma("unroll") for (int k = 0; k < 2; ++k) \
        acc[ai][m][n] = __builtin_amdgcn_mfma_f32_16x16x32_bf16(Bt[n][k], At[m][k], acc[ai][m][n], 0, 0, 0); __builtin_amdgcn_s_setprio(0); } while (0)
#define N1_WAIT_V(n) asm volatile("s_waitcnt vmcnt(" #n ")" ::: "memory")
#define N1_WAIT_L(n) asm volatile("s_waitcnt lgkmcnt(" #n ")" ::: "memory")
#define N1_BAR __builtin_amdgcn_s_barrier()
#define N1_SCHED __builtin_amdgcn_sched_barrier(0)
    GUnit cur, nxt; int ui = 0;
    if (!S.next(0, cur)) return;
    E.prepare(S, lds, tid);
    f32x4 acc[2][4][2];
#pragma unroll
    for (int x = 0; x < 2; ++x)
#pragma unroll
        for (int m = 0; m < 4; ++m)
#pragma unroll
            for (int n = 0; n < 2; ++n) acc[x][m][n] = (f32x4){0.f, 0.f, 0.f, 0.f};
    bf16x8 At[4][2], B0[2][2];
    const char* cA = cur.A; const char* cB = cur.B;
    N1_STAGE(N1_SB(0), cB, voffB); N1_STAGE(N1_SA(0, 0), cA, voffA); N1_STAGE(N1_SA(0, 1), cA + hstepA, voffA);
    if (wr == 1) N1_BAR;
    N1_WAIT_V(0); N1_BAR;
    N1_STAGE(N1_SB(1), cB + kstep, voffB); N1_STAGE(N1_SA(1, 0), cA + kstep, voffA);
    N1_BAR;
    for (;;) {
        const bool has_next = S.next(ui + 1, nxt);
        const char* nA = has_next ? nxt.A : cA; const char* nB = has_next ? nxt.B : cB;
        const int nt = cur.nt;
        for (int t = 0; t < nt; t += 2) {
            const bool last = (t == nt - 2);
            const char* a1 = cA + (size_t)(t + 1) * kstep;
            const char* a2 = last ? nA : cA + (size_t)(t + 2) * kstep; const char* b2 = last ? nB : cB + (size_t)(t + 2) * kstep;
            const char* a3 = a2 + kstep; const char* b3 = b2 + kstep;
            N1_LDB(B0, 0); N1_SCHED; N1_LDA(At, 0, 0); N1_STAGE(N1_SA(1, 1), a1 + hstepA, voffA);
            N1_WAIT_V(6); N1_WAIT_L(0); N1_BAR; N1_MMA(0, At, B0); N1_BAR; N1_SCHED;
            N1_LDA(At, 0, 1); N1_STAGE(N1_SA(0, 0), a2, voffA); N1_STAGE(N1_SB(0), b2, voffB);
            N1_WAIT_V(6); N1_WAIT_L(0); N1_BAR; N1_MMA(1, At, B0); N1_BAR; N1_SCHED;
            N1_LDB(B0, 1); N1_SCHED; N1_LDA(At, 1, 0); N1_STAGE(N1_SA(0, 1), a2 + hstepA, voffA);
            N1_WAIT_V(6); N1_WAIT_L(0); N1_BAR; N1_MMA(0, At, B0); N1_BAR; N1_SCHED;
            N1_LDA(At, 1, 1); N1_STAGE(N1_SA(1, 0), a3, voffA); N1_STAGE(N1_SB(1), b3, voffB);
            N1_WAIT_V(6); N1_WAIT_L(0); N1_BAR; N1_MMA(1, At, B0); N1_BAR; N1_SCHED;
        }
        if (wr == 0) N1_BAR;
        E(acc, cur, ui, wr, wc, fr, fq);
        if (!has_next) break;
#pragma unroll
        for (int x = 0; x < 2; ++x)
#pragma unroll
            for (int m = 0; m < 4; ++m)
#pragma unroll
                for (int n = 0; n < 2; ++n) acc[x][m][n] = (f32x4){0.f, 0.f, 0.f, 0.f};
        cur = nxt; cA = nA; cB = nB; ++ui;
        if (wr == 1) N1_BAR;
    }
    N1_WAIT_V(0);
    N1_BAR;
#undef N1_SA
#undef N1_SB
#undef N1_STAGE
#undef N1_LDA
#undef N1_LDB
#undef N1_MMA
#undef N1_WAIT_V
#undef N1_WAIT_L
#undef N1_BAR
#undef N1_SCHED
}
}
using pg8::GUnit;
typedef f32x4 AccT[2][2][4][2];
typedef f32x4 AccH[2][4][2];

template <class Sched> __device__ __forceinline__ void prep_rstd(LAS unsigned char* lds, const float* ssp, const Sched& S, bool cols, int tid) {
    LAS float* R = (LAS float*)(lds + RSTD_OFF);
    if (tid < 256) {
        f32x4 p[3][8]; bool ok[3];
#pragma unroll
        for (int i = 0; i < 3; ++i) { GUnit u; ok[i] = S.next(i, u);
            if (ok[i]) { const f32x4* q = (const f32x4*)(ssp + (size_t)((cols ? u.col0 : u.row0) + tid) * SSPN);
#pragma unroll
                for (int k = 0; k < 8; ++k) p[i][k] = q[k]; } }
#pragma unroll
        for (int i = 0; i < 3; ++i) if (ok[i]) { const f32x4 s4 = ((p[i][0] + p[i][1]) + (p[i][2] + p[i][3])) + ((p[i][4] + p[i][5]) + (p[i][6] + p[i][7]));
            R[i * 256 + tid] = rsqrtf(((s4[0] + s4[1]) + (s4[2] + s4[3])) * (1.f / 1024.f) + EPS); }
    }
    LDS_WAIT(); __builtin_amdgcn_s_barrier(); asm volatile("" ::: "memory");
}
struct EpiQKV {
    bf16_t* Q; bf16_t* KB; bf16_t* VB; float* nk; float* nv; const float* ropec; const float* ropes; const float* ssp; const float* sw; LAS unsigned char* lds;
    static constexpr bool PERM = false;
    template <class Sched> __device__ __forceinline__ void prepare(const Sched& S, LAS unsigned char* l, int tid) const { prep_rstd(l, ssp, S, false, tid); }
    __device__ __forceinline__ void operator()(const AccT& acc, const GUnit& u, int ui, int wr, int wc, int fr, int fq) const {
        const LAS float* R = (const LAS float*)(lds + RSTD_OFF) + ui * 256;
        const int sec = u.col0 >> 10;
        const bool lat = u.row0 >= NCTX;
        const int cbase = (u.col0 & 1023) + wc * 32 + 4 * fq;
        const float* swc = sw + cond_of_row(u.row0) * 3072 + u.col0 + wc * 32 + 4 * fq;
        f32x4 sv[2][2];
#pragma unroll
        for (int bj = 0; bj < 2; ++bj)
#pragma unroll
            for (int n = 0; n < 2; ++n) sv[bj][n] = *(const f32x4*)(swc + bj * 128 + n * 16);
#pragma unroll
        for (int ai = 0; ai < 2; ++ai)
#pragma unroll
            for (int m = 0; m < 4; ++m) {
                const int rl = ai * 128 + wr * 64 + m * 16 + fr, r = u.row0 + rl;
                const float rs = R[rl];
                int t = 0, kvrow = r; size_t orow = 0;
                if (lat) { const int rr = r - NCTX; t = rr & 1023; kvrow = NCTX + (rr >> 10) * 1536 + 512 + t; }
                else { const int b = r >> 8; orow = ((size_t)(b * 2) * 256 + (r & 255)) * 1024; }
                f32x4 cs = {1.f, 1.f, 1.f, 1.f}, sn = {0.f, 0.f, 0.f, 0.f};
                if (lat && sec < 2) { const int pos = (wc & 1) ? (t & 63) : (t >> 6); cs = *(const f32x4*)(ropec + pos * 16 + 4 * fq); sn = *(const f32x4*)(ropes + pos * 16 + 4 * fq); }
#pragma unroll
                for (int bj = 0; bj < 2; ++bj) {
                    f32x4 x1 = acc[ai][bj][m][0] * rs + sv[bj][0], x2 = acc[ai][bj][m][1] * rs + sv[bj][1];
                    const int c = cbase + bj * 128;
                    if (sec < 2) { const f32x4 y1 = x1 * cs - x2 * sn, y2 = x2 * cs + x1 * sn; x1 = y1; x2 = y2; }
                    u32x4 w; w.x = cvt_pk_bf16(x1[0], x1[1]); w.y = cvt_pk_bf16(x1[2], x1[3]); w.z = cvt_pk_bf16(x2[0], x2[1]); w.w = cvt_pk_bf16(x2[2], x2[3]);
                    const int c8 = c + 4 * fq;
                    if (sec == 0) *(u32x4*)(Q + (size_t)r * 1024 + c8) = w;
                    else {
                        *(u32x4*)((sec == 1 ? KB : VB) + (size_t)kvrow * 1024 + c8) = w;
                        if (!lat) { if (sec == 1) { float* o = nk + orow + c; *(f32x4*)o = x1; *(f32x4*)(o + 16) = x2; }
                                    else { float* o = nv + orow + c8; *(f32x4*)o = x1; *(f32x4*)(o + 4) = x2; } }
                    }
                }
            }
    }
};
struct EpiQKV128 {
    bf16_t* Q; bf16_t* KB; bf16_t* VB; float* nk; float* nv; const float* ropec; const float* ropes; const float* ssp; const float* sw; LAS unsigned char* lds;
    static constexpr bool PERM = false;
    template <class Sched> __device__ __forceinline__ void prepare(const Sched& S, LAS unsigned char* l, int tid) const { prep_rstd(l, ssp, S, false, tid); }
    __device__ __forceinline__ void operator()(const AccH& acc, const GUnit& u, int ui, int wr, int wc, int fr, int fq) const {
        const LAS float* R = (const LAS float*)(lds + RSTD_OFF) + ui * 256;
        const int sec = u.col0 >> 10;
        const bool lat = u.row0 >= NCTX;
        const int c = (u.col0 & 1023) + wc * 32 + 4 * fq;
        const float* swc = sw + cond_of_row(u.row0) * 3072 + u.col0 + wc * 32 + 4 * fq;
        const f32x4 sv0 = *(const f32x4*)swc, sv1 = *(const f32x4*)(swc + 16);
#pragma unroll
        for (int ai = 0; ai < 2; ++ai)
#pragma unroll
            for (int m = 0; m < 4; ++m) {
                const int rl = ai * 128 + wr * 64 + m * 16 + fr, r = u.row0 + rl;
                const float rs = R[rl];
                int t = 0, kvrow = r; size_t orow = 0;
                if (lat) { const int rr = r - NCTX; t = rr & 1023; kvrow = NCTX + (rr >> 10) * 1536 + 512 + t; }
                else { const int b = r >> 8; orow = ((size_t)(b * 2) * 256 + (r & 255)) * 1024; }
                f32x4 cs = {1.f, 1.f, 1.f, 1.f}, sn = {0.f, 0.f, 0.f, 0.f};
                if (lat && sec < 2) { const int pos = (wc & 1) ? (t & 63) : (t >> 6); cs = *(const f32x4*)(ropec + pos * 16 + 4 * fq); sn = *(const f32x4*)(ropes + pos * 16 + 4 * fq); }
                f32x4 x1 = acc[ai][m][0] * rs + sv0, x2 = acc[ai][m][1] * rs + sv1;
                if (sec < 2) { const f32x4 y1 = x1 * cs - x2 * sn, y2 = x2 * cs + x1 * sn; x1 = y1; x2 = y2; }
                u32x4 w; w.x = cvt_pk_bf16(x1[0], x1[1]); w.y = cvt_pk_bf16(x1[2], x1[3]); w.z = cvt_pk_bf16(x2[0], x2[1]); w.w = cvt_pk_bf16(x2[2], x2[3]);
                const int c8 = c + 4 * fq;
                if (sec == 0) *(u32x4*)(Q + (size_t)r * 1024 + c8) = w;
                else {
                    *(u32x4*)((sec == 1 ? KB : VB) + (size_t)kvrow * 1024 + c8) = w;
                    if (!lat) { if (sec == 1) { float* o = nk + orow + c; *(f32x4*)o = x1; *(f32x4*)(o + 16) = x2; }
                                else { float* o = nv + orow + c8; *(f32x4*)o = x1; *(f32x4*)(o + 4) = x2; } }
                }
            }
    }
};
struct EpiResid {
    float* X; const float* gate; const float* an; bf16_t* XA; float* ssp;
    static constexpr bool PERM = true;
    template <class Sched> __device__ __forceinline__ void prepare(const Sched&, LAS unsigned char*, int) const {}
    __device__ __forceinline__ void operator()(const AccT& acc, const GUnit& u, int ui, int wr, int wc, int fr, int fq) const {
        const int cbase = u.col0 + wc * 32 + 8 * fq;
        const int cnd = cond_of_row(u.row0);
        const float* g = gate + cnd * 6144;
        f32x4 gv[2][2];
#pragma unroll
        for (int bj = 0; bj < 2; ++bj)
#pragma unroll
            for (int n = 0; n < 2; ++n) gv[bj][n] = *(const f32x4*)(g + cbase + bj * 128 + n * 4);
        const float* anc = an + cnd * 1024 + cbase;
        const int slot = (u.col0 >> 8) * 4 + wc;
#pragma unroll
        for (int ai = 0; ai < 2; ++ai) {
#pragma unroll
            for (int mp = 0; mp < 2; ++mp) {
            f32x4 xo[2][2][2];
#pragma unroll
            for (int m2 = 0; m2 < 2; ++m2)
#pragma unroll
                for (int bj = 0; bj < 2; ++bj)
#pragma unroll
                    for (int n = 0; n < 2; ++n) xo[m2][bj][n] = *(const f32x4*)(X + (size_t)(u.row0 + ai * 128 + wr * 64 + (mp * 2 + m2) * 16 + fr) * 1024 + cbase + bj * 128 + n * 4);
#pragma unroll
            for (int m2 = 0; m2 < 2; ++m2) {
                const int m = mp * 2 + m2;
                const size_t ro = (size_t)(u.row0 + ai * 128 + wr * 64 + m * 16 + fr);
                float ss = 0.f;
#pragma unroll
                for (int bj = 0; bj < 2; ++bj) {
                    const f32x4 x0 = xo[m2][bj][0] + gv[bj][0] * acc[ai][bj][m][0], x1 = xo[m2][bj][1] + gv[bj][1] * acc[ai][bj][m][1];
                    *(f32x4*)(X + ro * 1024 + cbase + bj * 128) = x0; *(f32x4*)(X + ro * 1024 + cbase + bj * 128 + 4) = x1;
                    ss += ((x0[0] * x0[0] + x0[1] * x0[1]) + (x0[2] * x0[2] + x0[3] * x0[3])) + ((x1[0] * x1[0] + x1[1] * x1[1]) + (x1[2] * x1[2] + x1[3] * x1[3]));
                    if (an) { const f32x4 y0 = x0 * *(const f32x4*)(anc + bj * 128), y1 = x1 * *(const f32x4*)(anc + bj * 128 + 4); u32x4 w; w.x = cvt_pk_bf16(y0[0], y0[1]); w.y = cvt_pk_bf16(y0[2], y0[3]); w.z = cvt_pk_bf16(y1[0], y1[1]); w.w = cvt_pk_bf16(y1[2], y1[3]);
                        *(u32x4*)(XA + ro * 1024 + cbase + bj * 128) = w; }
                }
                ss += __shfl_xor(ss, 16); ss += __shfl_xor(ss, 32);
                if (fq == 0) ssp[ro * SSPN + slot] = ss;
            }
            }
            asm volatile("" ::: "memory");
        }
    }
};
struct EpiResid128 {
    bf16_t* X; const float* gate; const float* an; bf16_t* XA; float* ssp;
    static constexpr bool PERM = true;
    template <class Sched> __device__ __forceinline__ void prepare(const Sched&, LAS unsigned char*, int) const {}
    __device__ __forceinline__ void operator()(const AccH& acc, const GUnit& u, int ui, int wr, int wc, int fr, int fq) const {
        const int cbase = u.col0 + wc * 32 + 8 * fq;
        const int cnd = cond_of_row(u.row0);
        const float* g = gate + cnd * 6144;
        const f32x4 gv0 = *(const f32x4*)(g + cbase), gv1 = *(const f32x4*)(g + cbase + 4);
        f32x4 av0 = {0.f, 0.f, 0.f, 0.f}, av1 = av0;
        if (an) { av0 = *(const f32x4*)(an + cnd * 1024 + cbase); av1 = *(const f32x4*)(an + cnd * 1024 + cbase + 4); }
        const int slot = (u.col0 >> 7) * 4 + wc;
        u32x4 xo[2][4];
#pragma unroll
        for (int ai = 0; ai < 2; ++ai)
#pragma unroll
            for (int m = 0; m < 4; ++m) xo[ai][m] = *(const u32x4*)(X + (size_t)(u.row0 + ai * 128 + wr * 64 + m * 16 + fr) * 1024 + cbase);
#pragma unroll
        for (int ai = 0; ai < 2; ++ai)
#pragma unroll
            for (int m = 0; m < 4; ++m) {
                const size_t ro = (size_t)(u.row0 + ai * 128 + wr * 64 + m * 16 + fr);
                const u32x4 xw = xo[ai][m];
                const f32x4 xa = {bflo(xw.x), bfhi(xw.x), bflo(xw.y), bfhi(xw.y)}, xb = {bflo(xw.z), bfhi(xw.z), bflo(xw.w), bfhi(xw.w)};
                const f32x4 x0 = xa + gv0 * acc[ai][m][0], x1 = xb + gv1 * acc[ai][m][1];
                { u32x4 w; w.x = cvt_pk_bf16(x0[0], x0[1]); w.y = cvt_pk_bf16(x0[2], x0[3]); w.z = cvt_pk_bf16(x1[0], x1[1]); w.w = cvt_pk_bf16(x1[2], x1[3]); *(u32x4*)(X + ro * 1024 + cbase) = w; }
                float ss = ((x0[0] * x0[0] + x0[1] * x0[1]) + (x0[2] * x0[2] + x0[3] * x0[3])) + ((x1[0] * x1[0] + x1[1] * x1[1]) + (x1[2] * x1[2] + x1[3] * x1[3]));
                if (an) { const f32x4 y0 = x0 * av0, y1 = x1 * av1; u32x4 w; w.x = cvt_pk_bf16(y0[0], y0[1]); w.y = cvt_pk_bf16(y0[2], y0[3]); w.z = cvt_pk_bf16(y1[0], y1[1]); w.w = cvt_pk_bf16(y1[2], y1[3]);
                    *(u32x4*)(XA + ro * 1024 + cbase) = w; }
                ss += __shfl_xor(ss, 16); ss += __shfl_xor(ss, 32);
                if (fq == 0) ssp[ro * SSPN + slot] = ss;
            }
    }
};
struct EpiG128 {
    bf16_t* GH; const float* ssp; const float* sw; LAS unsigned char* lds;
    static constexpr bool PERM = true;
    template <class Sched> __device__ __forceinline__ void prepare(const Sched& S, LAS unsigned char* l, int tid) const { prep_rstd(l, ssp, S, false, tid); }
    __device__ __forceinline__ void operator()(const AccH& acc, const GUnit& u, int ui, int wr, int wc, int fr, int fq) const {
        const LAS float* R = (const LAS float*)(lds + RSTD_OFF) + ui * 256;
        const float* swc = sw + cond_of_row(u.row0) * 5120 + u.col0 + wc * 32 + 8 * fq;
        const f32x4 sv0 = *(const f32x4*)swc, sv1 = *(const f32x4*)(swc + 4);
        const int cbase = (u.col0 - 4096) + wc * 32 + 8 * fq;
#pragma unroll
        for (int ai = 0; ai < 2; ++ai)
#pragma unroll
            for (int m = 0; m < 4; ++m) {
                const int rl = ai * 128 + wr * 64 + m * 16 + fr; const float rs = R[rl];
                const f32x4 v0 = acc[ai][m][0] * rs + sv0, v1 = acc[ai][m][1] * rs + sv1;
                u32x4 w; w.x = cvt_pk_bf16(silu_f(v0[0]), silu_f(v0[1])); w.y = cvt_pk_bf16(silu_f(v0[2]), silu_f(v0[3])); w.z = cvt_pk_bf16(silu_f(v1[0]), silu_f(v1[1])); w.w = cvt_pk_bf16(silu_f(v1[2]), silu_f(v1[3]));
                *(u32x4*)(GH + (size_t)(u.row0 + rl) * 1024 + cbase) = w;
            }
    }
};
struct EpiFFN {
    bf16_t* ACT; const float* ssp; const float* sw; LAS unsigned char* lds;
    static constexpr bool PERM = true;
    template <class Sched> __device__ __forceinline__ void prepare(const Sched& S, LAS unsigned char* l, int tid) const { prep_rstd(l, ssp, S, false, tid); }
    __device__ __forceinline__ void operator()(const AccT& acc, const GUnit& u, int ui, int wr, int wc, int fr, int fq) const {
        const LAS float* R = (const LAS float*)(lds + RSTD_OFF) + ui * 256;
        const int abase = (u.col0 >> 1) + wc * 32 + 8 * fq;
        const float* swc = sw + cond_of_row(u.row0) * 5632 + u.col0 + wc * 32 + 8 * fq;
        f32x4 sv[2][2];
#pragma unroll
        for (int bj = 0; bj < 2; ++bj)
#pragma unroll
            for (int n = 0; n < 2; ++n) sv[bj][n] = *(const f32x4*)(swc + bj * 128 + n * 4);
#pragma unroll
        for (int ai = 0; ai < 2; ++ai)
#pragma unroll
            for (int m = 0; m < 4; ++m) {
                const int rl = ai * 128 + wr * 64 + m * 16 + fr;
                const float rs = R[rl];
                u32x4 w;
#pragma unroll
                for (int n = 0; n < 2; ++n) {
                    const f32x4 g = acc[ai][0][m][n] * rs + sv[0][n], up = acc[ai][1][m][n] * rs + sv[1][n];
                    w[2 * n] = cvt_pk_bf16(silu_f(g[0]) * up[0], silu_f(g[1]) * up[1]); w[2 * n + 1] = cvt_pk_bf16(silu_f(g[2]) * up[2], silu_f(g[3]) * up[3]);
                }
                *(u32x4*)(ACT + (size_t)(u.row0 + rl) * DFF + abase) = w;
            }
    }
};
__device__ __forceinline__ void quad_transpose(f32x4& v, int qi) {
#define QT_X1(x) __int_as_float(__builtin_amdgcn_update_dpp(0, __float_as_int(x), 0xB1, 0xF, 0xF, true))
#define QT_X2(x) __int_as_float(__builtin_amdgcn_update_dpp(0, __float_as_int(x), 0x4E, 0xF, 0xF, true))
    const bool o1 = qi & 1, o2 = qi & 2;
    { const float t0 = o1 ? v[0] : v[1], t1 = o1 ? v[2] : v[3]; const float r0 = QT_X1(t0), r1 = QT_X1(t1);
      if (o1) { v[0] = r0; v[2] = r1; } else { v[1] = r0; v[3] = r1; } }
    { const float t0 = o2 ? v[0] : v[2], t1 = o2 ? v[1] : v[3]; const float r0 = QT_X2(t0), r1 = QT_X2(t1);
      if (o2) { v[0] = r0; v[1] = r1; } else { v[2] = r0; v[3] = r1; } }
#undef QT_X1
#undef QT_X2
}
#define DPP_SHR(x, N) __int_as_float(__builtin_amdgcn_update_dpp(0, __float_as_int(x), 0x110 + (N), 0xF, 0xF, true))
#define DPP_SHL(x, N) __int_as_float(__builtin_amdgcn_update_dpp(0, __float_as_int(x), 0x100 + (N), 0xF, 0xF, true))
struct EpiHgrn {
    bf16_t* GH; bf16_t* QTF; bf16_t* KTF; bf16_t* QTB; bf16_t* KTB; bf16_t* KHTF; bf16_t* KHTB; bf16_t* VT; float* DDF; float* DDB; const float* lbv; const float* ssp; const float* sw; LAS unsigned char* lds;
    static constexpr bool PERM = false;
    template <class Sched> __device__ __forceinline__ void prepare(const Sched& S, LAS unsigned char* l, int tid) const { prep_rstd(l, ssp, S, false, tid); }
    __device__ __forceinline__ void operator()(const AccT& acc, const GUnit& u, int ui, int wr, int wc, int fr, int fq) const {
        const LAS float* R = (const LAS float*)(lds + RSTD_OFF) + ui * 256;
        const int t = u.col0 >> 8;
        const float* swc = sw + cond_of_row(u.row0) * 5120 + u.col0 + wc * 32 + 4 * fq;
        f32x4 sv[2][2];
#pragma unroll
        for (int bj = 0; bj < 2; ++bj)
#pragma unroll
            for (int n = 0; n < 2; ++n) sv[bj][n] = *(const f32x4*)(swc + bj * 128 + n * 16);
        if (t >= 16) {
            const int cbase = (u.col0 - 4096) + wc * 32 + 4 * fq;
#pragma unroll
            for (int ai = 0; ai < 2; ++ai)
#pragma unroll
                for (int m = 0; m < 4; ++m) {
                    const int rl = ai * 128 + wr * 64 + m * 16 + fr; const float rs = R[rl];
#pragma unroll
                    for (int bj = 0; bj < 2; ++bj)
#pragma unroll
                        for (int n = 0; n < 2; ++n) { const f32x4 v = acc[ai][bj][m][n] * rs + sv[bj][n];
                            u32x2 w; w.x = cvt_pk_bf16(silu_f(v[0]), silu_f(v[1])); w.y = cvt_pk_bf16(silu_f(v[2]), silu_f(v[3]));
                            *(u32x2*)(GH + (size_t)(u.row0 + rl) * 1024 + cbase + bj * 128 + n * 16) = w; }
                }
            return;
        }
        const int h = t >> 1, kk = (t & 1) * 64 + wc * 16 + 4 * fq, chg = t * 64 + wc * 16 + 4 * fq;
        const f32x4 lb0 = *(const f32x4*)(lbv + chg), lb1 = *(const f32x4*)(lbv + 1024 + chg);
        const int lane = fq * 16 + fr;
#pragma unroll 1
        for (int am = 0; am < 8; ++am) {
            const int ai = am >> 2, m = am & 3;
            f32x4 aq, av, azf, azb;
            switch (am) {
#define HG_CASE(I) case I: aq = acc[(I) >> 2][0][(I) & 3][0]; av = acc[(I) >> 2][0][(I) & 3][1]; azf = acc[(I) >> 2][1][(I) & 3][0]; azb = acc[(I) >> 2][1][(I) & 3][1]; break;
                HG_CASE(0) HG_CASE(1) HG_CASE(2) HG_CASE(3) HG_CASE(4) HG_CASE(5) HG_CASE(6) default: aq = acc[1][0][3][0]; av = acc[1][0][3][1]; azf = acc[1][1][3][0]; azb = acc[1][1][3][1]; break;
#undef HG_CASE
            }
            const int rl = ai * 128 + wr * 64 + m * 16 + fr; const float rs = R[rl];
            const int tok = u.row0 + rl; const size_t cg = (size_t)((tok >> 4) * 8 + h);
            const f32x4 q4 = aq * rs + sv[0][0], v4 = av * rs + sv[0][1], zf = azf * rs + sv[1][0], zb = azb * rs + sv[1][1];
            f32x4 q, kf, kb, bf, bb;
#pragma unroll
            for (int j = 0; j < 4; ++j) { q[j] = silu_f(q4[j]);
                const float ff = lb0[j] + (1.f - lb0[j]) * sigmoid_f(zf[j]), fb = lb1[j] + (1.f - lb1[j]) * sigmoid_f(zb[j]);
                kf[j] = 1.f - ff; kb[j] = 1.f - fb; bf[j] = __logf(ff); bb[j] = __logf(fb); }
#pragma unroll
            for (int j = 0; j < 4; ++j) {
                float x = bf[j]; x += DPP_SHR(x, 1); x += DPP_SHR(x, 2); x += DPP_SHR(x, 4); x += DPP_SHR(x, 8); bf[j] = x;
                float y = bb[j]; y += DPP_SHL(y, 1); y += DPP_SHL(y, 2); y += DPP_SHL(y, 4); y += DPP_SHL(y, 8); bb[j] = y; }
            f32x4 qtf, ktf, khf, ddf, qtb, ktb, khb, ddb;
#pragma unroll
            for (int j = 0; j < 4; ++j) {
                const float ef = __expf(bf[j]), eif = __expf(-bf[j]), eb = __expf(bb[j]), eib = __expf(-bb[j]);
                ddf[j] = __shfl(ef, lane | 15); ddb[j] = __shfl(eb, lane & ~15);
                qtf[j] = q[j] * ef; ktf[j] = kf[j] * eif; khf[j] = ktf[j] * ddf[j];
                qtb[j] = q[j] * eb; ktb[j] = kb[j] * eib; khb[j] = ktb[j] * ddb[j]; }
            const size_t ro = (size_t)tok * 1024 + h * 128 + kk;
            { u32x2 w; w.x = cvt_pk_bf16(qtf[0], qtf[1]); w.y = cvt_pk_bf16(qtf[2], qtf[3]); *(u32x2*)(QTF + ro) = w; }
            { u32x2 w; w.x = cvt_pk_bf16(ktf[0], ktf[1]); w.y = cvt_pk_bf16(ktf[2], ktf[3]); *(u32x2*)(KTF + ro) = w; }
            { u32x2 w; w.x = cvt_pk_bf16(qtb[0], qtb[1]); w.y = cvt_pk_bf16(qtb[2], qtb[3]); *(u32x2*)(QTB + ro) = w; }
            { u32x2 w; w.x = cvt_pk_bf16(ktb[0], ktb[1]); w.y = cvt_pk_bf16(ktb[2], ktb[3]); *(u32x2*)(KTB + ro) = w; }
            f32x4 vt = v4;
            quad_transpose(khf, fr & 3); quad_transpose(khb, fr & 3); quad_transpose(vt, fr & 3);
            const size_t to = (cg * 128 + kk + (fr & 3)) * 16 + (fr & ~3);
            { u32x2 w; w.x = cvt_pk_bf16(khf[0], khf[1]); w.y = cvt_pk_bf16(khf[2], khf[3]); *(u32x2*)(KHTF + to) = w; }
            { u32x2 w; w.x = cvt_pk_bf16(khb[0], khb[1]); w.y = cvt_pk_bf16(khb[2], khb[3]); *(u32x2*)(KHTB + to) = w; }
            { u32x2 w; w.x = cvt_pk_bf16(vt[0], vt[1]); w.y = cvt_pk_bf16(vt[2], vt[3]); *(u32x2*)(VT + to) = w; }
            if (fr == 15) *(f32x4*)(DDF + cg * 128 + kk) = ddf;
            if (fr == 0) *(f32x4*)(DDB + cg * 128 + kk) = ddb;
        }
    }
};
struct EpiFour1 {
    bf16_t* ZT; const float* ssp; const float* sw; LAS unsigned char* lds;
    static constexpr bool PERM = true;
    template <class Sched> __device__ __forceinline__ void prepare(const Sched& S, LAS unsigned char* l, int tid) const { prep_rstd(l, ssp, S, true, tid); }
    __device__ __forceinline__ void operator()(const AccT& acc, const GUnit& u, int ui, int wr, int wc, int fr, int fq) const {
        const LAS float* R = (const LAS float*)(lds + RSTD_OFF) + ui * 256;
        const int cs = u.row0 >> 10;
        const float* swc = sw + cond_of_row(u.col0) * 2048 + u.row0 + wr * 64 + fr;
#pragma unroll
        for (int bj = 0; bj < 2; ++bj) {
            const int tl = bj * 128 + wc * 32 + 8 * fq, tok = u.col0 + tl;
            const f32x4 rs0 = *(const LAS f32x4*)(R + tl), rs1 = *(const LAS f32x4*)(R + tl + 4);
            int off;
            if (tok < NCTX) off = (tok >> 8) * 512 + cs * 256 + (tok & 255);
            else { const int tt = tok - NCTX; off = 8192 + (tt >> 10) * 2048 + cs * 1024 + (tt & 1023); }
#pragma unroll
            for (int ai = 0; ai < 2; ++ai)
#pragma unroll
                for (int m = 0; m < 4; ++m) {
                    const int nrow = (u.row0 & 1023) + ai * 128 + wr * 64 + m * 16 + fr;
                    const float sh = swc[ai * 128 + m * 16];
                    const f32x4 v0 = acc[ai][bj][m][0] * rs0 + sh, v1 = acc[ai][bj][m][1] * rs1 + sh;
                    u32x4 w; w.x = cvt_pk_bf16(v0[0], v0[1]); w.y = cvt_pk_bf16(v0[2], v0[3]); w.z = cvt_pk_bf16(v1[0], v1[1]); w.w = cvt_pk_bf16(v1[2], v1[3]);
                    *(u32x4*)(ZT + (size_t)nrow * 16384 + off) = w;
                }
        }
    }
};
struct EpiBf16 {
    bf16_t* O; int ldc;
    static constexpr bool PERM = false;
    template <class Sched> __device__ __forceinline__ void prepare(const Sched&, LAS unsigned char*, int) const {}
    __device__ __forceinline__ void operator()(const AccT& acc, const GUnit& u, int ui, int wr, int wc, int fr, int fq) const {
        bf16_t* base = O + (size_t)u.aux;
        const int cbase = u.col0 + wc * 32 + 4 * fq;
#pragma unroll
        for (int ai = 0; ai < 2; ++ai)
#pragma unroll
            for (int m = 0; m < 4; ++m) {
                bf16_t* pr = base + (size_t)(u.row0 + ai * 128 + wr * 64 + m * 16 + fr) * ldc + cbase;
#pragma unroll
                for (int bj = 0; bj < 2; ++bj)
#pragma unroll
                    for (int n = 0; n < 2; ++n) { const f32x4 v = acc[ai][bj][m][n]; u32x2 w; w.x = cvt_pk_bf16(v[0], v[1]); w.y = cvt_pk_bf16(v[2], v[3]); *(u32x2*)(pr + bj * 128 + n * 16) = w; }
            }
    }
};
struct GenSched {
    const char* A; const char* A2; const char* B; int lda, ldb, nM, nN, nwg, G, c, nt, mode;
    __device__ __forceinline__ void init(int mode_, const void* A_, const void* A2_, int lda_, const void* B_, int ldb_, int M, int N, int K, int G_, int c_) {
        mode = mode_; A = (const char*)A_; A2 = (const char*)A2_; B = (const char*)B_; lda = lda_; ldb = ldb_; nM = M / 256; nN = N / 256; nwg = (mode_ == 0 || mode_ == 7 || mode_ == 8) ? nM * nN : mode_ == 1 ? 128 : mode_ == 2 ? 32 : mode_ == 5 ? 512 : 256; G = G_; c = c_; nt = K / 64; }
    __device__ __forceinline__ bool next(int i, GUnit& u) const {
        const int L = i * G + c; if (L >= nwg) return false;
        u.aux = 0;
        if (mode == 0 || mode == 7 || mode == 8) {
            if (mode == 7 && i > 0) return false;
            int half = 0; int wgid = L; if (mode == 8) { if (i > 0) return false; half = L & 1; wgid = 256 + (L >> 1); if (wgid >= nM * nN) return false; } { const int q = nwg / 8, r = nwg % 8, xcd = wgid % 8, off = wgid / 8; wgid = (xcd < r ? xcd * (q + 1) : r * (q + 1) + (xcd - r) * q) + off; }
            const int nig = 8 * nN, gid = wgid / nig, fm = gid * 8, gsz = (nM - fm) < 8 ? (nM - fm) : 8;
            const int pm = fm + ((wgid % nig) % gsz), pn = (wgid % nig) / gsz;
            u.A = A + (size_t)pm * 256 * lda * 2; u.B = B + (size_t)(pn * 256 + half * 128) * ldb * 2; u.nt = nt; u.row0 = pm * 256; u.col0 = pn * 256 + half * 128;
        } else if (mode == 1) {
            if (L < 64) { const int b = L >> 4, pm = (L >> 2) & 3, pn = L & 3;
                u.A = A + (size_t)pm * 256 * 2048 * 2; u.B = B + ((size_t)pn * 256 * 16384 + 8192 + b * 2048) * 2; u.nt = 32; u.row0 = NCTX + b * 1024 + pm * 256; u.col0 = pn * 256; }
            else { const int l = L - 64, b = l >> 2, pn = l & 3;
                u.A = A2; u.B = B + ((size_t)pn * 256 * 16384 + b * 512) * 2; u.nt = 8; u.row0 = b * 256; u.col0 = pn * 256; }
        } else if (mode == 5) {
            int wgid = L; { const int xcd = wgid % 8, off = wgid / 8; wgid = xcd * 64 + off; }
            const int gid = wgid >> 7, r = wgid & 127, pm = gid * 8 + (r & 7), pn = r >> 3;
            u.A = A + (size_t)pm * 256 * lda * 2; u.B = B + (size_t)pn * 256 * ldb * 2; u.nt = nt; u.row0 = pm * 256; u.col0 = pn * 256;
        } else if (mode == 6) {
            const int wgid = (L & 7) * 32 + (L >> 3), pm = wgid >> 3, pn = wgid & 7;
            u.A = A + (size_t)pm * 256 * lda * 2; u.B = B + (size_t)(4096 + pn * 128) * ldb * 2; u.nt = nt; u.row0 = pm * 256; u.col0 = 4096 + pn * 128;
        } else if (mode == 3) {
            const int wgid = (L & 7) * 32 + (L >> 3), pm = wgid >> 3, pn = wgid & 7;
            u.A = A + (size_t)pm * 256 * lda * 2; u.B = B + (size_t)pn * 128 * ldb * 2; u.nt = nt; u.row0 = pm * 256; u.col0 = pn * 128;
        } else if (mode == 4) {
            if (L < 128) { const int b = L >> 5, pm = (L >> 3) & 3, pn = L & 7;
                u.A = A + (size_t)pm * 256 * 2048 * 2; u.B = B + ((size_t)pn * 128 * 16384 + 8192 + b * 2048) * 2; u.nt = 32; u.row0 = NCTX + b * 1024 + pm * 256; u.col0 = pn * 128; }
            else { const int l = L - 128, b = l >> 3, pn = l & 7;
                u.A = A2; u.B = B + ((size_t)pn * 128 * 16384 + b * 512) * 2; u.nt = 8; u.row0 = b * 256; u.col0 = pn * 128; }
        } else {
            const int g = L >> 3, cs = (L >> 2) & 1, pm = L & 3;
            u.A = A + ((size_t)pm * 256 * 1024 + g * 256) * 2; u.B = B + (size_t)cs * 256 * 2; u.nt = nt;
            u.row0 = pm * 256; u.col0 = 0; u.aux = cs * 1024 * 1024 + g * 256;
        }
        return true;
    }
};
struct Args {
    const float* in[23];
    float* out; unsigned char* ws;
    int ph_lo, ph_hi; float lam_init0, lam_init1; int pad0, pad1;
};
typedef const __attribute__((address_space(4))) Args* ArgP;
enum { I_XP = 0, I_XS, I_CK, I_CV, I_ST, I_C, I_CCTX, I_WADA, I_BADA, I_GMIX, I_GFFN, I_WQKV, I_LAM, I_GSUB, I_WOA, I_WINR, I_LBL, I_GOUT, I_WOR, I_WFOUR, I_WFI, I_WFO, I_GFIN };

template <class RowMap>
__device__ __forceinline__ void transpose_item(const float* W, int K, int N, bf16_t* WT, const RowMap& rowmap, LAS float* scr, int item, int lane) {
    const int nblk = N / 32, kb = item / nblk, nb = item % nblk, k0 = 64 * kb, n0 = 32 * nb;
#pragma unroll
    for (int i = 0; i < 8; ++i) { const int kk = 8 * i + (lane >> 3), c4 = (lane & 7) * 4; const f32x4 v = __builtin_nontemporal_load((const f32x4*)(W + (size_t)(k0 + kk) * N + n0 + c4));
        LAS float* d = scr + kk * 33 + c4; d[0] = v[0]; d[1] = v[1]; d[2] = v[2]; d[3] = v[3]; }
    LDS_WAIT(); asm volatile("" ::: "memory");
    const int c = lane & 7;
#pragma unroll
    for (int j = 0; j < 4; ++j) { const int n = (lane >> 3) + 8 * j; const LAS float* s = scr + (8 * c) * 33 + n;
        u32x4 o; o.x = cvt_pk_bf16(s[0 * 33], s[1 * 33]); o.y = cvt_pk_bf16(s[2 * 33], s[3 * 33]); o.z = cvt_pk_bf16(s[4 * 33], s[5 * 33]); o.w = cvt_pk_bf16(s[6 * 33], s[7 * 33]);
        *(u32x4*)(WT + (size_t)rowmap(n0 + n) * K + k0 + 8 * c) = o; }
    LDS_WAIT(); asm volatile("" ::: "memory");
}
struct RowHin { __device__ __forceinline__ int operator()(int s) const { const int sec = s >> 10, ch = s & 1023; if (sec == 2) return 4096 + ch;
    const int t = ch >> 6, cl = ch & 63, bj = sec >= 3 ? 1 : 0, n = (sec == 1 || sec == 4) ? 1 : 0; return 256 * t + 128 * bj + 32 * (cl >> 4) + 16 * n + (cl & 15); } };
struct RowQKV { __device__ __forceinline__ int operator()(int s) const { if (s < 2048) return s; const int p = s & 31; return (s & ~31) + 16 * ((p >> 2) & 1) + 4 * (p >> 3) + (p & 3); } };
struct RowId { __device__ __forceinline__ int operator()(int n) const { return n; } };
struct RowFFN { __device__ __forceinline__ int operator()(int s) const { const int n = s >= DFF ? 1 : 0, a = s - n * DFF; return 256 * (a >> 7) + 128 * n + (a & 127); } };

__device__ __forceinline__ void cache_convert(ArgP a, int j, int gw, int ngw, int lane) {
    bf16_t* KB = (bf16_t*)(a->ws + WS_KB); bf16_t* VB = (bf16_t*)(a->ws + WS_VB);
    for (int it = gw; it < 2 * 4 * 512; it += ngw) {
        const int kv = it >> 11, r = it & 2047, b = r >> 9, s = r & 511;
        const float* src = a->in[kv ? I_CV : I_CK] + ((size_t)(b * 2 + j) * 512 + s) * 1024;
        bf16_t* dst = (kv ? VB : KB) + (size_t)(NCTX + b * 1536 + s) * 1024;
#pragma unroll
        for (int q = 0; q < 2; ++q) { const f32x8 v = *(const f32x8*)(src + q * 512 + lane * 8);
            u32x4 w; w.x = cvt_pk_bf16(v[0], v[1]); w.y = cvt_pk_bf16(v[2], v[3]); w.z = cvt_pk_bf16(v[4], v[5]); w.w = cvt_pk_bf16(v[6], v[7]);
            if (kv) *(u32x4*)(dst + q * 512 + lane * 8) = w;
            else { const int d0 = q * 512 + lane * 8, p0 = d0 & 31, n = p0 >> 4, f0 = (p0 & 15) >> 2;
                bf16_t* g = dst + (d0 & ~31);
                u32x2 lo, hi; lo.x = w.x; lo.y = w.y; hi.x = w.z; hi.y = w.w;
                *(u32x2*)(g + 8 * f0 + 4 * n) = lo; *(u32x2*)(g + 8 * (f0 + 1) + 4 * n) = hi; } }
    }
}

__device__ __forceinline__ void phase_prologue(ArgP a, LAS unsigned char* lds, int G, int bid) {
    const int tid = tid_opaque(), lane = tid & 63, wave = __builtin_amdgcn_readfirstlane(tid >> 6);
    const int gw = bid * NWAVES + wave, ngw = G * NWAVES, gt = bid * NTHREADS + tid, ngt = G * NTHREADS;
    {
        LAS float* SC = (LAS float*)lds;
        LAS float* RED = (LAS float*)(lds + 20480);
        for (int i = tid; i < 5 * 1024; i += NTHREADS) { const int cnd = i >> 10, k = i & 1023; const float x = cnd == 0 ? a->in[I_CCTX][k] : a->in[I_C][(cnd - 1) * 1024 + k]; SC[i] = silu_f(x); }
        __syncthreads();
        float* mod = (float*)(a->ws + WS_MOD);
        for (int it = bid; it < 4 * 48; it += G) {
            const int l = it / 48, cg = it % 48;
            const float* w = a->in[I_WADA] + (size_t)l * 1024 * 6144 + (size_t)(wave * 128) * 6144 + cg * 128 + lane * 2;
            float acc[5][2];
#pragma unroll
            for (int c = 0; c < 5; ++c) { acc[c][0] = 0.f; acc[c][1] = 0.f; }
            for (int k0 = 0; k0 < 128; k0 += 8) {
                f32x2 wv[8];
#pragma unroll
                for (int kk = 0; kk < 8; ++kk) wv[kk] = *(const f32x2*)(w + (size_t)(k0 + kk) * 6144);
#pragma unroll
                for (int kk = 0; kk < 8; ++kk)
#pragma unroll
                    for (int c = 0; c < 5; ++c) { const float s = SC[c * 1024 + wave * 128 + k0 + kk]; acc[c][0] += s * wv[kk].x; acc[c][1] += s * wv[kk].y; }
            }
#pragma unroll
            for (int c = 0; c < 5; ++c) { RED[(wave * 5 + c) * 128 + lane * 2] = acc[c][0]; RED[(wave * 5 + c) * 128 + lane * 2 + 1] = acc[c][1]; }
            __syncthreads();
            for (int i = tid; i < 5 * 128; i += NTHREADS) { const int c = i >> 7, col = i & 127; float s = 0.f;
#pragma unroll
                for (int wv2 = 0; wv2 < 8; ++wv2) s += RED[(wv2 * 5 + c) * 128 + col];
                mod[(size_t)(l * 5 + c) * 6144 + cg * 128 + col] = s + a->in[I_BADA][l * 6144 + cg * 128 + col]; }
            __syncthreads();
        }
    }
    {
        LAS float* scr = (LAS float*)(lds + wave * 16384);
        constexpr int I_Q = 16 * 96, I_O = 16 * 32, I_R = 16 * 160, I_FI = 16 * 176, I_FO = 44 * 32;
        constexpr int NIT = 2 * I_Q + 2 * I_O + I_R + I_O + I_O + 4 * I_FI + 4 * I_FO;
        for (int it = gw; it < NIT; it += ngw) {
            int r = it;
            if (r < 2 * I_Q) { const int j = r / I_Q; transpose_item(a->in[I_WQKV] + (size_t)j * 1024 * 3072, 1024, 3072, (bf16_t*)(a->ws + WS_WQKV) + (size_t)j * 3072 * 1024, RowQKV(), scr, r % I_Q, lane); continue; } r -= 2 * I_Q;
            if (r < 2 * I_O) { const int j = r / I_O; transpose_item(a->in[I_WOA] + (size_t)j * 1024 * 1024, 1024, 1024, (bf16_t*)(a->ws + WS_WOA) + (size_t)j * 1024 * 1024, RowId(), scr, r % I_O, lane); continue; } r -= 2 * I_O;
            if (r < I_R) { transpose_item(a->in[I_WINR], 1024, 5120, (bf16_t*)(a->ws + WS_WINR), RowHin(), scr, r, lane); continue; } r -= I_R;
            if (r < I_O) { transpose_item(a->in[I_WOR], 1024, 1024, (bf16_t*)(a->ws + WS_WOR), RowId(), scr, r, lane); continue; } r -= I_O;
            if (r < I_O) { transpose_item(a->in[I_WFOUR], 1024, 1024, (bf16_t*)(a->ws + WS_WFO), RowId(), scr, r, lane); continue; } r -= I_O;
            if (r < 4 * I_FI) { const int l = r / I_FI; transpose_item(a->in[I_WFI] + (size_t)l * 1024 * 5632, 1024, 5632, (bf16_t*)(a->ws + WS_WFI) + (size_t)l * 5632 * 1024, RowFFN(), scr, r % I_FI, lane); continue; } r -= 4 * I_FI;
            { const int l = r / I_FO; transpose_item(a->in[I_WFO] + (size_t)l * DFF * 1024, DFF, 1024, (bf16_t*)(a->ws + WS_WFOUT) + (size_t)l * 1024 * DFF, RowId(), scr, r % I_FO, lane); }
        }
    }
    {
        float* ropec = (float*)(a->ws + WS_ROPE); float* ropes = ropec + 1024;
        for (int i = gt; i < 1024; i += ngt) { const int pos = i >> 4, q = i & 15;
            float inv = (q & 3) == 0 ? 1.f : (q & 3) == 1 ? 0.56234132519f : (q & 3) == 2 ? 0.31622776602f : 0.17782794100f;
            inv *= (q >> 2) == 0 ? 1.f : (q >> 2) == 1 ? 0.1f : (q >> 2) == 2 ? 0.01f : 0.001f;
            const float ap = (float)pos * inv * 0.31830988618f;
            ropec[i] = cospif(ap); ropes[i] = sinpif(ap); }
        bf16_t* TC = (bf16_t*)(a->ws + WS_TC);
        for (int i = gt; i < 256 * 512; i += ngt) { const int c = i >> 9, k = i & 511, d = k & 255; const float ang = (float)((c * d) & 255) * (1.f / 128.f);
            const float v = (k < 256 ? cospif(ang) : sinpif(ang)) * 0.0625f; TC[c * 1024 + k] = (bf16_t)(cvt_pk_bf16(v, 0.f) & 0xffff); }
        bf16_t* C2 = (bf16_t*)(a->ws + WS_CS256);
        for (int i = gt; i < 256 * 512; i += ngt) { const int p = i >> 9, k = i & 511, t = k & 255; const float ang = (float)((p * t) & 255) * (1.f / 128.f);
            const float v = (k < 256 ? cospif(ang) : -sinpif(ang)) * 0.0625f; C2[p * 2048 + k] = (bf16_t)(cvt_pk_bf16(v, 0.f) & 0xffff); }
        bf16_t* C1 = (bf16_t*)(a->ws + WS_CS1024);
        for (int i = gt; i < 1024 * 2048; i += ngt) { const int p = i >> 11, k = i & 2047, t = k & 1023; const float ang = (float)((p * t) & 1023) * (1.f / 512.f);
            const float v = (k < 1024 ? cospif(ang) : -sinpif(ang)) * 0.03125f; C1[i] = (bf16_t)(cvt_pk_bf16(v, 0.f) & 0xffff); }
        float* lbv = (float*)(a->ws + WS_LBV);
        for (int i = gt; i < 2048; i += ngt) { const int d = i >> 10, k = i & 1023; const float* lg = a->in[I_LBL] + (size_t)d * 4096 + k;
            const float l0 = lg[0], l1 = lg[1024], l2 = lg[2048], l3 = lg[3072]; const float mx = fmaxf(fmaxf(l0, l1), fmaxf(l2, l3));
            const float e0 = __expf(l0 - mx), e1 = __expf(l1 - mx), e2 = __expf(l2 - mx), e3 = __expf(l3 - mx); lbv[i] = e1 / (e0 + e1 + e2 + e3); }
        if (gw < 2) { const int j = gw; const float* lp = a->in[I_LAM] + j * 256;
            float s1 = wave_sum(lp[lane] * lp[64 + lane]), s2 = wave_sum(lp[128 + lane] * lp[192 + lane]);
            if (lane == 0) ((float*)(a->ws + WS_LAM))[j] = __expf(s1) - __expf(s2) + (j == 0 ? a->lam_init0 : a->lam_init1); }
    }
    cache_convert(a, 0, gw, ngw, lane);
}

__device__ __forceinline__ void phase_first_norm(ArgP a, int gw, int ngw, int lane) {
    bf16_t* X = (bf16_t*)(a->ws + WS_X); bf16_t* XA = (bf16_t*)(a->ws + WS_H); float* ssp = (float*)(a->ws + WS_SSP);
    const float* an = (const float*)(a->ws + WS_AN);
    for (int r = gw; r < MTOK; r += ngw) {
        const float* xr = r < NCTX ? a->in[I_XP] + (size_t)r * 1024 : a->in[I_XS] + (size_t)(r - NCTX) * 1024;
        const float* ac = an + cond_of_row(r) * 1024;
        float s = 0.f;
#pragma unroll
        for (int j = 0; j < 4; ++j) {
            const int c = j * 256 + lane * 4;
            const f32x4 v = *(const f32x4*)(xr + c); s += (v.x * v.x + v.y * v.y) + (v.z * v.z + v.w * v.w);
            const f32x4 y = v * *(const f32x4*)(ac + c);
            u32x2 w; w.x = cvt_pk_bf16(y[0], y[1]); w.y = cvt_pk_bf16(y[2], y[3]);
            *(u32x2*)(XA + (size_t)r * 1024 + c) = w; { u32x2 xw; xw.x = cvt_pk_bf16(v[0], v[1]); xw.y = cvt_pk_bf16(v[2], v[3]); *(u32x2*)(X + (size_t)r * 1024 + c) = xw; }
        }
        s = wave_sum(s);
        if (lane < SSPN) ssp[(size_t)r * SSPN + lane] = lane == 0 ? s : 0.f;
    }
}
__device__ __forceinline__ void phase_final(ArgP a, int gw, int ngw, int lane) {
    const bf16_t* X = (const bf16_t*)(a->ws + WS_X); const float* g = a->in[I_GFIN]; const float* ssp = (const float*)(a->ws + WS_SSP) + 8ull * 8192 * SSPN;
    for (int r = gw; r < MTOK; r += ngw) {
        const bf16_t* xr = X + (size_t)r * 1024;
        float s = lane < SSPN ? ssp[(size_t)r * SSPN + lane] : 0.f;
        const float rstd = rsqrtf(wave_sum(s) * (1.f / 1024.f) + EPS);
#pragma unroll
        for (int j = 0; j < 4; ++j) { const int c = j * 256 + lane * 4; const u32x2 xw = *(const u32x2*)(xr + c); const f32x4 xv = {bflo(xw.x), bfhi(xw.x), bflo(xw.y), bfhi(xw.y)};
            *(f32x4*)(a->out + (size_t)r * 1024 + c) = xv * rstd * *(const f32x4*)(g + c); }
    }
}
__device__ __forceinline__ void phase_an(ArgP a, int gt, int ngt) {
    float* an = (float*)(a->ws + WS_AN); const float* mod = (const float*)(a->ws + WS_MOD);
    for (int i = gt; i < 8 * 5 * 1024; i += ngt) { const int nidx = i / 5120, c = (i / 1024) % 5, k = i & 1023, l = nidx >> 1, wh = nidx & 1;
        an[i] = a->in[wh ? I_GFFN : I_GMIX][l * 1024 + k] * (1.f + mod[(size_t)(l * 5 + c) * 6144 + (wh ? 4 : 1) * 1024 + k]); }
}
__device__ __forceinline__ void phase_sw(ArgP a, LAS unsigned char* lds, unsigned mask, int gw, int ngw, int tid, int lane) {
    LAS float* SH = (LAS float*)lds;
    const float* mod = (const float*)(a->ws + WS_MOD); float* swb = (float*)(a->ws + WS_SW);
    for (int nidx = 0; nidx < 8; ++nidx) {
        if (!((mask >> nidx) & 1)) continue;
        const int l = nidx >> 1, wh = nidx & 1, N = sw_n(nidx);
        const bf16_t* W = nidx == 0 ? (const bf16_t*)(a->ws + WS_WQKV) : nidx == 6 ? (const bf16_t*)(a->ws + WS_WQKV) + 3072ull * 1024 : nidx == 2 ? (const bf16_t*)(a->ws + WS_WINR)
                        : nidx == 4 ? (const bf16_t*)(a->ws + WS_WCS) : (const bf16_t*)(a->ws + WS_WFI) + (size_t)l * 5632 * 1024;
        __syncthreads();
        for (int i = tid; i < 5 * 1024; i += NTHREADS) SH[i] = mod[(size_t)(l * 5 + (i >> 10)) * 6144 + (wh ? 3 : 0) * 1024 + (i & 1023)];
        __syncthreads();
        float* sw = swb + sw_off(nidx);
        for (int n = gw; n < N; n += ngw) {
            const u32x4 w0 = *(const u32x4*)(W + (size_t)n * 1024 + lane * 8), w1 = *(const u32x4*)(W + (size_t)n * 1024 + 512 + lane * 8);
            float wf[16];
#pragma unroll
            for (int i = 0; i < 4; ++i) { wf[2 * i] = bflo(w0[i]); wf[2 * i + 1] = bfhi(w0[i]); wf[8 + 2 * i] = bflo(w1[i]); wf[8 + 2 * i + 1] = bfhi(w1[i]); }
            float acc[5];
#pragma unroll
            for (int c = 0; c < 5; ++c) {
                const f32x4 s0 = *(const LAS f32x4*)(SH + c * 1024 + lane * 8), s1 = *(const LAS f32x4*)(SH + c * 1024 + lane * 8 + 4);
                const f32x4 s2 = *(const LAS f32x4*)(SH + c * 1024 + 512 + lane * 8), s3 = *(const LAS f32x4*)(SH + c * 1024 + 512 + lane * 8 + 4);
                float t = 0.f;
#pragma unroll
                for (int i = 0; i < 4; ++i) t += wf[i] * s0[i] + wf[4 + i] * s1[i] + wf[8 + i] * s2[i] + wf[12 + i] * s3[i];
                acc[c] = wave_sum(t);
            }
            if (lane < 5) sw[(size_t)lane * N + n] = lane == 0 ? acc[0] : lane == 1 ? acc[1] : lane == 2 ? acc[2] : lane == 3 ? acc[3] : acc[4];
        }
    }
    __syncthreads();
}
__device__ __forceinline__ void phase_hgrn_final(ArgP a, int gw, int ngw, int lane) {
    const bf16_t* OF = (const bf16_t*)(a->ws + WS_OF); const bf16_t* OB = (const bf16_t*)(a->ws + WS_OB); const bf16_t* GH = (const bf16_t*)(a->ws + WS_GH);
    bf16_t* O = (bf16_t*)(a->ws + WS_O); const float* go = a->in[I_GOUT];
    for (int r = gw; r < MTOK; r += ngw) {
        const size_t off = (size_t)r * 1024 + lane * 16;
        u32x4 f0 = *(const u32x4*)(OF + off), f1 = *(const u32x4*)(OF + off + 8), b0 = *(const u32x4*)(OB + off), b1 = *(const u32x4*)(OB + off + 8);
        u32x4 g0 = *(const u32x4*)(GH + off), g1 = *(const u32x4*)(GH + off + 8);
        float o[16], gt[16];
#pragma unroll
        for (int i = 0; i < 4; ++i) { o[2 * i] = bflo(f0[i]) + bflo(b0[i]); o[2 * i + 1] = bfhi(f0[i]) + bfhi(b0[i]); o[8 + 2 * i] = bflo(f1[i]) + bflo(b1[i]); o[8 + 2 * i + 1] = bfhi(f1[i]) + bfhi(b1[i]);
            gt[2 * i] = bflo(g0[i]); gt[2 * i + 1] = bfhi(g0[i]); gt[8 + 2 * i] = bflo(g1[i]); gt[8 + 2 * i + 1] = bfhi(g1[i]); }
        float s = 0.f;
#pragma unroll
        for (int i = 0; i < 16; ++i) s += o[i] * o[i];
        s += __shfl_xor(s, 1); s += __shfl_xor(s, 2); s += __shfl_xor(s, 4);
        const float rstd = rsqrtf(s * (1.f / 128.f) + EPS);
        const int vc = (lane & 7) * 16;
        u32x4 w0, w1;
#pragma unroll
        for (int i = 0; i < 4; ++i) {
            w0[i] = cvt_pk_bf16(o[2 * i] * rstd * go[vc + 2 * i] * gt[2 * i], o[2 * i + 1] * rstd * go[vc + 2 * i + 1] * gt[2 * i + 1]);
            w1[i] = cvt_pk_bf16(o[8 + 2 * i] * rstd * go[vc + 8 + 2 * i] * gt[8 + 2 * i], o[8 + 2 * i + 1] * rstd * go[vc + 8 + 2 * i + 1] * gt[8 + 2 * i + 1]); }
        *(u32x4*)(O + off) = w0; *(u32x4*)(O + off + 8) = w1;
    }
}

namespace att {
constexpr int KVBLK = 64, LDQ = 1024;
constexpr float SCALE = 0.125f, THR = 8.f;
constexpr size_t SHM_V = KVBLK * 128 * 2, SHM_K = KVBLK * 128 * 2;
#define KSWZ(row, colB) ((row) * 256 + ((colB) ^ (((row) & 7) << 4)))
#define SBAR() __builtin_amdgcn_sched_barrier(0)
__device__ __forceinline__ int crow(int r, int hi) { return (r & 3) + 8 * (r >> 2) + 4 * hi; }
__device__ __forceinline__ unsigned cvtpk(float lo, float hi) { unsigned r; asm volatile("v_cvt_pk_bf16_f32 %0, %1, %2" : "=v"(r) : "v"(lo), "v"(hi)); return r; }
__device__ __forceinline__ void partialSM(f32x16& p0, f32x16& p1, float& m_reg, float& mn, float& alpha) {
  constexpr float C = SCALE * 1.4426950408889634f;
  float pmax = p0[0];
#pragma unroll
  for (int r = 1; r < 16; ++r) pmax = fmaxf(pmax, p0[r]);
#pragma unroll
  for (int r = 0; r < 16; ++r) pmax = fmaxf(pmax, p1[r]);
  { auto rr = __builtin_amdgcn_permlane32_swap(__float_as_uint(pmax), __float_as_uint(pmax), false, false);
    pmax = fmaxf(__uint_as_float(rr[0]), __uint_as_float(rr[1])); }
  if (__builtin_expect(__all(pmax - m_reg <= THR / SCALE), 1)) { mn = m_reg; alpha = 1.f; }
  else { mn = fmaxf(m_reg, pmax); alpha = __builtin_amdgcn_exp2f((m_reg - mn) * C); m_reg = mn; }
  float mnC = -mn * C;
#pragma unroll
  for (int r = 0; r < 16; ++r) p0[r] = fmaf(p0[r], C, mnC);
#pragma unroll
  for (int r = 0; r < 16; ++r) p1[r] = fmaf(p1[r], C, mnC);
#pragma unroll
  for (int r = 0; r < 16; ++r) p0[r] = __builtin_amdgcn_exp2f(p0[r]);
}
__device__ __forceinline__ void finishSM(f32x16& p0, f32x16& p1, float alpha, float& l_reg, bf16x8& pa0, bf16x8& pa1, bf16x8& pa2, bf16x8& pa3) {
#pragma unroll
  for (int r = 0; r < 16; ++r) p1[r] = __builtin_amdgcn_exp2f(p1[r]);
  float ps = 0;
#pragma unroll
  for (int r = 0; r < 16; ++r) ps += p0[r];
#pragma unroll
  for (int r = 0; r < 16; ++r) ps += p1[r];
  { auto rr = __builtin_amdgcn_permlane32_swap(__float_as_uint(ps), __float_as_uint(ps), false, false);
    ps = __uint_as_float(rr[0]) + __uint_as_float(rr[1]); }
  l_reg = l_reg * alpha + ps;
#define PK4(P, BASE, OUT) do { unsigned a0 = cvtpk(P[BASE + 0], P[BASE + 1]), a1 = cvtpk(P[BASE + 2], P[BASE + 3]);   \
    unsigned b0 = cvtpk(P[BASE + 4], P[BASE + 5]), b1 = cvtpk(P[BASE + 6], P[BASE + 7]);                              \
    auto r0 = __builtin_amdgcn_permlane32_swap(a0, b0, false, false); auto r1 = __builtin_amdgcn_permlane32_swap(a1, b1, false, false); \
    u32x4 w = {r0[0], r1[0], r0[1], r1[1]}; OUT = *reinterpret_cast<bf16x8*>(&w); } while (0)
  PK4(p0, 0, pa0); PK4(p0, 8, pa1); PK4(p1, 0, pa2); PK4(p1, 8, pa3);
#undef PK4
}
__device__ __forceinline__ void qkt(f32x16& p0, f32x16& p1, const bf16_t* Ks, const bf16x8* qr, int r32, int hi, int cc) {
  p0 = f32x16{}; p1 = f32x16{};
#pragma unroll
  for (int d0 = 0; d0 < 4; ++d0) { int cb = (cc * 64 + d0 * 16 + hi * 8) * 2;
    bf16x8 b0 = *reinterpret_cast<const bf16x8*>((const char*)Ks + KSWZ(r32, cb));
    bf16x8 b1 = *reinterpret_cast<const bf16x8*>((const char*)Ks + KSWZ(32 + r32, cb));
    p0 = __builtin_amdgcn_mfma_f32_32x32x16_bf16(b0, qr[d0], p0, 0, 0, 0);
    p1 = __builtin_amdgcn_mfma_f32_32x32x16_bf16(b1, qr[d0], p1, 0, 0, 0); }
}
__device__ __forceinline__ int v_st(int k, int c) { const int kk = (k & ~0xC) | ((k & 4) << 1) | ((k & 8) >> 1); return ((kk >> 3) * 4 + (c >> 5)) * 512 + ((kk & 7) * 32 + (c & 31)) * 2; }
__device__ __forceinline__ int v_rd_base(int lane) { return ((lane & 3) << 3) | (((lane >> 2) & 3) << 6) | (((lane >> 4) & 1) << 5) | (((lane >> 5) & 1) << 8); }
constexpr int v_rd_off(int d0, int ks, int half) { return d0 * 512 + ks * 4096 + half * 2048; }
template <int OFF> __device__ __forceinline__ s16x4 tr_read(int vb) {
  s16x4 r; asm volatile("ds_read_b64_tr_b16 %0, %1 offset:%2" : "=&v"(r) : "v"(vb), "i"(OFF) : "memory"); return r;
}
template <int D0> __device__ __forceinline__ void pv_one(f32x16& od, int vb, bf16x8 pa0, bf16x8 pa1, bf16x8 pa2, bf16x8 pa3) {
  const s16x4 l0 = tr_read<v_rd_off(D0, 0, 0)>(vb), h0 = tr_read<v_rd_off(D0, 0, 1)>(vb), l1 = tr_read<v_rd_off(D0, 1, 0)>(vb), h1 = tr_read<v_rd_off(D0, 1, 1)>(vb);
  const s16x4 l2 = tr_read<v_rd_off(D0, 2, 0)>(vb), h2 = tr_read<v_rd_off(D0, 2, 1)>(vb), l3 = tr_read<v_rd_off(D0, 3, 0)>(vb), h3 = tr_read<v_rd_off(D0, 3, 1)>(vb);
  asm volatile("s_waitcnt lgkmcnt(0)" ::: "memory"); SBAR();
#define PK(L, H) (bf16x8){L[0], L[1], L[2], L[3], H[0], H[1], H[2], H[3]}
  od = __builtin_amdgcn_mfma_f32_32x32x16_bf16(pa0, PK(l0, h0), od, 0, 0, 0);
  od = __builtin_amdgcn_mfma_f32_32x32x16_bf16(pa1, PK(l1, h1), od, 0, 0, 0);
  od = __builtin_amdgcn_mfma_f32_32x32x16_bf16(pa2, PK(l2, h2), od, 0, 0, 0);
  od = __builtin_amdgcn_mfma_f32_32x32x16_bf16(pa3, PK(l3, h3), od, 0, 0, 0);
#undef PK
}
__device__ __forceinline__ void pv_d0(f32x16* o, int vb, bf16x8 pa0, bf16x8 pa1, bf16x8 pa2, bf16x8 pa3) {
  pv_one<0>(o[0], vb, pa0, pa1, pa2, pa3); pv_one<1>(o[1], vb, pa0, pa1, pa2, pa3); pv_one<2>(o[2], vb, pa0, pa1, pa2, pa3); pv_one<3>(o[3], vb, pa0, pa1, pa2, pa3);
}
__device__ __forceinline__ void diff_attn_unit(const bf16_t* __restrict__ Qb, const bf16_t* __restrict__ Kh, const bf16_t* __restrict__ Vh, bf16_t* __restrict__ Ob,
                                               int seq, char* lds, float lam, const float* __restrict__ gsub, float oscale) {
  const int tid = tid_opaque(), wid = tid >> 6, lane = tid & 63, r32 = lane & 31, hi = lane >> 5;
  const int qblk = wid >> 1, cc = wid & 1;
  bf16_t* V_lds = (bf16_t*)lds; bf16_t* K_lds = (bf16_t*)(lds + 2 * SHM_V);
  float* ws = (float*)(lds + 2 * SHM_V + 2 * SHM_K) + wid * 64; float* li_l = ws; float* al_l = ws + 32;
  float m_reg = -1e30f, l_reg = 0; f32x16 o[4] = {}; bf16x8 qr[4];
  const bf16_t* Qw = Qb + (long)(qblk * 32 + r32) * LDQ + cc * 64 + hi * 8;
#pragma unroll
  for (int d0 = 0; d0 < 4; ++d0) qr[d0] = *reinterpret_cast<const bf16x8*>(Qw + d0 * 16);
  const int sr = tid >> 4, sc = (tid & 15) * 8, vst0 = v_st(sr, sc), vst1 = v_st(32 + sr, sc);
  const int vb0 = (int)(uintptr_t)V_lds + v_rd_base(lane);
  struct { bf16x8 vs0, vs1, ks0, ks1; } sr_[2];
#define SLOAD(i, k0) do { sr_[i].vs0 = *reinterpret_cast<const bf16x8*>(&Vh[(long)((k0) + sr) * LDQ + sc]); sr_[i].vs1 = *reinterpret_cast<const bf16x8*>(&Vh[(long)((k0) + 32 + sr) * LDQ + sc]); \
    sr_[i].ks0 = *reinterpret_cast<const bf16x8*>(&Kh[(long)((k0) + sr) * LDQ + sc]); sr_[i].ks1 = *reinterpret_cast<const bf16x8*>(&Kh[(long)((k0) + 32 + sr) * LDQ + sc]); } while (0)
#define SWRITE(b, i) do { *(bf16x8*)((char*)V_lds + (b) * SHM_V + vst0) = sr_[i].vs0;          \
    *(bf16x8*)((char*)V_lds + (b) * SHM_V + vst1) = sr_[i].vs1; int kc = sc * 2;               \
    *(bf16x8*)((char*)K_lds + (b) * SHM_K + KSWZ(sr, kc)) = sr_[i].ks0;                       \
    *(bf16x8*)((char*)K_lds + (b) * SHM_K + KSWZ(32 + sr, kc)) = sr_[i].ks1; } while (0)
#define SWAIT() asm volatile("s_waitcnt vmcnt(4)" ::: "memory")
#define RESC(a) do { if (__any((a) < 1.f)) { if (hi == 0) al_l[r32] = (a); asm volatile("s_waitcnt lgkmcnt(0)" ::: "memory"); \
    _Pragma("unroll") for (int d = 0; d < 4; ++d) _Pragma("unroll") for (int r = 0; r < 16; ++r) o[d][r] *= al_l[crow(r, hi)]; } } while (0)
  f32x16 pA0, pA1, pB0, pB1; float mnA, mnB, alA, alB; bf16x8 pa0, pa1, pa2, pa3; const int NT = seq / KVBLK;
  constexpr int SE = 0, SO = 1;
  SLOAD(SE, 0); asm volatile("s_waitcnt vmcnt(0)" ::: "memory"); SWRITE(0, SE); __syncthreads();
  qkt(pA0, pA1, K_lds, qr, r32, hi, cc); partialSM(pA0, pA1, m_reg, mnA, alA);
  SLOAD(SO, KVBLK); if (2 < NT) SLOAD(SE, 2 * KVBLK);
  SWAIT(); SWRITE(1, SO); __syncthreads();
  for (int j = 1; j + 1 < NT; j += 2) {
    SBAR(); qkt(pB0, pB1, (bf16_t*)((char*)K_lds + SHM_K), qr, r32, hi, cc);
    finishSM(pA0, pA1, alA, l_reg, pa0, pa1, pa2, pa3); SBAR();
    SLOAD(SO, (j + 2) * KVBLK); SBAR();
    pv_d0(o, vb0, pa0, pa1, pa2, pa3); partialSM(pB0, pB1, m_reg, mnB, alB);
    __syncthreads(); SWAIT(); SWRITE(0, SE);
    RESC(alB); __syncthreads();
    SBAR(); qkt(pA0, pA1, K_lds, qr, r32, hi, cc);
    finishSM(pB0, pB1, alB, l_reg, pa0, pa1, pa2, pa3); SBAR();
    if (j + 3 < NT) SLOAD(SE, (j + 3) * KVBLK); SBAR();
    pv_d0(o, vb0 + (int)SHM_V, pa0, pa1, pa2, pa3); partialSM(pA0, pA1, m_reg, mnA, alA);
    __syncthreads(); SWAIT(); SWRITE(1, SO);
    RESC(alA); __syncthreads();
  }
  SBAR(); qkt(pB0, pB1, (bf16_t*)((char*)K_lds + SHM_K), qr, r32, hi, cc);
  finishSM(pA0, pA1, alA, l_reg, pa0, pa1, pa2, pa3); SBAR();
  pv_d0(o, vb0, pa0, pa1, pa2, pa3); partialSM(pB0, pB1, m_reg, mnB, alB);
  __syncthreads(); RESC(alB);
  finishSM(pB0, pB1, alB, l_reg, pa0, pa1, pa2, pa3); SBAR();
  pv_d0(o, vb0 + (int)SHM_V, pa0, pa1, pa2, pa3);
  if (hi == 0) li_l[r32] = l_reg; asm volatile("s_waitcnt lgkmcnt(0)" ::: "memory");
  float rli[16];
#pragma unroll
  for (int r = 0; r < 16; ++r) rli[r] = __builtin_amdgcn_rcpf(li_l[crow(r, hi)]);
  __syncthreads();
  float* xch = (float*)lds + qblk * (32 * 128);
  if (cc == 1) {
#pragma unroll
    for (int r = 0; r < 16; ++r)
#pragma unroll
      for (int d0 = 0; d0 < 4; ++d0) xch[crow(r, hi) * 128 + d0 * 32 + r32] = lam * o[d0][r] * rli[r];
  }
  __syncthreads();
  if (cc == 0) {
    float gs[4];
#pragma unroll
    for (int d0 = 0; d0 < 4; ++d0) gs[d0] = gsub[d0 * 32 + r32] * oscale;
#pragma unroll
    for (int r = 0; r < 16; ++r) {
      float ss = 0.f;
#pragma unroll
      for (int d0 = 0; d0 < 4; ++d0) { const float v = o[d0][r] * rli[r] - xch[crow(r, hi) * 128 + d0 * 32 + r32]; o[d0][r] = v; ss += v * v; }
      ss += __shfl_xor(ss, 1); ss += __shfl_xor(ss, 2); ss += __shfl_xor(ss, 4); ss += __shfl_xor(ss, 8); ss += __shfl_xor(ss, 16);
      const float rs = rsqrtf(ss * (1.f / 128.f) + EPS);
      bf16_t* orow = Ob + (long)(qblk * 32 + crow(r, hi)) * LDQ;
#pragma unroll
      for (int d0 = 0; d0 < 4; ++d0) orow[d0 * 32 + r32] = (bf16_t)(cvtpk(o[d0][r] * rs * gs[d0], 0.f) & 0xffff);
    }
  }
  __syncthreads();
#undef SLOAD
#undef SWRITE
#undef SWAIT
#undef RESC
}
#undef KSWZ
#undef SBAR
constexpr int LDS_NEED = 2 * SHM_V + 2 * SHM_K + 8 * 64 * 4;
}

__device__ __forceinline__ void phase_attn(ArgP a, int j, char* lds, int G, int bid) {
    const bf16_t* Q = (const bf16_t*)(a->ws + WS_Q); const bf16_t* KB = (const bf16_t*)(a->ws + WS_KB); const bf16_t* VB = (const bf16_t*)(a->ws + WS_VB);
    bf16_t* O = (bf16_t*)(a->ws + WS_O);
    const float lam = ((const float*)(a->ws + WS_LAM))[j];
    const float oscale = 1.f - (j == 0 ? a->lam_init0 : a->lam_init1);
    const float* gsub = a->in[I_GSUB] + j * 128;
    for (int u = bid; u < 512; u += G) {
        int qrow, krow, seq, h;
        if (u < 256) { const int b = u >> 6; h = (u >> 3) & 7; const int qb = u & 7; qrow = NCTX + b * 1024 + qb * 128; krow = NCTX + b * 1536; seq = 1536; }
        else { const int v = u - 256, b = v >> 4; h = (v >> 1) & 7; const int qb = v & 1; qrow = b * 256 + qb * 128; krow = b * 256; seq = 256; }
        att::diff_attn_unit(Q + (size_t)qrow * 1024 + h * 128, KB + (size_t)krow * 1024 + h * 128, VB + (size_t)krow * 1024 + h * 128, O + (size_t)qrow * 1024 + h * 128,
                            seq, lds, lam, gsub, oscale);
    }
}

namespace hg {
constexpr int QT_OFF = 0, KT_OFF = 64 * 272, KHT_OFF = 2 * 64 * 272, VT_OFF = KHT_OFF + 128 * 144, DD_OFF = VT_OFF + 128 * 144, LDS_NEED = DD_OFF + 4 * 128 * 4;
__device__ __forceinline__ s16x4 pk4(f32x4 v) { u32x2 w; w.x = cvt_pk_bf16(v[0], v[1]); w.y = cvt_pk_bf16(v[2], v[3]); return __builtin_bit_cast(s16x4, w); }
struct Stage { u32x4 q[2], k[2], kh[2], v[2], d; };
__device__ __forceinline__ void scan_unit(int tok0, int n, int h, int dir, int vbase, int nwv, const bf16_t* __restrict__ QT, const bf16_t* __restrict__ KT, const bf16_t* __restrict__ KHT, const bf16_t* __restrict__ VT,
                                          const float* __restrict__ DD, const float* __restrict__ s0, float* __restrict__ sout, bf16_t* __restrict__ Od, LAS unsigned char* lds) {
    const int tid = tid_opaque(), lane = tid & 63, wv = __builtin_amdgcn_readfirstlane(tid >> 6), l15 = lane & 15, g = lane >> 4;
    const bool act = wv < nwv;
    const int vc = vbase + 16 * wv + l15;
    f32x4 S[8];
#pragma unroll
    for (int i = 0; i < 8; ++i) {
        if (s0 && act) {
#pragma unroll
            for (int r = 0; r < 4; ++r) S[i][r] = s0[(size_t)(16 * i + 4 * g + r) * 128 + vc]; }
        else S[i] = (f32x4){0.f, 0.f, 0.f, 0.f};
    }
    const int nms = n >> 6;
    Stage st;
#define HG_LOAD(msn) do { const int tb_ = tok0 + (msn) * 64; \
        _Pragma("unroll") for (int i_ = 0; i_ < 2; ++i_) { const int p_ = tid + 512 * i_; \
            const size_t so_ = (size_t)(tb_ + (p_ >> 4)) * 1024 + h * 128 + (p_ & 15) * 8; st.q[i_] = *(const u32x4*)(QT + so_); st.k[i_] = *(const u32x4*)(KT + so_); \
            const size_t to_ = ((size_t)(((tb_ >> 4) + (p_ >> 8)) * 8 + h) * 128 + ((p_ & 255) >> 1)) * 16 + (p_ & 1) * 8; st.kh[i_] = *(const u32x4*)(KHT + to_); st.v[i_] = *(const u32x4*)(VT + to_); } \
        if (tid < 128) st.d = *(const u32x4*)(DD + (size_t)(((tb_ >> 4) + (tid >> 5)) * 8 + h) * 128 + (tid & 31) * 4); } while (0)
#define HG_STORE() do { \
        _Pragma("unroll") for (int i_ = 0; i_ < 2; ++i_) { const int p_ = tid + 512 * i_; \
            *(LAS u32x4*)(lds + QT_OFF + (p_ >> 4) * 272 + (p_ & 15) * 16) = st.q[i_]; *(LAS u32x4*)(lds + KT_OFF + (p_ >> 4) * 272 + (p_ & 15) * 16) = st.k[i_]; \
            const int lo_ = ((p_ & 255) >> 1) * 144 + ((p_ >> 8) * 16 + (p_ & 1) * 8) * 2; *(LAS u32x4*)(lds + KHT_OFF + lo_) = st.kh[i_]; *(LAS u32x4*)(lds + VT_OFF + lo_) = st.v[i_]; } \
        if (tid < 128) *(LAS u32x4*)(lds + DD_OFF + ((tid >> 5) * 128 + (tid & 31) * 4) * 4) = st.d; } while (0)
    HG_LOAD(dir ? nms - 1 : 0);
    HG_STORE();
    __syncthreads();
    for (int ms = 0; ms < nms; ++ms) {
        const int msn = dir ? nms - 1 - ms : ms;
        if (ms + 1 < nms) HG_LOAD(dir ? msn - 1 : msn + 1);
        __builtin_amdgcn_sched_barrier(0);
        if (act) {
        s16x4 xb[4];
#pragma unroll
        for (int cp = 0; cp < 4; cp += 2) {
            bf16x8 ka[2][4], qb[2][4];
#pragma unroll
            for (int q = 0; q < 2; ++q)
#pragma unroll
                for (int kk = 0; kk < 4; ++kk) {
                    ka[q][kk] = *(const LAS bf16x8*)(lds + KT_OFF + ((cp + q) * 16 + l15) * 272 + kk * 64 + g * 16);
                    qb[q][kk] = *(const LAS bf16x8*)(lds + QT_OFF + ((cp + q) * 16 + l15) * 272 + kk * 64 + g * 16); }
            __builtin_amdgcn_sched_barrier(0);
            f32x4 X0 = {0.f, 0.f, 0.f, 0.f}, X1 = {0.f, 0.f, 0.f, 0.f};
#pragma unroll
            for (int kk = 0; kk < 4; ++kk) { X0 = __builtin_amdgcn_mfma_f32_16x16x32_bf16(ka[0][kk], qb[0][kk], X0, 0, 0, 0); X1 = __builtin_amdgcn_mfma_f32_16x16x32_bf16(ka[1][kk], qb[1][kk], X1, 0, 0, 0); }
#pragma unroll
            for (int r = 0; r < 4; ++r) if (dir ? (4 * g + r < l15) : (4 * g + r > l15)) { X0[r] = 0.f; X1[r] = 0.f; }
            xb[cp] = pk4(X0); xb[cp + 1] = pk4(X1);
            __builtin_amdgcn_sched_barrier(0);
        }
        f32x4 dvA[8]; s16x4 kaA[8], qaA[8], vbA;
#define HG_OPS(c_, DV, KA, QA, VB) do { VB = *(const LAS s16x4*)(lds + VT_OFF + vc * 144 + ((c_) * 16 + 4 * g) * 2); \
            _Pragma("unroll") for (int i_ = 0; i_ < 8; ++i_) { DV[i_] = *(const LAS f32x4*)(lds + DD_OFF + ((c_) * 128 + 16 * i_ + 4 * g) * 4); \
                KA[i_] = *(const LAS s16x4*)(lds + KHT_OFF + (16 * i_ + l15) * 144 + ((c_) * 16 + 4 * g) * 2); \
                QA[i_] = *(const LAS s16x4*)(lds + QT_OFF + ((c_) * 16 + l15) * 272 + (16 * i_ + 4 * g) * 2); } } while (0)
#define HG_CHUNK(c_, XB, DV, KA, QA, VB) do { \
            f32x4 o0_ = {0.f, 0.f, 0.f, 0.f}, o1_ = {0.f, 0.f, 0.f, 0.f}; s16x4 sb_[8]; \
            _Pragma("unroll") for (int i_ = 0; i_ < 8; ++i_) sb_[i_] = pk4(S[i_]); \
            _Pragma("unroll") for (int i_ = 0; i_ < 8; ++i_) S[i_] = __builtin_amdgcn_mfma_f32_16x16x16bf16_1k(KA[i_], VB, S[i_] * DV[i_], 0, 0, 0); \
            _Pragma("unroll") for (int i_ = 0; i_ < 8; i_ += 2) { o0_ = __builtin_amdgcn_mfma_f32_16x16x16bf16_1k(QA[i_], sb_[i_], o0_, 0, 0, 0); o1_ = __builtin_amdgcn_mfma_f32_16x16x16bf16_1k(QA[i_ + 1], sb_[i_ + 1], o1_, 0, 0, 0); } \
            o0_ = __builtin_amdgcn_mfma_f32_16x16x16bf16_1k(XB, VB, o0_, 0, 0, 0); \
            const f32x4 o_ = o0_ + o1_; \
            _Pragma("unroll") for (int r_ = 0; r_ < 4; ++r_) Od[(size_t)(tok0 + msn * 64 + (c_) * 16 + 4 * g + r_) * 1024 + h * 128 + vc] = (bf16_t)(cvt_pk_bf16(o_[r_], 0.f) & 0xffff); } while (0)
#pragma unroll 1
        for (int cc = 0; cc < 4; ++cc) {
            const int c = dir ? 3 - cc : cc;
            const s16x4 xbc = c == 0 ? xb[0] : c == 1 ? xb[1] : c == 2 ? xb[2] : xb[3];
            HG_OPS(c, dvA, kaA, qaA, vbA); __builtin_amdgcn_sched_barrier(0);
            HG_CHUNK(c, xbc, dvA, kaA, qaA, vbA); __builtin_amdgcn_sched_barrier(0);
        }
#undef HG_OPS
#undef HG_CHUNK
        }
        __syncthreads();
        if (ms + 1 < nms) { HG_STORE(); }
        __syncthreads();
    }
#undef HG_LOAD
#undef HG_STORE
    if (sout && act) {
#pragma unroll
        for (int i = 0; i < 8; ++i)
#pragma unroll
            for (int r = 0; r < 4; ++r) sout[(size_t)(16 * i + 4 * g + r) * 128 + vc] = S[i][r];
    }
}
}

__device__ __forceinline__ void phase_scan(ArgP a, LAS unsigned char* lds, int G, int bid) {
    for (int i = 0;; ++i) {
        const int u = i * G + ((i & 1) ? (G - 1 - bid) : bid);
        if (u >= 384) break;
        int tok0, n, h, dir, vbase = 0, nwv = 8; const float* s0 = nullptr; float* sout = nullptr;
        if (u < 128) { const int b = u >> 5; h = (u >> 2) & 7; dir = (u >> 1) & 1; vbase = (u & 1) * 64; nwv = 4; tok0 = NCTX + b * 1024; n = 1024; s0 = a->in[I_ST] + ((size_t)(b * 2 + dir) * 8 + h) * 16384; }
        else { const int v = u - 128, b = v >> 4; h = (v >> 1) & 7; dir = v & 1; tok0 = b * 256; n = 256; sout = a->out + OUT_NS + ((size_t)(b * 2 + dir) * 8 + h) * 16384; }
        hg::scan_unit(tok0, n, h, dir, vbase, nwv, (const bf16_t*)(a->ws + (dir ? WS_QTB : WS_QTF)), (const bf16_t*)(a->ws + (dir ? WS_KTB : WS_KTF)), (const bf16_t*)(a->ws + (dir ? WS_KHTB : WS_KHTF)),
                      (const bf16_t*)(a->ws + WS_VT), (const float*)(a->ws + (dir ? WS_DDB : WS_DDF)), s0, sout, (bf16_t*)(a->ws + (dir ? WS_OB : WS_OF)), lds);
    }
}

#ifndef PHMASK
#define PHMASK 0xFFFF
#endif
#ifndef REPMASK
#define REPMASK 0
#endif
#ifndef XBAR
#define XBAR 0
#endif
enum PhType { T_PRO = 0, T_NORM, T_QKV, T_ATTN, T_RES, T_FFN, T_HIN, T_SCAN, T_HFIN, T_F1, T_FINAL, T_FOLD };
struct PhDesc { int type, layer, sub; };
constexpr int NPH = 24;
__device__ __forceinline__ PhDesc phase_desc(int p) {
    switch (p) {
        case 0: return {T_PRO, 0, 0};
        case 1: return {T_FOLD, 0, 0};
        case 2: return {T_NORM, 0, 0};
        case 3: return {T_QKV, 0, 0}; case 4: return {T_ATTN, 0, 0}; case 5: return {T_RES, 0, 0}; case 6: return {T_FFN, 0, 0}; case 7: return {T_RES, 0, 2};
        case 8: return {T_HIN, 1, 0}; case 9: return {T_SCAN, 1, 0}; case 10: return {T_HFIN, 1, 0}; case 11: return {T_RES, 1, 1}; case 12: return {T_FFN, 1, 0}; case 13: return {T_RES, 1, 2};
        case 14: return {T_F1, 2, 0}; case 15: return {T_RES, 2, 3}; case 16: return {T_FFN, 2, 0}; case 17: return {T_RES, 2, 2};
        case 18: return {T_QKV, 3, 1}; case 19: return {T_ATTN, 3, 1}; case 20: return {T_RES, 3, 0}; case 21: return {T_FFN, 3, 0}; case 22: return {T_RES, 3, 2};
        default: return {T_FINAL, 0, 0};
    }
}

__global__ void __launch_bounds__(NTHREADS, 2) fwd_megakernel(Args a_unused) {
    extern __shared__ __attribute__((aligned(16))) unsigned char lds_raw[];
    LAS unsigned char* lds = (LAS unsigned char*)lds_raw;
    constexpr int G = 256; const int bid = blockIdx.x;
    ArgP a = (ArgP)__builtin_amdgcn_kernarg_segment_ptr();
    for (int u = threadIdx.x; u < (LDS_BYTES - LDSCTL_OFF) / 4; u += NTHREADS) ((LAS unsigned*)(lds + LDSCTL_OFF))[u] = 0u;
    __syncthreads();
    volatile LAS unsigned* MISC = (volatile LAS unsigned*)(lds + MISC_OFF);
    XcdBarrier bar = xcd_barrier_post((unsigned*)(a->ws + WS_CTL), MISC + 8);

    const int nrun = a->ph_hi < NPH ? a->ph_hi + 1 : NPH;
#if REPMASK
    for (int pj = 2 * a->ph_lo; pj < 2 * nrun; ++pj) {
        const int pi = pj >> 1, rep = pj & 1;
        const int ph = pi < a->ph_hi ? pi : NPH - 1;
        const PhDesc d = phase_desc(ph);
        if (rep && !((REPMASK >> d.type) & 1)) continue;
        if (pj > 2 * a->ph_lo) xcd_barrier(bar);
#else
    for (int pi = a->ph_lo; pi < nrun; ++pi) {
        const int rep = 0;
        const int ph = pi < a->ph_hi ? pi : NPH - 1;
        const PhDesc d = phase_desc(ph);
        if (pi > a->ph_lo) xcd_barrier(bar);
#endif
        for (int xb = 0; xb < XBAR; ++xb) xcd_barrier(bar);
#define PH_TID const int tid = tid_opaque(), lane = tid & 63, wave = __builtin_amdgcn_readfirstlane(tid >> 6), gw = bid * NWAVES + wave, ngw = G * NWAVES; (void)lane; (void)gw; (void)ngw
        asm volatile("" : "+s"(a));
        const int L = d.layer;
        switch (d.type) {
#if (PHMASK >> 0) & 1
        case T_PRO: phase_prologue(a, lds, G, bid);
            if (a->ph_hi < NPH) { PH_TID; for (size_t i = (size_t)bid * NTHREADS + tid; i < 29360128 / 4; i += (size_t)G * NTHREADS) ((f32x4*)a->out)[i] = (f32x4){0.f, 0.f, 0.f, 0.f}; }
            break;
#endif
#if (PHMASK >> 1) & 1
        case T_FOLD: {
            GenSched S; S.init(2, a->ws + WS_WFO, nullptr, 1024, a->ws + WS_TC, 1024, 1024, 256, a->ph_hi > 0 ? 256 : 320, G, bid);
            EpiBf16 E{(bf16_t*)(a->ws + WS_WCS), 1024};
            pg8::gemm_phase(lds, 1024, 1024, S, E);
            PH_TID;
            phase_an(a, bid * NTHREADS + tid, G * NTHREADS);
            phase_sw(a, lds, 0xEF, gw, ngw, tid, lane);
        } break;
#endif
#if (PHMASK >> 2) & 1
        case T_NORM: {
            PH_TID;
            phase_first_norm(a, gw, ngw, lane);
            phase_sw(a, lds, 0x10, gw, ngw, tid, lane);
        } break;
#endif
#if (PHMASK >> 3) & 1
        case T_QKV: {
            const int j = d.sub, nidx = 2 * L;
            if (j == 1) { PH_TID; cache_convert(a, 1, gw, ngw, lane); }
            const float* sspn = (const float*)(a->ws + WS_SSP) + (size_t)nidx * 8192 * SSPN; const float* swn = (const float*)(a->ws + WS_SW) + sw_off(nidx);
            { GenSched S; S.init(7, a->ws + WS_H, nullptr, 1024, a->ws + WS_WQKV + (size_t)j * 3072 * 1024 * 2, 1024, MTOK, 3072, 1024, G, bid);
              EpiQKV E{(bf16_t*)(a->ws + WS_Q), (bf16_t*)(a->ws + WS_KB), (bf16_t*)(a->ws + WS_VB), a->out + OUT_NK + (size_t)j * 256 * 1024, a->out + OUT_NV + (size_t)j * 256 * 1024,
                       (const float*)(a->ws + WS_ROPE), (const float*)(a->ws + WS_ROPE) + 1024, sspn, swn, lds};
              pg8::gemm_phase(lds, 1024, 1024, S, E); }
            { GenSched S; S.init(8, a->ws + WS_H, nullptr, 1024, a->ws + WS_WQKV + (size_t)j * 3072 * 1024 * 2, 1024, MTOK, 3072, 1024, G, bid);
              EpiQKV128 E{(bf16_t*)(a->ws + WS_Q), (bf16_t*)(a->ws + WS_KB), (bf16_t*)(a->ws + WS_VB), a->out + OUT_NK + (size_t)j * 256 * 1024, a->out + OUT_NV + (size_t)j * 256 * 1024,
                          (const float*)(a->ws + WS_ROPE), (const float*)(a->ws + WS_ROPE) + 1024, sspn, swn, lds};
              pg8::gemm_phase_n128(lds, 1024, 1024, S, E); }
        } break;
#endif
#if (PHMASK >> 4) & 1
        case T_ATTN: phase_attn(a, d.sub, (char*)lds_raw, G, bid); break;
#endif
#if (PHMASK >> 5) & 1
        case T_RES: {
            const int nn = d.sub == 2 ? 2 * L + 2 : 2 * L + 1;
            EpiResid128 E{(bf16_t*)(a->ws + WS_X), (float*)(a->ws + WS_MOD) + (size_t)L * 5 * 6144 + (d.sub == 2 ? 5 : 2) * 1024,
                          nn < 8 ? (const float*)(a->ws + WS_AN) + nn * 5120 : nullptr, (bf16_t*)(a->ws + WS_H), (float*)(a->ws + WS_SSP) + (size_t)nn * 8192 * SSPN};
            GenSched S; int lda, ldb;
            if (d.sub == 3) { lda = 2048; ldb = 16384; S.init(4, a->ws + WS_CS1024, a->ws + WS_CS256, lda, a->ws + WS_ZT, ldb, 0, 0, 2048, G, bid); }
            else if (d.sub == 2) { lda = DFF; ldb = DFF; S.init(3, a->ws + WS_ACT, nullptr, lda, a->ws + WS_WFOUT + (size_t)L * 1024 * DFF * 2, ldb, MTOK, 1024, DFF, G, bid); }
            else { lda = 1024; ldb = 1024; const unsigned char* w = d.sub == 0 ? a->ws + WS_WOA + (size_t)(L == 0 ? 0 : 1) * 1024 * 1024 * 2 : a->ws + WS_WOR;
                S.init(3, a->ws + WS_O, nullptr, lda, w, ldb, MTOK, 1024, 1024, G, bid); }
            pg8::gemm_phase_n128(lds, lda, ldb, S, E);
        } break;
#endif
#if (PHMASK >> 6) & 1
        case T_FFN: {
            const int nidx = 2 * L + 1;
            GenSched S; S.init(0, a->ws + WS_H, nullptr, 1024, a->ws + WS_WFI + (size_t)L * 5632 * 1024 * 2, 1024, MTOK, 5632, 1024, G, bid);
            EpiFFN E{(bf16_t*)(a->ws + WS_ACT), (const float*)(a->ws + WS_SSP) + (size_t)nidx * 8192 * SSPN, (const float*)(a->ws + WS_SW) + sw_off(nidx), lds};
            pg8::gemm_phase(lds, 1024, 1024, S, E);
        } break;
#endif
#if (PHMASK >> 7) & 1
        case T_HIN: {
            { GenSched S; S.init(5, a->ws + WS_H, nullptr, 1024, a->ws + WS_WINR, 1024, MTOK, 4096, 1024, G, bid);
              EpiHgrn E{(bf16_t*)(a->ws + WS_GH), (bf16_t*)(a->ws + WS_QTF), (bf16_t*)(a->ws + WS_KTF), (bf16_t*)(a->ws + WS_QTB), (bf16_t*)(a->ws + WS_KTB), (bf16_t*)(a->ws + WS_KHTF), (bf16_t*)(a->ws + WS_KHTB),
                        (bf16_t*)(a->ws + WS_VT), (float*)(a->ws + WS_DDF), (float*)(a->ws + WS_DDB), (const float*)(a->ws + WS_LBV), (const float*)(a->ws + WS_SSP) + 2ull * 8192 * SSPN, (const float*)(a->ws + WS_SW) + sw_off(2), lds};
              pg8::gemm_phase(lds, 1024, 1024, S, E); }
            { GenSched S; S.init(6, a->ws + WS_H, nullptr, 1024, a->ws + WS_WINR, 1024, MTOK, 1024, 1024, G, bid);
              EpiG128 E{(bf16_t*)(a->ws + WS_GH), (const float*)(a->ws + WS_SSP) + 2ull * 8192 * SSPN, (const float*)(a->ws + WS_SW) + sw_off(2), lds};
              pg8::gemm_phase_n128(lds, 1024, 1024, S, E); }
        } break;
#endif
#if (PHMASK >> 8) & 1
        case T_SCAN: phase_scan(a, lds, G, bid); break;
#endif
#if (PHMASK >> 9) & 1
        case T_HFIN: { PH_TID; phase_hgrn_final(a, gw, ngw, lane); } break;
#endif
#if (PHMASK >> 10) & 1
        case T_F1: {
            GenSched S; S.init(0, a->ws + WS_WCS, nullptr, 1024, a->ws + WS_H, 1024, 2048, MTOK, 1024, G, bid);
            EpiFour1 E{(bf16_t*)(a->ws + WS_ZT), (const float*)(a->ws + WS_SSP) + 4ull * 8192 * SSPN, (const float*)(a->ws + WS_SW) + sw_off(4), lds};
            pg8::gemm_phase(lds, 1024, 1024, S, E);
        } break;
#endif
        default: { PH_TID; phase_final(a, gw, ngw, lane); } break;
        }
    }
}

extern "C" void kernel_launch(void* const* d_in, const int* in_sizes, int n_in, void* d_out, int out_size, void* d_ws, size_t ws_size, hipStream_t stream) {
    static int grid = 0;
    if (grid == 0) {
        if (n_in != 23 || out_size != 29360128 || ws_size < WS_END2) {
            fprintf(stderr, "kernel_launch: unexpected shapes: n_in %d out %d ws %zu (need >= %zu); nothing launched\n", n_in, out_size, ws_size, (size_t)WS_END); grid = -1; return; }
        int dev = 0, cus = 0, per_cu = 0;
        if (hipGetDevice(&dev) != hipSuccess || hipDeviceGetAttribute(&cus, hipDeviceAttributeMultiprocessorCount, dev) != hipSuccess) { fprintf(stderr, "kernel_launch: device query failed\n"); grid = -1; return; }
        if (hipFuncSetAttribute((const void*)fwd_megakernel, hipFuncAttributeMaxDynamicSharedMemorySize, LDS_BYTES) != hipSuccess) { fprintf(stderr, "kernel_launch: hipFuncSetAttribute failed\n"); grid = -1; return; }
        if (hipOccupancyMaxActiveBlocksPerMultiprocessor(&per_cu, (const void*)fwd_megakernel, NTHREADS, LDS_BYTES) != hipSuccess || per_cu < 1) {
            fprintf(stderr, "kernel_launch: occupancy query reports %d workgroups per CU; nothing launched\n", per_cu); (void)hipGetLastError(); grid = -1; return; }
        if (cus < 256) { fprintf(stderr, "kernel_launch: needs >= 256 CUs (have %d); nothing launched\n", cus); grid = -1; return; }
        grid = 256;
    }
    if (grid < 0) return;
    (void)hipMemsetAsync((char*)d_ws + WS_CTL, 0, CTL_BYTES, stream);
    Args a{};
    for (int i = 0; i < 23; ++i) a.in[i] = (const float*)d_in[i];
    a.out = (float*)d_out; a.ws = (unsigned char*)d_ws;
    a.lam_init0 = 0.2f; a.lam_init1 = (float)(0.8 - 0.6 * 0.40656965974059917);
    a.ph_lo = 0; a.ph_hi = NPH;
    hipLaunchKernelGGL(fwd_megakernel, dim3(grid), dim3(NTHREADS), LDS_BYTES, stream, a);
    const hipError_t le = hipPeekAtLastError();
    if (le != hipSuccess) fprintf(stderr, "kernel_launch: launch failed: %s\n", hipGetErrorName(le));
}
```

```cpp
#include <hip/hip_runtime.h>
#include <cstdio>
#include <cstdint>

#define LAS __attribute__((address_space(3)))
#define GAS __attribute__((address_space(1)))
typedef unsigned short bf16_t;
typedef short bf16x8 __attribute__((ext_vector_type(8)));
typedef short s16x4 __attribute__((ext_vector_type(4)));
typedef float f32x2 __attribute__((ext_vector_type(2)));
typedef float f32x4 __attribute__((ext_vector_type(4)));
typedef float f32x8 __attribute__((ext_vector_type(8)));
typedef float f32x16 __attribute__((ext_vector_type(16)));
typedef unsigned u32x2 __attribute__((ext_vector_type(2)));
typedef unsigned u32x4 __attribute__((ext_vector_type(4)));

constexpr int DM = 1024, MTOK = 8192, NCTX = 4096, DFF = 2816, NKV = 4096 + 4 * 1536;
constexpr float EPS = 1e-6f;
constexpr int NWAVES = 8, NTHREADS = 512;

constexpr size_t al256(size_t x) { return (x + 255) / 256 * 256; }
constexpr size_t WS_CTL = 0, CTL_BYTES = 65536;
constexpr size_t WS_MOD = WS_CTL + CTL_BYTES;
constexpr size_t WS_ROPE = WS_MOD + al256(4 * 5 * 6144 * 4);
constexpr size_t WS_LBV = WS_ROPE + 8192;
constexpr size_t WS_LAM = WS_LBV + 8192;
constexpr size_t WS_AN = WS_LAM + 256;
constexpr size_t WS_SW = WS_AN + 8 * 5 * 1024 * 4;
constexpr size_t WS_SSP = WS_SW + al256(35840 * 5 * 4);
constexpr int SSPN = 32;
constexpr size_t WS_TC = WS_SSP + 9ull * 8192 * SSPN * 4;
constexpr size_t WS_CS256 = WS_TC + 256 * 1024 * 2;
constexpr size_t WS_CS1024 = WS_CS256 + 256 * 2048 * 2;
constexpr size_t WS_WQKV = WS_CS1024 + 1024 * 2048 * 2;
constexpr size_t WS_WOA = WS_WQKV + 2ull * 3072 * 1024 * 2;
constexpr size_t WS_WINR = WS_WOA + 2ull * 1024 * 1024 * 2;
constexpr size_t WS_WOR = WS_WINR + 5120ull * 1024 * 2;
constexpr size_t WS_WFO = WS_WOR + 1024ull * 1024 * 2;
constexpr size_t WS_WCS = WS_WFO + 1024ull * 1024 * 2;
constexpr size_t WS_WFI = WS_WCS + 2048ull * 1024 * 2;
constexpr size_t WS_WFOUT = WS_WFI + 4ull * 5632 * 1024 * 2;
constexpr size_t WS_X = WS_WFOUT + 4ull * 1024 * 2816 * 2;
constexpr size_t WS_H = WS_X + 8192ull * 1024 * 4;
constexpr size_t WS_O = WS_H + 8192ull * 1024 * 2;
constexpr size_t WS_SCR = WS_O + 8192ull * 1024 * 2;
constexpr size_t SZ_TOK = 8192ull * 1024 * 2;
constexpr size_t WS_Q = WS_SCR, WS_KB = WS_Q + SZ_TOK, WS_VB = WS_KB + (size_t)NKV * 1024 * 2;
constexpr size_t WS_GH = WS_SCR, WS_QTF = WS_GH + SZ_TOK, WS_KTF = WS_QTF + SZ_TOK, WS_QTB = WS_KTF + SZ_TOK, WS_KTB = WS_QTB + SZ_TOK, WS_KHTF = WS_KTB + SZ_TOK, WS_KHTB = WS_KHTF + SZ_TOK,
                 WS_VT = WS_KHTB + SZ_TOK, WS_OF = WS_VT + SZ_TOK, WS_OB = WS_OF + SZ_TOK, WS_DDF = WS_OB + SZ_TOK, WS_DDB = WS_DDF + 512ull * 8 * 128 * 4;
constexpr size_t WS_ZT = WS_SCR;
constexpr size_t WS_ACT = WS_SCR;
constexpr size_t WS_END = WS_DDB + 512ull * 8 * 128 * 4;
constexpr size_t WS_END2 = WS_END;
__host__ __device__ constexpr int sw_n(int nidx) { return nidx == 0 || nidx == 6 ? 3072 : nidx == 2 ? 5120 : nidx == 4 ? 2048 : 5632; }
__host__ __device__ constexpr int sw_off(int nidx) { int o = 0; for (int i = 0; i < nidx; ++i) o += 5 * sw_n(i); return o; }

constexpr size_t OUT_YP = 0, OUT_YS = 4194304, OUT_NK = 8388608, OUT_NV = 16777216, OUT_NS = 25165824;

constexpr int RING_BYTES = 131072;
constexpr int LDSCTL_OFF = RING_BYTES, MISC_OFF = LDSCTL_OFF + 320, RSTD_OFF = LDSCTL_OFF + 1024;
constexpr int LDS_BYTES = 147456;

typedef __bf16 bf16x2_t __attribute__((ext_vector_type(2)));
__device__ __forceinline__ unsigned cvt_pk_bf16(float lo, float hi) { f32x2 v = {lo, hi}; bf16x2_t b = __builtin_convertvector(v, bf16x2_t); return __builtin_bit_cast(unsigned, b); }
__device__ __forceinline__ float bf2f(unsigned short b) { return __uint_as_float((unsigned)b << 16); }
__device__ __forceinline__ float bflo(unsigned w) { return __uint_as_float(w << 16); }
__device__ __forceinline__ float bfhi(unsigned w) { return __uint_as_float(w & 0xffff0000u); }
__device__ __forceinline__ float fast_rcp(float x) { return __builtin_amdgcn_rcpf(x); }
__device__ __forceinline__ float silu_f(float x) { return x * fast_rcp(1.f + __expf(-x)); }
__device__ __forceinline__ float sigmoid_f(float x) { return fast_rcp(1.f + __expf(-x)); }
__device__ __forceinline__ float wave_sum(float v) {
#pragma unroll
    for (int o = 1; o < 64; o <<= 1) v += __shfl_xor(v, o);
    return v;
}
__device__ __forceinline__ int tid_opaque() { int t = threadIdx.x; asm volatile("" : "+v"(t)); return t; }
__device__ __forceinline__ int cond_of_row(int r) { return r < NCTX ? 0 : 1 + ((r - NCTX) >> 10); }
#define LDS_WAIT() asm volatile("s_waitcnt lgkmcnt(0)" ::: "memory")
#define VM_WAIT() asm volatile("s_waitcnt vmcnt(0)" ::: "memory")

#define XB_TMO      128
#define XB_XCNT(j)  (256  + 64 * (j))
#define XB_XSUB(j)  (1280 + 64 * (j))
#define XB_XGEN(j)  (2304 + 64 * (j))
#define XB_TOP      3328
#define XB_TOPGEN   3392
#define XCD_BAR_WORDS 3456
#define XB_SPIN_CAP (1u << 22)
__device__ __forceinline__ unsigned xb_ld(unsigned* p)              { return __hip_atomic_load(p, __ATOMIC_RELAXED, __HIP_MEMORY_SCOPE_AGENT); }
__device__ __forceinline__ unsigned xb_add(unsigned* p, unsigned v) { return __hip_atomic_fetch_add(p, v, __ATOMIC_RELAXED, __HIP_MEMORY_SCOPE_AGENT); }
__device__ __forceinline__ unsigned xb_xcc_id() { return (unsigned)__builtin_amdgcn_s_getreg((3 << 11) | 20) & 0xFu; }
#define XB_SPIN(cond, bar) do { unsigned _sp = 0; while (cond) { __builtin_amdgcn_s_sleep(1); \
    if ((++_sp & 255u) == 0u) { if (xb_ld(&(bar)[XB_TMO])) break; if (_sp > XB_SPIN_CAP) { atomicAdd(&(bar)[XB_TMO], 1u); break; } } } } while (0)
struct XcdBarrier { unsigned* bar; unsigned x; volatile LAS unsigned* st; };
__device__ __forceinline__ XcdBarrier xcd_barrier_post(unsigned* bar, volatile LAS unsigned* st) {
    XcdBarrier b; b.bar = bar; b.x = xb_xcc_id(); b.st = st;
    if (threadIdx.x == 0) (void)xb_add(&bar[XB_XCNT(b.x)], 1u);
    return b;
}
__device__ __forceinline__ void xcd_barrier_complete(unsigned* bar, unsigned x, unsigned& nloc, unsigned& nx) {
    const unsigned G = gridDim.x * gridDim.y * gridDim.z;
    unsigned sum, cnt, mine, sp = 0u;
    for (;;) {
        sum = 0u; cnt = 0u; mine = 0u;
#pragma unroll
        for (unsigned j = 0; j < 16; ++j) { const unsigned c = xb_ld(&bar[XB_XCNT(j)]); sum += c; cnt += (c > 0u) ? 1u : 0u; mine = (j == x) ? c : mine; }
        if (sum == G) break;
        __builtin_amdgcn_s_sleep(1);
        if ((++sp & 255u) == 0u) { if (xb_ld(&bar[XB_TMO])) break; if (sp > XB_SPIN_CAP) { atomicAdd(&bar[XB_TMO], 1u); break; } }
    }
    nloc = mine > 0u ? mine : 1u; nx = cnt > 0u ? cnt : 1u;
}
__device__ __forceinline__ void xcd_barrier(const XcdBarrier& b) {
    asm volatile("s_waitcnt vmcnt(0)" ::: "memory");
    __syncthreads();
    if (threadIdx.x == 0) {
        unsigned* bar = b.bar;
        __builtin_amdgcn_s_waitcnt(0);
        unsigned nloc = b.st[0], nx = b.st[1];
        if (nloc == 0u) { xcd_barrier_complete(bar, b.x, nloc, nx); b.st[0] = nloc; b.st[1] = nx; }
        const unsigned old = xb_add(&bar[XB_XSUB(b.x)], 1u);
        const unsigned gen = old / nloc;
        if (old + 1u == (gen + 1u) * nloc) {
            __builtin_amdgcn_fence(__ATOMIC_RELEASE, "agent");
            asm volatile("s_waitcnt vmcnt(0)" ::: "memory");
            const unsigned og = xb_add(&bar[XB_TOP], 1u);
            const unsigned tg = og / nx;
            asm volatile("buffer_inv sc1" ::: "memory");
            if (og + 1u == (tg + 1u) * nx) xb_add(&bar[XB_TOPGEN], 1u);
            else XB_SPIN(xb_ld(&bar[XB_TOPGEN]) == tg, bar);
            xb_add(&bar[XB_XGEN(b.x)], 1u);
            asm volatile("s_waitcnt vmcnt(0)" ::: "memory");
        } else {
            asm volatile("buffer_inv sc1" ::: "memory");
            XB_SPIN(xb_ld(&bar[XB_XGEN(b.x)]) == gen, bar);
            asm volatile("s_waitcnt vmcnt(0)" ::: "memory");
        }
    }
    __syncthreads();
}

namespace pg8 {
constexpr int BM = 256, BK = 64, HALF = 128, HTB = HALF * BK * 2, NXCD = 8, WGM = 8;
__host__ __device__ __forceinline__ int lds_byte(int r, int c) { const int st = (r >> 4) * 2 + (c >> 5), rr = r & 15, cc = c & 31, ob = rr * 64 + cc * 2; return st * 1024 + (ob ^ (((ob >> 9) & 1) << 5)); }
__host__ __device__ __forceinline__ int perm32(int rho) { const int n = rho >> 4, i = rho & 15; return 8 * (i >> 2) + 4 * n + (i & 3); }
__host__ __device__ __forceinline__ void stage_rc(int b, int& R, int& C) { const int st = b / 1024, sb = b % 1024, swz = sb ^ (((sb >> 9) & 1) << 5); R = (st >> 1) * 16 + swz / 64; C = (st & 1) * 32 + (swz % 64) / 2; }

struct GUnit { const char* A; const char* B; int nt; int row0; int col0; int aux; };

template <class Epi, class Sched>
__device__ __forceinline__ void gemm_phase(LAS unsigned char* lds, const int lda, const int ldb, const Sched& S, const Epi& E) {
    const int tid = tid_opaque(), wid = __builtin_amdgcn_readfirstlane(tid >> 6), lane = tid & 63, wr = wid >> 2, wc = wid & 3, fr = lane & 15, fq = lane >> 4;
    unsigned voffA[2], voffB[2];
#pragma unroll
    for (int i = 0; i < 2; ++i) { int R, C; stage_rc(tid * 16 + i * 8192, R, C); const int Rb = Epi::PERM ? ((R & ~31) + perm32(R & 31)) : R; voffA[i] = (unsigned)(R * lda + C) * 2u; voffB[i] = (unsigned)(Rb * ldb + C) * 2u; }
    const size_t kstep = (size_t)(BK * 2);
    const size_t hstepA = (size_t)HALF * lda * 2, hstepB = (size_t)HALF * ldb * 2;
    const unsigned ldsw = (unsigned)wid * 1024u;
    const int aoff = lds_byte(wr * 64 + fr, fq * 8), boff = lds_byte(wc * 32 + fr, fq * 8);
#define PG8_SA(b, h) (((b) * 2 + (h)) * HTB)
#define PG8_SB(b, h) ((4 + (b) * 2 + (h)) * HTB)
#define PG8_STAGE(bufoff, gbase, voff) do { _Pragma("unroll") for (int _i = 0; _i < 2; ++_i) \
        __builtin_amdgcn_global_load_lds((const unsigned*)((const char*)(gbase) + (voff)[_i]), (LAS unsigned*)(lds + (bufoff) + ldsw + _i * 8192), 16, 0, 0); } while (0)
#define PG8_LDA(dst, b, h) do { _Pragma("unroll") for (int m = 0; m < 4; ++m) _Pragma("unroll") for (int k = 0; k < 2; ++k) dst[m][k] = *(const LAS bf16x8*)(lds + PG8_SA(b, h) + aoff + m * 2048 + k * 1024); } while (0)
#define PG8_LDB(dst, b, h) do { _Pragma("unroll") for (int n = 0; n < 2; ++n) _Pragma("unroll") for (int k = 0; k < 2; ++k) dst[n][k] = *(const LAS bf16x8*)(lds + PG8_SB(b, h) + boff + n * 2048 + k * 1024); } while (0)
#define PG8_MMA(ai, bj, At, Bt) do { __builtin_amdgcn_s_setprio(1); _Pragma("unroll") for (int m = 0; m < 4; ++m) _Pragma("unroll") for (int n = 0; n < 2; ++n) _Pragma("unroll") for (int k = 0; k < 2; ++k) \
        acc[ai][bj][m][n] = __builtin_amdgcn_mfma_f32_16x16x32_bf16(Bt[n][k], At[m][k], acc[ai][bj][m][n], 0, 0, 0); __builtin_amdgcn_s_setprio(0); } while (0)
#define PG8_WAIT_V(n) asm volatile("s_waitcnt vmcnt(" #n ")" ::: "memory")
#define PG8_WAIT_L(n) asm volatile("s_waitcnt lgkmcnt(" #n ")" ::: "memory")
#define PG8_BAR __builtin_amdgcn_s_barrier()
#define PG8_SCHED __builtin_amdgcn_sched_barrier(0)
    GUnit cur, nxt; int ui = 0;
    if (!S.next(0, cur)) return;
    E.prepare(S, lds, tid);
    f32x4 acc[2][2][4][2];
#pragma unroll
    for (int a = 0; a < 2; ++a)
#pragma unroll
        for (int b = 0; b < 2; ++b)
#pragma unroll
            for (int m = 0; m < 4; ++m)
#pragma unroll
                for (int n = 0; n < 2; ++n) acc[a][b][m][n] = (f32x4){0.f, 0.f, 0.f, 0.f};
    bf16x8 At[4][2], B0[2][2], B1[2][2];
    const char* cA = cur.A; const char* cB = cur.B;
    PG8_STAGE(PG8_SB(0, 0), cB, voffB); PG8_STAGE(PG8_SB(0, 1), cB + hstepB, voffB); PG8_STAGE(PG8_SA(0, 0), cA, voffA); PG8_STAGE(PG8_SA(0, 1), cA + hstepA, voffA);
    if (wr == 1) PG8_BAR;
    PG8_WAIT_V(2); PG8_BAR;
    PG8_STAGE(PG8_SB(1, 0), cB + kstep, voffB); PG8_STAGE(PG8_SA(1, 0), cA + kstep, voffA); PG8_STAGE(PG8_SB(1, 1), cB + hstepB + kstep, voffB);
    PG8_WAIT_V(6); PG8_BAR;
    for (;;) {
        const bool has_next = S.next(ui + 1, nxt);
        const char* nA = has_next ? nxt.A : cA; const char* nB = has_next ? nxt.B : cB;
        const int nt = cur.nt;
        for (int t = 0; t < nt; t += 2) {
            const bool last = (t == nt - 2);
            const char* a1 = cA + (size_t)(t + 1) * kstep;
            const char* a2 = last ? nA : cA + (size_t)(t + 2) * kstep; const char* b2 = last ? nB : cB + (size_t)(t + 2) * kstep;
            const char* a3 = a2 + kstep; const char* b3 = b2 + kstep;
            PG8_LDB(B0, 0, 0); PG8_LDB(B1, 0, 1); PG8_SCHED; PG8_LDA(At, 0, 0); PG8_STAGE(PG8_SA(1, 1), a1 + hstepA, voffA);
            PG8_WAIT_V(8); PG8_WAIT_L(0); PG8_BAR; PG8_MMA(0, 0, At, B0); PG8_MMA(0, 1, At, B1); PG8_BAR; PG8_SCHED;
            PG8_LDA(At, 0, 1); PG8_STAGE(PG8_SB(0, 0), b2, voffB); PG8_STAGE(PG8_SB(0, 1), b2 + hstepB, voffB); PG8_STAGE(PG8_SA(0, 0), a2, voffA);
            PG8_WAIT_V(8); PG8_WAIT_L(0); PG8_BAR; PG8_MMA(1, 0, At, B0); PG8_MMA(1, 1, At, B1); PG8_BAR; PG8_SCHED;
            PG8_LDB(B0, 1, 0); PG8_LDB(B1, 1, 1); PG8_SCHED; PG8_LDA(At, 1, 0); PG8_STAGE(PG8_SA(0, 1), a2 + hstepA, voffA);
            PG8_WAIT_V(8); PG8_WAIT_L(0); PG8_BAR; PG8_MMA(0, 0, At, B0); PG8_MMA(0, 1, At, B1); PG8_BAR; PG8_SCHED;
            PG8_LDA(At, 1, 1); PG8_STAGE(PG8_SB(1, 0), b3, voffB); PG8_STAGE(PG8_SB(1, 1), b3 + hstepB, voffB); PG8_STAGE(PG8_SA(1, 0), a3, voffA);
            PG8_WAIT_V(8); PG8_WAIT_L(0); PG8_BAR; PG8_MMA(1, 0, At, B0); PG8_MMA(1, 1, At, B1); PG8_BAR; PG8_SCHED;
        }
        if (wr == 0) PG8_BAR;
        E(acc, cur, ui, wr, wc, fr, fq);
        if (!has_next) break;
#pragma unroll
        for (int a = 0; a < 2; ++a)
#pragma unroll
            for (int b = 0; b < 2; ++b)
#pragma unroll
                for (int m = 0; m < 4; ++m)
#pragma unroll
                    for (int n = 0; n < 2; ++n) acc[a][b][m][n] = (f32x4){0.f, 0.f, 0.f, 0.f};
        cur = nxt; cA = nA; cB = nB; ++ui;
        if (wr == 1) PG8_BAR;
    }
    PG8_WAIT_V(0);
    PG8_BAR;
#undef PG8_SA
#undef PG8_SB
#undef PG8_STAGE
#undef PG8_LDA
#undef PG8_LDB
#undef PG8_MMA
#undef PG8_WAIT_V
#undef PG8_WAIT_L
#undef PG8_BAR
#undef PG8_SCHED
}

template <class Epi, class Sched>
__device__ __forceinline__ void gemm_phase_n128(LAS unsigned char* lds, const int lda, const int ldb, const Sched& S, const Epi& E) {
    const int tid = tid_opaque(), wid = __builtin_amdgcn_readfirstlane(tid >> 6), lane = tid & 63, wr = wid >> 2, wc = wid & 3, fr = lane & 15, fq = lane >> 4;
    unsigned voffA[2], voffB[2];
#pragma unroll
    for (int i = 0; i < 2; ++i) { int R, C; stage_rc(tid * 16 + i * 8192, R, C); const int Rb = Epi::PERM ? ((R & ~31) + perm32(R & 31)) : R; voffA[i] = (unsigned)(R * lda + C) * 2u; voffB[i] = (unsigned)(Rb * ldb + C) * 2u; }
    const size_t kstep = (size_t)(BK * 2);
    const size_t hstepA = (size_t)HALF * lda * 2;
    const unsigned ldsw = (unsigned)wid * 1024u;
    const int aoff = lds_byte(wr * 64 + fr, fq * 8), boff = lds_byte(wc * 32 + fr, fq * 8);
#define N1_SA(b, h) (((b) * 2 + (h)) * HTB)
#define N1_SB(b) ((4 + (b)) * HTB)
#define N1_STAGE(bufoff, gbase, voff) do { _Pragma("unroll") for (int _i = 0; _i < 2; ++_i) \
        __builtin_amdgcn_global_load_lds((const unsigned*)((const char*)(gbase) + (voff)[_i]), (LAS unsigned*)(lds + (bufoff) + ldsw + _i * 8192), 16, 0, 0); } while (0)
#define N1_LDA(dst, b, h) do { _Pragma("unroll") for (int m = 0; m < 4; ++m) _Pragma("unroll") for (int k = 0; k < 2; ++k) dst[m][k] = *(const LAS bf16x8*)(lds + N1_SA(b, h) + aoff + m * 2048 + k * 1024); } while (0)
#define N1_LDB(dst, b) do { _Pragma("unroll") for (int n = 0; n < 2; ++n) _Pragma("unroll") for (int k = 0; k < 2; ++k) dst[n][k] = *(const LAS bf16x8*)(lds + N1_SB(b) + boff + n * 2048 + k * 1024); } while (0)
#define N1_MMA(ai, At, Bt) do { __builtin_amdgcn_s_setprio(1); _Pragma("unroll") for (int m = 0; m < 4; ++m) _Pragma("unroll") for (int n = 0; n < 2; ++n) _Pragma("unroll") for (int k = 0; k < 2; ++k) \
        acc[ai][m][n] = __builtin_amdgcn_mfma_f32_16x16x32_bf16(Bt[n][k], At[m][k], acc[ai][m][n], 0, 0, 0); __builtin_amdgcn_s_setprio(0); } while (0)
#define N1_WAIT_V(n) asm volatile("s_waitcnt vmcnt(" #n ")" ::: "memory")
#define N1_WAIT_L(n) asm volatile("s_waitcnt lgkmcnt(" #n ")" ::: "memory")
#define N1_BAR __builtin_amdgcn_s_barrier()
#define N1_SCHED __builtin_amdgcn_sched_barrier(0)
    GUnit cur, nxt; int ui = 0;
    if (!S.next(0, cur)) return;
    E.prepare(S, lds, tid);
    f32x4 acc[2][4][2];
#pragma unroll
    for (int x = 0; x < 2; ++x)
#pragma unroll
        for (int m = 0; m < 4; ++m)
#pragma unroll
            for (int n = 0; n < 2; ++n) acc[x][m][n] = (f32x4){0.f, 0.f, 0.f, 0.f};
    bf16x8 At[4][2], B0[2][2];
    const char* cA = cur.A; const char* cB = cur.B;
    N1_STAGE(N1_SB(0), cB, voffB); N1_STAGE(N1_SA(0, 0), cA, voffA); N1_STAGE(N1_SA(0, 1), cA + hstepA, voffA);
    if (wr == 1) N1_BAR;
    N1_WAIT_V(0); N1_BAR;
    N1_STAGE(N1_SB(1), cB + kstep, voffB); N1_STAGE(N1_SA(1, 0), cA + kstep, voffA);
    N1_BAR;
    for (;;) {
        const bool has_next = S.next(ui + 1, nxt);
        const char* nA = has_next ? nxt.A : cA; const char* nB = has_next ? nxt.B : cB;
        const int nt = cur.nt;
        for (int t = 0; t < nt; t += 2) {
            const bool last = (t == nt - 2);
            const char* a1 = cA + (size_t)(t + 1) * kstep;
            const char* a2 = last ? nA : cA + (size_t)(t + 2) * kstep; const char* b2 = last ? nB : cB + (size_t)(t + 2) * kstep;
            const char* a3 = a2 + kstep; const char* b3 = b2 + kstep;
            N1_LDB(B0, 0); N1_SCHED; N1_LDA(At, 0, 0); N1_STAGE(N1_SA(1, 1), a1 + hstepA, voffA);
            N1_WAIT_V(6); N1_WAIT_L(0); N1_BAR; N1_MMA(0, At, B0); N1_BAR; N1_SCHED;
            N1_LDA(At, 0, 1); N1_STAGE(N1_SA(0, 0), a2, voffA); N1_STAGE(N1_SB(0), b2, voffB);
            N1_WAIT_V(6); N1_WAIT_L(0); N1_BAR; N1_MMA(1, At, B0); N1_BAR; N1_SCHED;
            N1_LDB(B0, 1); N1_SCHED; N1_LDA(At, 1, 0); N1_STAGE(N1_SA(0, 1), a2 + hstepA, voffA);
            N1_WAIT_V(6); N1_WAIT_L(0); N1_BAR; N1_MMA(0, At, B0); N1_BAR; N1_SCHED;
            N1_LDA(At, 1, 1); N1_STAGE(N1_SA(1, 0), a3, voffA); N1_STAGE(N1_SB(1), b3, voffB);
            N1_WAIT_V(6); N1_WAIT_L(0); N1_BAR; N1_MMA(1, At, B0); N1_BAR; N1_SCHED;
        }
        if (wr == 0) N1_BAR;
        E(acc, cur, ui, wr, wc, fr, fq);
        if (!has_next) break;
#pragma unroll
        for (int x = 0; x < 2; ++x)
#pragma unroll
            for (int m = 0; m < 4; ++m)
#pragma unroll
                for (int n = 0; n < 2; ++n) acc[x][m][n] = (f32x4){0.f, 0.f, 0.f, 0.f};
        cur = nxt; cA = nA; cB = nB; ++ui;
        if (wr == 1) N1_BAR;
    }
    N1_WAIT_V(0);
    N1_BAR;
#undef N1_SA
#undef N1_SB
#undef N1_STAGE
#undef N1_LDA
#undef N1_LDB
#undef N1_MMA
#undef N1_WAIT_V
#undef N1_WAIT_L
#undef N1_BAR
#undef N1_SCHED
}
}
using pg8::GUnit;
typedef f32x4 AccT[2][2][4][2];
typedef f32x4 AccH[2][4][2];

template <class Sched> __device__ __forceinline__ void prep_rstd(LAS unsigned char* lds, const float* ssp, const Sched& S, bool cols, int tid) {
    LAS float* R = (LAS float*)(lds + RSTD_OFF);
    if (tid < 256) {
        f32x4 p[3][8]; bool ok[3];
#pragma unroll
        for (int i = 0; i < 3; ++i) { GUnit u; ok[i] = S.next(i, u);
            if (ok[i]) { const f32x4* q = (const f32x4*)(ssp + (size_t)((cols ? u.col0 : u.row0) + tid) * SSPN);
#pragma unroll
                for (int k = 0; k < 8; ++k) p[i][k] = q[k]; } }
#pragma unroll
        for (int i = 0; i < 3; ++i) if (ok[i]) { const f32x4 s4 = ((p[i][0] + p[i][1]) + (p[i][2] + p[i][3])) + ((p[i][4] + p[i][5]) + (p[i][6] + p[i][7]));
            R[i * 256 + tid] = rsqrtf(((s4[0] + s4[1]) + (s4[2] + s4[3])) * (1.f / 1024.f) + EPS); }
    }
    LDS_WAIT(); __builtin_amdgcn_s_barrier(); asm volatile("" ::: "memory");
}
struct EpiQKV {
    bf16_t* Q; bf16_t* KB; bf16_t* VB; float* nk; float* nv; const float* ropec; const float* ropes; const float* ssp; const float* sw; LAS unsigned char* lds;
    static constexpr bool PERM = false;
    template <class Sched> __device__ __forceinline__ void prepare(const Sched& S, LAS unsigned char* l, int tid) const { prep_rstd(l, ssp, S, false, tid); }
    __device__ __forceinline__ void operator()(const AccT& acc, const GUnit& u, int ui, int wr, int wc, int fr, int fq) const {
        const LAS float* R = (const LAS float*)(lds + RSTD_OFF) + ui * 256;
        const int sec = u.col0 >> 10;
        const bool lat = u.row0 >= NCTX;
        const int cbase = (u.col0 & 1023) + wc * 32 + 4 * fq;
        const float* swc = sw + cond_of_row(u.row0) * 3072 + u.col0 + wc * 32 + 4 * fq;
        f32x4 sv[2][2];
#pragma unroll
        for (int bj = 0; bj < 2; ++bj)
#pragma unroll
            for (int n = 0; n < 2; ++n) sv[bj][n] = *(const f32x4*)(swc + bj * 128 + n * 16);
#pragma unroll
        for (int ai = 0; ai < 2; ++ai)
#pragma unroll
            for (int m = 0; m < 4; ++m) {
                const int rl = ai * 128 + wr * 64 + m * 16 + fr, r = u.row0 + rl;
                const float rs = R[rl];
                int t = 0, kvrow = r; size_t orow = 0;
                if (lat) { const int rr = r - NCTX; t = rr & 1023; kvrow = NCTX + (rr >> 10) * 1536 + 512 + t; }
                else { const int b = r >> 8; orow = ((size_t)(b * 2) * 256 + (r & 255)) * 1024; }
                f32x4 cs = {1.f, 1.f, 1.f, 1.f}, sn = {0.f, 0.f, 0.f, 0.f};
                if (lat && sec < 2) { const int pos = (wc & 1) ? (t & 63) : (t >> 6); cs = *(const f32x4*)(ropec + pos * 16 + 4 * fq); sn = *(const f32x4*)(ropes + pos * 16 + 4 * fq); }
#pragma unroll
                for (int bj = 0; bj < 2; ++bj) {
                    f32x4 x1 = acc[ai][bj][m][0] * rs + sv[bj][0], x2 = acc[ai][bj][m][1] * rs + sv[bj][1];
                    const int c = cbase + bj * 128;
                    if (sec < 2) { const f32x4 y1 = x1 * cs - x2 * sn, y2 = x2 * cs + x1 * sn; x1 = y1; x2 = y2; }
                    u32x4 w; w.x = cvt_pk_bf16(x1[0], x1[1]); w.y = cvt_pk_bf16(x1[2], x1[3]); w.z = cvt_pk_bf16(x2[0], x2[1]); w.w = cvt_pk_bf16(x2[2], x2[3]);
                    const int c8 = c + 4 * fq;
                    if (sec == 0) *(u32x4*)(Q + (size_t)r * 1024 + c8) = w;
                    else {
                        *(u32x4*)((sec == 1 ? KB : VB) + (size_t)kvrow * 1024 + c8) = w;
                        if (!lat) { if (sec == 1) { float* o = nk + orow + c; *(f32x4*)o = x1; *(f32x4*)(o + 16) = x2; }
                                    else { float* o = nv + orow + c8; *(f32x4*)o = x1; *(f32x4*)(o + 4) = x2; } }
                    }
                }
            }
    }
};
struct EpiQKV128 {
    bf16_t* Q; bf16_t* KB; bf16_t* VB; float* nk; float* nv; const float* ropec; const float* ropes; const float* ssp; const float* sw; LAS unsigned char* lds;
    static constexpr bool PERM = false;
    template <class Sched> __device__ __forceinline__ void prepare(const Sched& S, LAS unsigned char* l, int tid) const { prep_rstd(l, ssp, S, false, tid); }
    __device__ __forceinline__ void operator()(const AccH& acc, const GUnit& u, int ui, int wr, int wc, int fr, int fq) const {
        const LAS float* R = (const LAS float*)(lds + RSTD_OFF) + ui * 256;
        const int sec = u.col0 >> 10;
        const bool lat = u.row0 >= NCTX;
        const int c = (u.col0 & 1023) + wc * 32 + 4 * fq;
        const float* swc = sw + cond_of_row(u.row0) * 3072 + u.col0 + wc * 32 + 4 * fq;
        const f32x4 sv0 = *(const f32x4*)swc, sv1 = *(const f32x4*)(swc + 16);
#pragma unroll
        for (int ai = 0; ai < 2; ++ai)
#pragma unroll
            for (int m = 0; m < 4; ++m) {
                const int rl = ai * 128 + wr * 64 + m * 16 + fr, r = u.row0 + rl;
                const float rs = R[rl];
                int t = 0, kvrow = r; size_t orow = 0;
                if (lat) { const int rr = r - NCTX; t = rr & 1023; kvrow = NCTX + (rr >> 10) * 1536 + 512 + t; }
                else { const int b = r >> 8; orow = ((size_t)(b * 2) * 256 + (r & 255)) * 1024; }
                f32x4 cs = {1.f, 1.f, 1.f, 1.f}, sn = {0.f, 0.f, 0.f, 0.f};
                if (lat && sec < 2) { const int pos = (wc & 1) ? (t & 63) : (t >> 6); cs = *(const f32x4*)(ropec + pos * 16 + 4 * fq); sn = *(const f32x4*)(ropes + pos * 16 + 4 * fq); }
                f32x4 x1 = acc[ai][m][0] * rs + sv0, x2 = acc[ai][m][1] * rs + sv1;
                if (sec < 2) { const f32x4 y1 = x1 * cs - x2 * sn, y2 = x2 * cs + x1 * sn; x1 = y1; x2 = y2; }
                u32x4 w; w.x = cvt_pk_bf16(x1[0], x1[1]); w.y = cvt_pk_bf16(x1[2], x1[3]); w.z = cvt_pk_bf16(x2[0], x2[1]); w.w = cvt_pk_bf16(x2[2], x2[3]);
                const int c8 = c + 4 * fq;
                if (sec == 0) *(u32x4*)(Q + (size_t)r * 1024 + c8) = w;
                else {
                    *(u32x4*)((sec == 1 ? KB : VB) + (size_t)kvrow * 1024 + c8) = w;
                    if (!lat) { if (sec == 1) { float* o = nk + orow + c; *(f32x4*)o = x1; *(f32x4*)(o + 16) = x2; }
                                else { float* o = nv + orow + c8; *(f32x4*)o = x1; *(f32x4*)(o + 4) = x2; } }
                }
            }
    }
};
struct EpiResid {
    float* X; const float* gate; const float* an; bf16_t* XA; float* ssp;
    static constexpr bool PERM = true;
    template <class Sched> __device__ __forceinline__ void prepare(const Sched&, LAS unsigned char*, int) const {}
    __device__ __forceinline__ void operator()(const AccT& acc, const GUnit& u, int ui, int wr, int wc, int fr, int fq) const {
        const int cbase = u.col0 + wc * 32 + 8 * fq;
        const int cnd = cond_of_row(u.row0);
        const float* g = gate + cnd * 6144;
        f32x4 gv[2][2];
#pragma unroll
        for (int bj = 0; bj < 2; ++bj)
#pragma unroll
            for (int n = 0; n < 2; ++n) gv[bj][n] = *(const f32x4*)(g + cbase + bj * 128 + n * 4);
        const float* anc = an + cnd * 1024 + cbase;
        const int slot = (u.col0 >> 8) * 4 + wc;
#pragma unroll
        for (int ai = 0; ai < 2; ++ai) {
#pragma unroll
            for (int mp = 0; mp < 2; ++mp) {
            f32x4 xo[2][2][2];
#pragma unroll
            for (int m2 = 0; m2 < 2; ++m2)
#pragma unroll
                for (int bj = 0; bj < 2; ++bj)
#pragma unroll
                    for (int n = 0; n < 2; ++n) xo[m2][bj][n] = *(const f32x4*)(X + (size_t)(u.row0 + ai * 128 + wr * 64 + (mp * 2 + m2) * 16 + fr) * 1024 + cbase + bj * 128 + n * 4);
#pragma unroll
            for (int m2 = 0; m2 < 2; ++m2) {
                const int m = mp * 2 + m2;
                const size_t ro = (size_t)(u.row0 + ai * 128 + wr * 64 + m * 16 + fr);
                float ss = 0.f;
#pragma unroll
                for (int bj = 0; bj < 2; ++bj) {
                    const f32x4 x0 = xo[m2][bj][0] + gv[bj][0] * acc[ai][bj][m][0], x1 = xo[m2][bj][1] + gv[bj][1] * acc[ai][bj][m][1];
                    *(f32x4*)(X + ro * 1024 + cbase + bj * 128) = x0; *(f32x4*)(X + ro * 1024 + cbase + bj * 128 + 4) = x1;
                    ss += ((x0[0] * x0[0] + x0[1] * x0[1]) + (x0[2] * x0[2] + x0[3] * x0[3])) + ((x1[0] * x1[0] + x1[1] * x1[1]) + (x1[2] * x1[2] + x1[3] * x1[3]));
                    if (an) { const f32x4 y0 = x0 * *(const f32x4*)(anc + bj * 128), y1 = x1 * *(const f32x4*)(anc + bj * 128 + 4); u32x4 w; w.x = cvt_pk_bf16(y0[0], y0[1]); w.y = cvt_pk_bf16(y0[2], y0[3]); w.z = cvt_pk_bf16(y1[0], y1[1]); w.w = cvt_pk_bf16(y1[2], y1[3]);
                        *(u32x4*)(XA + ro * 1024 + cbase + bj * 128) = w; }
                }
                ss += __shfl_xor(ss, 16); ss += __shfl_xor(ss, 32);
                if (fq == 0) ssp[ro * SSPN + slot] = ss;
            }
            }
            asm volatile("" ::: "memory");
        }
    }
};
struct EpiResid128 {
    bf16_t* X; const float* gate; const float* an; bf16_t* XA; float* ssp;
    static constexpr bool PERM = true;
    template <class Sched> __device__ __forceinline__ void prepare(const Sched&, LAS unsigned char*, int) const {}
    __device__ __forceinline__ void operator()(const AccH& acc, const GUnit& u, int ui, int wr, int wc, int fr, int fq) const {
        const int cbase = u.col0 + wc * 32 + 8 * fq;
        const int cnd = cond_of_row(u.row0);
        const float* g = gate + cnd * 6144;
        const f32x4 gv0 = *(const f32x4*)(g + cbase), gv1 = *(const f32x4*)(g + cbase + 4);
        f32x4 av0 = {0.f, 0.f, 0.f, 0.f}, av1 = av0;
        if (an) { av0 = *(const f32x4*)(an + cnd * 1024 + cbase); av1 = *(const f32x4*)(an + cnd * 1024 + cbase + 4); }
        const int slot = (u.col0 >> 7) * 4 + wc;
        u32x4 xo[2][4];
#pragma unroll
        for (int ai = 0; ai < 2; ++ai)
#pragma unroll
            for (int m = 0; m < 4; ++m) xo[ai][m] = *(const u32x4*)(X + (size_t)(u.row0 + ai * 128 + wr * 64 + m * 16 + fr) * 1024 + cbase);
#pragma unroll
        for (int ai = 0; ai < 2; ++ai)
#pragma unroll
            for (int m = 0; m < 4; ++m) {
                const size_t ro = (size_t)(u.row0 + ai * 128 + wr * 64 + m * 16 + fr);
                const u32x4 xw = xo[ai][m];
                const f32x4 xa = {bflo(xw.x), bfhi(xw.x), bflo(xw.y), bfhi(xw.y)}, xb = {bflo(xw.z), bfhi(xw.z), bflo(xw.w), bfhi(xw.w)};
                const f32x4 x0 = xa + gv0 * acc[ai][m][0], x1 = xb + gv1 * acc[ai][m][1];
                { u32x4 w; w.x = cvt_pk_bf16(x0[0], x0[1]); w.y = cvt_pk_bf16(x0[2], x0[3]); w.z = cvt_pk_bf16(x1[0], x1[1]); w.w = cvt_pk_bf16(x1[2], x1[3]); *(u32x4*)(X + ro * 1024 + cbase) = w; }
                float ss = ((x0[0] * x0[0] + x0[1] * x0[1]) + (x0[2] * x0[2] + x0[3] * x0[3])) + ((x1[0] * x1[0] + x1[1] * x1[1]) + (x1[2] * x1[2] + x1[3] * x1[3]));
                if (an) { const f32x4 y0 = x0 * av0, y1 = x1 * av1; u32x4 w; w.x = cvt_pk_bf16(y0[0], y0[1]); w.y = cvt_pk_bf16(y0[2], y0[3]); w.z = cvt_pk_bf16(y1[0], y1[1]); w.w = cvt_pk_bf16(y1[2], y1[3]);
                    *(u32x4*)(XA + ro * 1024 + cbase) = w; }
                ss += __shfl_xor(ss, 16); ss += __shfl_xor(ss, 32);
                if (fq == 0) ssp[ro * SSPN + slot] = ss;
            }
    }
};
struct EpiG128 {
    bf16_t* GH; const float* ssp; const float* sw; LAS unsigned char* lds;
    static constexpr bool PERM = true;
    template <class Sched> __device__ __forceinline__ void prepare(const Sched& S, LAS unsigned char* l, int tid) const { prep_rstd(l, ssp, S, false, tid); }
    __device__ __forceinline__ void operator()(const AccH& acc, const GUnit& u, int ui, int wr, int wc, int fr, int fq) const {
        const LAS float* R = (const LAS float*)(lds + RSTD_OFF) + ui * 256;
        const float* swc = sw + cond_of_row(u.row0) * 5120 + u.col0 + wc * 32 + 8 * fq;
        const f32x4 sv0 = *(const f32x4*)swc, sv1 = *(const f32x4*)(swc + 4);
        const int cbase = (u.col0 - 4096) + wc * 32 + 8 * fq;
#pragma unroll
        for (int ai = 0; ai < 2; ++ai)
#pragma unroll
            for (int m = 0; m < 4; ++m) {
                const int rl = ai * 128 + wr * 64 + m * 16 + fr; const float rs = R[rl];
                const f32x4 v0 = acc[ai][m][0] * rs + sv0, v1 = acc[ai][m][1] * rs + sv1;
                u32x4 w; w.x = cvt_pk_bf16(silu_f(v0[0]), silu_f(v0[1])); w.y = cvt_pk_bf16(silu_f(v0[2]), silu_f(v0[3])); w.z = cvt_pk_bf16(silu_f(v1[0]), silu_f(v1[1])); w.w = cvt_pk_bf16(silu_f(v1[2]), silu_f(v1[3]));
                *(u32x4*)(GH + (size_t)(u.row0 + rl) * 1024 + cbase) = w;
            }
    }
};
struct EpiFFN {
    bf16_t* ACT; const float* ssp; const float* sw; LAS unsigned char* lds;
    static constexpr bool PERM = true;
    template <class Sched> __device__ __forceinline__ void prepare(const Sched& S, LAS unsigned char* l, int tid) const { prep_rstd(l, ssp, S, false, tid); }
    __device__ __forceinline__ void operator()(const AccT& acc, const GUnit& u, int ui, int wr, int wc, int fr, int fq) const {
        const LAS float* R = (const LAS float*)(lds + RSTD_OFF) + ui * 256;
        const int abase = (u.col0 >> 1) + wc * 32 + 8 * fq;
        const float* swc = sw + cond_of_row(u.row0) * 5632 + u.col0 + wc * 32 + 8 * fq;
        f32x4 sv[2][2];
#pragma unroll
        for (int bj = 0; bj < 2; ++bj)
#pragma unroll
            for (int n = 0; n < 2; ++n) sv[bj][n] = *(const f32x4*)(swc + bj * 128 + n * 4);
#pragma unroll
        for (int ai = 0; ai < 2; ++ai)
#pragma unroll
            for (int m = 0; m < 4; ++m) {
                const int rl = ai * 128 + wr * 64 + m * 16 + fr;
                const float rs = R[rl];
                u32x4 w;
#pragma unroll
                for (int n = 0; n < 2; ++n) {
                    const f32x4 g = acc[ai][0][m][n] * rs + sv[0][n], up = acc[ai][1][m][n] * rs + sv[1][n];
                    w[2 * n] = cvt_pk_bf16(silu_f(g[0]) * up[0], silu_f(g[1]) * up[1]); w[2 * n + 1] = cvt_pk_bf16(silu_f(g[2]) * up[2], silu_f(g[3]) * up[3]);
                }
                *(u32x4*)(ACT + (size_t)(u.row0 + rl) * DFF + abase) = w;
            }
    }
};
__device__ __forceinline__ void quad_transpose(f32x4& v, int qi) {
#define QT_X1(x) __int_as_float(__builtin_amdgcn_update_dpp(0, __float_as_int(x), 0xB1, 0xF, 0xF, true))
#define QT_X2(x) __int_as_float(__builtin_amdgcn_update_dpp(0, __float_as_int(x), 0x4E, 0xF, 0xF, true))
    const bool o1 = qi & 1, o2 = qi & 2;
    { const float t0 = o1 ? v[0] : v[1], t1 = o1 ? v[2] : v[3]; const float r0 = QT_X1(t0), r1 = QT_X1(t1);
      if (o1) { v[0] = r0; v[2] = r1; } else { v[1] = r0; v[3] = r1; } }
    { const float t0 = o2 ? v[0] : v[2], t1 = o2 ? v[1] : v[3]; const float r0 = QT_X2(t0), r1 = QT_X2(t1);
      if (o2) { v[0] = r0; v[1] = r1; } else { v[2] = r0; v[3] = r1; } }
#undef QT_X1
#undef QT_X2
}
#define DPP_SHR(x, N) __int_as_float(__builtin_amdgcn_update_dpp(0, __float_as_int(x), 0x110 + (N), 0xF, 0xF, true))
#define DPP_SHL(x, N) __int_as_float(__builtin_amdgcn_update_dpp(0, __float_as_int(x), 0x100 + (N), 0xF, 0xF, true))
struct EpiHgrn {
    bf16_t* GH; bf16_t* QTF; bf16_t* KTF; bf16_t* QTB; bf16_t* KTB; bf16_t* KHTF; bf16_t* KHTB; bf16_t* VT; float* DDF; float* DDB; const float* lbv; const float* ssp; const float* sw; LAS unsigned char* lds;
    static constexpr bool PERM = false;
    template <class Sched> __device__ __forceinline__ void prepare(const Sched& S, LAS unsigned char* l, int tid) const { prep_rstd(l, ssp, S, false, tid); }
    __device__ __forceinline__ void operator()(const AccT& acc, const GUnit& u, int ui, int wr, int wc, int fr, int fq) const {
        const LAS float* R = (const LAS float*)(lds + RSTD_OFF) + ui * 256;
        const int t = u.col0 >> 8;
        const float* swc = sw + cond_of_row(u.row0) * 5120 + u.col0 + wc * 32 + 4 * fq;
        f32x4 sv[2][2];
#pragma unroll
        for (int bj = 0; bj < 2; ++bj)
#pragma unroll
            for (int n = 0; n < 2; ++n) sv[bj][n] = *(const f32x4*)(swc + bj * 128 + n * 16);
        if (t >= 16) {
            const int cbase = (u.col0 - 4096) + wc * 32 + 4 * fq;
#pragma unroll
            for (int ai = 0; ai < 2; ++ai)
#pragma unroll
                for (int m = 0; m < 4; ++m) {
                    const int rl = ai * 128 + wr * 64 + m * 16 + fr; const float rs = R[rl];
#pragma unroll
                    for (int bj = 0; bj < 2; ++bj)
#pragma unroll
                        for (int n = 0; n < 2; ++n) { const f32x4 v = acc[ai][bj][m][n] * rs + sv[bj][n];
                            u32x2 w; w.x = cvt_pk_bf16(silu_f(v[0]), silu_f(v[1])); w.y = cvt_pk_bf16(silu_f(v[2]), silu_f(v[3]));
                            *(u32x2*)(GH + (size_t)(u.row0 + rl) * 1024 + cbase + bj * 128 + n * 16) = w; }
                }
            return;
        }
        const int h = t >> 1, kk = (t & 1) * 64 + wc * 16 + 4 * fq, chg = t * 64 + wc * 16 + 4 * fq;
        const f32x4 lb0 = *(const f32x4*)(lbv + chg), lb1 = *(const f32x4*)(lbv + 1024 + chg);
        const int lane = fq * 16 + fr;
#pragma unroll 1
        for (int am = 0; am < 8; ++am) {
            const int ai = am >> 2, m = am & 3;
            f32x4 aq, av, azf, azb;
            switch (am) {
#define HG_CASE(I) case I: aq = acc[(I) >> 2][0][(I) & 3][0]; av = acc[(I) >> 2][0][(I) & 3][1]; azf = acc[(I) >> 2][1][(I) & 3][0]; azb = acc[(I) >> 2][1][(I) & 3][1]; break;
                HG_CASE(0) HG_CASE(1) HG_CASE(2) HG_CASE(3) HG_CASE(4) HG_CASE(5) HG_CASE(6) default: aq = acc[1][0][3][0]; av = acc[1][0][3][1]; azf = acc[1][1][3][0]; azb = acc[1][1][3][1]; break;
#undef HG_CASE
            }
            const int rl = ai * 128 + wr * 64 + m * 16 + fr; const float rs = R[rl];
            const int tok = u.row0 + rl; const size_t cg = (size_t)((tok >> 4) * 8 + h);
            const f32x4 q4 = aq * rs + sv[0][0], v4 = av * rs + sv[0][1], zf = azf * rs + sv[1][0], zb = azb * rs + sv[1][1];
            f32x4 q, kf, kb, bf, bb;
#pragma unroll
            for (int j = 0; j < 4; ++j) { q[j] = silu_f(q4[j]);
                const float ff = lb0[j] + (1.f - lb0[j]) * sigmoid_f(zf[j]), fb = lb1[j] + (1.f - lb1[j]) * sigmoid_f(zb[j]);
                kf[j] = 1.f - ff; kb[j] = 1.f - fb; bf[j] = __logf(ff); bb[j] = __logf(fb); }
#pragma unroll
            for (int j = 0; j < 4; ++j) {
                float x = bf[j]; x += DPP_SHR(x, 1); x += DPP_SHR(x, 2); x += DPP_SHR(x, 4); x += DPP_SHR(x, 8); bf[j] = x;
                float y = bb[j]; y += DPP_SHL(y, 1); y += DPP_SHL(y, 2); y += DPP_SHL(y, 4); y += DPP_SHL(y, 8); bb[j] = y; }
            f32x4 qtf, ktf, khf, ddf, qtb, ktb, khb, ddb;
#pragma unroll
            for (int j = 0; j < 4; ++j) {
                const float ef = __expf(bf[j]), eif = __expf(-bf[j]), eb = __expf(bb[j]), eib = __expf(-bb[j]);
                ddf[j] = __shfl(ef, lane | 15); ddb[j] = __shfl(eb, lane & ~15);
                qtf[j] = q[j] * ef; ktf[j] = kf[j] * eif; khf[j] = ktf[j] * ddf[j];
                qtb[j] = q[j] * eb; ktb[j] = kb[j] * eib; khb[j] = ktb[j] * ddb[j]; }
            const size_t ro = (size_t)tok * 1024 + h * 128 + kk;
            { u32x2 w; w.x = cvt_pk_bf16(qtf[0], qtf[1]); w.y = cvt_pk_bf16(qtf[2], qtf[3]); *(u32x2*)(QTF + ro) = w; }
            { u32x2 w; w.x = cvt_pk_bf16(ktf[0], ktf[1]); w.y = cvt_pk_bf16(ktf[2], ktf[3]); *(u32x2*)(KTF + ro) = w; }
            { u32x2 w; w.x = cvt_pk_bf16(qtb[0], qtb[1]); w.y = cvt_pk_bf16(qtb[2], qtb[3]); *(u32x2*)(QTB + ro) = w; }
            { u32x2 w; w.x = cvt_pk_bf16(ktb[0], ktb[1]); w.y = cvt_pk_bf16(ktb[2], ktb[3]); *(u32x2*)(KTB + ro) = w; }
            f32x4 vt = v4;
            quad_transpose(khf, fr & 3); quad_transpose(khb, fr & 3); quad_transpose(vt, fr & 3);
            const size_t to = (cg * 128 + kk + (fr & 3)) * 16 + (fr & ~3);
            { u32x2 w; w.x = cvt_pk_bf16(khf[0], khf[1]); w.y = cvt_pk_bf16(khf[2], khf[3]); *(u32x2*)(KHTF + to) = w; }
            { u32x2 w; w.x = cvt_pk_bf16(khb[0], khb[1]); w.y = cvt_pk_bf16(khb[2], khb[3]); *(u32x2*)(KHTB + to) = w; }
            { u32x2 w; w.x = cvt_pk_bf16(vt[0], vt[1]); w.y = cvt_pk_bf16(vt[2], vt[3]); *(u32x2*)(VT + to) = w; }
            if (fr == 15) *(f32x4*)(DDF + cg * 128 + kk) = ddf;
            if (fr == 0) *(f32x4*)(DDB + cg * 128 + kk) = ddb;
        }
    }
};
struct EpiFour1 {
    bf16_t* ZT; const float* ssp; const float* sw; LAS unsigned char* lds;
    static constexpr bool PERM = true;
    template <class Sched> __device__ __forceinline__ void prepare(const Sched& S, LAS unsigned char* l, int tid) const { prep_rstd(l, ssp, S, true, tid); }
    __device__ __forceinline__ void operator()(const AccT& acc, const GUnit& u, int ui, int wr, int wc, int fr, int fq) const {
        const LAS float* R = (const LAS float*)(lds + RSTD_OFF) + ui * 256;
        const int cs = u.row0 >> 10;
        const float* swc = sw + cond_of_row(u.col0) * 2048 + u.row0 + wr * 64 + fr;
#pragma unroll
        for (int bj = 0; bj < 2; ++bj) {
            const int tl = bj * 128 + wc * 32 + 8 * fq, tok = u.col0 + tl;
            const f32x4 rs0 = *(const LAS f32x4*)(R + tl), rs1 = *(const LAS f32x4*)(R + tl + 4);
            int off;
            if (tok < NCTX) off = (tok >> 8) * 512 + cs * 256 + (tok & 255);
            else { const int tt = tok - NCTX; off = 8192 + (tt >> 10) * 2048 + cs * 1024 + (tt & 1023); }
#pragma unroll
            for (int ai = 0; ai < 2; ++ai)
#pragma unroll
                for (int m = 0; m < 4; ++m) {
                    const int nrow = (u.row0 & 1023) + ai * 128 + wr * 64 + m * 16 + fr;
                    const float sh = swc[ai * 128 + m * 16];
                    const f32x4 v0 = acc[ai][bj][m][0] * rs0 + sh, v1 = acc[ai][bj][m][1] * rs1 + sh;
                    u32x4 w; w.x = cvt_pk_bf16(v0[0], v0[1]); w.y = cvt_pk_bf16(v0[2], v0[3]); w.z = cvt_pk_bf16(v1[0], v1[1]); w.w = cvt_pk_bf16(v1[2], v1[3]);
                    *(u32x4*)(ZT + (size_t)nrow * 16384 + off) = w;
                }
        }
    }
};
struct EpiBf16 {
    bf16_t* O; int ldc;
    static constexpr bool PERM = false;
    template <class Sched> __device__ __forceinline__ void prepare(const Sched&, LAS unsigned char*, int) const {}
    __device__ __forceinline__ void operator()(const AccT& acc, const GUnit& u, int ui, int wr, int wc, int fr, int fq) const {
        bf16_t* base = O + (size_t)u.aux;
        const int cbase = u.col0 + wc * 32 + 4 * fq;
#pragma unroll
        for (int ai = 0; ai < 2; ++ai)
#pragma unroll
            for (int m = 0; m < 4; ++m) {
                bf16_t* pr = base + (size_t)(u.row0 + ai * 128 + wr * 64 + m * 16 + fr) * ldc + cbase;
#pragma unroll
                for (int bj = 0; bj < 2; ++bj)
#pragma unroll
                    for (int n = 0; n < 2; ++n) { const f32x4 v = acc[ai][bj][m][n]; u32x2 w; w.x = cvt_pk_bf16(v[0], v[1]); w.y = cvt_pk_bf16(v[2], v[3]); *(u32x2*)(pr + bj * 128 + n * 16) = w; }
            }
    }
};
struct GenSched {
    const char* A; const char* A2; const char* B; int lda, ldb, nM, nN, nwg, G, c, nt, mode;
    __device__ __forceinline__ void init(int mode_, const void* A_, const void* A2_, int lda_, const void* B_, int ldb_, int M, int N, int K, int G_, int c_) {
        mode = mode_; A = (const char*)A_; A2 = (const char*)A2_; B = (const char*)B_; lda = lda_; ldb = ldb_; nM = M / 256; nN = N / 256; nwg = (mode_ == 0 || mode_ == 7 || mode_ == 8) ? nM * nN : mode_ == 1 ? 128 : mode_ == 2 ? 32 : mode_ == 5 ? 512 : 256; G = G_; c = c_; nt = K / 64; }
    __device__ __forceinline__ bool next(int i, GUnit& u) const {
        const int L = i * G + c; if (L >= nwg) return false;
        u.aux = 0;
        if (mode == 0 || mode == 7 || mode == 8) {
            if (mode == 7 && i > 0) return false;
            int half = 0; int wgid = L; if (mode == 8) { if (i > 0) return false; half = L & 1; wgid = 256 + (L >> 1); if (wgid >= nM * nN) return false; } { const int q = nwg / 8, r = nwg % 8, xcd = wgid % 8, off = wgid / 8; wgid = (xcd < r ? xcd * (q + 1) : r * (q + 1) + (xcd - r) * q) + off; }
            const int nig = 8 * nN, gid = wgid / nig, fm = gid * 8, gsz = (nM - fm) < 8 ? (nM - fm) : 8;
            const int pm = fm + ((wgid % nig) % gsz), pn = (wgid % nig) / gsz;
            u.A = A + (size_t)pm * 256 * lda * 2; u.B = B + (size_t)(pn * 256 + half * 128) * ldb * 2; u.nt = nt; u.row0 = pm * 256; u.col0 = pn * 256 + half * 128;
        } else if (mode == 1) {
            if (L < 64) { const int b = L >> 4, pm = (L >> 2) & 3, pn = L & 3;
                u.A = A + (size_t)pm * 256 * 2048 * 2; u.B = B + ((size_t)pn * 256 * 16384 + 8192 + b * 2048) * 2; u.nt = 32; u.row0 = NCTX + b * 1024 + pm * 256; u.col0 = pn * 256; }
            else { const int l = L - 64, b = l >> 2, pn = l & 3;
                u.A = A2; u.B = B + ((size_t)pn * 256 * 16384 + b * 512) * 2; u.nt = 8; u.row0 = b * 256; u.col0 = pn * 256; }
        } else if (mode == 5) {
            int wgid = L; { const int xcd = wgid % 8, off = wgid / 8; wgid = xcd * 64 + off; }
            const int gid = wgid >> 7, r = wgid & 127, pm = gid * 8 + (r & 7), pn = r >> 3;
            u.A = A + (size_t)pm * 256 * lda * 2; u.B = B + (size_t)pn * 256 * ldb * 2; u.nt = nt; u.row0 = pm * 256; u.col0 = pn * 256;
        } else if (mode == 6) {
            const int wgid = (L & 7) * 32 + (L >> 3), pm = wgid >> 3, pn = wgid & 7;
            u.A = A + (size_t)pm * 256 * lda * 2; u.B = B + (size_t)(4096 + pn * 128) * ldb * 2; u.nt = nt; u.row0 = pm * 256; u.col0 = 4096 + pn * 128;
        } else if (mode == 3) {
            const int wgid = (L & 7) * 32 + (L >> 3), pm = wgid >> 3, pn = wgid & 7;
            u.A = A + (size_t)pm * 256 * lda * 2; u.B = B + (size_t)pn * 128 * ldb * 2; u.nt = nt; u.row0 = pm * 256; u.col0 = pn * 128;
        } else if (mode == 4) {
            if (L < 128) { const int b = L >> 5, pm = (L >> 3) & 3, pn = L & 7;
                u.A = A + (size_t)pm * 256 * 2048 * 2; u.B = B + ((size_t)pn * 128 * 16384 + 8192 + b * 2048) * 2; u.nt = 32; u.row0 = NCTX + b * 1024 + pm * 256; u.col0 = pn * 128; }
            else { const int l = L - 128, b = l >> 3, pn = l & 7;
                u.A = A2; u.B = B + ((size_t)pn * 128 * 16384 + b * 512) * 2; u.nt = 8; u.row0 = b * 256; u.col0 = pn * 128; }
        } else {
            const int g = L >> 3, cs = (L >> 2) & 1, pm = L & 3;
            u.A = A + ((size_t)pm * 256 * 1024 + g * 256) * 2; u.B = B + (size_t)cs * 256 * 2; u.nt = nt;
            u.row0 = pm * 256; u.col0 = 0; u.aux = cs * 1024 * 1024 + g * 256;
        }
        return true;
    }
};
struct Args {
    const float* in[23];
    float* out; unsigned char* ws;
    int ph_lo, ph_hi; float lam_init0, lam_init1; int pad0, pad1;
};
typedef const __attribute__((address_space(4))) Args* ArgP;
enum { I_XP = 0, I_XS, I_CK, I_CV, I_ST, I_C, I_CCTX, I_WADA, I_BADA, I_GMIX, I_GFFN, I_WQKV, I_LAM, I_GSUB, I_WOA, I_WINR, I_LBL, I_GOUT, I_WOR, I_WFOUR, I_WFI, I_WFO, I_GFIN };

template <class RowMap>
__device__ __forceinline__ void transpose_item(const float* W, int K, int N, bf16_t* WT, const RowMap& rowmap, LAS float* scr, int item, int lane) {
    const int nblk = N / 32, kb = item / nblk, nb = item % nblk, k0 = 64 * kb, n0 = 32 * nb;
#pragma unroll
    for (int i = 0; i < 8; ++i) { const int kk = 8 * i + (lane >> 3), c4 = (lane & 7) * 4; const f32x4 v = __builtin_nontemporal_load((const f32x4*)(W + (size_t)(k0 + kk) * N + n0 + c4));
        LAS float* d = scr + kk * 33 + c4; d[0] = v[0]; d[1] = v[1]; d[2] = v[2]; d[3] = v[3]; }
    LDS_WAIT(); asm volatile("" ::: "memory");
    const int c = lane & 7;
#pragma unroll
    for (int j = 0; j < 4; ++j) { const int n = (lane >> 3) + 8 * j; const LAS float* s = scr + (8 * c) * 33 + n;
        u32x4 o; o.x = cvt_pk_bf16(s[0 * 33], s[1 * 33]); o.y = cvt_pk_bf16(s[2 * 33], s[3 * 33]); o.z = cvt_pk_bf16(s[4 * 33], s[5 * 33]); o.w = cvt_pk_bf16(s[6 * 33], s[7 * 33]);
        *(u32x4*)(WT + (size_t)rowmap(n0 + n) * K + k0 + 8 * c) = o; }
    LDS_WAIT(); asm volatile("" ::: "memory");
}
struct RowHin { __device__ __forceinline__ int operator()(int s) const { const int sec = s >> 10, ch = s & 1023; if (sec == 2) return 4096 + ch;
    const int t = ch >> 6, cl = ch & 63, bj = sec >= 3 ? 1 : 0, n = (sec == 1 || sec == 4) ? 1 : 0; return 256 * t + 128 * bj + 32 * (cl >> 4) + 16 * n + (cl & 15); } };
struct RowQKV { __device__ __forceinline__ int operator()(int s) const { if (s < 2048) return s; const int p = s & 31; return (s & ~31) + 16 * ((p >> 2) & 1) + 4 * (p >> 3) + (p & 3); } };
struct RowId { __device__ __forceinline__ int operator()(int n) const { return n; } };
struct RowFFN { __device__ __forceinline__ int operator()(int s) const { const int n = s >= DFF ? 1 : 0, a = s - n * DFF; return 256 * (a >> 7) + 128 * n + (a & 127); } };

__device__ __forceinline__ void cache_convert(ArgP a, int j, int gw, int ngw, int lane) {
    bf16_t* KB = (bf16_t*)(a->ws + WS_KB); bf16_t* VB = (bf16_t*)(a->ws + WS_VB);
    for (int it = gw; it < 2 * 4 * 512; it += ngw) {
        const int kv = it >> 11, r = it & 2047, b = r >> 9, s = r & 511;
        const float* src = a->in[kv ? I_CV : I_CK] + ((size_t)(b * 2 + j) * 512 + s) * 1024;
        bf16_t* dst = (kv ? VB : KB) + (size_t)(NCTX + b * 1536 + s) * 1024;
#pragma unroll
        for (int q = 0; q < 2; ++q) { const f32x8 v = *(const f32x8*)(src + q * 512 + lane * 8);
            u32x4 w; w.x = cvt_pk_bf16(v[0], v[1]); w.y = cvt_pk_bf16(v[2], v[3]); w.z = cvt_pk_bf16(v[4], v[5]); w.w = cvt_pk_bf16(v[6], v[7]);
            if (kv) *(u32x4*)(dst + q * 512 + lane * 8) = w;
            else { const int d0 = q * 512 + lane * 8, p0 = d0 & 31, n = p0 >> 4, f0 = (p0 & 15) >> 2;
                bf16_t* g = dst + (d0 & ~31);
                u32x2 lo, hi; lo.x = w.x; lo.y = w.y; hi.x = w.z; hi.y = w.w;
                *(u32x2*)(g + 8 * f0 + 4 * n) = lo; *(u32x2*)(g + 8 * (f0 + 1) + 4 * n) = hi; } }
    }
}

__device__ __forceinline__ void phase_prologue(ArgP a, LAS unsigned char* lds, int G, int bid) {
    const int tid = tid_opaque(), lane = tid & 63, wave = __builtin_amdgcn_readfirstlane(tid >> 6);
    const int gw = bid * NWAVES + wave, ngw = G * NWAVES, gt = bid * NTHREADS + tid, ngt = G * NTHREADS;
    {
        LAS float* SC = (LAS float*)lds;
        LAS float* RED = (LAS float*)(lds + 20480);
        for (int i = tid; i < 5 * 1024; i += NTHREADS) { const int cnd = i >> 10, k = i & 1023; const float x = cnd == 0 ? a->in[I_CCTX][k] : a->in[I_C][(cnd - 1) * 1024 + k]; SC[i] = silu_f(x); }
        __syncthreads();
        float* mod = (float*)(a->ws + WS_MOD);
        for (int it = bid; it < 4 * 48; it += G) {
            const int l = it / 48, cg = it % 48;
            const float* w = a->in[I_WADA] + (size_t)l * 1024 * 6144 + (size_t)(wave * 128) * 6144 + cg * 128 + lane * 2;
            float acc[5][2];
#pragma unroll
            for (int c = 0; c < 5; ++c) { acc[c][0] = 0.f; acc[c][1] = 0.f; }
            for (int k0 = 0; k0 < 128; k0 += 8) {
                f32x2 wv[8];
#pragma unroll
                for (int kk = 0; kk < 8; ++kk) wv[kk] = *(const f32x2*)(w + (size_t)(k0 + kk) * 6144);
#pragma unroll
                for (int kk = 0; kk < 8; ++kk)
#pragma unroll
                    for (int c = 0; c < 5; ++c) { const float s = SC[c * 1024 + wave * 128 + k0 + kk]; acc[c][0] += s * wv[kk].x; acc[c][1] += s * wv[kk].y; }
            }
#pragma unroll
            for (int c = 0; c < 5; ++c) { RED[(wave * 5 + c) * 128 + lane * 2] = acc[c][0]; RED[(wave * 5 + c) * 128 + lane * 2 + 1] = acc[c][1]; }
            __syncthreads();
            for (int i = tid; i < 5 * 128; i += NTHREADS) { const int c = i >> 7, col = i & 127; float s = 0.f;
#pragma unroll
                for (int wv2 = 0; wv2 < 8; ++wv2) s += RED[(wv2 * 5 + c) * 128 + col];
                mod[(size_t)(l * 5 + c) * 6144 + cg * 128 + col] = s + a->in[I_BADA][l * 6144 + cg * 128 + col]; }
            __syncthreads();
        }
    }
    {
        LAS float* scr = (LAS float*)(lds + wave * 16384);
        constexpr int I_Q = 16 * 96, I_O = 16 * 32, I_R = 16 * 160, I_FI = 16 * 176, I_FO = 44 * 32;
        constexpr int NIT = 2 * I_Q + 2 * I_O + I_R + I_O + I_O + 4 * I_FI + 4 * I_FO;
        for (int it = gw; it < NIT; it += ngw) {
            int r = it;
            if (r < 2 * I_Q) { const int j = r / I_Q; transpose_item(a->in[I_WQKV] + (size_t)j * 1024 * 3072, 1024, 3072, (bf16_t*)(a->ws + WS_WQKV) + (size_t)j * 3072 * 1024, RowQKV(), scr, r % I_Q, lane); continue; } r -= 2 * I_Q;
            if (r < 2 * I_O) { const int j = r / I_O; transpose_item(a->in[I_WOA] + (size_t)j * 1024 * 1024, 1024, 1024, (bf16_t*)(a->ws + WS_WOA) + (size_t)j * 1024 * 1024, RowId(), scr, r % I_O, lane); continue; } r -= 2 * I_O;
            if (r < I_R) { transpose_item(a->in[I_WINR], 1024, 5120, (bf16_t*)(a->ws + WS_WINR), RowHin(), scr, r, lane); continue; } r -= I_R;
            if (r < I_O) { transpose_item(a->in[I_WOR], 1024, 1024, (bf16_t*)(a->ws + WS_WOR), RowId(), scr, r, lane); continue; } r -= I_O;
            if (r < I_O) { transpose_item(a->in[I_WFOUR], 1024, 1024, (bf16_t*)(a->ws + WS_WFO), RowId(), scr, r, lane); continue; } r -= I_O;
            if (r < 4 * I_FI) { const int l = r / I_FI; transpose_item(a->in[I_WFI] + (size_t)l * 1024 * 5632, 1024, 5632, (bf16_t*)(a->ws + WS_WFI) + (size_t)l * 5632 * 1024, RowFFN(), scr, r % I_FI, lane); continue; } r -= 4 * I_FI;
            { const int l = r / I_FO; transpose_item(a->in[I_WFO] + (size_t)l * DFF * 1024, DFF, 1024, (bf16_t*)(a->ws + WS_WFOUT) + (size_t)l * 1024 * DFF, RowId(), scr, r % I_FO, lane); }
        }
    }
    {
        float* ropec = (float*)(a->ws + WS_ROPE); float* ropes = ropec + 1024;
        for (int i = gt; i < 1024; i += ngt) { const int pos = i >> 4, q = i & 15;
            float inv = (q & 3) == 0 ? 1.f : (q & 3) == 1 ? 0.56234132519f : (q & 3) == 2 ? 0.31622776602f : 0.17782794100f;
            inv *= (q >> 2) == 0 ? 1.f : (q >> 2) == 1 ? 0.1f : (q >> 2) == 2 ? 0.01f : 0.001f;
            const float ap = (float)pos * inv * 0.31830988618f;
            ropec[i] = cospif(ap); ropes[i] = sinpif(ap); }
        bf16_t* TC = (bf16_t*)(a->ws + WS_TC);
        for (int i = gt; i < 256 * 512; i += ngt) { const int c = i >> 9, k = i & 511, d = k & 255; const float ang = (float)((c * d) & 255) * (1.f / 128.f);
            const float v = (k < 256 ? cospif(ang) : sinpif(ang)) * 0.0625f; TC[c * 1024 + k] = (bf16_t)(cvt_pk_bf16(v, 0.f) & 0xffff); }
        bf16_t* C2 = (bf16_t*)(a->ws + WS_CS256);
        for (int i = gt; i < 256 * 512; i += ngt) { const int p = i >> 9, k = i & 511, t = k & 255; const float ang = (float)((p * t) & 255) * (1.f / 128.f);
            const float v = (k < 256 ? cospif(ang) : -sinpif(ang)) * 0.0625f; C2[p * 2048 + k] = (bf16_t)(cvt_pk_bf16(v, 0.f) & 0xffff); }
        bf16_t* C1 = (bf16_t*)(a->ws + WS_CS1024);
        for (int i = gt; i < 1024 * 2048; i += ngt) { const int p = i >> 11, k = i & 2047, t = k & 1023; const float ang = (float)((p * t) & 1023) * (1.f / 512.f);
            const float v = (k < 1024 ? cospif(ang) : -sinpif(ang)) * 0.03125f; C1[i] = (bf16_t)(cvt_pk_bf16(v, 0.f) & 0xffff); }
        float* lbv = (float*)(a->ws + WS_LBV);
        for (int i = gt; i < 2048; i += ngt) { const int d = i >> 10, k = i & 1023; const float* lg = a->in[I_LBL] + (size_t)d * 4096 + k;
            const float l0 = lg[0], l1 = lg[1024], l2 = lg[2048], l3 = lg[3072]; const float mx = fmaxf(fmaxf(l0, l1), fmaxf(l2, l3));
            const float e0 = __expf(l0 - mx), e1 = __expf(l1 - mx), e2 = __expf(l2 - mx), e3 = __expf(l3 - mx); lbv[i] = e1 / (e0 + e1 + e2 + e3); }
        if (gw < 2) { const int j = gw; const float* lp = a->in[I_LAM] + j * 256;
            float s1 = wave_sum(lp[lane] * lp[64 + lane]), s2 = wave_sum(lp[128 + lane] * lp[192 + lane]);
            if (lane == 0) ((float*)(a->ws + WS_LAM))[j] = __expf(s1) - __expf(s2) + (j == 0 ? a->lam_init0 : a->lam_init1); }
    }
    cache_convert(a, 0, gw, ngw, lane);
}

__device__ __forceinline__ void phase_first_norm(ArgP a, int gw, int ngw, int lane) {
    bf16_t* X = (bf16_t*)(a->ws + WS_X); bf16_t* XA = (bf16_t*)(a->ws + WS_H); float* ssp = (float*)(a->ws + WS_SSP);
    const float* an = (const float*)(a->ws + WS_AN);
    for (int r = gw; r < MTOK; r += ngw) {
        const float* xr = r < NCTX ? a->in[I_XP] + (size_t)r * 1024 : a->in[I_XS] + (size_t)(r - NCTX) * 1024;
        const float* ac = an + cond_of_row(r) * 1024;
        float s = 0.f;
#pragma unroll
        for (int j = 0; j < 4; ++j) {
            const int c = j * 256 + lane * 4;
            const f32x4 v = *(const f32x4*)(xr + c); s += (v.x * v.x + v.y * v.y) + (v.z * v.z + v.w * v.w);
            const f32x4 y = v * *(const f32x4*)(ac + c);
            u32x2 w; w.x = cvt_pk_bf16(y[0], y[1]); w.y = cvt_pk_bf16(y[2], y[3]);
            *(u32x2*)(XA + (size_t)r * 1024 + c) = w; { u32x2 xw; xw.x = cvt_pk_bf16(v[0], v[1]); xw.y = cvt_pk_bf16(v[2], v[3]); *(u32x2*)(X + (size_t)r * 1024 + c) = xw; }
        }
        s = wave_sum(s);
        if (lane < SSPN) ssp[(size_t)r * SSPN + lane] = lane == 0 ? s : 0.f;
    }
}
__device__ __forceinline__ void phase_final(ArgP a, int gw, int ngw, int lane) {
    const bf16_t* X = (const bf16_t*)(a->ws + WS_X); const float* g = a->in[I_GFIN]; const float* ssp = (const float*)(a->ws + WS_SSP) + 8ull * 8192 * SSPN;
    for (int r = gw; r < MTOK; r += ngw) {
        const bf16_t* xr = X + (size_t)r * 1024;
        float s = lane < SSPN ? ssp[(size_t)r * SSPN + lane] : 0.f;
        const float rstd = rsqrtf(wave_sum(s) * (1.f / 1024.f) + EPS);
#pragma unroll
        for (int j = 0; j < 4; ++j) { const int c = j * 256 + lane * 4; const u32x2 xw = *(const u32x2*)(xr + c); const f32x4 xv = {bflo(xw.x), bfhi(xw.x), bflo(xw.y), bfhi(xw.y)};
            *(f32x4*)(a->out + (size_t)r * 1024 + c) = xv * rstd * *(const f32x4*)(g + c); }
    }
}
__device__ __forceinline__ void phase_an(ArgP a, int gt, int ngt) {
    float* an = (float*)(a->ws + WS_AN); const float* mod = (const float*)(a->ws + WS_MOD);
    for (int i = gt; i < 8 * 5 * 1024; i += ngt) { const int nidx = i / 5120, c = (i / 1024) % 5, k = i & 1023, l = nidx >> 1, wh = nidx & 1;
        an[i] = a->in[wh ? I_GFFN : I_GMIX][l * 1024 + k] * (1.f + mod[(size_t)(l * 5 + c) * 6144 + (wh ? 4 : 1) * 1024 + k]); }
}
__device__ __forceinline__ void phase_sw(ArgP a, LAS unsigned char* lds, unsigned mask, int gw, int ngw, int tid, int lane) {
    LAS float* SH = (LAS float*)lds;
    const float* mod = (const float*)(a->ws + WS_MOD); float* swb = (float*)(a->ws + WS_SW);
    for (int nidx = 0; nidx < 8; ++nidx) {
        if (!((mask >> nidx) & 1)) continue;
        const int l = nidx >> 1, wh = nidx & 1, N = sw_n(nidx);
        const bf16_t* W = nidx == 0 ? (const bf16_t*)(a->ws + WS_WQKV) : nidx == 6 ? (const bf16_t*)(a->ws + WS_WQKV) + 3072ull * 1024 : nidx == 2 ? (const bf16_t*)(a->ws + WS_WINR)
                        : nidx == 4 ? (const bf16_t*)(a->ws + WS_WCS) : (const bf16_t*)(a->ws + WS_WFI) + (size_t)l * 5632 * 1024;
        __syncthreads();
        for (int i = tid; i < 5 * 1024; i += NTHREADS) SH[i] = mod[(size_t)(l * 5 + (i >> 10)) * 6144 + (wh ? 3 : 0) * 1024 + (i & 1023)];
        __syncthreads();
        float* sw = swb + sw_off(nidx);
        for (int n = gw; n < N; n += ngw) {
            const u32x4 w0 = *(const u32x4*)(W + (size_t)n * 1024 + lane * 8), w1 = *(const u32x4*)(W + (size_t)n * 1024 + 512 + lane * 8);
            float wf[16];
#pragma unroll
            for (int i = 0; i < 4; ++i) { wf[2 * i] = bflo(w0[i]); wf[2 * i + 1] = bfhi(w0[i]); wf[8 + 2 * i] = bflo(w1[i]); wf[8 + 2 * i + 1] = bfhi(w1[i]); }
            float acc[5];
#pragma unroll
            for (int c = 0; c < 5; ++c) {
                const f32x4 s0 = *(const LAS f32x4*)(SH + c * 1024 + lane * 8), s1 = *(const LAS f32x4*)(SH + c * 1024 + lane * 8 + 4);
                const f32x4 s2 = *(const LAS f32x4*)(SH + c * 1024 + 512 + lane * 8), s3 = *(const LAS f32x4*)(SH + c * 1024 + 512 + lane * 8 + 4);
                float t = 0.f;
#pragma unroll
                for (int i = 0; i < 4; ++i) t += wf[i] * s0[i] + wf[4 + i] * s1[i] + wf[8 + i] * s2[i] + wf[12 + i] * s3[i];
                acc[c] = wave_sum(t);
            }
            if (lane < 5) sw[(size_t)lane * N + n] = lane == 0 ? acc[0] : lane == 1 ? acc[1] : lane == 2 ? acc[2] : lane == 3 ? acc[3] : acc[4];
        }
    }
    __syncthreads();
}
__device__ __forceinline__ void phase_hgrn_final(ArgP a, int gw, int ngw, int lane) {
    const bf16_t* OF = (const bf16_t*)(a->ws + WS_OF); const bf16_t* OB = (const bf16_t*)(a->ws + WS_OB); const bf16_t* GH = (const bf16_t*)(a->ws + WS_GH);
    bf16_t* O = (bf16_t*)(a->ws + WS_O); const float* go = a->in[I_GOUT];
    for (int r = gw; r < MTOK; r += ngw) {
        const size_t off = (size_t)r * 1024 + lane * 16;
        u32x4 f0 = *(const u32x4*)(OF + off), f1 = *(const u32x4*)(OF + off + 8), b0 = *(const u32x4*)(OB + off), b1 = *(const u32x4*)(OB + off + 8);
        u32x4 g0 = *(const u32x4*)(GH + off), g1 = *(const u32x4*)(GH + off + 8);
        float o[16], gt[16];
#pragma unroll
        for (int i = 0; i < 4; ++i) { o[2 * i] = bflo(f0[i]) + bflo(b0[i]); o[2 * i + 1] = bfhi(f0[i]) + bfhi(b0[i]); o[8 + 2 * i] = bflo(f1[i]) + bflo(b1[i]); o[8 + 2 * i + 1] = bfhi(f1[i]) + bfhi(b1[i]);
            gt[2 * i] = bflo(g0[i]); gt[2 * i + 1] = bfhi(g0[i]); gt[8 + 2 * i] = bflo(g1[i]); gt[8 + 2 * i + 1] = bfhi(g1[i]); }
        float s = 0.f;
#pragma unroll
        for (int i = 0; i < 16; ++i) s += o[i] * o[i];
        s += __shfl_xor(s, 1); s += __shfl_xor(s, 2); s += __shfl_xor(s, 4);
        const float rstd = rsqrtf(s * (1.f / 128.f) + EPS);
        const int vc = (lane & 7) * 16;
        u32x4 w0, w1;
#pragma unroll
        for (int i = 0; i < 4; ++i) {
            w0[i] = cvt_pk_bf16(o[2 * i] * rstd * go[vc + 2 * i] * gt[2 * i], o[2 * i + 1] * rstd * go[vc + 2 * i + 1] * gt[2 * i + 1]);
            w1[i] = cvt_pk_bf16(o[8 + 2 * i] * rstd * go[vc + 8 + 2 * i] * gt[8 + 2 * i], o[8 + 2 * i + 1] * rstd * go[vc + 8 + 2 * i + 1] * gt[8 + 2 * i + 1]); }
        *(u32x4*)(O + off) = w0; *(u32x4*)(O + off + 8) = w1;
    }
}

namespace att {
constexpr int KVBLK = 64, LDQ = 1024;
constexpr float SCALE = 0.125f, THR = 8.f;
constexpr size_t SHM_V = KVBLK * 128 * 2, SHM_K = KVBLK * 128 * 2;
#define KSWZ(row, colB) ((row) * 256 + ((colB) ^ (((row) & 7) << 4)))
#define SBAR() __builtin_amdgcn_sched_barrier(0)
__device__ __forceinline__ int crow(int r, int hi) { return (r & 3) + 8 * (r >> 2) + 4 * hi; }
__device__ __forceinline__ unsigned cvtpk(float lo, float hi) { unsigned r; asm volatile("v_cvt_pk_bf16_f32 %0, %1, %2" : "=v"(r) : "v"(lo), "v"(hi)); return r; }
__device__ __forceinline__ void partialSM(f32x16& p0, f32x16& p1, float& m_reg, float& mn, float& alpha) {
  constexpr float C = SCALE * 1.4426950408889634f;
  float pmax = p0[0];
#pragma unroll
  for (int r = 1; r < 16; ++r) pmax = fmaxf(pmax, p0[r]);
#pragma unroll
  for (int r = 0; r < 16; ++r) pmax = fmaxf(pmax, p1[r]);
  { auto rr = __builtin_amdgcn_permlane32_swap(__float_as_uint(pmax), __float_as_uint(pmax), false, false);
    pmax = fmaxf(__uint_as_float(rr[0]), __uint_as_float(rr[1])); }
  if (__builtin_expect(__all(pmax - m_reg <= THR / SCALE), 1)) { mn = m_reg; alpha = 1.f; }
  else { mn = fmaxf(m_reg, pmax); alpha = __builtin_amdgcn_exp2f((m_reg - mn) * C); m_reg = mn; }
  float mnC = -mn * C;
#pragma unroll
  for (int r = 0; r < 16; ++r) p0[r] = fmaf(p0[r], C, mnC);
#pragma unroll
  for (int r = 0; r < 16; ++r) p1[r] = fmaf(p1[r], C, mnC);
#pragma unroll
  for (int r = 0; r < 16; ++r) p0[r] = __builtin_amdgcn_exp2f(p0[r]);
}
__device__ __forceinline__ void finishSM(f32x16& p0, f32x16& p1, float alpha, float& l_reg, bf16x8& pa0, bf16x8& pa1, bf16x8& pa2, bf16x8& pa3) {
#pragma unroll
  for (int r = 0; r < 16; ++r) p1[r] = __builtin_amdgcn_exp2f(p1[r]);
  float ps = 0;
#pragma unroll
  for (int r = 0; r < 16; ++r) ps += p0[r];
#pragma unroll
  for (int r = 0; r < 16; ++r) ps += p1[r];
  { auto rr = __builtin_amdgcn_permlane32_swap(__float_as_uint(ps), __float_as_uint(ps), false, false);
    ps = __uint_as_float(rr[0]) + __uint_as_float(rr[1]); }
  l_reg = l_reg * alpha + ps;
#define PK4(P, BASE, OUT) do { unsigned a0 = cvtpk(P[BASE + 0], P[BASE + 1]), a1 = cvtpk(P[BASE + 2], P[BASE + 3]);   \
    unsigned b0 = cvtpk(P[BASE + 4], P[BASE + 5]), b1 = cvtpk(P[BASE + 6], P[BASE + 7]);                              \
    auto r0 = __builtin_amdgcn_permlane32_swap(a0, b0, false, false); auto r1 = __builtin_amdgcn_permlane32_swap(a1, b1, false, false); \
    u32x4 w = {r0[0], r1[0], r0[1], r1[1]}; OUT = *reinterpret_cast<bf16x8*>(&w); } while (0)
  PK4(p0, 0, pa0); PK4(p0, 8, pa1); PK4(p1, 0, pa2); PK4(p1, 8, pa3);
#undef PK4
}
__device__ __forceinline__ void qkt(f32x16& p0, f32x16& p1, const bf16_t* Ks, const bf16x8* qr, int r32, int hi, int cc) {
  p0 = f32x16{}; p1 = f32x16{};
#pragma unroll
  for (int d0 = 0; d0 < 4; ++d0) { int cb = (cc * 64 + d0 * 16 + hi * 8) * 2;
    bf16x8 b0 = *reinterpret_cast<const bf16x8*>((const char*)Ks + KSWZ(r32, cb));
    bf16x8 b1 = *reinterpret_cast<const bf16x8*>((const char*)Ks + KSWZ(32 + r32, cb));
    p0 = __builtin_amdgcn_mfma_f32_32x32x16_bf16(b0, qr[d0], p0, 0, 0, 0);
    p1 = __builtin_amdgcn_mfma_f32_32x32x16_bf16(b1, qr[d0], p1, 0, 0, 0); }
}
__device__ __forceinline__ int v_st(int k, int c) { const int kk = (k & ~0xC) | ((k & 4) << 1) | ((k & 8) >> 1); return ((kk >> 3) * 4 + (c >> 5)) * 512 + ((kk & 7) * 32 + (c & 31)) * 2; }
__device__ __forceinline__ int v_rd_base(int lane) { return ((lane & 3) << 3) | (((lane >> 2) & 3) << 6) | (((lane >> 4) & 1) << 5) | (((lane >> 5) & 1) << 8); }
constexpr int v_rd_off(int d0, int ks, int half) { return d0 * 512 + ks * 4096 + half * 2048; }
template <int OFF> __device__ __forceinline__ s16x4 tr_read(int vb) {
  s16x4 r; asm volatile("ds_read_b64_tr_b16 %0, %1 offset:%2" : "=&v"(r) : "v"(vb), "i"(OFF) : "memory"); return r;
}
template <int D0> __device__ __forceinline__ void pv_one(f32x16& od, int vb, bf16x8 pa0, bf16x8 pa1, bf16x8 pa2, bf16x8 pa3) {
  const s16x4 l0 = tr_read<v_rd_off(D0, 0, 0)>(vb), h0 = tr_read<v_rd_off(D0, 0, 1)>(vb), l1 = tr_read<v_rd_off(D0, 1, 0)>(vb), h1 = tr_read<v_rd_off(D0, 1, 1)>(vb);
  const s16x4 l2 = tr_read<v_rd_off(D0, 2, 0)>(vb), h2 = tr_read<v_rd_off(D0, 2, 1)>(vb), l3 = tr_read<v_rd_off(D0, 3, 0)>(vb), h3 = tr_read<v_rd_off(D0, 3, 1)>(vb);
  asm volatile("s_waitcnt lgkmcnt(0)" ::: "memory"); SBAR();
#define PK(L, H) (bf16x8){L[0], L[1], L[2], L[3], H[0], H[1], H[2], H[3]}
  od = __builtin_amdgcn_mfma_f32_32x32x16_bf16(pa0, PK(l0, h0), od, 0, 0, 0);
  od = __builtin_amdgcn_mfma_f32_32x32x16_bf16(pa1, PK(l1, h1), od, 0, 0, 0);
  od = __builtin_amdgcn_mfma_f32_32x32x16_bf16(pa2, PK(l2, h2), od, 0, 0, 0);
  od = __builtin_amdgcn_mfma_f32_32x32x16_bf16(pa3, PK(l3, h3), od, 0, 0, 0);
#undef PK
}
__device__ __forceinline__ void pv_d0(f32x16* o, int vb, bf16x8 pa0, bf16x8 pa1, bf16x8 pa2, bf16x8 pa3) {
  pv_one<0>(o[0], vb, pa0, pa1, pa2, pa3); pv_one<1>(o[1], vb, pa0, pa1, pa2, pa3); pv_one<2>(o[2], vb, pa0, pa1, pa2, pa3); pv_one<3>(o[3], vb, pa0, pa1, pa2, pa3);
}
__device__ __forceinline__ void diff_attn_unit(const bf16_t* __restrict__ Qb, const bf16_t* __restrict__ Kh, const bf16_t* __restrict__ Vh, bf16_t* __restrict__ Ob,
                                               int seq, char* lds, float lam, const float* __restrict__ gsub, float oscale) {
  const int tid = tid_opaque(), wid = tid >> 6, lane = tid & 63, r32 = lane & 31, hi = lane >> 5;
  const int qblk = wid >> 1, cc = wid & 1;
  bf16_t* V_lds = (bf16_t*)lds; bf16_t* K_lds = (bf16_t*)(lds + 2 * SHM_V);
  float* ws = (float*)(lds + 2 * SHM_V + 2 * SHM_K) + wid * 64; float* li_l = ws; float* al_l = ws + 32;
  float m_reg = -1e30f, l_reg = 0; f32x16 o[4] = {}; bf16x8 qr[4];
  const bf16_t* Qw = Qb + (long)(qblk * 32 + r32) * LDQ + cc * 64 + hi * 8;
#pragma unroll
  for (int d0 = 0; d0 < 4; ++d0) qr[d0] = *reinterpret_cast<const bf16x8*>(Qw + d0 * 16);
  const int sr = tid >> 4, sc = (tid & 15) * 8, vst0 = v_st(sr, sc), vst1 = v_st(32 + sr, sc);
  const int vb0 = (int)(uintptr_t)V_lds + v_rd_base(lane);
  struct { bf16x8 vs0, vs1, ks0, ks1; } sr_[2];
#define SLOAD(i, k0) do { sr_[i].vs0 = *reinterpret_cast<const bf16x8*>(&Vh[(long)((k0) + sr) * LDQ + sc]); sr_[i].vs1 = *reinterpret_cast<const bf16x8*>(&Vh[(long)((k0) + 32 + sr) * LDQ + sc]); \
    sr_[i].ks0 = *reinterpret_cast<const bf16x8*>(&Kh[(long)((k0) + sr) * LDQ + sc]); sr_[i].ks1 = *reinterpret_cast<const bf16x8*>(&Kh[(long)((k0) + 32 + sr) * LDQ + sc]); } while (0)
#define SWRITE(b, i) do { *(bf16x8*)((char*)V_lds + (b) * SHM_V + vst0) = sr_[i].vs0;          \
    *(bf16x8*)((char*)V_lds + (b) * SHM_V + vst1) = sr_[i].vs1; int kc = sc * 2;               \
    *(bf16x8*)((char*)K_lds + (b) * SHM_K + KSWZ(sr, kc)) = sr_[i].ks0;                       \
    *(bf16x8*)((char*)K_lds + (b) * SHM_K + KSWZ(32 + sr, kc)) = sr_[i].ks1; } while (0)
#define SWAIT() asm volatile("s_waitcnt vmcnt(4)" ::: "memory")
#define RESC(a) do { if (__any((a) < 1.f)) { if (hi == 0) al_l[r32] = (a); asm volatile("s_waitcnt lgkmcnt(0)" ::: "memory"); \
    _Pragma("unroll") for (int d = 0; d < 4; ++d) _Pragma("unroll") for (int r = 0; r < 16; ++r) o[d][r] *= al_l[crow(r, hi)]; } } while (0)
  f32x16 pA0, pA1, pB0, pB1; float mnA, mnB, alA, alB; bf16x8 pa0, pa1, pa2, pa3; const int NT = seq / KVBLK;
  constexpr int SE = 0, SO = 1;
  SLOAD(SE, 0); asm volatile("s_waitcnt vmcnt(0)" ::: "memory"); SWRITE(0, SE); __syncthreads();
  qkt(pA0, pA1, K_lds, qr, r32, hi, cc); partialSM(pA0, pA1, m_reg, mnA, alA);
  SLOAD(SO, KVBLK); if (2 < NT) SLOAD(SE, 2 * KVBLK);
  SWAIT(); SWRITE(1, SO); __syncthreads();
  for (int j = 1; j + 1 < NT; j += 2) {
    SBAR(); qkt(pB0, pB1, (bf16_t*)((char*)K_lds + SHM_K), qr, r32, hi, cc);
    finishSM(pA0, pA1, alA, l_reg, pa0, pa1, pa2, pa3); SBAR();
    SLOAD(SO, (j + 2) * KVBLK); SBAR();
    pv_d0(o, vb0, pa0, pa1, pa2, pa3); partialSM(pB0, pB1, m_reg, mnB, alB);
    __syncthreads(); SWAIT(); SWRITE(0, SE);
    RESC(alB); __syncthreads();
    SBAR(); qkt(pA0, pA1, K_lds, qr, r32, hi, cc);
    finishSM(pB0, pB1, alB, l_reg, pa0, pa1, pa2, pa3); SBAR();
    if (j + 3 < NT) SLOAD(SE, (j + 3) * KVBLK); SBAR();
    pv_d0(o, vb0 + (int)SHM_V, pa0, pa1, pa2, pa3); partialSM(pA0, pA1, m_reg, mnA, alA);
    __syncthreads(); SWAIT(); SWRITE(1, SO);
    RESC(alA); __syncthreads();
  }
  SBAR(); qkt(pB0, pB1, (bf16_t*)((char*)K_lds + SHM_K), qr, r32, hi, cc);
  finishSM(pA0, pA1, alA, l_reg, pa0, pa1, pa2, pa3); SBAR();
  pv_d0(o, vb0, pa0, pa1, pa2, pa3); partialSM(pB0, pB1, m_reg, mnB, alB);
  __syncthreads(); RESC(alB);
  finishSM(pB0, pB1, alB, l_reg, pa0, pa1, pa2, pa3); SBAR();
  pv_d0(o, vb0 + (int)SHM_V, pa0, pa1, pa2, pa3);
  if (hi == 0) li_l[r32] = l_reg; asm volatile("s_waitcnt lgkmcnt(0)" ::: "memory");
  float rli[16];
#pragma unroll
  for (int r = 0; r < 16; ++r) rli[r] = __builtin_amdgcn_rcpf(li_l[crow(r, hi)]);
  __syncthreads();
  float* xch = (float*)lds + qblk * (32 * 128);
  if (cc == 1) {
#pragma unroll
    for (int r = 0; r < 16; ++r)
#pragma unroll
      for (int d0 = 0; d0 < 4; ++d0) xch[crow(r, hi) * 128 + d0 * 32 + r32] = lam * o[d0][r] * rli[r];
  }
  __syncthreads();
  if (cc == 0) {
    float gs[4];
#pragma unroll
    for (int d0 = 0; d0 < 4; ++d0) gs[d0] = gsub[d0 * 32 + r32] * oscale;
#pragma unroll
    for (int r = 0; r < 16; ++r) {
      float ss = 0.f;
#pragma unroll
      for (int d0 = 0; d0 < 4; ++d0) { const float v = o[d0][r] * rli[r] - xch[crow(r, hi) * 128 + d0 * 32 + r32]; o[d0][r] = v; ss += v * v; }
      ss += __shfl_xor(ss, 1); ss += __shfl_xor(ss, 2); ss += __shfl_xor(ss, 4); ss += __shfl_xor(ss, 8); ss += __shfl_xor(ss, 16);
      const float rs = rsqrtf(ss * (1.f / 128.f) + EPS);
      bf16_t* orow = Ob + (long)(qblk * 32 + crow(r, hi)) * LDQ;
#pragma unroll
      for (int d0 = 0; d0 < 4; ++d0) orow[d0 * 32 + r32] = (bf16_t)(cvtpk(o[d0][r] * rs * gs[d0], 0.f) & 0xffff);
    }
  }
  __syncthreads();
#undef SLOAD
#undef SWRITE
#undef SWAIT
#undef RESC
}
#undef KSWZ
#undef SBAR
constexpr int LDS_NEED = 2 * SHM_V + 2 * SHM_K + 8 * 64 * 4;
}

__device__ __forceinline__ void phase_attn(ArgP a, int j, char* lds, int G, int bid) {
    const bf16_t* Q = (const bf16_t*)(a->ws + WS_Q); const bf16_t* KB = (const bf16_t*)(a->ws + WS_KB); const bf16_t* VB = (const bf16_t*)(a->ws + WS_VB);
    bf16_t* O = (bf16_t*)(a->ws + WS_O);
    const float lam = ((const float*)(a->ws + WS_LAM))[j];
    const float oscale = 1.f - (j == 0 ? a->lam_init0 : a->lam_init1);
    const float* gsub = a->in[I_GSUB] + j * 128;
    for (int u = bid; u < 512; u += G) {
        int qrow, krow, seq, h;
        if (u < 256) { const int b = u >> 6; h = (u >> 3) & 7; const int qb = u & 7; qrow = NCTX + b * 1024 + qb * 128; krow = NCTX + b * 1536; seq = 1536; }
        else { const int v = u - 256, b = v >> 4; h = (v >> 1) & 7; const int qb = v & 1; qrow = b * 256 + qb * 128; krow = b * 256; seq = 256; }
        att::diff_attn_unit(Q + (size_t)qrow * 1024 + h * 128, KB + (size_t)krow * 1024 + h * 128, VB + (size_t)krow * 1024 + h * 128, O + (size_t)qrow * 1024 + h * 128,
                            seq, lds, lam, gsub, oscale);
    }
}

namespace hg {
constexpr int QT_OFF = 0, KT_OFF = 64 * 272, KHT_OFF = 2 * 64 * 272, VT_OFF = KHT_OFF + 128 * 144, DD_OFF = VT_OFF + 128 * 144, LDS_NEED = DD_OFF + 4 * 128 * 4;
__device__ __forceinline__ s16x4 pk4(f32x4 v) { u32x2 w; w.x = cvt_pk_bf16(v[0], v[1]); w.y = cvt_pk_bf16(v[2], v[3]); return __builtin_bit_cast(s16x4, w); }
struct Stage { u32x4 q[2], k[2], kh[2], v[2], d; };
__device__ __forceinline__ void scan_unit(int tok0, int n, int h, int dir, int vbase, int nwv, const bf16_t* __restrict__ QT, const bf16_t* __restrict__ KT, const bf16_t* __restrict__ KHT, const bf16_t* __restrict__ VT,
                                          const float* __restrict__ DD, const float* __restrict__ s0, float* __restrict__ sout, bf16_t* __restrict__ Od, LAS unsigned char* lds) {
    const int tid = tid_opaque(), lane = tid & 63, wv = __builtin_amdgcn_readfirstlane(tid >> 6), l15 = lane & 15, g = lane >> 4;
    const bool act = wv < nwv;
    const int vc = vbase + 16 * wv + l15;
    f32x4 S[8];
#pragma unroll
    for (int i = 0; i < 8; ++i) {
        if (s0 && act) {
#pragma unroll
            for (int r = 0; r < 4; ++r) S[i][r] = s0[(size_t)(16 * i + 4 * g + r) * 128 + vc]; }
        else S[i] = (f32x4){0.f, 0.f, 0.f, 0.f};
    }
    const int nms = n >> 6;
    Stage st;
#define HG_LOAD(msn) do { const int tb_ = tok0 + (msn) * 64; \
        _Pragma("unroll") for (int i_ = 0; i_ < 2; ++i_) { const int p_ = tid + 512 * i_; \
            const size_t so_ = (size_t)(tb_ + (p_ >> 4)) * 1024 + h * 128 + (p_ & 15) * 8; st.q[i_] = *(const u32x4*)(QT + so_); st.k[i_] = *(const u32x4*)(KT + so_); \
            const size_t to_ = ((size_t)(((tb_ >> 4) + (p_ >> 8)) * 8 + h) * 128 + ((p_ & 255) >> 1)) * 16 + (p_ & 1) * 8; st.kh[i_] = *(const u32x4*)(KHT + to_); st.v[i_] = *(const u32x4*)(VT + to_); } \
        if (tid < 128) st.d = *(const u32x4*)(DD + (size_t)(((tb_ >> 4) + (tid >> 5)) * 8 + h) * 128 + (tid & 31) * 4); } while (0)
#define HG_STORE() do { \
        _Pragma("unroll") for (int i_ = 0; i_ < 2; ++i_) { const int p_ = tid + 512 * i_; \
            *(LAS u32x4*)(lds + QT_OFF + (p_ >> 4) * 272 + (p_ & 15) * 16) = st.q[i_]; *(LAS u32x4*)(lds + KT_OFF + (p_ >> 4) * 272 + (p_ & 15) * 16) = st.k[i_]; \
            const int lo_ = ((p_ & 255) >> 1) * 144 + ((p_ >> 8) * 16 + (p_ & 1) * 8) * 2; *(LAS u32x4*)(lds + KHT_OFF + lo_) = st.kh[i_]; *(LAS u32x4*)(lds + VT_OFF + lo_) = st.v[i_]; } \
        if (tid < 128) *(LAS u32x4*)(lds + DD_OFF + ((tid >> 5) * 128 + (tid & 31) * 4) * 4) = st.d; } while (0)
    HG_LOAD(dir ? nms - 1 : 0);
    HG_STORE();
    __syncthreads();
    for (int ms = 0; ms < nms; ++ms) {
        const int msn = dir ? nms - 1 - ms : ms;
        if (ms + 1 < nms) HG_LOAD(dir ? msn - 1 : msn + 1);
        __builtin_amdgcn_sched_barrier(0);
        if (act) {
        s16x4 xb[4];
#pragma unroll
        for (int cp = 0; cp < 4; cp += 2) {
            bf16x8 ka[2][4], qb[2][4];
#pragma unroll
            for (int q = 0; q < 2; ++q)
#pragma unroll
                for (int kk = 0; kk < 4; ++kk) {
                    ka[q][kk] = *(const LAS bf16x8*)(lds + KT_OFF + ((cp + q) * 16 + l15) * 272 + kk * 64 + g * 16);
                    qb[q][kk] = *(const LAS bf16x8*)(lds + QT_OFF + ((cp + q) * 16 + l15) * 272 + kk * 64 + g * 16); }
            __builtin_amdgcn_sched_barrier(0);
            f32x4 X0 = {0.f, 0.f, 0.f, 0.f}, X1 = {0.f, 0.f, 0.f, 0.f};
#pragma unroll
            for (int kk = 0; kk < 4; ++kk) { X0 = __builtin_amdgcn_mfma_f32_16x16x32_bf16(ka[0][kk], qb[0][kk], X0, 0, 0, 0); X1 = __builtin_amdgcn_mfma_f32_16x16x32_bf16(ka[1][kk], qb[1][kk], X1, 0, 0, 0); }
#pragma unroll
            for (int r = 0; r < 4; ++r) if (dir ? (4 * g + r < l15) : (4 * g + r > l15)) { X0[r] = 0.f; X1[r] = 0.f; }
            xb[cp] = pk4(X0); xb[cp + 1] = pk4(X1);
            __builtin_amdgcn_sched_barrier(0);
        }
        f32x4 dvA[8]; s16x4 kaA[8], qaA[8], vbA;
#define HG_OPS(c_, DV, KA, QA, VB) do { VB = *(const LAS s16x4*)(lds + VT_OFF + vc * 144 + ((c_) * 16 + 4 * g) * 2); \
            _Pragma("unroll") for (int i_ = 0; i_ < 8; ++i_) { DV[i_] = *(const LAS f32x4*)(lds + DD_OFF + ((c_) * 128 + 16 * i_ + 4 * g) * 4); \
                KA[i_] = *(const LAS s16x4*)(lds + KHT_OFF + (16 * i_ + l15) * 144 + ((c_) * 16 + 4 * g) * 2); \
                QA[i_] = *(const LAS s16x4*)(lds + QT_OFF + ((c_) * 16 + l15) * 272 + (16 * i_ + 4 * g) * 2); } } while (0)
#define HG_CHUNK(c_, XB, DV, KA, QA, VB) do { \
            f32x4 o0_ = {0.f, 0.f, 0.f, 0.f}, o1_ = {0.f, 0.f, 0.f, 0.f}; s16x4 sb_[8]; \
            _Pragma("unroll") for (int i_ = 0; i_ < 8; ++i_) sb_[i_] = pk4(S[i_]); \
            _Pragma("unroll") for (int i_ = 0; i_ < 8; ++i_) S[i_] = __builtin_amdgcn_mfma_f32_16x16x16bf16_1k(KA[i_], VB, S[i_] * DV[i_], 0, 0, 0); \
            _Pragma("unroll") for (int i_ = 0; i_ < 8; i_ += 2) { o0_ = __builtin_amdgcn_mfma_f32_16x16x16bf16_1k(QA[i_], sb_[i_], o0_, 0, 0, 0); o1_ = __builtin_amdgcn_mfma_f32_16x16x16bf16_1k(QA[i_ + 1], sb_[i_ + 1], o1_, 0, 0, 0); } \
            o0_ = __builtin_amdgcn_mfma_f32_16x16x16bf16_1k(XB, VB, o0_, 0, 0, 0); \
            const f32x4 o_ = o0_ + o1_; \
            _Pragma("unroll") for (int r_ = 0; r_ < 4; ++r_) Od[(size_t)(tok0 + msn * 64 + (c_) * 16 + 4 * g + r_) * 1024 + h * 128 + vc] = (bf16_t)(cvt_pk_bf16(o_[r_], 0.f) & 0xffff); } while (0)
#pragma unroll 1
        for (int cc = 0; cc < 4; ++cc) {
            const int c = dir ? 3 - cc : cc;
            const s16x4 xbc = c == 0 ? xb[0] : c == 1 ? xb[1] : c == 2 ? xb[2] : xb[3];
            HG_OPS(c, dvA, kaA, qaA, vbA); __builtin_amdgcn_sched_barrier(0);
            HG_CHUNK(c, xbc, dvA, kaA, qaA, vbA); __builtin_amdgcn_sched_barrier(0);
        }
#undef HG_OPS
#undef HG_CHUNK
        }
        __syncthreads();
        if (ms + 1 < nms) { HG_STORE(); }
        __syncthreads();
    }
#undef HG_LOAD
#undef HG_STORE
    if (sout && act) {
#pragma unroll
        for (int i = 0; i < 8; ++i)
#pragma unroll
            for (int r = 0; r < 4; ++r) sout[(size_t)(16 * i + 4 * g + r) * 128 + vc] = S[i][r];
    }
}
}

__device__ __forceinline__ void phase_scan(ArgP a, LAS unsigned char* lds, int G, int bid) {
    for (int i = 0;; ++i) {
        const int u = i * G + ((i & 1) ? (G - 1 - bid) : bid);
        if (u >= 384) break;
        int tok0, n, h, dir, vbase = 0, nwv = 8; const float* s0 = nullptr; float* sout = nullptr;
        if (u < 128) { const int b = u >> 5; h = (u >> 2) & 7; dir = (u >> 1) & 1; vbase = (u & 1) * 64; nwv = 4; tok0 = NCTX + b * 1024; n = 1024; s0 = a->in[I_ST] + ((size_t)(b * 2 + dir) * 8 + h) * 16384; }
        else { const int v = u - 128, b = v >> 4; h = (v >> 1) & 7; dir = v & 1; tok0 = b * 256; n = 256; sout = a->out + OUT_NS + ((size_t)(b * 2 + dir) * 8 + h) * 16384; }
        hg::scan_unit(tok0, n, h, dir, vbase, nwv, (const bf16_t*)(a->ws + (dir ? WS_QTB : WS_QTF)), (const bf16_t*)(a->ws + (dir ? WS_KTB : WS_KTF)), (const bf16_t*)(a->ws + (dir ? WS_KHTB : WS_KHTF)),
                      (const bf16_t*)(a->ws + WS_VT), (const float*)(a->ws + (dir ? WS_DDB : WS_DDF)), s0, sout, (bf16_t*)(a->ws + (dir ? WS_OB : WS_OF)), lds);
    }
}

#ifndef PHMASK
#define PHMASK 0xFFFF
#endif
#ifndef REPMASK
#define REPMASK 0
#endif
#ifndef XBAR
#define XBAR 0
#endif
enum PhType { T_PRO = 0, T_NORM, T_QKV, T_ATTN, T_RES, T_FFN, T_HIN, T_SCAN, T_HFIN, T_F1, T_FINAL, T_FOLD };
struct PhDesc { int type, layer, sub; };
constexpr int NPH = 24;
__device__ __forceinline__ PhDesc phase_desc(int p) {
    switch (p) {
        case 0: return {T_PRO, 0, 0};
        case 1: return {T_FOLD, 0, 0};
        case 2: return {T_NORM, 0, 0};
        case 3: return {T_QKV, 0, 0}; case 4: return {T_ATTN, 0, 0}; case 5: return {T_RES, 0, 0}; case 6: return {T_FFN, 0, 0}; case 7: return {T_RES, 0, 2};
        case 8: return {T_HIN, 1, 0}; case 9: return {T_SCAN, 1, 0}; case 10: return {T_HFIN, 1, 0}; case 11: return {T_RES, 1, 1}; case 12: return {T_FFN, 1, 0}; case 13: return {T_RES, 1, 2};
        case 14: return {T_F1, 2, 0}; case 15: return {T_RES, 2, 3}; case 16: return {T_FFN, 2, 0}; case 17: return {T_RES, 2, 2};
        case 18: return {T_QKV, 3, 1}; case 19: return {T_ATTN, 3, 1}; case 20: return {T_RES, 3, 0}; case 21: return {T_FFN, 3, 0}; case 22: return {T_RES, 3, 2};
        default: return {T_FINAL, 0, 0};
    }
}

__global__ void __launch_bounds__(NTHREADS, 2) fwd_megakernel(Args a_unused) {
    extern __shared__ __attribute__((aligned(16))) unsigned char lds_raw[];
    LAS unsigned char* lds = (LAS unsigned char*)lds_raw;
    constexpr int G = 256; const int bid = blockIdx.x;
    ArgP a = (ArgP)__builtin_amdgcn_kernarg_segment_ptr();
    for (int u = threadIdx.x; u < (LDS_BYTES - LDSCTL_OFF) / 4; u += NTHREADS) ((LAS unsigned*)(lds + LDSCTL_OFF))[u] = 0u;
    __syncthreads();
    volatile LAS unsigned* MISC = (volatile LAS unsigned*)(lds + MISC_OFF);
    XcdBarrier bar = xcd_barrier_post((unsigned*)(a->ws + WS_CTL), MISC + 8);

    const int nrun = a->ph_hi < NPH ? a->ph_hi + 1 : NPH;
#if REPMASK
    for (int pj = 2 * a->ph_lo; pj < 2 * nrun; ++pj) {
        const int pi = pj >> 1, rep = pj & 1;
        const int ph = pi < a->ph_hi ? pi : NPH - 1;
        const PhDesc d = phase_desc(ph);
        if (rep && !((REPMASK >> d.type) & 1)) continue;
        if (pj > 2 * a->ph_lo) xcd_barrier(bar);
#else
    for (int pi = a->ph_lo; pi < nrun; ++pi) {
        const int rep = 0;
        const int ph = pi < a->ph_hi ? pi : NPH - 1;
        const PhDesc d = phase_desc(ph);
        if (pi > a->ph_lo) xcd_barrier(bar);
#endif
        for (int xb = 0; xb < XBAR; ++xb) xcd_barrier(bar);
#define PH_TID const int tid = tid_opaque(), lane = tid & 63, wave = __builtin_amdgcn_readfirstlane(tid >> 6), gw = bid * NWAVES + wave, ngw = G * NWAVES; (void)lane; (void)gw; (void)ngw
        asm volatile("" : "+s"(a));
        const int L = d.layer;
        switch (d.type) {
#if (PHMASK >> 0) & 1
        case T_PRO: phase_prologue(a, lds, G, bid);
            if (a->ph_hi < NPH) { PH_TID; for (size_t i = (size_t)bid * NTHREADS + tid; i < 29360128 / 4; i += (size_t)G * NTHREADS) ((f32x4*)a->out)[i] = (f32x4){0.f, 0.f, 0.f, 0.f}; }
            break;
#endif
#if (PHMASK >> 1) & 1
        case T_FOLD: {
            GenSched S; S.init(2, a->ws + WS_WFO, nullptr, 1024, a->ws + WS_TC, 1024, 1024, 256, a->ph_hi > 0 ? 256 : 320, G, bid);
            EpiBf16 E{(bf16_t*)(a->ws + WS_WCS), 1024};
            pg8::gemm_phase(lds, 1024, 1024, S, E);
            PH_TID;
            phase_an(a, bid * NTHREADS + tid, G * NTHREADS);
            phase_sw(a, lds, 0xEF, gw, ngw, tid, lane);
        } break;
#endif
#if (PHMASK >> 2) & 1
        case T_NORM: {
            PH_TID;
            phase_first_norm(a, gw, ngw, lane);
            phase_sw(a, lds, 0x10, gw, ngw, tid, lane);
        } break;
#endif
#if (PHMASK >> 3) & 1
        case T_QKV: {
            const int j = d.sub, nidx = 2 * L;
            if (j == 1) { PH_TID; cache_convert(a, 1, gw, ngw, lane); }
            const float* sspn = (const float*)(a->ws + WS_SSP) + (size_t)nidx * 8192 * SSPN; const float* swn = (const float*)(a->ws + WS_SW) + sw_off(nidx);
            { GenSched S; S.init(7, a->ws + WS_H, nullptr, 1024, a->ws + WS_WQKV + (size_t)j * 3072 * 1024 * 2, 1024, MTOK, 3072, 1024, G, bid);
              EpiQKV E{(bf16_t*)(a->ws + WS_Q), (bf16_t*)(a->ws + WS_KB), (bf16_t*)(a->ws + WS_VB), a->out + OUT_NK + (size_t)j * 256 * 1024, a->out + OUT_NV + (size_t)j * 256 * 1024,
                       (const float*)(a->ws + WS_ROPE), (const float*)(a->ws + WS_ROPE) + 1024, sspn, swn, lds};
              pg8::gemm_phase(lds, 1024, 1024, S, E); }
            { GenSched S; S.init(8, a->ws + WS_H, nullptr, 1024, a->ws + WS_WQKV + (size_t)j * 3072 * 1024 * 2, 1024, MTOK, 3072, 1024, G, bid);
              EpiQKV128 E{(bf16_t*)(a->ws + WS_Q), (bf16_t*)(a->ws + WS_KB), (bf16_t*)(a->ws + WS_VB), a->out + OUT_NK + (size_t)j * 256 * 1024, a->out + OUT_NV + (size_t)j * 256 * 1024,
                          (const float*)(a->ws + WS_ROPE), (const float*)(a->ws + WS_ROPE) + 1024, sspn, swn, lds};
              pg8::gemm_phase_n128(lds, 1024, 1024, S, E); }
        } break;
#endif
#if (PHMASK >> 4) & 1
        case T_ATTN: phase_attn(a, d.sub, (char*)lds_raw, G, bid); break;
#endif
#if (PHMASK >> 5) & 1
        case T_RES: {
            const int nn = d.sub == 2 ? 2 * L + 2 : 2 * L + 1;
            EpiResid128 E{(bf16_t*)(a->ws + WS_X), (float*)(a->ws + WS_MOD) + (size_t)L * 5 * 6144 + (d.sub == 2 ? 5 : 2) * 1024,
                          nn < 8 ? (const float*)(a->ws + WS_AN) + nn * 5120 : nullptr, (bf16_t*)(a->ws + WS_H), (float*)(a->ws + WS_SSP) + (size_t)nn * 8192 * SSPN};
            GenSched S; int lda, ldb;
            if (d.sub == 3) { lda = 2048; ldb = 16384; S.init(4, a->ws + WS_CS1024, a->ws + WS_CS256, lda, a->ws + WS_ZT, ldb, 0, 0, 2048, G, bid); }
            else if (d.sub == 2) { lda = DFF; ldb = DFF; S.init(3, a->ws + WS_ACT, nullptr, lda, a->ws + WS_WFOUT + (size_t)L * 1024 * DFF * 2, ldb, MTOK, 1024, DFF, G, bid); }
            else { lda = 1024; ldb = 1024; const unsigned char* w = d.sub == 0 ? a->ws + WS_WOA + (size_t)(L == 0 ? 0 : 1) * 1024 * 1024 * 2 : a->ws + WS_WOR;
                S.init(3, a->ws + WS_O, nullptr, lda, w, ldb, MTOK, 1024, 1024, G, bid); }
            pg8::gemm_phase_n128(lds, lda, ldb, S, E);
        } break;
#endif
#if (PHMASK >> 6) & 1
        case T_FFN: {
            const int nidx = 2 * L + 1;
            GenSched S; S.init(0, a->ws + WS_H, nullptr, 1024, a->ws + WS_WFI + (size_t)L * 5632 * 1024 * 2, 1024, MTOK, 5632, 1024, G, bid);
            EpiFFN E{(bf16_t*)(a->ws + WS_ACT), (const float*)(a->ws + WS_SSP) + (size_t)nidx * 8192 * SSPN, (const float*)(a->ws + WS_SW) + sw_off(nidx), lds};
            pg8::gemm_phase(lds, 1024, 1024, S, E);
        } break;
#endif
#if (PHMASK >> 7) & 1
        case T_HIN: {
            { GenSched S; S.init(5, a->ws + WS_H, nullptr, 1024, a->ws + WS_WINR, 1024, MTOK, 4096, 1024, G, bid);
              EpiHgrn E{(bf16_t*)(a->ws + WS_GH), (bf16_t*)(a->ws + WS_QTF), (bf16_t*)(a->ws + WS_KTF), (bf16_t*)(a->ws + WS_QTB), (bf16_t*)(a->ws + WS_KTB), (bf16_t*)(a->ws + WS_KHTF), (bf16_t*)(a->ws + WS_KHTB),
                        (bf16_t*)(a->ws + WS_VT), (float*)(a->ws + WS_DDF), (float*)(a->ws + WS_DDB), (const float*)(a->ws + WS_LBV), (const float*)(a->ws + WS_SSP) + 2ull * 8192 * SSPN, (const float*)(a->ws + WS_SW) + sw_off(2), lds};
              pg8::gemm_phase(lds, 1024, 1024, S, E); }
            { GenSched S; S.init(6, a->ws + WS_H, nullptr, 1024, a->ws + WS_WINR, 1024, MTOK, 1024, 1024, G, bid);
              EpiG128 E{(bf16_t*)(a->ws + WS_GH), (const float*)(a->ws + WS_SSP) + 2ull * 8192 * SSPN, (const float*)(a->ws + WS_SW) + sw_off(2), lds};
              pg8::gemm_phase_n128(lds, 1024, 1024, S, E); }
        } break;
#endif
#if (PHMASK >> 8) & 1
        case T_SCAN: phase_scan(a, lds, G, bid); break;
#endif
#if (PHMASK >> 9) & 1
        case T_HFIN: { PH_TID; phase_hgrn_final(a, gw, ngw, lane); } break;
#endif
#if (PHMASK >> 10) & 1
        case T_F1: {
            GenSched S; S.init(0, a->ws + WS_WCS, nullptr, 1024, a->ws + WS_H, 1024, 2048, MTOK, 1024, G, bid);
            EpiFour1 E{(bf16_t*)(a->ws + WS_ZT), (const float*)(a->ws + WS_SSP) + 4ull * 8192 * SSPN, (const float*)(a->ws + WS_SW) + sw_off(4), lds};
            pg8::gemm_phase(lds, 1024, 1024, S, E);
        } break;
#endif
        default: { PH_TID; phase_final(a, gw, ngw, lane); } break;
        }
    }
}

extern "C" void kernel_launch(void* const* d_in, const int* in_sizes, int n_in, void* d_out, int out_size, void* d_ws, size_t ws_size, hipStream_t stream) {
    static int grid = 0;
    if (grid == 0) {
        if (n_in != 23 || out_size != 29360128 || ws_size < WS_END2) {
            fprintf(stderr, "kernel_launch: unexpected shapes: n_in %d out %d ws %zu (need >= %zu); nothing launched\n", n_in, out_size, ws_size, (size_t)WS_END); grid = -1; return; }
        int dev = 0, cus = 0, per_cu = 0;
        if (hipGetDevice(&dev) != hipSuccess || hipDeviceGetAttribute(&cus, hipDeviceAttributeMultiprocessorCount, dev) != hipSuccess) { fprintf(stderr, "kernel_launch: device query failed\n"); grid = -1; return; }
        if (hipFuncSetAttribute((const void*)fwd_megakernel, hipFuncAttributeMaxDynamicSharedMemorySize, LDS_BYTES) != hipSuccess) { fprintf(stderr, "kernel_launch: hipFuncSetAttribute failed\n"); grid = -1; return; }
        if (hipOccupancyMaxActiveBlocksPerMultiprocessor(&per_cu, (const void*)fwd_megakernel, NTHREADS, LDS_BYTES) != hipSuccess || per_cu < 1) {
            fprintf(stderr, "kernel_launch: occupancy query reports %d workgroups per CU; nothing launched\n", per_cu); (void)hipGetLastError(); grid = -1; return; }
        if (cus < 256) { fprintf(stderr, "kernel_launch: needs >= 256 CUs (have %d); nothing launched\n", cus); grid = -1; return; }
        grid = 256;
    }
    if (grid < 0) return;
    (void)hipMemsetAsync((char*)d_ws + WS_CTL, 0, CTL_BYTES, stream);
    Args a{};
    for (int i = 0; i < 23; ++i) a.in[i] = (const float*)d_in[i];
    a.out = (float*)d_out; a.ws = (unsigned char*)d_ws;
    a.lam_init0 = 0.2f; a.lam_init1 = (float)(0.8 - 0.6 * 0.40656965974059917);
    a.ph_lo = 0; a.ph_hi = NPH;
    hipLaunchKernelGGL(fwd_megakernel, dim3(grid), dim3(NTHREADS), LDS_BYTES, stream, a);
    const hipError_t le = hipPeekAtLastError();
    if (le != hipSuccess) fprintf(stderr, "kernel_launch: launch failed: %s\n", hipGetErrorName(le));
}
```

```cpp
#include <hip/hip_runtime.h>
#include <cstdio>
#include <cstdint>

#define LAS __attribute__((address_space(3)))
#define GAS __attribute__((address_space(1)))
typedef unsigned short bf16_t;
typedef short bf16x8 __attribute__((ext_vector_type(8)));
typedef short s16x4 __attribute__((ext_vector_type(4)));
typedef float f32x2 __attribute__((ext_vector_type(2)));
typedef float f32x4 __attribute__((ext_vector_type(4)));
typedef float f32x8 __attribute__((ext_vector_type(8)));
typedef float f32x16 __attribute__((ext_vector_type(16)));
typedef unsigned u32x2 __attribute__((ext_vector_type(2)));
typedef unsigned u32x4 __attribute__((ext_vector_type(4)));

constexpr int DM = 1024, MTOK = 8192, NCTX = 4096, DFF = 2816, NKV = 4096 + 4 * 1536;
constexpr float EPS = 1e-6f;
constexpr int NWAVES = 8, NTHREADS = 512;

constexpr size_t al256(size_t x) { return (x + 255) / 256 * 256; }
constexpr size_t WS_CTL = 0, CTL_BYTES = 65536;
constexpr size_t WS_MOD = WS_CTL + CTL_BYTES;
constexpr size_t WS_ROPE = WS_MOD + al256(4 * 5 * 6144 * 4);
constexpr size_t WS_LBV = WS_ROPE + 8192;
constexpr size_t WS_LAM = WS_LBV + 8192;
constexpr size_t WS_AN = WS_LAM + 256;
constexpr size_t WS_SW = WS_AN + 8 * 5 * 1024 * 4;
constexpr size_t WS_SSP = WS_SW + al256(35840 * 5 * 4);
constexpr int SSPN = 32;
constexpr size_t WS_TC = WS_SSP + 9ull * 8192 * SSPN * 4;
constexpr size_t WS_CS256 = WS_TC + 256 * 1024 * 2;
constexpr size_t WS_CS1024 = WS_CS256 + 256 * 2048 * 2;
constexpr size_t WS_WQKV = WS_CS1024 + 1024 * 2048 * 2;
constexpr size_t WS_WOA = WS_WQKV + 2ull * 3072 * 1024 * 2;
constexpr size_t WS_WINR = WS_WOA + 2ull * 1024 * 1024 * 2;
constexpr size_t WS_WOR = WS_WINR + 5120ull * 1024 * 2;
constexpr size_t WS_WFO = WS_WOR + 1024ull * 1024 * 2;
constexpr size_t WS_WCS = WS_WFO + 1024ull * 1024 * 2;
constexpr size_t WS_WFI = WS_WCS + 2048ull * 1024 * 2;
constexpr size_t WS_WFOUT = WS_WFI + 4ull * 5632 * 1024 * 2;
constexpr size_t WS_X = WS_WFOUT + 4ull * 1024 * 2816 * 2;
constexpr size_t WS_H = WS_X + 8192ull * 1024 * 4;
constexpr size_t WS_O = WS_H + 8192ull * 1024 * 2;
constexpr size_t WS_SCR = WS_O + 8192ull * 1024 * 2;
constexpr size_t SZ_TOK = 8192ull * 1024 * 2;
constexpr size_t WS_Q = WS_SCR, WS_KB = WS_Q + SZ_TOK, WS_VB = WS_KB + (size_t)NKV * 1024 * 2;
constexpr size_t WS_GH = WS_SCR, WS_QTF = WS_GH + SZ_TOK, WS_KTF = WS_QTF + SZ_TOK, WS_QTB = WS_KTF + SZ_TOK, WS_KTB = WS_QTB + SZ_TOK, WS_KHTF = WS_KTB + SZ_TOK, WS_KHTB = WS_KHTF + SZ_TOK,
                 WS_VT = WS_KHTB + SZ_TOK, WS_OF = WS_VT + SZ_TOK, WS_OB = WS_OF + SZ_TOK, WS_DDF = WS_OB + SZ_TOK, WS_DDB = WS_DDF + 512ull * 8 * 128 * 4;
constexpr size_t WS_ZT = WS_SCR;
constexpr size_t WS_ACT = WS_SCR;
constexpr size_t WS_END = WS_DDB + 512ull * 8 * 128 * 4;
constexpr size_t WS_END2 = WS_END;
__host__ __device__ constexpr int sw_n(int nidx) { return nidx == 0 || nidx == 6 ? 3072 : nidx == 2 ? 5120 : nidx == 4 ? 2048 : 5632; }
__host__ __device__ constexpr int sw_off(int nidx) { int o = 0; for (int i = 0; i < nidx; ++i) o += 5 * sw_n(i); return o; }

constexpr size_t OUT_YP = 0, OUT_YS = 4194304, OUT_NK = 8388608, OUT_NV = 16777216, OUT_NS = 25165824;

constexpr int RING_BYTES = 131072;
constexpr int LDSCTL_OFF = RING_BYTES, MISC_OFF = LDSCTL_OFF + 320, RSTD_OFF = LDSCTL_OFF + 1024;
constexpr int LDS_BYTES = 147456;

typedef __bf16 bf16x2_t __attribute__((ext_vector_type(2)));
__device__ __forceinline__ unsigned cvt_pk_bf16(float lo, float hi) { f32x2 v = {lo, hi}; bf16x2_t b = __builtin_convertvector(v, bf16x2_t); return __builtin_bit_cast(unsigned, b); }
__device__ __forceinline__ float bf2f(unsigned short b) { return __uint_as_float((unsigned)b << 16); }
__device__ __forceinline__ float bflo(unsigned w) { return __uint_as_float(w << 16); }
__device__ __forceinline__ float bfhi(unsigned w) { return __uint_as_float(w & 0xffff0000u); }
__device__ __forceinline__ float fast_rcp(float x) { return __builtin_amdgcn_rcpf(x); }
__device__ __forceinline__ float silu_f(float x) { return x * fast_rcp(1.f + __expf(-x)); }
__device__ __forceinline__ float sigmoid_f(float x) { return fast_rcp(1.f + __expf(-x)); }
__device__ __forceinline__ float wave_sum(float v) {
#pragma unroll
    for (int o = 1; o < 64; o <<= 1) v += __shfl_xor(v, o);
    return v;
}
__device__ __forceinline__ int tid_opaque() { int t = threadIdx.x; asm volatile("" : "+v"(t)); return t; }
__device__ __forceinline__ int cond_of_row(int r) { return r < NCTX ? 0 : 1 + ((r - NCTX) >> 10); }
#define LDS_WAIT() asm volatile("s_waitcnt lgkmcnt(0)" ::: "memory")
#define VM_WAIT() asm volatile("s_waitcnt vmcnt(0)" ::: "memory")

#define XB_TMO      128
#define XB_XCNT(j)  (256  + 64 * (j))
#define XB_XSUB(j)  (1280 + 64 * (j))
#define XB_XGEN(j)  (2304 + 64 * (j))
#define XB_TOP      3328
#define XB_TOPGEN   3392
#define XCD_BAR_WORDS 3456
#define XB_SPIN_CAP (1u << 22)
__device__ __forceinline__ unsigned xb_ld(unsigned* p)              { return __hip_atomic_load(p, __ATOMIC_RELAXED, __HIP_MEMORY_SCOPE_AGENT); }
__device__ __forceinline__ unsigned xb_add(unsigned* p, unsigned v) { return __hip_atomic_fetch_add(p, v, __ATOMIC_RELAXED, __HIP_MEMORY_SCOPE_AGENT); }
__device__ __forceinline__ unsigned xb_xcc_id() { return (unsigned)__builtin_amdgcn_s_getreg((3 << 11) | 20) & 0xFu; }
#define XB_SPIN(cond, bar) do { unsigned _sp = 0; while (cond) { __builtin_amdgcn_s_sleep(1); \
    if ((++_sp & 255u) == 0u) { if (xb_ld(&(bar)[XB_TMO])) break; if (_sp > XB_SPIN_CAP) { atomicAdd(&(bar)[XB_TMO], 1u); break; } } } } while (0)
struct XcdBarrier { unsigned* bar; unsigned x; volatile LAS unsigned* st; };
__device__ __forceinline__ XcdBarrier xcd_barrier_post(unsigned* bar, volatile LAS unsigned* st) {
    XcdBarrier b; b.bar = bar; b.x = xb_xcc_id(); b.st = st;
    if (threadIdx.x == 0) (void)xb_add(&bar[XB_XCNT(b.x)], 1u);
    return b;
}
__device__ __forceinline__ void xcd_barrier_complete(unsigned* bar, unsigned x, unsigned& nloc, unsigned& nx) {
    const unsigned G = gridDim.x * gridDim.y * gridDim.z;
    unsigned sum, cnt, mine, sp = 0u;
    for (;;) {
        sum = 0u; cnt = 0u; mine = 0u;
#pragma unroll
        for (unsigned j = 0; j < 16; ++j) { const unsigned c = xb_ld(&bar[XB_XCNT(j)]); sum += c; cnt += (c > 0u) ? 1u : 0u; mine = (j == x) ? c : mine; }
        if (sum == G) break;
        __builtin_amdgcn_s_sleep(1);
        if ((++sp & 255u) == 0u) { if (xb_ld(&bar[XB_TMO])) break; if (sp > XB_SPIN_CAP) { atomicAdd(&bar[XB_TMO], 1u); break; } }
    }
    nloc = mine > 0u ? mine : 1u; nx = cnt > 0u ? cnt : 1u;
}
__device__ __forceinline__ void xcd_barrier(const XcdBarrier& b) {
    asm volatile("s_waitcnt vmcnt(0)" ::: "memory");
    __syncthreads();
    if (threadIdx.x == 0) {
        unsigned* bar = b.bar;
        __builtin_amdgcn_s_waitcnt(0);
        unsigned nloc = b.st[0], nx = b.st[1];
        if (nloc == 0u) { xcd_barrier_complete(bar, b.x, nloc, nx); b.st[0] = nloc; b.st[1] = nx; }
        const unsigned old = xb_add(&bar[XB_XSUB(b.x)], 1u);
        const unsigned gen = old / nloc;
        if (old + 1u == (gen + 1u) * nloc) {
            __builtin_amdgcn_fence(__ATOMIC_RELEASE, "agent");
            asm volatile("s_waitcnt vmcnt(0)" ::: "memory");
            const unsigned og = xb_add(&bar[XB_TOP], 1u);
            const unsigned tg = og / nx;
            asm volatile("buffer_inv sc1" ::: "memory");
            if (og + 1u == (tg + 1u) * nx) xb_add(&bar[XB_TOPGEN], 1u);
            else XB_SPIN(xb_ld(&bar[XB_TOPGEN]) == tg, bar);
            xb_add(&bar[XB_XGEN(b.x)], 1u);
            asm volatile("s_waitcnt vmcnt(0)" ::: "memory");
        } else {
            asm volatile("buffer_inv sc1" ::: "memory");
            XB_SPIN(xb_ld(&bar[XB_XGEN(b.x)]) == gen, bar);
            asm volatile("s_waitcnt vmcnt(0)" ::: "memory");
        }
    }
    __syncthreads();
}

namespace pg8 {
constexpr int BM = 256, BK = 64, HALF = 128, HTB = HALF * BK * 2, NXCD = 8, WGM = 8;
__host__ __device__ __forceinline__ int lds_byte(int r, int c) { const int st = (r >> 4) * 2 + (c >> 5), rr = r & 15, cc = c & 31, ob = rr * 64 + cc * 2; return st * 1024 + (ob ^ (((ob >> 9) & 1) << 5)); }
__host__ __device__ __forceinline__ int perm32(int rho) { const int n = rho >> 4, i = rho & 15; return 8 * (i >> 2) + 4 * n + (i & 3); }
__host__ __device__ __forceinline__ void stage_rc(int b, int& R, int& C) { const int st = b / 1024, sb = b % 1024, swz = sb ^ (((sb >> 9) & 1) << 5); R = (st >> 1) * 16 + swz / 64; C = (st & 1) * 32 + (swz % 64) / 2; }

struct GUnit { const char* A; const char* B; int nt; int row0; int col0; int aux; };

template <class Epi, class Sched>
__device__ __forceinline__ void gemm_phase(LAS unsigned char* lds, const int lda, const int ldb, const Sched& S, const Epi& E) {
    const int tid = tid_opaque(), wid = __builtin_amdgcn_readfirstlane(tid >> 6), lane = tid & 63, wr = wid >> 2, wc = wid & 3, fr = lane & 15, fq = lane >> 4;
    unsigned voffA[2], voffB[2];
#pragma unroll
    for (int i = 0; i < 2; ++i) { int R, C; stage_rc(tid * 16 + i * 8192, R, C); const int Rb = Epi::PERM ? ((R & ~31) + perm32(R & 31)) : R; voffA[i] = (unsigned)(R * lda + C) * 2u; voffB[i] = (unsigned)(Rb * ldb + C) * 2u; }
    const size_t kstep = (size_t)(BK * 2);
    const size_t hstepA = (size_t)HALF * lda * 2, hstepB = (size_t)HALF * ldb * 2;
    const unsigned ldsw = (unsigned)wid * 1024u;
    const int aoff = lds_byte(wr * 64 + fr, fq * 8), boff = lds_byte(wc * 32 + fr, fq * 8);
#define PG8_SA(b, h) (((b) * 2 + (h)) * HTB)
#define PG8_SB(b, h) ((4 + (b) * 2 + (h)) * HTB)
#define PG8_STAGE(bufoff, gbase, voff) do { _Pragma("unroll") for (int _i = 0; _i < 2; ++_i) \
        __builtin_amdgcn_global_load_lds((const unsigned*)((const char*)(gbase) + (voff)[_i]), (LAS unsigned*)(lds + (bufoff) + ldsw + _i * 8192), 16, 0, 0); } while (0)
#define PG8_LDA(dst, b, h) do { _Pragma("unroll") for (int m = 0; m < 4; ++m) _Pragma("unroll") for (int k = 0; k < 2; ++k) dst[m][k] = *(const LAS bf16x8*)(lds + PG8_SA(b, h) + aoff + m * 2048 + k * 1024); } while (0)
#define PG8_LDB(dst, b, h) do { _Pragma("unroll") for (int n = 0; n < 2; ++n) _Pragma("unroll") for (int k = 0; k < 2; ++k) dst[n][k] = *(const LAS bf16x8*)(lds + PG8_SB(b, h) + boff + n * 2048 + k * 1024); } while (0)
#define PG8_MMA(ai, bj, At, Bt) do { __builtin_amdgcn_s_setprio(1); _Pragma("unroll") for (int m = 0; m < 4; ++m) _Pragma("unroll") for (int n = 0; n < 2; ++n) _Pragma("unroll") for (int k = 0; k < 2; ++k) \
        acc[ai][bj][m][n] = __builtin_amdgcn_mfma_f32_16x16x32_bf16(Bt[n][k], At[m][k], acc[ai][bj][m][n], 0, 0, 0); __builtin_amdgcn_s_setprio(0); } while (0)
#define PG8_WAIT_V(n) asm volatile("s_waitcnt vmcnt(" #n ")" ::: "memory")
#define PG8_WAIT_L(n) asm volatile("s_waitcnt lgkmcnt(" #n ")" ::: "memory")
#define PG8_BAR __builtin_amdgcn_s_barrier()
#define PG8_SCHED __builtin_amdgcn_sched_barrier(0)
    GUnit cur, nxt; int ui = 0;
    if (!S.next(0, cur)) return;
    E.prepare(S, lds, tid);
    f32x4 acc[2][2][4][2];
#pragma unroll
    for (int a = 0; a < 2; ++a)
#pragma unroll
        for (int b = 0; b < 2; ++b)
#pragma unroll
            for (int m = 0; m < 4; ++m)
#pragma unroll
                for (int n = 0; n < 2; ++n) acc[a][b][m][n] = (f32x4){0.f, 0.f, 0.f, 0.f};
    bf16x8 At[4][2], B0[2][2], B1[2][2];
    const char* cA = cur.A; const char* cB = cur.B;
    PG8_STAGE(PG8_SB(0, 0), cB, voffB); PG8_STAGE(PG8_SB(0, 1), cB + hstepB, voffB); PG8_STAGE(PG8_SA(0, 0), cA, voffA); PG8_STAGE(PG8_SA(0, 1), cA + hstepA, voffA);
    if (wr == 1) PG8_BAR;
    PG8_WAIT_V(2); PG8_BAR;
    PG8_STAGE(PG8_SB(1, 0), cB + kstep, voffB); PG8_STAGE(PG8_SA(1, 0), cA + kstep, voffA); PG8_STAGE(PG8_SB(1, 1), cB + hstepB + kstep, voffB);
    PG8_WAIT_V(6); PG8_BAR;
    for (;;) {
        const bool has_next = S.next(ui + 1, nxt);
        const char* nA = has_next ? nxt.A : cA; const char* nB = has_next ? nxt.B : cB;
        const int nt = cur.nt;
        for (int t = 0; t < nt; t += 2) {
            const bool last = (t == nt - 2);
            const char* a1 = cA + (size_t)(t + 1) * kstep;
            const char* a2 = last ? nA : cA + (size_t)(t + 2) * kstep; const char* b2 = last ? nB : cB + (size_t)(t + 2) * kstep;
            const char* a3 = a2 + kstep; const char* b3 = b2 + kstep;
            PG8_LDB(B0, 0, 0); PG8_LDB(B1, 0, 1); PG8_SCHED; PG8_LDA(At, 0, 0); PG8_STAGE(PG8_SA(1, 1), a1 + hstepA, voffA);
            PG8_WAIT_V(8); PG8_WAIT_L(0); PG8_BAR; PG8_MMA(0, 0, At, B0); PG8_MMA(0, 1, At, B1); PG8_BAR; PG8_SCHED;
            PG8_LDA(At, 0, 1); PG8_STAGE(PG8_SB(0, 0), b2, voffB); PG8_STAGE(PG8_SB(0, 1), b2 + hstepB, voffB); PG8_STAGE(PG8_SA(0, 0), a2, voffA);
            PG8_WAIT_V(8); PG8_WAIT_L(0); PG8_BAR; PG8_MMA(1, 0, At, B0); PG8_MMA(1, 1, At, B1); PG8_BAR; PG8_SCHED;
            PG8_LDB(B0, 1, 0); PG8_LDB(B1, 1, 1); PG8_SCHED; PG8_LDA(At, 1, 0); PG8_STAGE(PG8_SA(0, 1), a2 + hstepA, voffA);
            PG8_WAIT_V(8); PG8_WAIT_L(0); PG8_BAR; PG8_MMA(0, 0, At, B0); PG8_MMA(0, 1, At, B1); PG8_BAR; PG8_SCHED;
            PG8_LDA(At, 1, 1); PG8_STAGE(PG8_SB(1, 0), b3, voffB); PG8_STAGE(PG8_SB(1, 1), b3 + hstepB, voffB); PG8_STAGE(PG8_SA(1, 0), a3, voffA);
            PG8_WAIT_V(8); PG8_WAIT_L(0); PG8_BAR; PG8_MMA(1, 0, At, B0); PG8_MMA(1, 1, At, B1); PG8_BAR; PG8_SCHED;
        }
        if (wr == 0) PG8_BAR;
        E(acc, cur, ui, wr, wc, fr, fq);
        if (!has_next) break;
#pragma unroll
        for (int a = 0; a < 2; ++a)
#pragma unroll
            for (int b = 0; b < 2; ++b)
#pragma unroll
                for (int m = 0; m < 4; ++m)
#pragma unroll
                    for (int n = 0; n < 2; ++n) acc[a][b][m][n] = (f32x4){0.f, 0.f, 0.f, 0.f};
        cur = nxt; cA = nA; cB = nB; ++ui;
        if (wr == 1) PG8_BAR;
    }
    PG8_WAIT_V(0);
    PG8_BAR;
#undef PG8_SA
#undef PG8_SB
#undef PG8_STAGE
#undef PG8_LDA
#undef PG8_LDB
#undef PG8_MMA
#undef PG8_WAIT_V
#undef PG8_WAIT_L
#undef PG8_BAR
#undef PG8_SCHED
}

template <class Epi, class Sched>
__device__ __forceinline__ void gemm_phase_n128(LAS unsigned char* lds, const int lda, const int ldb, const Sched& S, const Epi& E) {
    const int tid = tid_opaque(), wid = __builtin_amdgcn_readfirstlane(tid >> 6), lane = tid & 63, wr = wid >> 2, wc = wid & 3, fr = lane & 15, fq = lane >> 4;
    unsigned voffA[2], voffB[2];
#pragma unroll
    for (int i = 0; i < 2; ++i) { int R, C; stage_rc(tid * 16 + i * 8192, R, C); const int Rb = Epi::PERM ? ((R & ~31) + perm32(R & 31)) : R; voffA[i] = (unsigned)(R * lda + C) * 2u; voffB[i] = (unsigned)(Rb * ldb + C) * 2u; }
    const size_t kstep = (size_t)(BK * 2);
    const size_t hstepA = (size_t)HALF * lda * 2;
    const unsigned ldsw = (unsigned)wid * 1024u;
    const int aoff = lds_byte(wr * 64 + fr, fq * 8), boff = lds_byte(wc * 32 + fr, fq * 8);
#define N1_SA(b, h) (((b) * 2 + (h)) * HTB)
#define N1_SB(b) ((4 + (b)) * HTB)
#define N1_STAGE(bufoff, gbase, voff) do { _Pragma("unroll") for (int _i = 0; _i < 2; ++_i) \
        __builtin_amdgcn_global_load_lds((const unsigned*)((const char*)(gbase) + (voff)[_i]), (LAS unsigned*)(lds + (bufoff) + ldsw + _i * 8192), 16, 0, 0); } while (0)
#define N1_LDA(dst, b, h) do { _Pragma("unroll") for (int m = 0; m < 4; ++m) _Pragma("unroll") for (int k = 0; k < 2; ++k) dst[m][k] = *(const LAS bf16x8*)(lds + N1_SA(b, h) + aoff + m * 2048 + k * 1024); } while (0)
#define N1_LDB(dst, b) do { _Pragma("unroll") for (int n = 0; n < 2; ++n) _Pragma("unroll") for (int k = 0; k < 2; ++k) dst[n][k] = *(const LAS bf16x8*)(lds + N1_SB(b) + boff + n * 2048 + k * 1024); } while (0)
#define N1_MMA(ai, At, Bt) do { __builtin_amdgcn_s_setprio(1); _Pragma("unroll") for (int m = 0; m < 4; ++m) _Pragma("unroll") for (int n = 0; n < 2; ++n) _Pragma("unroll") for (int k = 0; k < 2; ++k) \
        acc[ai][m][n] = __builtin_amdgcn_mfma_f32_16x16x32_bf16(Bt[n][k], At[m][k], acc[ai][m][n], 0, 0, 0); __builtin_amdgcn_s_setprio(0); } while (0)
#define N1_WAIT_V(n) asm volatile("s_waitcnt vmcnt(" #n ")" ::: "memory")
#define N1_WAIT_L(n) asm volatile("s_waitcnt lgkmcnt(" #n ")" ::: "memory")
#define N1_BAR __builtin_amdgcn_s_barrier()
#define N1_SCHED __builtin_amdgcn_sched_barrier(0)
    GUnit cur, nxt; int ui = 0;
    if (!S.next(0, cur)) return;
    E.prepare(S, lds, tid);
    f32x4 acc[2][4][2];
#pragma unroll
    for (int x = 0; x < 2; ++x)
#pragma unroll
        for (int m = 0; m < 4; ++m)
#pragma unroll
            for (int n = 0; n < 2; ++n) acc[x][m][n] = (f32x4){0.f, 0.f, 0.f, 0.f};
    bf16x8 At[4][2], B0[2][2];
    const char* cA = cur.A; const char* cB = cur.B;
    N1_STAGE(N1_SB(0), cB, voffB); N1_STAGE(N1_SA(0, 0), cA, voffA); N1_STAGE(N1_SA(0, 1), cA + hstepA, voffA);
    if (wr == 1) N1_BAR;
    N1_WAIT_V(0); N1_BAR;
    N1_STAGE(N1_SB(1), cB + kstep, voffB); N1_STAGE(N1_SA(1, 0), cA + kstep, voffA);
    N1_BAR;
    for (;;) {
        const bool has_next = S.next(ui + 1, nxt);
        const char* nA = has_next ? nxt.A : cA; const char* nB = has_next ? nxt.B : cB;
        const int nt = cur.nt;
        for (int t = 0; t < nt; t += 2) {
            const bool last = (t == nt - 2);
            const char* a1 = cA + (size_t)(t + 1) * kstep;
            const char* a2 = last ? nA : cA + (size_t)(t + 2) * kstep; const char* b2 = last ? nB : cB + (size_t)(t + 2) * kstep;
            const char* a3 = a2 + kstep; const char* b3 = b2 + kstep;
            N1_LDB(B0, 0); N1_SCHED; N1_LDA(At, 0, 0); N1_STAGE(N1_SA(1, 1), a1 + hstepA, voffA);
            N1_WAIT_V(6); N1_WAIT_L(0); N1_BAR; N1_MMA(0, At, B0); N1_BAR; N1_SCHED;
            N1_LDA(At, 0, 1); N1_STAGE(N1_SA(0, 0), a2, voffA); N1_STAGE(N1_SB(0), b2, voffB);
            N1_WAIT_V(6); N1_WAIT_L(0); N1_BAR; N1_MMA(1, At, B0); N1_BAR; N1_SCHED;
            N1_LDB(B0, 1); N1_SCHED; N1_LDA(At, 1, 0); N1_STAGE(N1_SA(0, 1), a2 + hstepA, voffA);
            N1_WAIT_V(6); N1_WAIT_L(0); N1_BAR; N1_MMA(0, At, B0); N1_BAR; N1_SCHED;
            N1_LDA(At, 1, 1); N1_STAGE(N1_SA(1, 0), a3, voffA); N1_STAGE(N1_SB(1), b3, voffB);
            N1_WAIT_V(6); N1_WAIT_L(0); N1_BAR; N1_MMA(1, At, B0); N1_BAR; N1_SCHED;
        }
        if (wr == 0) N1_BAR;
        E(acc, cur, ui, wr, wc, fr, fq);
        if (!has_next) break;
#pragma unroll
        for (int x = 0; x < 2; ++x)
#pragma unroll
            for (int m = 0; m < 4; ++m)
#pragma unroll
                for (int n = 0; n < 2; ++n) acc[x][m][n] = (f32x4){0.f, 0.f, 0.f, 0.f};
        cur = nxt; cA = nA; cB = nB; ++ui;
        if (wr == 1) N1_BAR;
    }
    N1_WAIT_V(0);
    N1_BAR;
#undef N1_SA
#undef N1_SB
#undef N1_STAGE
#undef N1_LDA
#undef N1_LDB
#undef N1_MMA
#undef N1_WAIT_V
#undef N1_WAIT_L
#undef N1_BAR
#undef N1_SCHED
}
}
using pg8::GUnit;
typedef f32x4 AccT[2][2][4][2];
typedef f32x4 AccH[2][4][2];

template <class Sched> __device__ __forceinline__ void prep_rstd(LAS unsigned char* lds, const float* ssp, const Sched& S, bool cols, int tid) {
    LAS float* R = (LAS float*)(lds + RSTD_OFF);
    if (tid < 256) {
        f32x4 p[3][8]; bool ok[3];
#pragma unroll
        for (int i = 0; i < 3; ++i) { GUnit u; ok[i] = S.next(i, u);
            if (ok[i]) { const f32x4* q = (const f32x4*)(ssp + (size_t)((cols ? u.col0 : u.row0) + tid) * SSPN);
#pragma unroll
                for (int k = 0; k < 8; ++k) p[i][k] = q[k]; } }
#pragma unroll
        for (int i = 0; i < 3; ++i) if (ok[i]) { const f32x4 s4 = ((p[i][0] + p[i][1]) + (p[i][2] + p[i][3])) + ((p[i][4] + p[i][5]) + (p[i][6] + p[i][7]));
            R[i * 256 + tid] = rsqrtf(((s4[0] + s4[1]) + (s4[2] + s4[3])) * (1.f / 1024.f) + EPS); }
    }
    LDS_WAIT(); __builtin_amdgcn_s_barrier(); asm volatile("" ::: "memory");
}
struct EpiQKV {
    bf16_t* Q; bf16_t* KB; bf16_t* VB; float* nk; float* nv; const float* ropec; const float* ropes; const float* ssp; const float* sw; LAS unsigned char* lds;
    static constexpr bool PERM = false;
    template <class Sched> __device__ __forceinline__ void prepare(const Sched& S, LAS unsigned char* l, int tid) const { prep_rstd(l, ssp, S, false, tid); }
    __device__ __forceinline__ void operator()(const AccT& acc, const GUnit& u, int ui, int wr, int wc, int fr, int fq) const {
        const LAS float* R = (const LAS float*)(lds + RSTD_OFF) + ui * 256;
        const int sec = u.col0 >> 10;
        const bool lat = u.row0 >= NCTX;
        const int cbase = (u.col0 & 1023) + wc * 32 + 4 * fq;
        const float* swc = sw + cond_of_row(u.row0) * 3072 + u.col0 + wc * 32 + 4 * fq;
        f32x4 sv[2][2];
#pragma unroll
        for (int bj = 0; bj < 2; ++bj)
#pragma unroll
            for (int n = 0; n < 2; ++n) sv[bj][n] = *(const f32x4*)(swc + bj * 128 + n * 16);
#pragma unroll
        for (int ai = 0; ai < 2; ++ai)
#pragma unroll
            for (int m = 0; m < 4; ++m) {
                const int rl = ai * 128 + wr * 64 + m * 16 + fr, r = u.row0 + rl;
                const float rs = R[rl];
                int t = 0, kvrow = r; size_t orow = 0;
                if (lat) { const int rr = r - NCTX; t = rr & 1023; kvrow = NCTX + (rr >> 10) * 1536 + 512 + t; }
                else { const int b = r >> 8; orow = ((size_t)(b * 2) * 256 + (r & 255)) * 1024; }
                f32x4 cs = {1.f, 1.f, 1.f, 1.f}, sn = {0.f, 0.f, 0.f, 0.f};
                if (lat && sec < 2) { const int pos = (wc & 1) ? (t & 63) : (t >> 6); cs = *(const f32x4*)(ropec + pos * 16 + 4 * fq); sn = *(const f32x4*)(ropes + pos * 16 + 4 * fq); }
#pragma unroll
                for (int bj = 0; bj < 2; ++bj) {
                    f32x4 x1 = acc[ai][bj][m][0] * rs + sv[bj][0], x2 = acc[ai][bj][m][1] * rs + sv[bj][1];
                    const int c = cbase + bj * 128;
                    if (sec < 2) { const f32x4 y1 = x1 * cs - x2 * sn, y2 = x2 * cs + x1 * sn; x1 = y1; x2 = y2; }
                    u32x4 w; w.x = cvt_pk_bf16(x1[0], x1[1]); w.y = cvt_pk_bf16(x1[2], x1[3]); w.z = cvt_pk_bf16(x2[0], x2[1]); w.w = cvt_pk_bf16(x2[2], x2[3]);
                    const int c8 = c + 4 * fq;
                    if (sec == 0) *(u32x4*)(Q + (size_t)r * 1024 + c8) = w;
                    else {
                        *(u32x4*)((sec == 1 ? KB : VB) + (size_t)kvrow * 1024 + c8) = w;
                        if (!lat) { if (sec == 1) { float* o = nk + orow + c; *(f32x4*)o = x1; *(f32x4*)(o + 16) = x2; }
                                    else { float* o = nv + orow + c8; *(f32x4*)o = x1; *(f32x4*)(o + 4) = x2; } }
                    }
                }
            }
    }
};
struct EpiQKV128 {
    bf16_t* Q; bf16_t* KB; bf16_t* VB; float* nk; float* nv; const float* ropec; const float* ropes; const float* ssp; const float* sw; LAS unsigned char* lds;
    static constexpr bool PERM = false;
    template <class Sched> __device__ __forceinline__ void prepare(const Sched& S, LAS unsigned char* l, int tid) const { prep_rstd(l, ssp, S, false, tid); }
    __device__ __forceinline__ void operator()(const AccH& acc, const GUnit& u, int ui, int wr, int wc, int fr, int fq) const {
        const LAS float* R = (const LAS float*)(lds + RSTD_OFF) + ui * 256;
        const int sec = u.col0 >> 10;
        const bool lat = u.row0 >= NCTX;
        const int c = (u.col0 & 1023) + wc * 32 + 4 * fq;
        const float* swc = sw + cond_of_row(u.row0) * 3072 + u.col0 + wc * 32 + 4 * fq;
        const f32x4 sv0 = *(const f32x4*)swc, sv1 = *(const f32x4*)(swc + 16);
#pragma unroll
        for (int ai = 0; ai < 2; ++ai)
#pragma unroll
            for (int m = 0; m < 4; ++m) {
                const int rl = ai * 128 + wr * 64 + m * 16 + fr, r = u.row0 + rl;
                const float rs = R[rl];
                int t = 0, kvrow = r; size_t orow = 0;
                if (lat) { const int rr = r - NCTX; t = rr & 1023; kvrow = NCTX + (rr >> 10) * 1536 + 512 + t; }
                else { const int b = r >> 8; orow = ((size_t)(b * 2) * 256 + (r & 255)) * 1024; }
                f32x4 cs = {1.f, 1.f, 1.f, 1.f}, sn = {0.f, 0.f, 0.f, 0.f};
                if (lat && sec < 2) { const int pos = (wc & 1) ? (t & 63) : (t >> 6); cs = *(const f32x4*)(ropec + pos * 16 + 4 * fq); sn = *(const f32x4*)(ropes + pos * 16 + 4 * fq); }
                f32x4 x1 = acc[ai][m][0] * rs + sv0, x2 = acc[ai][m][1] * rs + sv1;
                if (sec < 2) { const f32x4 y1 = x1 * cs - x2 * sn, y2 = x2 * cs + x1 * sn; x1 = y1; x2 = y2; }
                u32x4 w; w.x = cvt_pk_bf16(x1[0], x1[1]); w.y = cvt_pk_bf16(x1[2], x1[3]); w.z = cvt_pk_bf16(x2[0], x2[1]); w.w = cvt_pk_bf16(x2[2], x2[3]);
                const int c8 = c + 4 * fq;
                if (sec == 0) *(u32x4*)(Q + (size_t)r * 1024 + c8) = w;
                else {
                    *(u32x4*)((sec == 1 ? KB : VB) + (size_t)kvrow * 1024 + c8) = w;
                    if (!lat) { if (sec == 1) { float* o = nk + orow + c; *(f32x4*)o = x1; *(f32x4*)(o + 16) = x2; }
                                else { float* o = nv + orow + c8; *(f32x4*)o = x1; *(f32x4*)(o + 4) = x2; } }
                }
            }
    }
};
struct EpiResid {
    float* X; const float* gate; const float* an; bf16_t* XA; float* ssp;
    static constexpr bool PERM = true;
    template <class Sched> __device__ __forceinline__ void prepare(const Sched&, LAS unsigned char*, int) const {}
    __device__ __forceinline__ void operator()(const AccT& acc, const GUnit& u, int ui, int wr, int wc, int fr, int fq) const {
        const int cbase = u.col0 + wc * 32 + 8 * fq;
        const int cnd = cond_of_row(u.row0);
        const float* g = gate + cnd * 6144;
        f32x4 gv[2][2];
#pragma unroll
        for (int bj = 0; bj < 2; ++bj)
#pragma unroll
            for (int n = 0; n < 2; ++n) gv[bj][n] = *(const f32x4*)(g + cbase + bj * 128 + n * 4);
        const float* anc = an + cnd * 1024 + cbase;
        const int slot = (u.col0 >> 8) * 4 + wc;
#pragma unroll
        for (int ai = 0; ai < 2; ++ai) {
#pragma unroll
            for (int mp = 0; mp < 2; ++mp) {
            f32x4 xo[2][2][2];
#pragma unroll
            for (int m2 = 0; m2 < 2; ++m2)
#pragma unroll
                for (int bj = 0; bj < 2; ++bj)
#pragma unroll
                    for (int n = 0; n < 2; ++n) xo[m2][bj][n] = *(const f32x4*)(X + (size_t)(u.row0 + ai * 128 + wr * 64 + (mp * 2 + m2) * 16 + fr) * 1024 + cbase + bj * 128 + n * 4);
#pragma unroll
            for (int m2 = 0; m2 < 2; ++m2) {
                const int m = mp * 2 + m2;
                const size_t ro = (size_t)(u.row0 + ai * 128 + wr * 64 + m * 16 + fr);
                float ss = 0.f;
#pragma unroll
                for (int bj = 0; bj < 2; ++bj) {
                    const f32x4 x0 = xo[m2][bj][0] + gv[bj][0] * acc[ai][bj][m][0], x1 = xo[m2][bj][1] + gv[bj][1] * acc[ai][bj][m][1];
                    *(f32x4*)(X + ro * 1024 + cbase + bj * 128) = x0; *(f32x4*)(X + ro * 1024 + cbase + bj * 128 + 4) = x1;
                    ss += ((x0[0] * x0[0] + x0[1] * x0[1]) + (x0[2] * x0[2] + x0[3] * x0[3])) + ((x1[0] * x1[0] + x1[1] * x1[1]) + (x1[2] * x1[2] + x1[3] * x1[3]));
                    if (an) { const f32x4 y0 = x0 * *(const f32x4*)(anc + bj * 128), y1 = x1 * *(const f32x4*)(anc + bj * 128 + 4); u32x4 w; w.x = cvt_pk_bf16(y0[0], y0[1]); w.y = cvt_pk_bf16(y0[2], y0[3]); w.z = cvt_pk_bf16(y1[0], y1[1]); w.w = cvt_pk_bf16(y1[2], y1[3]);
                        *(u32x4*)(XA + ro * 1024 + cbase + bj * 128) = w; }
                }
                ss += __shfl_xor(ss, 16); ss += __shfl_xor(ss, 32);
                if (fq == 0) ssp[ro * SSPN + slot] = ss;
            }
            }
            asm volatile("" ::: "memory");
        }
    }
};
struct EpiResid128 {
    bf16_t* X; const float* gate; const float* an; bf16_t* XA; float* ssp;
    static constexpr bool PERM = true;
    template <class Sched> __device__ __forceinline__ void prepare(const Sched&, LAS unsigned char*, int) const {}
    __device__ __forceinline__ void operator()(const AccH& acc, const GUnit& u, int ui, int wr, int wc, int fr, int fq) const {
        const int cbase = u.col0 + wc * 32 + 8 * fq;
        const int cnd = cond_of_row(u.row0);
        const float* g = gate + cnd * 6144;
        const f32x4 gv0 = *(const f32x4*)(g + cbase), gv1 = *(const f32x4*)(g + cbase + 4);
        f32x4 av0 = {0.f, 0.f, 0.f, 0.f}, av1 = av0;
        if (an) { av0 = *(const f32x4*)(an + cnd * 1024 + cbase); av1 = *(const f32x4*)(an + cnd * 1024 + cbase + 4); }
        const int slot = (u.col0 >> 7) * 4 + wc;
        u32x4 xo[2][4];
#pragma unroll
        for (int ai = 0; ai < 2; ++ai)
#pragma unroll
            for (int m = 0; m < 4; ++m) xo[ai][m] = *(const u32x4*)(X + (size_t)(u.row0 + ai * 128 + wr * 64 + m * 16 + fr) * 1024 + cbase);
#pragma unroll
        for (int ai = 0; ai < 2; ++ai)
#pragma unroll
            for (int m = 0; m < 4; ++m) {
                const size_t ro = (size_t)(u.row0 + ai * 128 + wr * 64 + m * 16 + fr);
                const u32x4 xw = xo[ai][m];
                const f32x4 xa = {bflo(xw.x), bfhi(xw.x), bflo(xw.y), bfhi(xw.y)}, xb = {bflo(xw.z), bfhi(xw.z), bflo(xw.w), bfhi(xw.w)};
                const f32x4 x0 = xa + gv0 * acc[ai][m][0], x1 = xb + gv1 * acc[ai][m][1];
                { u32x4 w; w.x = cvt_pk_bf16(x0[0], x0[1]); w.y = cvt_pk_bf16(x0[2], x0[3]); w.z = cvt_pk_bf16(x1[0], x1[1]); w.w = cvt_pk_bf16(x1[2], x1[3]); *(u32x4*)(X + ro * 1024 + cbase) = w; }
                float ss = ((x0[0] * x0[0] + x0[1] * x0[1]) + (x0[2] * x0[2] + x0[3] * x0[3])) + ((x1[0] * x1[0] + x1[1] * x1[1]) + (x1[2] * x1[2] + x1[3] * x1[3]));
                if (an) { const f32x4 y0 = x0 * av0, y1 = x1 * av1; u32x4 w; w.x = cvt_pk_bf16(y0[0], y0[1]); w.y = cvt_pk_bf16(y0[2], y0[3]); w.z = cvt_pk_bf16(y1[0], y1[1]); w.w = cvt_pk_bf16(y1[2], y1[3]);
                    *(u32x4*)(XA + ro * 1024 + cbase) = w; }
                ss += __shfl_xor(ss, 16); ss += __shfl_xor(ss, 32);
                if (fq == 0) ssp[ro * SSPN + slot] = ss;
            }
    }
};
struct EpiG128 {
    bf16_t* GH; const float* ssp; const float* sw; LAS unsigned char* lds;
    static constexpr bool PERM = true;
    template <class Sched> __device__ __forceinline__ void prepare(const Sched& S, LAS unsigned char* l, int tid) const { prep_rstd(l, ssp, S, false, tid); }
    __device__ __forceinline__ void operator()(const AccH& acc, const GUnit& u, int ui, int wr, int wc, int fr, int fq) const {
        const LAS float* R = (const LAS float*)(lds + RSTD_OFF) + ui * 256;
        const float* swc = sw + cond_of_row(u.row0) * 5120 + u.col0 + wc * 32 + 8 * fq;
        const f32x4 sv0 = *(const f32x4*)swc, sv1 = *(const f32x4*)(swc + 4);
        const int cbase = (u.col0 - 4096) + wc * 32 + 8 * fq;
#pragma unroll
        for (int ai = 0; ai < 2; ++ai)
#pragma unroll
            for (int m = 0; m < 4; ++m) {
                const int rl = ai * 128 + wr * 64 + m * 16 + fr; const float rs = R[rl];
                const f32x4 v0 = acc[ai][m][0] * rs + sv0, v1 = acc[ai][m][1] * rs + sv1;
                u32x4 w; w.x = cvt_pk_bf16(silu_f(v0[0]), silu_f(v0[1])); w.y = cvt_pk_bf16(silu_f(v0[2]), silu_f(v0[3])); w.z = cvt_pk_bf16(silu_f(v1[0]), silu_f(v1[1])); w.w = cvt_pk_bf16(silu_f(v1[2]), silu_f(v1[3]));
                *(u32x4*)(GH + (size_t)(u.row0 + rl) * 1024 + cbase) = w;
            }
    }
};
struct EpiFFN {
    bf16_t* ACT; const float* ssp; const float* sw; LAS unsigned char* lds;
    static constexpr bool PERM = true;
    template <class Sched> __device__ __forceinline__ void prepare(const Sched& S, LAS unsigned char* l, int tid) const { prep_rstd(l, ssp, S, false, tid); }
    __device__ __forceinline__ void operator()(const AccT& acc, const GUnit& u, int ui, int wr, int wc, int fr, int fq) const {
        const LAS float* R = (const LAS float*)(lds + RSTD_OFF) + ui * 256;
        const int abase = (u.col0 >> 1) + wc * 32 + 8 * fq;
        const float* swc = sw + cond_of_row(u.row0) * 5632 + u.col0 + wc * 32 + 8 * fq;
        f32x4 sv[2][2];
#pragma unroll
        for (int bj = 0; bj < 2; ++bj)
#pragma unroll
            for (int n = 0; n < 2; ++n) sv[bj][n] = *(const f32x4*)(swc + bj * 128 + n * 4);
#pragma unroll
        for (int ai = 0; ai < 2; ++ai)
#pragma unroll
            for (int m = 0; m < 4; ++m) {
                const int rl = ai * 128 + wr * 64 + m * 16 + fr;
                const float rs = R[rl];
                u32x4 w;
#pragma unroll
                for (int n = 0; n < 2; ++n) {
                    const f32x4 g = acc[ai][0][m][n] * rs + sv[0][n], up = acc[ai][1][m][n] * rs + sv[1][n];
                    w[2 * n] = cvt_pk_bf16(silu_f(g[0]) * up[0], silu_f(g[1]) * up[1]); w[2 * n + 1] = cvt_pk_bf16(silu_f(g[2]) * up[2], silu_f(g[3]) * up[3]);
                }
                *(u32x4*)(ACT + (size_t)(u.row0 + rl) * DFF + abase) = w;
            }
    }
};
__device__ __forceinline__ void quad_transpose(f32x4& v, int qi) {
#define QT_X1(x) __int_as_float(__builtin_amdgcn_update_dpp(0, __float_as_int(x), 0xB1, 0xF, 0xF, true))
#define QT_X2(x) __int_as_float(__builtin_amdgcn_update_dpp(0, __float_as_int(x), 0x4E, 0xF, 0xF, true))
    const bool o1 = qi & 1, o2 = qi & 2;
    { const float t0 = o1 ? v[0] : v[1], t1 = o1 ? v[2] : v[3]; const float r0 = QT_X1(t0), r1 = QT_X1(t1);
      if (o1) { v[0] = r0; v[2] = r1; } else { v[1] = r0; v[3] = r1; } }
    { const float t0 = o2 ? v[0] : v[2], t1 = o2 ? v[1] : v[3]; const float r0 = QT_X2(t0), r1 = QT_X2(t1);
      if (o2) { v[0] = r0; v[1] = r1; } else { v[2] = r0; v[3] = r1; } }
#undef QT_X1
#undef QT_X2
}
#define DPP_SHR(x, N) __int_as_float(__builtin_amdgcn_update_dpp(0, __float_as_int(x), 0x110 + (N), 0xF, 0xF, true))
#define DPP_SHL(x, N) __int_as_float(__builtin_amdgcn_update_dpp(0, __float_as_int(x), 0x100 + (N), 0xF, 0xF, true))
struct EpiHgrn {
    bf16_t* GH; bf16_t* QTF; bf16_t* KTF; bf16_t* QTB; bf16_t* KTB; bf16_t* KHTF; bf16_t* KHTB; bf16_t* VT; float* DDF; float* DDB; const float* lbv; const float* ssp; const float* sw; LAS unsigned char* lds;
    static constexpr bool PERM = false;
    template <class Sched> __device__ __forceinline__ void prepare(const Sched& S, LAS unsigned char* l, int tid) const { prep_rstd(l, ssp, S, false, tid); }
    __device__ __forceinline__ void operator()(const AccT& acc, const GUnit& u, int ui, int wr, int wc, int fr, int fq) const {
        const LAS float* R = (const LAS float*)(lds + RSTD_OFF) + ui * 256;
        const int t = u.col0 >> 8;
        const float* swc = sw + cond_of_row(u.row0) * 5120 + u.col0 + wc * 32 + 4 * fq;
        f32x4 sv[2][2];
#pragma unroll
        for (int bj = 0; bj < 2; ++bj)
#pragma unroll
            for (int n = 0; n < 2; ++n) sv[bj][n] = *(const f32x4*)(swc + bj * 128 + n * 16);
        if (t >= 16) {
            const int cbase = (u.col0 - 4096) + wc * 32 + 4 * fq;
#pragma unroll
            for (int ai = 0; ai < 2; ++ai)
#pragma unroll
                for (int m = 0; m < 4; ++m) {
                    const int rl = ai * 128 + wr * 64 + m * 16 + fr; const float rs = R[rl];
#pragma unroll
                    for (int bj = 0; bj < 2; ++bj)
#pragma unroll
                        for (int n = 0; n < 2; ++n) { const f32x4 v = acc[ai][bj][m][n] * rs + sv[bj][n];
                            u32x2 w; w.x = cvt_pk_bf16(silu_f(v[0]), silu_f(v[1])); w.y = cvt_pk_bf16(silu_f(v[2]), silu_f(v[3]));
                            *(u32x2*)(GH + (size_t)(u.row0 + rl) * 1024 + cbase + bj * 128 + n * 16) = w; }
                }
            return;
        }
        const int h = t >> 1, kk = (t & 1) * 64 + wc * 16 + 4 * fq, chg = t * 64 + wc * 16 + 4 * fq;
        const f32x4 lb0 = *(const f32x4*)(lbv + chg), lb1 = *(const f32x4*)(lbv + 1024 + chg);
        const int lane = fq * 16 + fr;
#pragma unroll 1
        for (int am = 0; am < 8; ++am) {
            const int ai = am >> 2, m = am & 3;
            f32x4 aq, av, azf, azb;
            switch (am) {
#define HG_CASE(I) case I: aq = acc[(I) >> 2][0][(I) & 3][0]; av = acc[(I) >> 2][0][(I) & 3][1]; azf = acc[(I) >> 2][1][(I) & 3][0]; azb = acc[(I) >> 2][1][(I) & 3][1]; break;
                HG_CASE(0) HG_CASE(1) HG_CASE(2) HG_CASE(3) HG_CASE(4) HG_CASE(5) HG_CASE(6) default: aq = acc[1][0][3][0]; av = acc[1][0][3][1]; azf = acc[1][1][3][0]; azb = acc[1][1][3][1]; break;
#undef HG_CASE
            }
            const int rl = ai * 128 + wr * 64 + m * 16 + fr; const float rs = R[rl];
            const int tok = u.row0 + rl; const size_t cg = (size_t)((tok >> 4) * 8 + h);
            const f32x4 q4 = aq * rs + sv[0][0], v4 = av * rs + sv[0][1], zf = azf * rs + sv[1][0], zb = azb * rs + sv[1][1];
            f32x4 q, kf, kb, bf, bb;
#pragma unroll
            for (int j = 0; j < 4; ++j) { q[j] = silu_f(q4[j]);
                const float ff = lb0[j] + (1.f - lb0[j]) * sigmoid_f(zf[j]), fb = lb1[j] + (1.f - lb1[j]) * sigmoid_f(zb[j]);
                kf[j] = 1.f - ff; kb[j] = 1.f - fb; bf[j] = __logf(ff); bb[j] = __logf(fb); }
#pragma unroll
            for (int j = 0; j < 4; ++j) {
                float x = bf[j]; x += DPP_SHR(x, 1); x += DPP_SHR(x, 2); x += DPP_SHR(x, 4); x += DPP_SHR(x, 8); bf[j] = x;
                float y = bb[j]; y += DPP_SHL(y, 1); y += DPP_SHL(y, 2); y += DPP_SHL(y, 4); y += DPP_SHL(y, 8); bb[j] = y; }
            f32x4 qtf, ktf, khf, ddf, qtb, ktb, khb, ddb;
#pragma unroll
            for (int j = 0; j < 4; ++j) {
                const float ef = __expf(bf[j]), eif = __expf(-bf[j]), eb = __expf(bb[j]), eib = __expf(-bb[j]);
                ddf[j] = __shfl(ef, lane | 15); ddb[j] = __shfl(eb, lane & ~15);
                qtf[j] = q[j] * ef; ktf[j] = kf[j] * eif; khf[j] = ktf[j] * ddf[j];
                qtb[j] = q[j] * eb; ktb[j] = kb[j] * eib; khb[j] = ktb[j] * ddb[j]; }
            bf16_t* rec = QTF + ((size_t)(tok * 8 + h) * 32 + (kk >> 2)) * 16;
            { u32x4 w; w.x = cvt_pk_bf16(qtf[0], qtf[1]); w.y = cvt_pk_bf16(qtf[2], qtf[3]); w.z = cvt_pk_bf16(ktf[0], ktf[1]); w.w = cvt_pk_bf16(ktf[2], ktf[3]); *(u32x4*)rec = w; }
            { u32x4 w; w.x = cvt_pk_bf16(qtb[0], qtb[1]); w.y = cvt_pk_bf16(qtb[2], qtb[3]); w.z = cvt_pk_bf16(ktb[0], ktb[1]); w.w = cvt_pk_bf16(ktb[2], ktb[3]); *(u32x4*)(rec + 8) = w; }
            f32x4 vt = v4;
            quad_transpose(khf, fr & 3); quad_transpose(khb, fr & 3); quad_transpose(vt, fr & 3);
            const size_t to = (cg * 128 + kk + (fr & 3)) * 16 + (fr & ~3);
            { u32x2 w; w.x = cvt_pk_bf16(khf[0], khf[1]); w.y = cvt_pk_bf16(khf[2], khf[3]); *(u32x2*)(KHTF + to) = w; }
            { u32x2 w; w.x = cvt_pk_bf16(khb[0], khb[1]); w.y = cvt_pk_bf16(khb[2], khb[3]); *(u32x2*)(KHTB + to) = w; }
            { u32x2 w; w.x = cvt_pk_bf16(vt[0], vt[1]); w.y = cvt_pk_bf16(vt[2], vt[3]); *(u32x2*)(VT + to) = w; }
            if (fr == 15) *(f32x4*)(DDF + cg * 128 + kk) = ddf;
            if (fr == 0) *(f32x4*)(DDB + cg * 128 + kk) = ddb;
        }
    }
};
struct EpiFour1 {
    bf16_t* ZT; const float* ssp; const float* sw; LAS unsigned char* lds;
    static constexpr bool PERM = true;
    template <class Sched> __device__ __forceinline__ void prepare(const Sched& S, LAS unsigned char* l, int tid) const { prep_rstd(l, ssp, S, true, tid); }
    __device__ __forceinline__ void operator()(const AccT& acc, const GUnit& u, int ui, int wr, int wc, int fr, int fq) const {
        const LAS float* R = (const LAS float*)(lds + RSTD_OFF) + ui * 256;
        const int cs = u.row0 >> 10;
        const float* swc = sw + cond_of_row(u.col0) * 2048 + u.row0 + wr * 64 + fr;
#pragma unroll
        for (int bj = 0; bj < 2; ++bj) {
            const int tl = bj * 128 + wc * 32 + 8 * fq, tok = u.col0 + tl;
            const f32x4 rs0 = *(const LAS f32x4*)(R + tl), rs1 = *(const LAS f32x4*)(R + tl + 4);
            int off;
            if (tok < NCTX) off = (tok >> 8) * 512 + cs * 256 + (tok & 255);
            else { const int tt = tok - NCTX; off = 8192 + (tt >> 10) * 2048 + cs * 1024 + (tt & 1023); }
#pragma unroll
            for (int ai = 0; ai < 2; ++ai)
#pragma unroll
                for (int m = 0; m < 4; ++m) {
                    const int nrow = (u.row0 & 1023) + ai * 128 + wr * 64 + m * 16 + fr;
                    const float sh = swc[ai * 128 + m * 16];
                    const f32x4 v0 = acc[ai][bj][m][0] * rs0 + sh, v1 = acc[ai][bj][m][1] * rs1 + sh;
                    u32x4 w; w.x = cvt_pk_bf16(v0[0], v0[1]); w.y = cvt_pk_bf16(v0[2], v0[3]); w.z = cvt_pk_bf16(v1[0], v1[1]); w.w = cvt_pk_bf16(v1[2], v1[3]);
                    *(u32x4*)(ZT + (size_t)nrow * 16384 + off) = w;
                }
        }
    }
};
struct EpiBf16 {
    bf16_t* O; int ldc;
    static constexpr bool PERM = false;
    template <class Sched> __device__ __forceinline__ void prepare(const Sched&, LAS unsigned char*, int) const {}
    __device__ __forceinline__ void operator()(const AccT& acc, const GUnit& u, int ui, int wr, int wc, int fr, int fq) const {
        bf16_t* base = O + (size_t)u.aux;
        const int cbase = u.col0 + wc * 32 + 4 * fq;
#pragma unroll
        for (int ai = 0; ai < 2; ++ai)
#pragma unroll
            for (int m = 0; m < 4; ++m) {
                bf16_t* pr = base + (size_t)(u.row0 + ai * 128 + wr * 64 + m * 16 + fr) * ldc + cbase;
#pragma unroll
                for (int bj = 0; bj < 2; ++bj)
#pragma unroll
                    for (int n = 0; n < 2; ++n) { const f32x4 v = acc[ai][bj][m][n]; u32x2 w; w.x = cvt_pk_bf16(v[0], v[1]); w.y = cvt_pk_bf16(v[2], v[3]); *(u32x2*)(pr + bj * 128 + n * 16) = w; }
            }
    }
};
struct GenSched {
    const char* A; const char* A2; const char* B; int lda, ldb, nM, nN, nwg, G, c, nt, mode;
    __device__ __forceinline__ void init(int mode_, const void* A_, const void* A2_, int lda_, const void* B_, int ldb_, int M, int N, int K, int G_, int c_) {
        mode = mode_; A = (const char*)A_; A2 = (const char*)A2_; B = (const char*)B_; lda = lda_; ldb = ldb_; nM = M / 256; nN = N / 256; nwg = (mode_ == 0 || mode_ == 7 || mode_ == 8) ? nM * nN : mode_ == 1 ? 128 : mode_ == 2 ? 32 : mode_ == 5 ? 512 : 256; G = G_; c = c_; nt = K / 64; }
    __device__ __forceinline__ bool next(int i, GUnit& u) const {
        const int L = i * G + c; if (L >= nwg) return false;
        u.aux = 0;
        if (mode == 0 || mode == 7 || mode == 8) {
            if (mode == 7 && i > 0) return false;
            int half = 0; int wgid = L; if (mode == 8) { if (i > 0) return false; half = L & 1; wgid = 256 + (L >> 1); if (wgid >= nM * nN) return false; } { const int q = nwg / 8, r = nwg % 8, xcd = wgid % 8, off = wgid / 8; wgid = (xcd < r ? xcd * (q + 1) : r * (q + 1) + (xcd - r) * q) + off; }
            const int nig = 8 * nN, gid = wgid / nig, fm = gid * 8, gsz = (nM - fm) < 8 ? (nM - fm) : 8;
            const int pm = fm + ((wgid % nig) % gsz), pn = (wgid % nig) / gsz;
            u.A = A + (size_t)pm * 256 * lda * 2; u.B = B + (size_t)(pn * 256 + half * 128) * ldb * 2; u.nt = nt; u.row0 = pm * 256; u.col0 = pn * 256 + half * 128;
        } else if (mode == 1) {
            if (L < 64) { const int b = L >> 4, pm = (L >> 2) & 3, pn = L & 3;
                u.A = A + (size_t)pm * 256 * 2048 * 2; u.B = B + ((size_t)pn * 256 * 16384 + 8192 + b * 2048) * 2; u.nt = 32; u.row0 = NCTX + b * 1024 + pm * 256; u.col0 = pn * 256; }
            else { const int l = L - 64, b = l >> 2, pn = l & 3;
                u.A = A2; u.B = B + ((size_t)pn * 256 * 16384 + b * 512) * 2; u.nt = 8; u.row0 = b * 256; u.col0 = pn * 256; }
        } else if (mode == 5) {
            int wgid = L; { const int xcd = wgid % 8, off = wgid / 8; wgid = xcd * 64 + off; }
            const int gid = wgid >> 7, r = wgid & 127, pm = gid * 8 + (r & 7), pn = r >> 3;
            u.A = A + (size_t)pm * 256 * lda * 2; u.B = B + (size_t)pn * 256 * ldb * 2; u.nt = nt; u.row0 = pm * 256; u.col0 = pn * 256;
        } else if (mode == 6) {
            const int wgid = (L & 7) * 32 + (L >> 3), pm = wgid >> 3, pn = wgid & 7;
            u.A = A + (size_t)pm * 256 * lda * 2; u.B = B + (size_t)(4096 + pn * 128) * ldb * 2; u.nt = nt; u.row0 = pm * 256; u.col0 = 4096 + pn * 128;
        } else if (mode == 3) {
            const int wgid = (L & 7) * 32 + (L >> 3), pm = wgid >> 3, pn = wgid & 7;
            u.A = A + (size_t)pm * 256 * lda * 2; u.B = B + (size_t)pn * 128 * ldb * 2; u.nt = nt; u.row0 = pm * 256; u.col0 = pn * 128;
        } else if (mode == 4) {
            if (L < 128) { const int b = L >> 5, pm = (L >> 3) & 3, pn = L & 7;
                u.A = A + (size_t)pm * 256 * 2048 * 2; u.B = B + ((size_t)pn * 128 * 16384 + 8192 + b * 2048) * 2; u.nt = 32; u.row0 = NCTX + b * 1024 + pm * 256; u.col0 = pn * 128; }
            else { const int l = L - 128, b = l >> 3, pn = l & 7;
                u.A = A2; u.B = B + ((size_t)pn * 128 * 16384 + b * 512) * 2; u.nt = 8; u.row0 = b * 256; u.col0 = pn * 128; }
        } else {
            const int g = L >> 3, cs = (L >> 2) & 1, pm = L & 3;
            u.A = A + ((size_t)pm * 256 * 1024 + g * 256) * 2; u.B = B + (size_t)cs * 256 * 2; u.nt = nt;
            u.row0 = pm * 256; u.col0 = 0; u.aux = cs * 1024 * 1024 + g * 256;
        }
        return true;
    }
};
struct Args {
    const float* in[23];
    float* out; unsigned char* ws;
    int ph_lo, ph_hi; float lam_init0, lam_init1; int pad0, pad1;
};
typedef const __attribute__((address_space(4))) Args* ArgP;
enum { I_XP = 0, I_XS, I_CK, I_CV, I_ST, I_C, I_CCTX, I_WADA, I_BADA, I_GMIX, I_GFFN, I_WQKV, I_LAM, I_GSUB, I_WOA, I_WINR, I_LBL, I_GOUT, I_WOR, I_WFOUR, I_WFI, I_WFO, I_GFIN };

template <class RowMap>
__device__ __forceinline__ void transpose_item(const float* W, int K, int N, bf16_t* WT, const RowMap& rowmap, LAS float* scr, int item, int lane) {
    const int nblk = N / 32, kb = item / nblk, nb = item % nblk, k0 = 64 * kb, n0 = 32 * nb;
#pragma unroll
    for (int i = 0; i < 8; ++i) { const int kk = 8 * i + (lane >> 3), c4 = (lane & 7) * 4; const f32x4 v = __builtin_nontemporal_load((const f32x4*)(W + (size_t)(k0 + kk) * N + n0 + c4));
        LAS float* d = scr + kk * 33 + c4; d[0] = v[0]; d[1] = v[1]; d[2] = v[2]; d[3] = v[3]; }
    LDS_WAIT(); asm volatile("" ::: "memory");
    const int c = lane & 7;
#pragma unroll
    for (int j = 0; j < 4; ++j) { const int n = (lane >> 3) + 8 * j; const LAS float* s = scr + (8 * c) * 33 + n;
        u32x4 o; o.x = cvt_pk_bf16(s[0 * 33], s[1 * 33]); o.y = cvt_pk_bf16(s[2 * 33], s[3 * 33]); o.z = cvt_pk_bf16(s[4 * 33], s[5 * 33]); o.w = cvt_pk_bf16(s[6 * 33], s[7 * 33]);
        *(u32x4*)(WT + (size_t)rowmap(n0 + n) * K + k0 + 8 * c) = o; }
    LDS_WAIT(); asm volatile("" ::: "memory");
}
struct RowHin { __device__ __forceinline__ int operator()(int s) const { const int sec = s >> 10, ch = s & 1023; if (sec == 2) return 4096 + ch;
    const int t = ch >> 6, cl = ch & 63, bj = sec >= 3 ? 1 : 0, n = (sec == 1 || sec == 4) ? 1 : 0; return 256 * t + 128 * bj + 32 * (cl >> 4) + 16 * n + (cl & 15); } };
struct RowQKV { __device__ __forceinline__ int operator()(int s) const { if (s < 2048) return s; const int p = s & 31; return (s & ~31) + 16 * ((p >> 2) & 1) + 4 * (p >> 3) + (p & 3); } };
struct RowId { __device__ __forceinline__ int operator()(int n) const { return n; } };
struct RowFFN { __device__ __forceinline__ int operator()(int s) const { const int n = s >= DFF ? 1 : 0, a = s - n * DFF; return 256 * (a >> 7) + 128 * n + (a & 127); } };

__device__ __forceinline__ void cache_convert(ArgP a, int j, int gw, int ngw, int lane) {
    bf16_t* KB = (bf16_t*)(a->ws + WS_KB); bf16_t* VB = (bf16_t*)(a->ws + WS_VB);
    for (int it = gw; it < 2 * 4 * 512; it += ngw) {
        const int kv = it >> 11, r = it & 2047, b = r >> 9, s = r & 511;
        const float* src = a->in[kv ? I_CV : I_CK] + ((size_t)(b * 2 + j) * 512 + s) * 1024;
        bf16_t* dst = (kv ? VB : KB) + (size_t)(NCTX + b * 1536 + s) * 1024;
#pragma unroll
        for (int q = 0; q < 2; ++q) { const f32x8 v = *(const f32x8*)(src + q * 512 + lane * 8);
            u32x4 w; w.x = cvt_pk_bf16(v[0], v[1]); w.y = cvt_pk_bf16(v[2], v[3]); w.z = cvt_pk_bf16(v[4], v[5]); w.w = cvt_pk_bf16(v[6], v[7]);
            if (kv) *(u32x4*)(dst + q * 512 + lane * 8) = w;
            else { const int d0 = q * 512 + lane * 8, p0 = d0 & 31, n = p0 >> 4, f0 = (p0 & 15) >> 2;
                bf16_t* g = dst + (d0 & ~31);
                u32x2 lo, hi; lo.x = w.x; lo.y = w.y; hi.x = w.z; hi.y = w.w;
                *(u32x2*)(g + 8 * f0 + 4 * n) = lo; *(u32x2*)(g + 8 * (f0 + 1) + 4 * n) = hi; } }
    }
}

__device__ __forceinline__ void phase_prologue(ArgP a, LAS unsigned char* lds, int G, int bid) {
    const int tid = tid_opaque(), lane = tid & 63, wave = __builtin_amdgcn_readfirstlane(tid >> 6);
    const int gw = bid * NWAVES + wave, ngw = G * NWAVES, gt = bid * NTHREADS + tid, ngt = G * NTHREADS;
    {
        LAS float* SC = (LAS float*)lds;
        LAS float* RED = (LAS float*)(lds + 20480);
        for (int i = tid; i < 5 * 1024; i += NTHREADS) { const int cnd = i >> 10, k = i & 1023; const float x = cnd == 0 ? a->in[I_CCTX][k] : a->in[I_C][(cnd - 1) * 1024 + k]; SC[i] = silu_f(x); }
        __syncthreads();
        float* mod = (float*)(a->ws + WS_MOD);
        for (int it = bid; it < 4 * 48; it += G) {
            const int l = it / 48, cg = it % 48;
            const float* w = a->in[I_WADA] + (size_t)l * 1024 * 6144 + (size_t)(wave * 128) * 6144 + cg * 128 + lane * 2;
            float acc[5][2];
#pragma unroll
            for (int c = 0; c < 5; ++c) { acc[c][0] = 0.f; acc[c][1] = 0.f; }
            for (int k0 = 0; k0 < 128; k0 += 8) {
                f32x2 wv[8];
#pragma unroll
                for (int kk = 0; kk < 8; ++kk) wv[kk] = *(const f32x2*)(w + (size_t)(k0 + kk) * 6144);
#pragma unroll
                for (int kk = 0; kk < 8; ++kk)
#pragma unroll
                    for (int c = 0; c < 5; ++c) { const float s = SC[c * 1024 + wave * 128 + k0 + kk]; acc[c][0] += s * wv[kk].x; acc[c][1] += s * wv[kk].y; }
            }
#pragma unroll
            for (int c = 0; c < 5; ++c) { RED[(wave * 5 + c) * 128 + lane * 2] = acc[c][0]; RED[(wave * 5 + c) * 128 + lane * 2 + 1] = acc[c][1]; }
            __syncthreads();
            for (int i = tid; i < 5 * 128; i += NTHREADS) { const int c = i >> 7, col = i & 127; float s = 0.f;
#pragma unroll
                for (int wv2 = 0; wv2 < 8; ++wv2) s += RED[(wv2 * 5 + c) * 128 + col];
                mod[(size_t)(l * 5 + c) * 6144 + cg * 128 + col] = s + a->in[I_BADA][l * 6144 + cg * 128 + col]; }
            __syncthreads();
        }
    }
    {
        LAS float* scr = (LAS float*)(lds + wave * 16384);
        constexpr int I_Q = 16 * 96, I_O = 16 * 32, I_R = 16 * 160, I_FI = 16 * 176, I_FO = 44 * 32;
        constexpr int NIT = 2 * I_Q + 2 * I_O + I_R + I_O + I_O + 4 * I_FI + 4 * I_FO;
        for (int it = gw; it < NIT; it += ngw) {
            int r = it;
            if (r < 2 * I_Q) { const int j = r / I_Q; transpose_item(a->in[I_WQKV] + (size_t)j * 1024 * 3072, 1024, 3072, (bf16_t*)(a->ws + WS_WQKV) + (size_t)j * 3072 * 1024, RowQKV(), scr, r % I_Q, lane); continue; } r -= 2 * I_Q;
            if (r < 2 * I_O) { const int j = r / I_O; transpose_item(a->in[I_WOA] + (size_t)j * 1024 * 1024, 1024, 1024, (bf16_t*)(a->ws + WS_WOA) + (size_t)j * 1024 * 1024, RowId(), scr, r % I_O, lane); continue; } r -= 2 * I_O;
            if (r < I_R) { transpose_item(a->in[I_WINR], 1024, 5120, (bf16_t*)(a->ws + WS_WINR), RowHin(), scr, r, lane); continue; } r -= I_R;
            if (r < I_O) { transpose_item(a->in[I_WOR], 1024, 1024, (bf16_t*)(a->ws + WS_WOR), RowId(), scr, r, lane); continue; } r -= I_O;
            if (r < I_O) { transpose_item(a->in[I_WFOUR], 1024, 1024, (bf16_t*)(a->ws + WS_WFO), RowId(), scr, r, lane); continue; } r -= I_O;
            if (r < 4 * I_FI) { const int l = r / I_FI; transpose_item(a->in[I_WFI] + (size_t)l * 1024 * 5632, 1024, 5632, (bf16_t*)(a->ws + WS_WFI) + (size_t)l * 5632 * 1024, RowFFN(), scr, r % I_FI, lane); continue; } r -= 4 * I_FI;
            { const int l = r / I_FO; transpose_item(a->in[I_WFO] + (size_t)l * DFF * 1024, DFF, 1024, (bf16_t*)(a->ws + WS_WFOUT) + (size_t)l * 1024 * DFF, RowId(), scr, r % I_FO, lane); }
        }
    }
    {
        float* ropec = (float*)(a->ws + WS_ROPE); float* ropes = ropec + 1024;
        for (int i = gt; i < 1024; i += ngt) { const int pos = i >> 4, q = i & 15;
            float inv = (q & 3) == 0 ? 1.f : (q & 3) == 1 ? 0.56234132519f : (q & 3) == 2 ? 0.31622776602f : 0.17782794100f;
            inv *= (q >> 2) == 0 ? 1.f : (q >> 2) == 1 ? 0.1f : (q >> 2) == 2 ? 0.01f : 0.001f;
            const float ap = (float)pos * inv * 0.31830988618f;
            ropec[i] = cospif(ap); ropes[i] = sinpif(ap); }
        bf16_t* TC = (bf16_t*)(a->ws + WS_TC);
        for (int i = gt; i < 256 * 512; i += ngt) { const int c = i >> 9, k = i & 511, d = k & 255; const float ang = (float)((c * d) & 255) * (1.f / 128.f);
            const float v = (k < 256 ? cospif(ang) : sinpif(ang)) * 0.0625f; TC[c * 1024 + k] = (bf16_t)(cvt_pk_bf16(v, 0.f) & 0xffff); }
        bf16_t* C2 = (bf16_t*)(a->ws + WS_CS256);
        for (int i = gt; i < 256 * 512; i += ngt) { const int p = i >> 9, k = i & 511, t = k & 255; const float ang = (float)((p * t) & 255) * (1.f / 128.f);
            const float v = (k < 256 ? cospif(ang) : -sinpif(ang)) * 0.0625f; C2[p * 2048 + k] = (bf16_t)(cvt_pk_bf16(v, 0.f) & 0xffff); }
        bf16_t* C1 = (bf16_t*)(a->ws + WS_CS1024);
        for (int i = gt; i < 1024 * 2048; i += ngt) { const int p = i >> 11, k = i & 2047, t = k & 1023; const float ang = (float)((p * t) & 1023) * (1.f / 512.f);
            const float v = (k < 1024 ? cospif(ang) : -sinpif(ang)) * 0.03125f; C1[i] = (bf16_t)(cvt_pk_bf16(v, 0.f) & 0xffff); }
        float* lbv = (float*)(a->ws + WS_LBV);
        for (int i = gt; i < 2048; i += ngt) { const int d = i >> 10, k = i & 1023; const float* lg = a->in[I_LBL] + (size_t)d * 4096 + k;
            const float l0 = lg[0], l1 = lg[1024], l2 = lg[2048], l3 = lg[3072]; const float mx = fmaxf(fmaxf(l0, l1), fmaxf(l2, l3));
            const float e0 = __expf(l0 - mx), e1 = __expf(l1 - mx), e2 = __expf(l2 - mx), e3 = __expf(l3 - mx); lbv[i] = e1 / (e0 + e1 + e2 + e3); }
        if (gw < 2) { const int j = gw; const float* lp = a->in[I_LAM] + j * 256;
            float s1 = wave_sum(lp[lane] * lp[64 + lane]), s2 = wave_sum(lp[128 + lane] * lp[192 + lane]);
            if (lane == 0) ((float*)(a->ws + WS_LAM))[j] = __expf(s1) - __expf(s2) + (j == 0 ? a->lam_init0 : a->lam_init1); }
    }
    cache_convert(a, 0, gw, ngw, lane);
}

__device__ __forceinline__ void phase_first_norm(ArgP a, int gw, int ngw, int lane) {
    bf16_t* X = (bf16_t*)(a->ws + WS_X); bf16_t* XA = (bf16_t*)(a->ws + WS_H); float* ssp = (float*)(a->ws + WS_SSP);
    const float* an = (const float*)(a->ws + WS_AN);
    for (int r = gw; r < MTOK; r += ngw) {
        const float* xr = r < NCTX ? a->in[I_XP] + (size_t)r * 1024 : a->in[I_XS] + (size_t)(r - NCTX) * 1024;
        const float* ac = an + cond_of_row(r) * 1024;
        float s = 0.f;
#pragma unroll
        for (int j = 0; j < 4; ++j) {
            const int c = j * 256 + lane * 4;
            const f32x4 v = *(const f32x4*)(xr + c); s += (v.x * v.x + v.y * v.y) + (v.z * v.z + v.w * v.w);
            const f32x4 y = v * *(const f32x4*)(ac + c);
            u32x2 w; w.x = cvt_pk_bf16(y[0], y[1]); w.y = cvt_pk_bf16(y[2], y[3]);
            *(u32x2*)(XA + (size_t)r * 1024 + c) = w; { u32x2 xw; xw.x = cvt_pk_bf16(v[0], v[1]); xw.y = cvt_pk_bf16(v[2], v[3]); *(u32x2*)(X + (size_t)r * 1024 + c) = xw; }
        }
        s = wave_sum(s);
        if (lane < SSPN) ssp[(size_t)r * SSPN + lane] = lane == 0 ? s : 0.f;
    }
}
__device__ __forceinline__ void phase_final(ArgP a, int gw, int ngw, int lane) {
    const bf16_t* X = (const bf16_t*)(a->ws + WS_X); const float* g = a->in[I_GFIN]; const float* ssp = (const float*)(a->ws + WS_SSP) + 8ull * 8192 * SSPN;
    for (int r = gw; r < MTOK; r += ngw) {
        const bf16_t* xr = X + (size_t)r * 1024;
        float s = lane < SSPN ? ssp[(size_t)r * SSPN + lane] : 0.f;
        const float rstd = rsqrtf(wave_sum(s) * (1.f / 1024.f) + EPS);
#pragma unroll
        for (int j = 0; j < 4; ++j) { const int c = j * 256 + lane * 4; const u32x2 xw = *(const u32x2*)(xr + c); const f32x4 xv = {bflo(xw.x), bfhi(xw.x), bflo(xw.y), bfhi(xw.y)};
            *(f32x4*)(a->out + (size_t)r * 1024 + c) = xv * rstd * *(const f32x4*)(g + c); }
    }
}
__device__ __forceinline__ void phase_an(ArgP a, int gt, int ngt) {
    float* an = (float*)(a->ws + WS_AN); const float* mod = (const float*)(a->ws + WS_MOD);
    for (int i = gt; i < 8 * 5 * 1024; i += ngt) { const int nidx = i / 5120, c = (i / 1024) % 5, k = i & 1023, l = nidx >> 1, wh = nidx & 1;
        an[i] = a->in[wh ? I_GFFN : I_GMIX][l * 1024 + k] * (1.f + mod[(size_t)(l * 5 + c) * 6144 + (wh ? 4 : 1) * 1024 + k]); }
}
__device__ __forceinline__ void phase_sw(ArgP a, LAS unsigned char* lds, unsigned mask, int gw, int ngw, int tid, int lane) {
    LAS float* SH = (LAS float*)lds;
    const float* mod = (const float*)(a->ws + WS_MOD); float* swb = (float*)(a->ws + WS_SW);
    for (int nidx = 0; nidx < 8; ++nidx) {
        if (!((mask >> nidx) & 1)) continue;
        const int l = nidx >> 1, wh = nidx & 1, N = sw_n(nidx);
        const bf16_t* W = nidx == 0 ? (const bf16_t*)(a->ws + WS_WQKV) : nidx == 6 ? (const bf16_t*)(a->ws + WS_WQKV) + 3072ull * 1024 : nidx == 2 ? (const bf16_t*)(a->ws + WS_WINR)
                        : nidx == 4 ? (const bf16_t*)(a->ws + WS_WCS) : (const bf16_t*)(a->ws + WS_WFI) + (size_t)l * 5632 * 1024;
        __syncthreads();
        for (int i = tid; i < 5 * 1024; i += NTHREADS) SH[i] = mod[(size_t)(l * 5 + (i >> 10)) * 6144 + (wh ? 3 : 0) * 1024 + (i & 1023)];
        __syncthreads();
        float* sw = swb + sw_off(nidx);
        for (int n = gw; n < N; n += ngw) {
            const u32x4 w0 = *(const u32x4*)(W + (size_t)n * 1024 + lane * 8), w1 = *(const u32x4*)(W + (size_t)n * 1024 + 512 + lane * 8);
            float wf[16];
#pragma unroll
            for (int i = 0; i < 4; ++i) { wf[2 * i] = bflo(w0[i]); wf[2 * i + 1] = bfhi(w0[i]); wf[8 + 2 * i] = bflo(w1[i]); wf[8 + 2 * i + 1] = bfhi(w1[i]); }
            float acc[5];
#pragma unroll
            for (int c = 0; c < 5; ++c) {
                const f32x4 s0 = *(const LAS f32x4*)(SH + c * 1024 + lane * 8), s1 = *(const LAS f32x4*)(SH + c * 1024 + lane * 8 + 4);
                const f32x4 s2 = *(const LAS f32x4*)(SH + c * 1024 + 512 + lane * 8), s3 = *(const LAS f32x4*)(SH + c * 1024 + 512 + lane * 8 + 4);
                float t = 0.f;
#pragma unroll
                for (int i = 0; i < 4; ++i) t += wf[i] * s0[i] + wf[4 + i] * s1[i] + wf[8 + i] * s2[i] + wf[12 + i] * s3[i];
                acc[c] = wave_sum(t);
            }
            if (lane < 5) sw[(size_t)lane * N + n] = lane == 0 ? acc[0] : lane == 1 ? acc[1] : lane == 2 ? acc[2] : lane == 3 ? acc[3] : acc[4];
        }
    }
    __syncthreads();
}
__device__ __forceinline__ void phase_hgrn_final(ArgP a, int gw, int ngw, int lane) {
    const bf16_t* OF = (const bf16_t*)(a->ws + WS_OF); const bf16_t* OB = (const bf16_t*)(a->ws + WS_OB); const bf16_t* GH = (const bf16_t*)(a->ws + WS_GH);
    bf16_t* O = (bf16_t*)(a->ws + WS_O); const float* go = a->in[I_GOUT];
    for (int r = gw; r < MTOK; r += ngw) {
        const size_t off = (size_t)r * 1024 + lane * 16;
        u32x4 f0 = *(const u32x4*)(OF + off), f1 = *(const u32x4*)(OF + off + 8), b0 = *(const u32x4*)(OB + off), b1 = *(const u32x4*)(OB + off + 8);
        u32x4 g0 = *(const u32x4*)(GH + off), g1 = *(const u32x4*)(GH + off + 8);
        float o[16], gt[16];
#pragma unroll
        for (int i = 0; i < 4; ++i) { o[2 * i] = bflo(f0[i]) + bflo(b0[i]); o[2 * i + 1] = bfhi(f0[i]) + bfhi(b0[i]); o[8 + 2 * i] = bflo(f1[i]) + bflo(b1[i]); o[8 + 2 * i + 1] = bfhi(f1[i]) + bfhi(b1[i]);
            gt[2 * i] = bflo(g0[i]); gt[2 * i + 1] = bfhi(g0[i]); gt[8 + 2 * i] = bflo(g1[i]); gt[8 + 2 * i + 1] = bfhi(g1[i]); }
        float s = 0.f;
#pragma unroll
        for (int i = 0; i < 16; ++i) s += o[i] * o[i];
        s += __shfl_xor(s, 1); s += __shfl_xor(s, 2); s += __shfl_xor(s, 4);
        const float rstd = rsqrtf(s * (1.f / 128.f) + EPS);
        const int vc = (lane & 7) * 16;
        u32x4 w0, w1;
#pragma unroll
        for (int i = 0; i < 4; ++i) {
            w0[i] = cvt_pk_bf16(o[2 * i] * rstd * go[vc + 2 * i] * gt[2 * i], o[2 * i + 1] * rstd * go[vc + 2 * i + 1] * gt[2 * i + 1]);
            w1[i] = cvt_pk_bf16(o[8 + 2 * i] * rstd * go[vc + 8 + 2 * i] * gt[8 + 2 * i], o[8 + 2 * i + 1] * rstd * go[vc + 8 + 2 * i + 1] * gt[8 + 2 * i + 1]); }
        *(u32x4*)(O + off) = w0; *(u32x4*)(O + off + 8) = w1;
    }
}

namespace att {
constexpr int KVBLK = 64, LDQ = 1024;
constexpr float SCALE = 0.125f, THR = 8.f;
constexpr size_t SHM_V = KVBLK * 128 * 2, SHM_K = KVBLK * 128 * 2;
#define KSWZ(row, colB) ((row) * 256 + ((colB) ^ (((row) & 7) << 4)))
#define SBAR() __builtin_amdgcn_sched_barrier(0)
__device__ __forceinline__ int crow(int r, int hi) { return (r & 3) + 8 * (r >> 2) + 4 * hi; }
__device__ __forceinline__ unsigned cvtpk(float lo, float hi) { unsigned r; asm volatile("v_cvt_pk_bf16_f32 %0, %1, %2" : "=v"(r) : "v"(lo), "v"(hi)); return r; }
__device__ __forceinline__ void partialSM(f32x16& p0, f32x16& p1, float& m_reg, float& mn, float& alpha) {
  constexpr float C = SCALE * 1.4426950408889634f;
  float pmax = p0[0];
#pragma unroll
  for (int r = 1; r < 16; ++r) pmax = fmaxf(pmax, p0[r]);
#pragma unroll
  for (int r = 0; r < 16; ++r) pmax = fmaxf(pmax, p1[r]);
  { auto rr = __builtin_amdgcn_permlane32_swap(__float_as_uint(pmax), __float_as_uint(pmax), false, false);
    pmax = fmaxf(__uint_as_float(rr[0]), __uint_as_float(rr[1])); }
  if (__builtin_expect(__all(pmax - m_reg <= THR / SCALE), 1)) { mn = m_reg; alpha = 1.f; }
  else { mn = fmaxf(m_reg, pmax); alpha = __builtin_amdgcn_exp2f((m_reg - mn) * C); m_reg = mn; }
  float mnC = -mn * C;
#pragma unroll
  for (int r = 0; r < 16; ++r) p0[r] = fmaf(p0[r], C, mnC);
#pragma unroll
  for (int r = 0; r < 16; ++r) p1[r] = fmaf(p1[r], C, mnC);
#pragma unroll
  for (int r = 0; r < 16; ++r) p0[r] = __builtin_amdgcn_exp2f(p0[r]);
}
__device__ __forceinline__ void finishSM(f32x16& p0, f32x16& p1, float alpha, float& l_reg, bf16x8& pa0, bf16x8& pa1, bf16x8& pa2, bf16x8& pa3) {
#pragma unroll
  for (int r = 0; r < 16; ++r) p1[r] = __builtin_amdgcn_exp2f(p1[r]);
  float ps = 0;
#pragma unroll
  for (int r = 0; r < 16; ++r) ps += p0[r];
#pragma unroll
  for (int r = 0; r < 16; ++r) ps += p1[r];
  { auto rr = __builtin_amdgcn_permlane32_swap(__float_as_uint(ps), __float_as_uint(ps), false, false);
    ps = __uint_as_float(rr[0]) + __uint_as_float(rr[1]); }
  l_reg = l_reg * alpha + ps;
#define PK4(P, BASE, OUT) do { unsigned a0 = cvtpk(P[BASE + 0], P[BASE + 1]), a1 = cvtpk(P[BASE + 2], P[BASE + 3]);   \
    unsigned b0 = cvtpk(P[BASE + 4], P[BASE + 5]), b1 = cvtpk(P[BASE + 6], P[BASE + 7]);                              \
    auto r0 = __builtin_amdgcn_permlane32_swap(a0, b0, false, false); auto r1 = __builtin_amdgcn_permlane32_swap(a1, b1, false, false); \
    u32x4 w = {r0[0], r1[0], r0[1], r1[1]}; OUT = *reinterpret_cast<bf16x8*>(&w); } while (0)
  PK4(p0, 0, pa0); PK4(p0, 8, pa1); PK4(p1, 0, pa2); PK4(p1, 8, pa3);
#undef PK4
}
__device__ __forceinline__ void qkt(f32x16& p0, f32x16& p1, const bf16_t* Ks, const bf16x8* qr, int r32, int hi, int cc) {
  p0 = f32x16{}; p1 = f32x16{};
#pragma unroll
  for (int d0 = 0; d0 < 4; ++d0) { int cb = (cc * 64 + d0 * 16 + hi * 8) * 2;
    bf16x8 b0 = *reinterpret_cast<const bf16x8*>((const char*)Ks + KSWZ(r32, cb));
    bf16x8 b1 = *reinterpret_cast<const bf16x8*>((const char*)Ks + KSWZ(32 + r32, cb));
    p0 = __builtin_amdgcn_mfma_f32_32x32x16_bf16(b0, qr[d0], p0, 0, 0, 0);
    p1 = __builtin_amdgcn_mfma_f32_32x32x16_bf16(b1, qr[d0], p1, 0, 0, 0); }
}
__device__ __forceinline__ int v_st(int k, int c) { const int kk = (k & ~0xC) | ((k & 4) << 1) | ((k & 8) >> 1); return ((kk >> 3) * 4 + (c >> 5)) * 512 + ((kk & 7) * 32 + (c & 31)) * 2; }
__device__ __forceinline__ int v_rd_base(int lane) { return ((lane & 3) << 3) | (((lane >> 2) & 3) << 6) | (((lane >> 4) & 1) << 5) | (((lane >> 5) & 1) << 8); }
constexpr int v_rd_off(int d0, int ks, int half) { return d0 * 512 + ks * 4096 + half * 2048; }
template <int OFF> __device__ __forceinline__ s16x4 tr_read(int vb) {
  s16x4 r; asm volatile("ds_read_b64_tr_b16 %0, %1 offset:%2" : "=&v"(r) : "v"(vb), "i"(OFF) : "memory"); return r;
}
template <int D0> __device__ __forceinline__ void pv_one(f32x16& od, int vb, bf16x8 pa0, bf16x8 pa1, bf16x8 pa2, bf16x8 pa3) {
  const s16x4 l0 = tr_read<v_rd_off(D0, 0, 0)>(vb), h0 = tr_read<v_rd_off(D0, 0, 1)>(vb), l1 = tr_read<v_rd_off(D0, 1, 0)>(vb), h1 = tr_read<v_rd_off(D0, 1, 1)>(vb);
  const s16x4 l2 = tr_read<v_rd_off(D0, 2, 0)>(vb), h2 = tr_read<v_rd_off(D0, 2, 1)>(vb), l3 = tr_read<v_rd_off(D0, 3, 0)>(vb), h3 = tr_read<v_rd_off(D0, 3, 1)>(vb);
  asm volatile("s_waitcnt lgkmcnt(0)" ::: "memory"); SBAR();
#define PK(L, H) (bf16x8){L[0], L[1], L[2], L[3], H[0], H[1], H[2], H[3]}
  od = __builtin_amdgcn_mfma_f32_32x32x16_bf16(pa0, PK(l0, h0), od, 0, 0, 0);
  od = __builtin_amdgcn_mfma_f32_32x32x16_bf16(pa1, PK(l1, h1), od, 0, 0, 0);
  od = __builtin_amdgcn_mfma_f32_32x32x16_bf16(pa2, PK(l2, h2), od, 0, 0, 0);
  od = __builtin_amdgcn_mfma_f32_32x32x16_bf16(pa3, PK(l3, h3), od, 0, 0, 0);
#undef PK
}
__device__ __forceinline__ void pv_d0(f32x16* o, int vb, bf16x8 pa0, bf16x8 pa1, bf16x8 pa2, bf16x8 pa3) {
  pv_one<0>(o[0], vb, pa0, pa1, pa2, pa3); pv_one<1>(o[1], vb, pa0, pa1, pa2, pa3); pv_one<2>(o[2], vb, pa0, pa1, pa2, pa3); pv_one<3>(o[3], vb, pa0, pa1, pa2, pa3);
}
__device__ __forceinline__ void diff_attn_unit(const bf16_t* __restrict__ Qb, const bf16_t* __restrict__ Kh, const bf16_t* __restrict__ Vh, bf16_t* __restrict__ Ob,
                                               int seq, char* lds, float lam, const float* __restrict__ gsub, float oscale) {
  const int tid = tid_opaque(), wid = tid >> 6, lane = tid & 63, r32 = lane & 31, hi = lane >> 5;
  const int qblk = wid >> 1, cc = wid & 1;
  bf16_t* V_lds = (bf16_t*)lds; bf16_t* K_lds = (bf16_t*)(lds + 2 * SHM_V);
  float* ws = (float*)(lds + 2 * SHM_V + 2 * SHM_K) + wid * 64; float* li_l = ws; float* al_l = ws + 32;
  float m_reg = -1e30f, l_reg = 0; f32x16 o[4] = {}; bf16x8 qr[4];
  const bf16_t* Qw = Qb + (long)(qblk * 32 + r32) * LDQ + cc * 64 + hi * 8;
#pragma unroll
  for (int d0 = 0; d0 < 4; ++d0) qr[d0] = *reinterpret_cast<const bf16x8*>(Qw + d0 * 16);
  const int sr = tid >> 4, sc = (tid & 15) * 8, vst0 = v_st(sr, sc), vst1 = v_st(32 + sr, sc);
  const int vb0 = (int)(uintptr_t)V_lds + v_rd_base(lane);
  struct { bf16x8 vs0, vs1, ks0, ks1; } sr_[2];
#define SLOAD(i, k0) do { sr_[i].vs0 = *reinterpret_cast<const bf16x8*>(&Vh[(long)((k0) + sr) * LDQ + sc]); sr_[i].vs1 = *reinterpret_cast<const bf16x8*>(&Vh[(long)((k0) + 32 + sr) * LDQ + sc]); \
    sr_[i].ks0 = *reinterpret_cast<const bf16x8*>(&Kh[(long)((k0) + sr) * LDQ + sc]); sr_[i].ks1 = *reinterpret_cast<const bf16x8*>(&Kh[(long)((k0) + 32 + sr) * LDQ + sc]); } while (0)
#define SWRITE(b, i) do { *(bf16x8*)((char*)V_lds + (b) * SHM_V + vst0) = sr_[i].vs0;          \
    *(bf16x8*)((char*)V_lds + (b) * SHM_V + vst1) = sr_[i].vs1; int kc = sc * 2;               \
    *(bf16x8*)((char*)K_lds + (b) * SHM_K + KSWZ(sr, kc)) = sr_[i].ks0;                       \
    *(bf16x8*)((char*)K_lds + (b) * SHM_K + KSWZ(32 + sr, kc)) = sr_[i].ks1; } while (0)
#define SWAIT() asm volatile("s_waitcnt vmcnt(4)" ::: "memory")
#define RESC(a) do { if (__any((a) < 1.f)) { if (hi == 0) al_l[r32] = (a); asm volatile("s_waitcnt lgkmcnt(0)" ::: "memory"); \
    _Pragma("unroll") for (int d = 0; d < 4; ++d) _Pragma("unroll") for (int r = 0; r < 16; ++r) o[d][r] *= al_l[crow(r, hi)]; } } while (0)
  f32x16 pA0, pA1, pB0, pB1; float mnA, mnB, alA, alB; bf16x8 pa0, pa1, pa2, pa3; const int NT = seq / KVBLK;
  constexpr int SE = 0, SO = 1;
  SLOAD(SE, 0); asm volatile("s_waitcnt vmcnt(0)" ::: "memory"); SWRITE(0, SE); __syncthreads();
  qkt(pA0, pA1, K_lds, qr, r32, hi, cc); partialSM(pA0, pA1, m_reg, mnA, alA);
  SLOAD(SO, KVBLK); if (2 < NT) SLOAD(SE, 2 * KVBLK);
  SWAIT(); SWRITE(1, SO); __syncthreads();
  for (int j = 1; j + 1 < NT; j += 2) {
    SBAR(); qkt(pB0, pB1, (bf16_t*)((char*)K_lds + SHM_K), qr, r32, hi, cc);
    finishSM(pA0, pA1, alA, l_reg, pa0, pa1, pa2, pa3); SBAR();
    SLOAD(SO, (j + 2) * KVBLK); SBAR();
    pv_d0(o, vb0, pa0, pa1, pa2, pa3); partialSM(pB0, pB1, m_reg, mnB, alB);
    __syncthreads(); SWAIT(); SWRITE(0, SE);
    RESC(alB); __syncthreads();
    SBAR(); qkt(pA0, pA1, K_lds, qr, r32, hi, cc);
    finishSM(pB0, pB1, alB, l_reg, pa0, pa1, pa2, pa3); SBAR();
    if (j + 3 < NT) SLOAD(SE, (j + 3) * KVBLK); SBAR();
    pv_d0(o, vb0 + (int)SHM_V, pa0, pa1, pa2, pa3); partialSM(pA0, pA1, m_reg, mnA, alA);
    __syncthreads(); SWAIT(); SWRITE(1, SO);
    RESC(alA); __syncthreads();
  }
  SBAR(); qkt(pB0, pB1, (bf16_t*)((char*)K_lds + SHM_K), qr, r32, hi, cc);
  finishSM(pA0, pA1, alA, l_reg, pa0, pa1, pa2, pa3); SBAR();
  pv_d0(o, vb0, pa0, pa1, pa2, pa3); partialSM(pB0, pB1, m_reg, mnB, alB);
  __syncthreads(); RESC(alB);
  finishSM(pB0, pB1, alB, l_reg, pa0, pa1, pa2, pa3); SBAR();
  pv_d0(o, vb0 + (int)SHM_V, pa0, pa1, pa2, pa3);
  if (hi == 0) li_l[r32] = l_reg; asm volatile("s_waitcnt lgkmcnt(0)" ::: "memory");
  float rli[16];
#pragma unroll
  for (int r = 0; r < 16; ++r) rli[r] = __builtin_amdgcn_rcpf(li_l[crow(r, hi)]);
  __syncthreads();
  float* xch = (float*)lds + qblk * (32 * 128);
  if (cc == 1) {
#pragma unroll
    for (int r = 0; r < 16; ++r)
#pragma unroll
      for (int d0 = 0; d0 < 4; ++d0) xch[crow(r, hi) * 128 + d0 * 32 + r32] = lam * o[d0][r] * rli[r];
  }
  __syncthreads();
  if (cc == 0) {
    float gs[4];
#pragma unroll
    for (int d0 = 0; d0 < 4; ++d0) gs[d0] = gsub[d0 * 32 + r32] * oscale;
#pragma unroll
    for (int r = 0; r < 16; ++r) {
      float ss = 0.f;
#pragma unroll
      for (int d0 = 0; d0 < 4; ++d0) { const float v = o[d0][r] * rli[r] - xch[crow(r, hi) * 128 + d0 * 32 + r32]; o[d0][r] = v; ss += v * v; }
      ss += __shfl_xor(ss, 1); ss += __shfl_xor(ss, 2); ss += __shfl_xor(ss, 4); ss += __shfl_xor(ss, 8); ss += __shfl_xor(ss, 16);
      const float rs = rsqrtf(ss * (1.f / 128.f) + EPS);
      bf16_t* orow = Ob + (long)(qblk * 32 + crow(r, hi)) * LDQ;
#pragma unroll
      for (int d0 = 0; d0 < 4; ++d0) orow[d0 * 32 + r32] = (bf16_t)(cvtpk(o[d0][r] * rs * gs[d0], 0.f) & 0xffff);
    }
  }
  __syncthreads();
#undef SLOAD
#undef SWRITE
#undef SWAIT
#undef RESC
}
#undef KSWZ
#undef SBAR
constexpr int LDS_NEED = 2 * SHM_V + 2 * SHM_K + 8 * 64 * 4;
}

__device__ __forceinline__ void phase_attn(ArgP a, int j, char* lds, int G, int bid) {
    const bf16_t* Q = (const bf16_t*)(a->ws + WS_Q); const bf16_t* KB = (const bf16_t*)(a->ws + WS_KB); const bf16_t* VB = (const bf16_t*)(a->ws + WS_VB);
    bf16_t* O = (bf16_t*)(a->ws + WS_O);
    const float lam = ((const float*)(a->ws + WS_LAM))[j];
    const float oscale = 1.f - (j == 0 ? a->lam_init0 : a->lam_init1);
    const float* gsub = a->in[I_GSUB] + j * 128;
    for (int u = bid; u < 512; u += G) {
        int qrow, krow, seq, h;
        if (u < 256) { const int b = u >> 6; h = (u >> 3) & 7; const int qb = u & 7; qrow = NCTX + b * 1024 + qb * 128; krow = NCTX + b * 1536; seq = 1536; }
        else { const int v = u - 256, b = v >> 4; h = (v >> 1) & 7; const int qb = v & 1; qrow = b * 256 + qb * 128; krow = b * 256; seq = 256; }
        att::diff_attn_unit(Q + (size_t)qrow * 1024 + h * 128, KB + (size_t)krow * 1024 + h * 128, VB + (size_t)krow * 1024 + h * 128, O + (size_t)qrow * 1024 + h * 128,
                            seq, lds, lam, gsub, oscale);
    }
}

namespace hg {
constexpr int QT_OFF = 0, KT_OFF = 64 * 272, KHT_OFF = 2 * 64 * 272, VT_OFF = KHT_OFF + 128 * 144, DD_OFF = VT_OFF + 128 * 144, LDS_NEED = DD_OFF + 4 * 128 * 4;
__device__ __forceinline__ s16x4 pk4(f32x4 v) { u32x2 w; w.x = cvt_pk_bf16(v[0], v[1]); w.y = cvt_pk_bf16(v[2], v[3]); return __builtin_bit_cast(s16x4, w); }
struct Stage { u32x4 qk[4], kh[2], v[2], d; };
__device__ __forceinline__ void scan_unit(int tok0, int n, int h, int dir, int vbase, int nwv, const bf16_t* __restrict__ QK, const bf16_t* __restrict__ KHT, const bf16_t* __restrict__ VT,
                                          const float* __restrict__ DD, const float* __restrict__ s0, float* __restrict__ sout, bf16_t* __restrict__ Od, LAS unsigned char* lds) {
    const int tid = tid_opaque(), lane = tid & 63, wv = __builtin_amdgcn_readfirstlane(tid >> 6), l15 = lane & 15, g = lane >> 4;
    const bool act = wv < nwv;
    const int vc = vbase + 16 * wv + l15;
    f32x4 S[8];
#pragma unroll
    for (int i = 0; i < 8; ++i) {
        if (s0 && act) {
#pragma unroll
            for (int r = 0; r < 4; ++r) S[i][r] = s0[(size_t)(16 * i + 4 * g + r) * 128 + vc]; }
        else S[i] = (f32x4){0.f, 0.f, 0.f, 0.f};
    }
    const int nms = n >> 6;
    Stage st;
#define HG_LOAD(msn) do { const int tb_ = tok0 + (msn) * 64; \
        _Pragma("unroll") for (int i_ = 0; i_ < 4; ++i_) { const int p_ = tid + 512 * i_; \
            st.qk[i_] = *(const u32x4*)(QK + ((size_t)((tb_ + (p_ >> 5)) * 8 + h) * 32 + (p_ & 31)) * 16 + dir * 8); } \
        _Pragma("unroll") for (int i_ = 0; i_ < 2; ++i_) { const int p_ = tid + 512 * i_; \
            const size_t to_ = ((size_t)(((tb_ >> 4) + (p_ >> 8)) * 8 + h) * 128 + ((p_ & 255) >> 1)) * 16 + (p_ & 1) * 8; st.kh[i_] = *(const u32x4*)(KHT + to_); st.v[i_] = *(const u32x4*)(VT + to_); } \
        if (tid < 128) st.d = *(const u32x4*)(DD + (size_t)(((tb_ >> 4) + (tid >> 5)) * 8 + h) * 128 + (tid & 31) * 4); } while (0)
#define HG_STORE() do { \
        _Pragma("unroll") for (int i_ = 0; i_ < 4; ++i_) { const int p_ = tid + 512 * i_; u32x2 lo_, hi_; lo_.x = st.qk[i_].x; lo_.y = st.qk[i_].y; hi_.x = st.qk[i_].z; hi_.y = st.qk[i_].w; \
            *(LAS u32x2*)(lds + QT_OFF + (p_ >> 5) * 272 + (p_ & 31) * 8) = lo_; *(LAS u32x2*)(lds + KT_OFF + (p_ >> 5) * 272 + (p_ & 31) * 8) = hi_; } \
        _Pragma("unroll") for (int i_ = 0; i_ < 2; ++i_) { const int p_ = tid + 512 * i_; \
            const int lo2_ = ((p_ & 255) >> 1) * 144 + ((p_ >> 8) * 16 + (p_ & 1) * 8) * 2; *(LAS u32x4*)(lds + KHT_OFF + lo2_) = st.kh[i_]; *(LAS u32x4*)(lds + VT_OFF + lo2_) = st.v[i_]; } \
        if (tid < 128) *(LAS u32x4*)(lds + DD_OFF + ((tid >> 5) * 128 + (tid & 31) * 4) * 4) = st.d; } while (0)
    HG_LOAD(dir ? nms - 1 : 0);
    HG_STORE();
    __syncthreads();
    for (int ms = 0; ms < nms; ++ms) {
        const int msn = dir ? nms - 1 - ms : ms;
        if (ms + 1 < nms) HG_LOAD(dir ? msn - 1 : msn + 1);
        __builtin_amdgcn_sched_barrier(0);
        if (act) {
        s16x4 xb[4];
#pragma unroll
        for (int cp = 0; cp < 4; cp += 2) {
            bf16x8 ka[2][4], qb[2][4];
#pragma unroll
            for (int q = 0; q < 2; ++q)
#pragma unroll
                for (int kk = 0; kk < 4; ++kk) {
                    ka[q][kk] = *(const LAS bf16x8*)(lds + KT_OFF + ((cp + q) * 16 + l15) * 272 + kk * 64 + g * 16);
                    qb[q][kk] = *(const LAS bf16x8*)(lds + QT_OFF + ((cp + q) * 16 + l15) * 272 + kk * 64 + g * 16); }
            __builtin_amdgcn_sched_barrier(0);
            f32x4 X0 = {0.f, 0.f, 0.f, 0.f}, X1 = {0.f, 0.f, 0.f, 0.f};
#pragma unroll
            for (int kk = 0; kk < 4; ++kk) { X0 = __builtin_amdgcn_mfma_f32_16x16x32_bf16(ka[0][kk], qb[0][kk], X0, 0, 0, 0); X1 = __builtin_amdgcn_mfma_f32_16x16x32_bf16(ka[1][kk], qb[1][kk], X1, 0, 0, 0); }
#pragma unroll
            for (int r = 0; r < 4; ++r) if (dir ? (4 * g + r < l15) : (4 * g + r > l15)) { X0[r] = 0.f; X1[r] = 0.f; }
            xb[cp] = pk4(X0); xb[cp + 1] = pk4(X1);
            __builtin_amdgcn_sched_barrier(0);
        }
        f32x4 dvA[8], dvB[8]; s16x4 kaA[8], kaB[8], vbA, vbB;
#define HG_OPS(c_, DV, KA, VB) do { VB = *(const LAS s16x4*)(lds + VT_OFF + vc * 144 + ((c_) * 16 + 4 * g) * 2); \
            _Pragma("unroll") for (int i_ = 0; i_ < 8; ++i_) { DV[i_] = *(const LAS f32x4*)(lds + DD_OFF + ((c_) * 128 + 16 * i_ + 4 * g) * 4); \
                KA[i_] = *(const LAS s16x4*)(lds + KHT_OFF + (16 * i_ + l15) * 144 + ((c_) * 16 + 4 * g) * 2); } } while (0)
#define HG_CHUNK(c_, XB, DV, KA, VB) do { \
            f32x4 o0_ = {0.f, 0.f, 0.f, 0.f}, o1_ = {0.f, 0.f, 0.f, 0.f}; s16x4 sb_[8], qa_[8]; \
            _Pragma("unroll") for (int i_ = 0; i_ < 8; ++i_) { sb_[i_] = pk4(S[i_]); qa_[i_] = *(const LAS s16x4*)(lds + QT_OFF + ((c_) * 16 + l15) * 272 + (16 * i_ + 4 * g) * 2); } \
            _Pragma("unroll") for (int i_ = 0; i_ < 8; ++i_) S[i_] = __builtin_amdgcn_mfma_f32_16x16x16bf16_1k(KA[i_], VB, S[i_] * DV[i_], 0, 0, 0); \
            _Pragma("unroll") for (int i_ = 0; i_ < 8; i_ += 2) { o0_ = __builtin_amdgcn_mfma_f32_16x16x16bf16_1k(qa_[i_], sb_[i_], o0_, 0, 0, 0); o1_ = __builtin_amdgcn_mfma_f32_16x16x16bf16_1k(qa_[i_ + 1], sb_[i_ + 1], o1_, 0, 0, 0); } \
            o0_ = __builtin_amdgcn_mfma_f32_16x16x16bf16_1k(XB, VB, o0_, 0, 0, 0); \
            const f32x4 o_ = o0_ + o1_; \
            _Pragma("unroll") for (int r_ = 0; r_ < 4; ++r_) Od[(size_t)(tok0 + msn * 64 + (c_) * 16 + 4 * g + r_) * 1024 + h * 128 + vc] = (bf16_t)(cvt_pk_bf16(o_[r_], 0.f) & 0xffff); } while (0)
        const int c0 = dir ? 3 : 0, cs = dir ? -1 : 1;
        HG_OPS(c0, dvA, kaA, vbA); __builtin_amdgcn_sched_barrier(0);
        HG_OPS(c0 + cs, dvB, kaB, vbB); __builtin_amdgcn_sched_barrier(0);
        { const s16x4 x0 = dir ? xb[3] : xb[0]; HG_CHUNK(c0, x0, dvA, kaA, vbA); } __builtin_amdgcn_sched_barrier(0);
        HG_OPS(c0 + 2 * cs, dvA, kaA, vbA); __builtin_amdgcn_sched_barrier(0);
        { const s16x4 x1 = dir ? xb[2] : xb[1]; HG_CHUNK(c0 + cs, x1, dvB, kaB, vbB); } __builtin_amdgcn_sched_barrier(0);
        HG_OPS(c0 + 3 * cs, dvB, kaB, vbB); __builtin_amdgcn_sched_barrier(0);
        { const s16x4 x2 = dir ? xb[1] : xb[2]; HG_CHUNK(c0 + 2 * cs, x2, dvA, kaA, vbA); } __builtin_amdgcn_sched_barrier(0);
        { const s16x4 x3 = dir ? xb[0] : xb[3]; HG_CHUNK(c0 + 3 * cs, x3, dvB, kaB, vbB); }
#undef HG_OPS
#undef HG_CHUNK
        }
        __syncthreads();
        if (ms + 1 < nms) { HG_STORE(); }
        __syncthreads();
    }
#undef HG_LOAD
#undef HG_STORE
    if (sout && act) {
#pragma unroll
        for (int i = 0; i < 8; ++i)
#pragma unroll
            for (int r = 0; r < 4; ++r) sout[(size_t)(16 * i + 4 * g + r) * 128 + vc] = S[i][r];
    }
}
}

__device__ __forceinline__ void phase_scan(ArgP a, LAS unsigned char* lds, int G, int bid) {
    for (int i = 0;; ++i) {
        const int u = i * G + ((i & 1) ? (G - 1 - bid) : bid);
        if (u >= 384) break;
        int tok0, n, h, dir, vbase = 0, nwv = 8; const float* s0 = nullptr; float* sout = nullptr;
        if (u < 128) { const int b = u >> 5; h = (u >> 2) & 7; dir = (u >> 1) & 1; vbase = (u & 1) * 64; nwv = 4; tok0 = NCTX + b * 1024; n = 1024; s0 = a->in[I_ST] + ((size_t)(b * 2 + dir) * 8 + h) * 16384; }
        else { const int v = u - 128, b = v >> 4; h = (v >> 1) & 7; dir = v & 1; tok0 = b * 256; n = 256; sout = a->out + OUT_NS + ((size_t)(b * 2 + dir) * 8 + h) * 16384; }
        hg::scan_unit(tok0, n, h, dir, vbase, nwv, (const bf16_t*)(a->ws + WS_QTF), (const bf16_t*)(a->ws + (dir ? WS_KHTB : WS_KHTF)),
                      (const bf16_t*)(a->ws + WS_VT), (const float*)(a->ws + (dir ? WS_DDB : WS_DDF)), s0, sout, (bf16_t*)(a->ws + (dir ? WS_OB : WS_OF)), lds);
    }
}

#ifndef PHMASK
#define PHMASK 0xFFFF
#endif
#ifndef REPMASK
#define REPMASK 0
#endif
#ifndef XBAR
#define XBAR 0
#endif
enum PhType { T_PRO = 0, T_NORM, T_QKV, T_ATTN, T_RES, T_FFN, T_HIN, T_SCAN, T_HFIN, T_F1, T_FINAL, T_FOLD };
struct PhDesc { int type, layer, sub; };
constexpr int NPH = 24;
__device__ __forceinline__ PhDesc phase_desc(int p) {
    switch (p) {
        case 0: return {T_PRO, 0, 0};
        case 1: return {T_FOLD, 0, 0};
        case 2: return {T_NORM, 0, 0};
        case 3: return {T_QKV, 0, 0}; case 4: return {T_ATTN, 0, 0}; case 5: return {T_RES, 0, 0}; case 6: return {T_FFN, 0, 0}; case 7: return {T_RES, 0, 2};
        case 8: return {T_HIN, 1, 0}; case 9: return {T_SCAN, 1, 0}; case 10: return {T_HFIN, 1, 0}; case 11: return {T_RES, 1, 1}; case 12: return {T_FFN, 1, 0}; case 13: return {T_RES, 1, 2};
        case 14: return {T_F1, 2, 0}; case 15: return {T_RES, 2, 3}; case 16: return {T_FFN, 2, 0}; case 17: return {T_RES, 2, 2};
        case 18: return {T_QKV, 3, 1}; case 19: return {T_ATTN, 3, 1}; case 20: return {T_RES, 3, 0}; case 21: return {T_FFN, 3, 0}; case 22: return {T_RES, 3, 2};
        default: return {T_FINAL, 0, 0};
    }
}

__global__ void __launch_bounds__(NTHREADS, 2) fwd_megakernel(Args a_unused) {
    extern __shared__ __attribute__((aligned(16))) unsigned char lds_raw[];
    LAS unsigned char* lds = (LAS unsigned char*)lds_raw;
    constexpr int G = 256; const int bid = blockIdx.x;
    ArgP a = (ArgP)__builtin_amdgcn_kernarg_segment_ptr();
    for (int u = threadIdx.x; u < (LDS_BYTES - LDSCTL_OFF) / 4; u += NTHREADS) ((LAS unsigned*)(lds + LDSCTL_OFF))[u] = 0u;
    __syncthreads();
    volatile LAS unsigned* MISC = (volatile LAS unsigned*)(lds + MISC_OFF);
    XcdBarrier bar = xcd_barrier_post((unsigned*)(a->ws + WS_CTL), MISC + 8);

    const int nrun = a->ph_hi < NPH ? a->ph_hi + 1 : NPH;
#if REPMASK
    for (int pj = 2 * a->ph_lo; pj < 2 * nrun; ++pj) {
        const int pi = pj >> 1, rep = pj & 1;
        const int ph = pi < a->ph_hi ? pi : NPH - 1;
        const PhDesc d = phase_desc(ph);
        if (rep && !((REPMASK >> d.type) & 1)) continue;
        if (pj > 2 * a->ph_lo) xcd_barrier(bar);
#else
    for (int pi = a->ph_lo; pi < nrun; ++pi) {
        const int rep = 0;
        const int ph = pi < a->ph_hi ? pi : NPH - 1;
        const PhDesc d = phase_desc(ph);
        if (pi > a->ph_lo) xcd_barrier(bar);
#endif
        for (int xb = 0; xb < XBAR; ++xb) xcd_barrier(bar);
#define PH_TID const int tid = tid_opaque(), lane = tid & 63, wave = __builtin_amdgcn_readfirstlane(tid >> 6), gw = bid * NWAVES + wave, ngw = G * NWAVES; (void)lane; (void)gw; (void)ngw
        asm volatile("" : "+s"(a));
        const int L = d.layer;
        switch (d.type) {
#if (PHMASK >> 0) & 1
        case T_PRO: phase_prologue(a, lds, G, bid);
            if (a->ph_hi < NPH) { PH_TID; for (size_t i = (size_t)bid * NTHREADS + tid; i < 29360128 / 4; i += (size_t)G * NTHREADS) ((f32x4*)a->out)[i] = (f32x4){0.f, 0.f, 0.f, 0.f}; }
            break;
#endif
#if (PHMASK >> 1) & 1
        case T_FOLD: {
            GenSched S; S.init(2, a->ws + WS_WFO, nullptr, 1024, a->ws + WS_TC, 1024, 1024, 256, a->ph_hi > 0 ? 256 : 320, G, bid);
            EpiBf16 E{(bf16_t*)(a->ws + WS_WCS), 1024};
            pg8::gemm_phase(lds, 1024, 1024, S, E);
            PH_TID;
            phase_an(a, bid * NTHREADS + tid, G * NTHREADS);
            phase_sw(a, lds, 0xEF, gw, ngw, tid, lane);
        } break;
#endif
#if (PHMASK >> 2) & 1
        case T_NORM: {
            PH_TID;
            phase_first_norm(a, gw, ngw, lane);
            phase_sw(a, lds, 0x10, gw, ngw, tid, lane);
        } break;
#endif
#if (PHMASK >> 3) & 1
        case T_QKV: {
            const int j = d.sub, nidx = 2 * L;
            if (j == 1) { PH_TID; cache_convert(a, 1, gw, ngw, lane); }
            const float* sspn = (const float*)(a->ws + WS_SSP) + (size_t)nidx * 8192 * SSPN; const float* swn = (const float*)(a->ws + WS_SW) + sw_off(nidx);
            { GenSched S; S.init(7, a->ws + WS_H, nullptr, 1024, a->ws + WS_WQKV + (size_t)j * 3072 * 1024 * 2, 1024, MTOK, 3072, 1024, G, bid);
              EpiQKV E{(bf16_t*)(a->ws + WS_Q), (bf16_t*)(a->ws + WS_KB), (bf16_t*)(a->ws + WS_VB), a->out + OUT_NK + (size_t)j * 256 * 1024, a->out + OUT_NV + (size_t)j * 256 * 1024,
                       (const float*)(a->ws + WS_ROPE), (const float*)(a->ws + WS_ROPE) + 1024, sspn, swn, lds};
              pg8::gemm_phase(lds, 1024, 1024, S, E); }
            { GenSched S; S.init(8, a->ws + WS_H, nullptr, 1024, a->ws + WS_WQKV + (size_t)j * 3072 * 1024 * 2, 1024, MTOK, 3072, 1024, G, bid);
              EpiQKV128 E{(bf16_t*)(a->ws + WS_Q), (bf16_t*)(a->ws + WS_KB), (bf16_t*)(a->ws + WS_VB), a->out + OUT_NK + (size_t)j * 256 * 1024, a->out + OUT_NV + (size_t)j * 256 * 1024,
                          (const float*)(a->ws + WS_ROPE), (const float*)(a->ws + WS_ROPE) + 1024, sspn, swn, lds};
              pg8::gemm_phase_n128(lds, 1024, 1024, S, E); }
        } break;
#endif
#if (PHMASK >> 4) & 1
        case T_ATTN: phase_attn(a, d.sub, (char*)lds_raw, G, bid); break;
#endif
#if (PHMASK >> 5) & 1
        case T_RES: {
            const int nn = d.sub == 2 ? 2 * L + 2 : 2 * L + 1;
            EpiResid128 E{(bf16_t*)(a->ws + WS_X), (float*)(a->ws + WS_MOD) + (size_t)L * 5 * 6144 + (d.sub == 2 ? 5 : 2) * 1024,
                          nn < 8 ? (const float*)(a->ws + WS_AN) + nn * 5120 : nullptr, (bf16_t*)(a->ws + WS_H), (float*)(a->ws + WS_SSP) + (size_t)nn * 8192 * SSPN};
            GenSched S; int lda, ldb;
            if (d.sub == 3) { lda = 2048; ldb = 16384; S.init(4, a->ws + WS_CS1024, a->ws + WS_CS256, lda, a->ws + WS_ZT, ldb, 0, 0, 2048, G, bid); }
            else if (d.sub == 2) { lda = DFF; ldb = DFF; S.init(3, a->ws + WS_ACT, nullptr, lda, a->ws + WS_WFOUT + (size_t)L * 1024 * DFF * 2, ldb, MTOK, 1024, DFF, G, bid); }
            else { lda = 1024; ldb = 1024; const unsigned char* w = d.sub == 0 ? a->ws + WS_WOA + (size_t)(L == 0 ? 0 : 1) * 1024 * 1024 * 2 : a->ws + WS_WOR;
                S.init(3, a->ws + WS_O, nullptr, lda, w, ldb, MTOK, 1024, 1024, G, bid); }
            pg8::gemm_phase_n128(lds, lda, ldb, S, E);
        } break;
#endif
#if (PHMASK >> 6) & 1
        case T_FFN: {
            const int nidx = 2 * L + 1;
            GenSched S; S.init(0, a->ws + WS_H, nullptr, 1024, a->ws + WS_WFI + (size_t)L * 5632 * 1024 * 2, 1024, MTOK, 5632, 1024, G, bid);
            EpiFFN E{(bf16_t*)(a->ws + WS_ACT), (const float*)(a->ws + WS_SSP) + (size_t)nidx * 8192 * SSPN, (const float*)(a->ws + WS_SW) + sw_off(nidx), lds};
            pg8::gemm_phase(lds, 1024, 1024, S, E);
        } break;
#endif
#if (PHMASK >> 7) & 1
        case T_HIN: {
            { GenSched S; S.init(5, a->ws + WS_H, nullptr, 1024, a->ws + WS_WINR, 1024, MTOK, 4096, 1024, G, bid);
              EpiHgrn E{(bf16_t*)(a->ws + WS_GH), (bf16_t*)(a->ws + WS_QTF), (bf16_t*)(a->ws + WS_KTF), (bf16_t*)(a->ws + WS_QTB), (bf16_t*)(a->ws + WS_KTB), (bf16_t*)(a->ws + WS_KHTF), (bf16_t*)(a->ws + WS_KHTB),
                        (bf16_t*)(a->ws + WS_VT), (float*)(a->ws + WS_DDF), (float*)(a->ws + WS_DDB), (const float*)(a->ws + WS_LBV), (const float*)(a->ws + WS_SSP) + 2ull * 8192 * SSPN, (const float*)(a->ws + WS_SW) + sw_off(2), lds};
              pg8::gemm_phase(lds, 1024, 1024, S, E); }
            { GenSched S; S.init(6, a->ws + WS_H, nullptr, 1024, a->ws + WS_WINR, 1024, MTOK, 1024, 1024, G, bid);
              EpiG128 E{(bf16_t*)(a->ws + WS_GH), (const float*)(a->ws + WS_SSP) + 2ull * 8192 * SSPN, (const float*)(a->ws + WS_SW) + sw_off(2), lds};
              pg8::gemm_phase_n128(lds, 1024, 1024, S, E); }
        } break;
#endif
#if (PHMASK >> 8) & 1
        case T_SCAN: phase_scan(a, lds, G, bid); break;
#endif
#if (PHMASK >> 9) & 1
        case T_HFIN: { PH_TID; phase_hgrn_final(a, gw, ngw, lane); } break;
#endif
#if (PHMASK >> 10) & 1
        case T_F1: {
            GenSched S; S.init(0, a->ws + WS_WCS, nullptr, 1024, a->ws + WS_H, 1024, 2048, MTOK, 1024, G, bid);
            EpiFour1 E{(bf16_t*)(a->ws + WS_ZT), (const float*)(a->ws + WS_SSP) + 4ull * 8192 * SSPN, (const float*)(a->ws + WS_SW) + sw_off(4), lds};
            pg8::gemm_phase(lds, 1024, 1024, S, E);
        } break;
#endif
        default: { PH_TID; phase_final(a, gw, ngw, lane); } break;
        }
    }
}

extern "C" void kernel_launch(void* const* d_in, const int* in_sizes, int n_in, void* d_out, int out_size, void* d_ws, size_t ws_size, hipStream_t stream) {
    static int grid = 0;
    if (grid == 0) {
        if (n_in != 23 || out_size != 29360128 || ws_size < WS_END2) {
            fprintf(stderr, "kernel_launch: unexpected shapes: n_in %d out %d ws %zu (need >= %zu); nothing launched\n", n_in, out_size, ws_size, (size_t)WS_END); grid = -1; return; }
        int dev = 0, cus = 0, per_cu = 0;
        if (hipGetDevice(&dev) != hipSuccess || hipDeviceGetAttribute(&cus, hipDeviceAttributeMultiprocessorCount, dev) != hipSuccess) { fprintf(stderr, "kernel_launch: device query failed\n"); grid = -1; return; }
        if (hipFuncSetAttribute((const void*)fwd_megakernel, hipFuncAttributeMaxDynamicSharedMemorySize, LDS_BYTES) != hipSuccess) { fprintf(stderr, "kernel_launch: hipFuncSetAttribute failed\n"); grid = -1; return; }
        if (hipOccupancyMaxActiveBlocksPerMultiprocessor(&per_cu, (const void*)fwd_megakernel, NTHREADS, LDS_BYTES) != hipSuccess || per_cu < 1) {
            fprintf(stderr, "kernel_launch: occupancy query reports %d workgroups per CU; nothing launched\n", per_cu); (void)hipGetLastError(); grid = -1; return; }
        if (cus < 256) { fprintf(stderr, "kernel_launch: needs >= 256 CUs (have %d); nothing launched\n", cus); grid = -1; return; }
        grid = 256;
    }
    if (grid < 0) return;
    (void)hipMemsetAsync((char*)d_ws + WS_CTL, 0, CTL_BYTES, stream);
    Args a{};
    for (int i = 0; i < 23; ++i) a.in[i] = (const float*)d_in[i];
    a.out = (float*)d_out; a.ws = (unsigned char*)d_ws;
    a.lam_init0 = 0.2f; a.lam_init1 = (float)(0.8 - 0.6 * 0.40656965974059917);
    a.ph_lo = 0; a.ph_hi = NPH;
    hipLaunchKernelGGL(fwd_megakernel, dim3(grid), dim3(NTHREADS), LDS_BYTES, stream, a);
    const hipError_t le = hipPeekAtLastError();
    if (le != hipSuccess) fprintf(stderr, "kernel_launch: launch failed: %s\n", hipGetErrorName(le));
}
```

```cpp
#include <hip/hip_runtime.h>
#include <cstdio>
#include <cstdint>

#define LAS __attribute__((address_space(3)))
#define GAS __attribute__((address_space(1)))
typedef unsigned short bf16_t;
typedef short bf16x8 __attribute__((ext_vector_type(8)));
typedef short s16x4 __attribute__((ext_vector_type(4)));
typedef float f32x2 __attribute__((ext_vector_type(2)));
typedef float f32x4 __attribute__((ext_vector_type(4)));
typedef float f32x8 __attribute__((ext_vector_type(8)));
typedef float f32x16 __attribute__((ext_vector_type(16)));
typedef unsigned u32x2 __attribute__((ext_vector_type(2)));
typedef unsigned u32x4 __attribute__((ext_vector_type(4)));

constexpr int DM = 1024, MTOK = 8192, NCTX = 4096, DFF = 2816, NKV = 4096 + 4 * 1536;
constexpr float EPS = 1e-6f;
constexpr int NWAVES = 8, NTHREADS = 512;

constexpr size_t al256(size_t x) { return (x + 255) / 256 * 256; }
constexpr size_t WS_CTL = 0, CTL_BYTES = 65536;
constexpr size_t WS_MOD = WS_CTL + CTL_BYTES;
constexpr size_t WS_ROPE = WS_MOD + al256(4 * 5 * 6144 * 4);
constexpr size_t WS_LBV = WS_ROPE + 8192;
constexpr size_t WS_LAM = WS_LBV + 8192;
constexpr size_t WS_AN = WS_LAM + 256;
constexpr size_t WS_SW = WS_AN + 8 * 5 * 1024 * 4;
constexpr size_t WS_SSP = WS_SW + al256(35840 * 5 * 4);
constexpr int SSPN = 32;
constexpr size_t WS_TC = WS_SSP + 9ull * 8192 * SSPN * 4;
constexpr size_t WS_CS256 = WS_TC + 256 * 1024 * 2;
constexpr size_t WS_CS1024 = WS_CS256 + 256 * 2048 * 2;
constexpr size_t WS_WQKV = WS_CS1024 + 1024 * 2048 * 2;
constexpr size_t WS_WOA = WS_WQKV + 2ull * 3072 * 1024 * 2;
constexpr size_t WS_WINR = WS_WOA + 2ull * 1024 * 1024 * 2;
constexpr size_t WS_WOR = WS_WINR + 5120ull * 1024 * 2;
constexpr size_t WS_WFO = WS_WOR + 1024ull * 1024 * 2;
constexpr size_t WS_WCS = WS_WFO + 1024ull * 1024 * 2;
constexpr size_t WS_WFI = WS_WCS + 2048ull * 1024 * 2;
constexpr size_t WS_WFOUT = WS_WFI + 4ull * 5632 * 1024 * 2;
constexpr size_t WS_X = WS_WFOUT + 4ull * 1024 * 2816 * 2;
constexpr size_t WS_H = WS_X + 8192ull * 1024 * 4;
constexpr size_t WS_O = WS_H + 8192ull * 1024 * 2;
constexpr size_t WS_SCR = WS_O + 8192ull * 1024 * 2;
constexpr size_t SZ_TOK = 8192ull * 1024 * 2;
constexpr size_t WS_Q = WS_SCR, WS_KB = WS_Q + SZ_TOK, WS_VB = WS_KB + (size_t)NKV * 1024 * 2;
constexpr size_t WS_GH = WS_SCR, WS_QTF = WS_GH + SZ_TOK, WS_KTF = WS_QTF + SZ_TOK, WS_QTB = WS_KTF + SZ_TOK, WS_KTB = WS_QTB + SZ_TOK, WS_KHTF = WS_KTB + SZ_TOK, WS_KHTB = WS_KHTF + SZ_TOK,
                 WS_VT = WS_KHTB + SZ_TOK, WS_OF = WS_VT + SZ_TOK, WS_OB = WS_OF + SZ_TOK, WS_DDF = WS_OB + SZ_TOK, WS_DDB = WS_DDF + 512ull * 8 * 128 * 4;
constexpr size_t WS_ZT = WS_SCR;
constexpr size_t WS_ACT = WS_SCR;
constexpr size_t WS_END = WS_DDB + 512ull * 8 * 128 * 4;
constexpr size_t WS_END2 = WS_END;
__host__ __device__ constexpr int sw_n(int nidx) { return nidx == 0 || nidx == 6 ? 3072 : nidx == 2 ? 5120 : nidx == 4 ? 2048 : 5632; }
__host__ __device__ constexpr int sw_off(int nidx) { int o = 0; for (int i = 0; i < nidx; ++i) o += 5 * sw_n(i); return o; }

constexpr size_t OUT_YP = 0, OUT_YS = 4194304, OUT_NK = 8388608, OUT_NV = 16777216, OUT_NS = 25165824;

constexpr int RING_BYTES = 131072;
constexpr int LDSCTL_OFF = RING_BYTES, MISC_OFF = LDSCTL_OFF + 320, RSTD_OFF = LDSCTL_OFF + 1024;
constexpr int LDS_BYTES = 147456;

typedef __bf16 bf16x2_t __attribute__((ext_vector_type(2)));
__device__ __forceinline__ unsigned cvt_pk_bf16(float lo, float hi) { f32x2 v = {lo, hi}; bf16x2_t b = __builtin_convertvector(v, bf16x2_t); return __builtin_bit_cast(unsigned, b); }
__device__ __forceinline__ float bf2f(unsigned short b) { return __uint_as_float((unsigned)b << 16); }
__device__ __forceinline__ float bflo(unsigned w) { return __uint_as_float(w << 16); }
__device__ __forceinline__ float bfhi(unsigned w) { return __uint_as_float(w & 0xffff0000u); }
__device__ __forceinline__ float fast_rcp(float x) { return __builtin_amdgcn_rcpf(x); }
__device__ __forceinline__ float silu_f(float x) { return x * fast_rcp(1.f + __expf(-x)); }
__device__ __forceinline__ float sigmoid_f(float x) { return fast_rcp(1.f + __expf(-x)); }
__device__ __forceinline__ float wave_sum(float v) {
#pragma unroll
    for (int o = 1; o < 64; o <<= 1) v += __shfl_xor(v, o);
    return v;
}
__device__ __forceinline__ int tid_opaque() { int t = threadIdx.x; asm volatile("" : "+v"(t)); return t; }
__device__ __forceinline__ int cond_of_row(int r) { return r < NCTX ? 0 : 1 + ((r - NCTX) >> 10); }
#define LDS_WAIT() asm volatile("s_waitcnt lgkmcnt(0)" ::: "memory")
#define VM_WAIT() asm volatile("s_waitcnt vmcnt(0)" ::: "memory")

#define XB_TMO      128
#define XB_XCNT(j)  (256  + 64 * (j))
#define XB_XSUB(j)  (1280 + 64 * (j))
#define XB_XGEN(j)  (2304 + 64 * (j))
#define XB_TOP      3328
#define XB_TOPGEN   3392
#define XCD_BAR_WORDS 3456
#define XB_SPIN_CAP (1u << 22)
__device__ __forceinline__ unsigned xb_ld(unsigned* p)              { return __hip_atomic_load(p, __ATOMIC_RELAXED, __HIP_MEMORY_SCOPE_AGENT); }
__device__ __forceinline__ unsigned xb_add(unsigned* p, unsigned v) { return __hip_atomic_fetch_add(p, v, __ATOMIC_RELAXED, __HIP_MEMORY_SCOPE_AGENT); }
__device__ __forceinline__ unsigned xb_xcc_id() { return (unsigned)__builtin_amdgcn_s_getreg((3 << 11) | 20) & 0xFu; }
#define XB_SPIN(cond, bar) do { unsigned _sp = 0; while (cond) { __builtin_amdgcn_s_sleep(1); \
    if ((++_sp & 255u) == 0u) { if (xb_ld(&(bar)[XB_TMO])) break; if (_sp > XB_SPIN_CAP) { atomicAdd(&(bar)[XB_TMO], 1u); break; } } } } while (0)
struct XcdBarrier { unsigned* bar; unsigned x; volatile LAS unsigned* st; };
__device__ __forceinline__ XcdBarrier xcd_barrier_post(unsigned* bar, volatile LAS unsigned* st) {
    XcdBarrier b; b.bar = bar; b.x = xb_xcc_id(); b.st = st;
    if (threadIdx.x == 0) (void)xb_add(&bar[XB_XCNT(b.x)], 1u);
    return b;
}
__device__ __forceinline__ void xcd_barrier_complete(unsigned* bar, unsigned x, unsigned& nloc, unsigned& nx) {
    const unsigned G = gridDim.x * gridDim.y * gridDim.z;
    unsigned sum, cnt, mine, sp = 0u;
    for (;;) {
        sum = 0u; cnt = 0u; mine = 0u;
#pragma unroll
        for (unsigned j = 0; j < 16; ++j) { const unsigned c = xb_ld(&bar[XB_XCNT(j)]); sum += c; cnt += (c > 0u) ? 1u : 0u; mine = (j == x) ? c : mine; }
        if (sum == G) break;
        __builtin_amdgcn_s_sleep(1);
        if ((++sp & 255u) == 0u) { if (xb_ld(&bar[XB_TMO])) break; if (sp > XB_SPIN_CAP) { atomicAdd(&bar[XB_TMO], 1u); break; } }
    }
    nloc = mine > 0u ? mine : 1u; nx = cnt > 0u ? cnt : 1u;
}
__device__ __forceinline__ void xcd_barrier(const XcdBarrier& b) {
    asm volatile("s_waitcnt vmcnt(0)" ::: "memory");
    __syncthreads();
    if (threadIdx.x == 0) {
        unsigned* bar = b.bar;
        __builtin_amdgcn_s_waitcnt(0);
        unsigned nloc = b.st[0], nx = b.st[1];
        if (nloc == 0u) { xcd_barrier_complete(bar, b.x, nloc, nx); b.st[0] = nloc; b.st[1] = nx; }
        const unsigned old = xb_add(&bar[XB_XSUB(b.x)], 1u);
        const unsigned gen = old / nloc;
        if (old + 1u == (gen + 1u) * nloc) {
            __builtin_amdgcn_fence(__ATOMIC_RELEASE, "agent");
            asm volatile("s_waitcnt vmcnt(0)" ::: "memory");
            const unsigned og = xb_add(&bar[XB_TOP], 1u);
            const unsigned tg = og / nx;
            asm volatile("buffer_inv sc1" ::: "memory");
            if (og + 1u == (tg + 1u) * nx) xb_add(&bar[XB_TOPGEN], 1u);
            else XB_SPIN(xb_ld(&bar[XB_TOPGEN]) == tg, bar);
            xb_add(&bar[XB_XGEN(b.x)], 1u);
            asm volatile("s_waitcnt vmcnt(0)" ::: "memory");
        } else {
            asm volatile("buffer_inv sc1" ::: "memory");
            XB_SPIN(xb_ld(&bar[XB_XGEN(b.x)]) == gen, bar);
            asm volatile("s_waitcnt vmcnt(0)" ::: "memory");
        }
    }
    __syncthreads();
}

namespace pg8 {
constexpr int BM = 256, BK = 64, HALF = 128, HTB = HALF * BK * 2, NXCD = 8, WGM = 8;
__host__ __device__ __forceinline__ int lds_byte(int r, int c) { const int st = (r >> 4) * 2 + (c >> 5), rr = r & 15, cc = c & 31, ob = rr * 64 + cc * 2; return st * 1024 + (ob ^ (((ob >> 9) & 1) << 5)); }
__host__ __device__ __forceinline__ int perm32(int rho) { const int n = rho >> 4, i = rho & 15; return 8 * (i >> 2) + 4 * n + (i & 3); }
__host__ __device__ __forceinline__ void stage_rc(int b, int& R, int& C) { const int st = b / 1024, sb = b % 1024, swz = sb ^ (((sb >> 9) & 1) << 5); R = (st >> 1) * 16 + swz / 64; C = (st & 1) * 32 + (swz % 64) / 2; }

struct GUnit { const char* A; const char* B; int nt; int row0; int col0; int aux; };

template <class Epi, class Sched>
__device__ __forceinline__ void gemm_phase(LAS unsigned char* lds, const int lda, const int ldb, const Sched& S, const Epi& E) {
    const int tid = tid_opaque(), wid = __builtin_amdgcn_readfirstlane(tid >> 6), lane = tid & 63, wr = wid >> 2, wc = wid & 3, fr = lane & 15, fq = lane >> 4;
    unsigned voffA[2], voffB[2];
#pragma unroll
    for (int i = 0; i < 2; ++i) { int R, C; stage_rc(tid * 16 + i * 8192, R, C); const int Rb = Epi::PERM ? ((R & ~31) + perm32(R & 31)) : R; voffA[i] = (unsigned)(R * lda + C) * 2u; voffB[i] = (unsigned)(Rb * ldb + C) * 2u; }
    const size_t kstep = (size_t)(BK * 2);
    const size_t hstepA = (size_t)HALF * lda * 2, hstepB = (size_t)HALF * ldb * 2;
    const unsigned ldsw = (unsigned)wid * 1024u;
    const int aoff = lds_byte(wr * 64 + fr, fq * 8), boff = lds_byte(wc * 32 + fr, fq * 8);
#define PG8_SA(b, h) (((b) * 2 + (h)) * HTB)
#define PG8_SB(b, h) ((4 + (b) * 2 + (h)) * HTB)
#define PG8_STAGE(bufoff, gbase, voff) do { _Pragma("unroll") for (int _i = 0; _i < 2; ++_i) \
        __builtin_amdgcn_global_load_lds((const unsigned*)((const char*)(gbase) + (voff)[_i]), (LAS unsigned*)(lds + (bufoff) + ldsw + _i * 8192), 16, 0, 0); } while (0)
#define PG8_LDA(dst, b, h) do { _Pragma("unroll") for (int m = 0; m < 4; ++m) _Pragma("unroll") for (int k = 0; k < 2; ++k) dst[m][k] = *(const LAS bf16x8*)(lds + PG8_SA(b, h) + aoff + m * 2048 + k * 1024); } while (0)
#define PG8_LDB(dst, b, h) do { _Pragma("unroll") for (int n = 0; n < 2; ++n) _Pragma("unroll") for (int k = 0; k < 2; ++k) dst[n][k] = *(const LAS bf16x8*)(lds + PG8_SB(b, h) + boff + n * 2048 + k * 1024); } while (0)
#define PG8_MMA(ai, bj, At, Bt) do { __builtin_amdgcn_s_setprio(1); _Pragma("unroll") for (int m = 0; m < 4; ++m) _Pragma("unroll") for (int n = 0; n < 2; ++n) _Pragma("unroll") for (int k = 0; k < 2; ++k) \
        acc[ai][bj][m][n] = __builtin_amdgcn_mfma_f32_16x16x32_bf16(Bt[n][k], At[m][k], acc[ai][bj][m][n], 0, 0, 0); __builtin_amdgcn_s_setprio(0); } while (0)
#define PG8_WAIT_V(n) asm volatile("s_waitcnt vmcnt(" #n ")" ::: "memory")
#define PG8_WAIT_L(n) asm volatile("s_waitcnt lgkmcnt(" #n ")" ::: "memory")
#define PG8_BAR __builtin_amdgcn_s_barrier()
#define PG8_SCHED __builtin_amdgcn_sched_barrier(0)
    GUnit cur, nxt; int ui = 0;
    if (!S.next(0, cur)) return;
    E.prepare(S, lds, tid);
    f32x4 acc[2][2][4][2];
#pragma unroll
    for (int a = 0; a < 2; ++a)
#pragma unroll
        for (int b = 0; b < 2; ++b)
#pragma unroll
            for (int m = 0; m < 4; ++m)
#pragma unroll
                for (int n = 0; n < 2; ++n) acc[a][b][m][n] = (f32x4){0.f, 0.f, 0.f, 0.f};
    bf16x8 At[4][2], B0[2][2], B1[2][2];
    const char* cA = cur.A; const char* cB = cur.B;
    PG8_STAGE(PG8_SB(0, 0), cB, voffB); PG8_STAGE(PG8_SB(0, 1), cB + hstepB, voffB); PG8_STAGE(PG8_SA(0, 0), cA, voffA); PG8_STAGE(PG8_SA(0, 1), cA + hstepA, voffA);
    if (wr == 1) PG8_BAR;
    PG8_WAIT_V(2); PG8_BAR;
    PG8_STAGE(PG8_SB(1, 0), cB + kstep, voffB); PG8_STAGE(PG8_SA(1, 0), cA + kstep, voffA); PG8_STAGE(PG8_SB(1, 1), cB + hstepB + kstep, voffB);
    PG8_WAIT_V(6); PG8_BAR;
    for (;;) {
        const bool has_next = S.next(ui + 1, nxt);
        const char* nA = has_next ? nxt.A : cA; const char* nB = has_next ? nxt.B : cB;
        const int nt = cur.nt;
        for (int t = 0; t < nt; t += 2) {
            const bool last = (t == nt - 2);
            const char* a1 = cA + (size_t)(t + 1) * kstep;
            const char* a2 = last ? nA : cA + (size_t)(t + 2) * kstep; const char* b2 = last ? nB : cB + (size_t)(t + 2) * kstep;
            const char* a3 = a2 + kstep; const char* b3 = b2 + kstep;
            PG8_LDB(B0, 0, 0); PG8_LDB(B1, 0, 1); PG8_SCHED; PG8_LDA(At, 0, 0); PG8_STAGE(PG8_SA(1, 1), a1 + hstepA, voffA);
            PG8_WAIT_V(8); PG8_WAIT_L(0); PG8_BAR; PG8_MMA(0, 0, At, B0); PG8_MMA(0, 1, At, B1); PG8_BAR; PG8_SCHED;
            PG8_LDA(At, 0, 1); PG8_STAGE(PG8_SB(0, 0), b2, voffB); PG8_STAGE(PG8_SB(0, 1), b2 + hstepB, voffB); PG8_STAGE(PG8_SA(0, 0), a2, voffA);
            PG8_WAIT_V(8); PG8_WAIT_L(0); PG8_BAR; PG8_MMA(1, 0, At, B0); PG8_MMA(1, 1, At, B1); PG8_BAR; PG8_SCHED;
            PG8_LDB(B0, 1, 0); PG8_LDB(B1, 1, 1); PG8_SCHED; PG8_LDA(At, 1, 0); PG8_STAGE(PG8_SA(0, 1), a2 + hstepA, voffA);
            PG8_WAIT_V(8); PG8_WAIT_L(0); PG8_BAR; PG8_MMA(0, 0, At, B0); PG8_MMA(0, 1, At, B1); PG8_BAR; PG8_SCHED;
            PG8_LDA(At, 1, 1); PG8_STAGE(PG8_SB(1, 0), b3, voffB); PG8_STAGE(PG8_SB(1, 1), b3 + hstepB, voffB); PG8_STAGE(PG8_SA(1, 0), a3, voffA);
            PG8_WAIT_V(8); PG8_WAIT_L(0); PG8_BAR; PG8_MMA(1, 0, At, B0); PG8_MMA(1, 1, At, B1); PG8_BAR; PG8_SCHED;
        }
        if (wr == 0) PG8_BAR;
        E(acc, cur, ui, wr, wc, fr, fq);
        if (!has_next) break;
#pragma unroll
        for (int a = 0; a < 2; ++a)
#pragma unroll
            for (int b = 0; b < 2; ++b)
#pragma unroll
                for (int m = 0; m < 4; ++m)
#pragma unroll
                    for (int n = 0; n < 2; ++n) acc[a][b][m][n] = (f32x4){0.f, 0.f, 0.f, 0.f};
        cur = nxt; cA = nA; cB = nB; ++ui;
        if (wr == 1) PG8_BAR;
    }
    PG8_WAIT_V(0);
    PG8_BAR;
#undef PG8_SA
#undef PG8_SB
#undef PG8_STAGE
#undef PG8_LDA
#undef PG8_LDB
#undef PG8_MMA
#undef PG8_WAIT_V
#undef PG8_WAIT_L
#undef PG8_BAR
#undef PG8_SCHED
}

template <class Epi, class Sched>
__device__ __forceinline__ void gemm_phase_n128(LAS unsigned char* lds, const int lda, const int ldb, const Sched& S, const Epi& E) {
    const int tid = tid_opaque(), wid = __builtin_amdgcn_readfirstlane(tid >> 6), lane = tid & 63, wr = wid >> 2, wc = wid & 3, fr = lane & 15, fq = lane >> 4;
    unsigned voffA[2], voffB[2];
#pragma unroll
    for (int i = 0; i < 2; ++i) { int R, C; stage_rc(tid * 16 + i * 8192, R, C); const int Rb = Epi::PERM ? ((R & ~31) + perm32(R & 31)) : R; voffA[i] = (unsigned)(R * lda + C) * 2u; voffB[i] = (unsigned)(Rb * ldb + C) * 2u; }
    const size_t kstep = (size_t)(BK * 2);
    const size_t hstepA = (size_t)HALF * lda * 2;
    const unsigned ldsw = (unsigned)wid * 1024u;
    const int aoff = lds_byte(wr * 64 + fr, fq * 8), boff = lds_byte(wc * 32 + fr, fq * 8);
#define N1_SA(b, h) (((b) * 2 + (h)) * HTB)
#define N1_SB(b) ((4 + (b)) * HTB)
#define N1_STAGE(bufoff, gbase, voff) do { _Pragma("unroll") for (int _i = 0; _i < 2; ++_i) \
        __builtin_amdgcn_global_load_lds((const unsigned*)((const char*)(gbase) + (voff)[_i]), (LAS unsigned*)(lds + (bufoff) + ldsw + _i * 8192), 16, 0, 0); } while (0)
#define N1_LDA(dst, b, h) do { _Pragma("unroll") for (int m = 0; m < 4; ++m) _Pragma("unroll") for (int k = 0; k < 2; ++k) dst[m][k] = *(const LAS bf16x8*)(lds + N1_SA(b, h) + aoff + m * 2048 + k * 1024); } while (0)
#define N1_LDB(dst, b) do { _Pragma("unroll") for (int n = 0; n < 2; ++n) _Pragma("unroll") for (int k = 0; k < 2; ++k) dst[n][k] = *(const LAS bf16x8*)(lds + N1_SB(b) + boff + n * 2048 + k * 1024); } while (0)
#define N1_MMA(ai, At, Bt) do { __builtin_amdgcn_s_setprio(1); _Pragma("unroll") for (int m = 0; m < 4; ++m) _Pragma("unroll") for (int n = 0; n < 2; ++n) _Pragma("unroll") for (int k = 0; k < 2; ++k) \
        acc[ai][m][n] = __builtin_amdgcn_mfma_f32_16x16x32_bf16(Bt[n][k], At[m][k], acc[ai][m][n], 0, 0, 0); __builtin_amdgcn_s_setprio(0); } while (0)
#define N1_WAIT_V(n) asm volatile("s_waitcnt vmcnt(" #n ")" ::: "memory")
#define N1_WAIT_L(n) asm volatile("s_waitcnt lgkmcnt(" #n ")" ::: "memory")
#define N1_BAR __builtin_amdgcn_s_barrier()
#define N1_SCHED __builtin_amdgcn_sched_barrier(0)
    GUnit cur, nxt; int ui = 0;
    if (!S.next(0, cur)) return;
    E.prepare(S, lds, tid);
    f32x4 acc[2][4][2];
#pragma unroll
    for (int x = 0; x < 2; ++x)
#pragma unroll
        for (int m = 0; m < 4; ++m)
#pragma unroll
            for (int n = 0; n < 2; ++n) acc[x][m][n] = (f32x4){0.f, 0.f, 0.f, 0.f};
    bf16x8 At[4][2], B0[2][2];
    const char* cA = cur.A; const char* cB = cur.B;
    N1_STAGE(N1_SB(0), cB, voffB); N1_STAGE(N1_SA(0, 0), cA, voffA); N1_STAGE(N1_SA(0, 1), cA + hstepA, voffA);
    if (wr == 1) N1_BAR;
    N1_WAIT_V(0); N1_BAR;
    N1_STAGE(N1_SB(1), cB + kstep, voffB); N1_STAGE(N1_SA(1, 0), cA + kstep, voffA);
    N1_BAR;
    for (;;) {
        const bool has_next = S.next(ui + 1, nxt);
        const char* nA = has_next ? nxt.A : cA; const char* nB = has_next ? nxt.B : cB;
        const int nt = cur.nt;
        for (int t = 0; t < nt; t += 2) {
            const bool last = (t == nt - 2);
            const char* a1 = cA + (size_t)(t + 1) * kstep;
            const char* a2 = last ? nA : cA + (size_t)(t + 2) * kstep; const char* b2 = last ? nB : cB + (size_t)(t + 2) * kstep;
            const char* a3 = a2 + kstep; const char* b3 = b2 + kstep;
            N1_LDB(B0, 0); N1_SCHED; N1_LDA(At, 0, 0); N1_STAGE(N1_SA(1, 1), a1 + hstepA, voffA);
            N1_WAIT_V(6); N1_WAIT_L(0); N1_BAR; N1_MMA(0, At, B0); N1_BAR; N1_SCHED;
            N1_LDA(At, 0, 1); N1_STAGE(N1_SA(0, 0), a2, voffA); N1_STAGE(N1_SB(0), b2, voffB);
            N1_WAIT_V(6); N1_WAIT_L(0); N1_BAR; N1_MMA(1, At, B0); N1_BAR; N1_SCHED;
            N1_LDB(B0, 1); N1_SCHED; N1_LDA(At, 1, 0); N1_STAGE(N1_SA(0, 1), a2 + hstepA, voffA);
            N1_WAIT_V(6); N1_WAIT_L(0); N1_BAR; N1_MMA(0, At, B0); N1_BAR; N1_SCHED;
            N1_LDA(At, 1, 1); N1_STAGE(N1_SA(1, 0), a3, voffA); N1_STAGE(N1_SB(1), b3, voffB);
            N1_WAIT_V(6); N1_WAIT_L(0); N1_BAR; N1_MMA(1, At, B0); N1_BAR; N1_SCHED;
        }
        if (wr == 0) N1_BAR;
        E(acc, cur, ui, wr, wc, fr, fq);
        if (!has_next) break;
#pragma unroll
        for (int x = 0; x < 2; ++x)
#pragma unroll
            for (int m = 0; m < 4; ++m)
#pragma unroll
                for (int n = 0; n < 2; ++n) acc[x][m][n] = (f32x4){0.f, 0.f, 0.f, 0.f};
        cur = nxt; cA = nA; cB = nB; ++ui;
        if (wr == 1) N1_BAR;
    }
    N1_WAIT_V(0);
    N1_BAR;
#undef N1_SA
#undef N1_SB
#undef N1_STAGE
#undef N1_LDA
#undef N1_LDB
#undef N1_MMA
#undef N1_WAIT_V
#undef N1_WAIT_L
#undef N1_BAR
#undef N1_SCHED
}
}
using pg8::GUnit;
typedef f32x4 AccT[2][2][4][2];
typedef f32x4 AccH[2][4][2];

template <class Sched> __device__ __forceinline__ void prep_rstd(LAS unsigned char* lds, const float* ssp, const Sched& S, bool cols, int tid) {
    LAS float* R = (LAS float*)(lds + RSTD_OFF);
    if (tid < 256) {
        f32x4 p[3][8]; bool ok[3];
#pragma unroll
        for (int i = 0; i < 3; ++i) { GUnit u; ok[i] = S.next(i, u);
            if (ok[i]) { const f32x4* q = (const f32x4*)(ssp + (size_t)((cols ? u.col0 : u.row0) + tid) * SSPN);
#pragma unroll
                for (int k = 0; k < 8; ++k) p[i][k] = q[k]; } }
#pragma unroll
        for (int i = 0; i < 3; ++i) if (ok[i]) { const f32x4 s4 = ((p[i][0] + p[i][1]) + (p[i][2] + p[i][3])) + ((p[i][4] + p[i][5]) + (p[i][6] + p[i][7]));
            R[i * 256 + tid] = rsqrtf(((s4[0] + s4[1]) + (s4[2] + s4[3])) * (1.f / 1024.f) + EPS); }
    }
    LDS_WAIT(); __builtin_amdgcn_s_barrier(); asm volatile("" ::: "memory");
}
struct EpiQKV {
    bf16_t* Q; bf16_t* KB; bf16_t* VB; float* nk; float* nv; const float* ropec; const float* ropes; const float* ssp; const float* sw; LAS unsigned char* lds;
    static constexpr bool PERM = false;
    template <class Sched> __device__ __forceinline__ void prepare(const Sched& S, LAS unsigned char* l, int tid) const { prep_rstd(l, ssp, S, false, tid); }
    __device__ __forceinline__ void operator()(const AccT& acc, const GUnit& u, int ui, int wr, int wc, int fr, int fq) const {
        const LAS float* R = (const LAS float*)(lds + RSTD_OFF) + ui * 256;
        const int sec = u.col0 >> 10;
        const bool lat = u.row0 >= NCTX;
        const int cbase = (u.col0 & 1023) + wc * 32 + 4 * fq;
        const float* swc = sw + cond_of_row(u.row0) * 3072 + u.col0 + wc * 32 + 4 * fq;
        f32x4 sv[2][2];
#pragma unroll
        for (int bj = 0; bj < 2; ++bj)
#pragma unroll
            for (int n = 0; n < 2; ++n) sv[bj][n] = *(const f32x4*)(swc + bj * 128 + n * 16);
#pragma unroll
        for (int ai = 0; ai < 2; ++ai)
#pragma unroll
            for (int m = 0; m < 4; ++m) {
                const int rl = ai * 128 + wr * 64 + m * 16 + fr, r = u.row0 + rl;
                const float rs = R[rl];
                int t = 0, kvrow = r; size_t orow = 0;
                if (lat) { const int rr = r - NCTX; t = rr & 1023; kvrow = NCTX + (rr >> 10) * 1536 + 512 + t; }
                else { const int b = r >> 8; orow = ((size_t)(b * 2) * 256 + (r & 255)) * 1024; }
                f32x4 cs = {1.f, 1.f, 1.f, 1.f}, sn = {0.f, 0.f, 0.f, 0.f};
                if (lat && sec < 2) { const int pos = (wc & 1) ? (t & 63) : (t >> 6); cs = *(const f32x4*)(ropec + pos * 16 + 4 * fq); sn = *(const f32x4*)(ropes + pos * 16 + 4 * fq); }
#pragma unroll
                for (int bj = 0; bj < 2; ++bj) {
                    f32x4 x1 = acc[ai][bj][m][0] * rs + sv[bj][0], x2 = acc[ai][bj][m][1] * rs + sv[bj][1];
                    const int c = cbase + bj * 128;
                    if (sec < 2) { const f32x4 y1 = x1 * cs - x2 * sn, y2 = x2 * cs + x1 * sn; x1 = y1; x2 = y2; }
                    u32x4 w; w.x = cvt_pk_bf16(x1[0], x1[1]); w.y = cvt_pk_bf16(x1[2], x1[3]); w.z = cvt_pk_bf16(x2[0], x2[1]); w.w = cvt_pk_bf16(x2[2], x2[3]);
                    const int c8 = c + 4 * fq;
                    if (sec == 0) *(u32x4*)(Q + (size_t)r * 1024 + c8) = w;
                    else {
                        *(u32x4*)((sec == 1 ? KB : VB) + (size_t)kvrow * 1024 + c8) = w;
                        if (!lat) { if (sec == 1) { float* o = nk + orow + c; *(f32x4*)o = x1; *(f32x4*)(o + 16) = x2; }
                                    else { float* o = nv + orow + c8; *(f32x4*)o = x1; *(f32x4*)(o + 4) = x2; } }
                    }
                }
            }
    }
};
struct EpiQKV128 {
    bf16_t* Q; bf16_t* KB; bf16_t* VB; float* nk; float* nv; const float* ropec; const float* ropes; const float* ssp; const float* sw; LAS unsigned char* lds;
    static constexpr bool PERM = false;
    template <class Sched> __device__ __forceinline__ void prepare(const Sched& S, LAS unsigned char* l, int tid) const { prep_rstd(l, ssp, S, false, tid); }
    __device__ __forceinline__ void operator()(const AccH& acc, const GUnit& u, int ui, int wr, int wc, int fr, int fq) const {
        const LAS float* R = (const LAS float*)(lds + RSTD_OFF) + ui * 256;
        const int sec = u.col0 >> 10;
        const bool lat = u.row0 >= NCTX;
        const int c = (u.col0 & 1023) + wc * 32 + 4 * fq;
        const float* swc = sw + cond_of_row(u.row0) * 3072 + u.col0 + wc * 32 + 4 * fq;
        const f32x4 sv0 = *(const f32x4*)swc, sv1 = *(const f32x4*)(swc + 16);
#pragma unroll
        for (int ai = 0; ai < 2; ++ai)
#pragma unroll
            for (int m = 0; m < 4; ++m) {
                const int rl = ai * 128 + wr * 64 + m * 16 + fr, r = u.row0 + rl;
                const float rs = R[rl];
                int t = 0, kvrow = r; size_t orow = 0;
                if (lat) { const int rr = r - NCTX; t = rr & 1023; kvrow = NCTX + (rr >> 10) * 1536 + 512 + t; }
                else { const int b = r >> 8; orow = ((size_t)(b * 2) * 256 + (r & 255)) * 1024; }
                f32x4 cs = {1.f, 1.f, 1.f, 1.f}, sn = {0.f, 0.f, 0.f, 0.f};
                if (lat && sec < 2) { const int pos = (wc & 1) ? (t & 63) : (t >> 6); cs = *(const f32x4*)(ropec + pos * 16 + 4 * fq); sn = *(const f32x4*)(ropes + pos * 16 + 4 * fq); }
                f32x4 x1 = acc[ai][m][0] * rs + sv0, x2 = acc[ai][m][1] * rs + sv1;
                if (sec < 2) { const f32x4 y1 = x1 * cs - x2 * sn, y2 = x2 * cs + x1 * sn; x1 = y1; x2 = y2; }
                u32x4 w; w.x = cvt_pk_bf16(x1[0], x1[1]); w.y = cvt_pk_bf16(x1[2], x1[3]); w.z = cvt_pk_bf16(x2[0], x2[1]); w.w = cvt_pk_bf16(x2[2], x2[3]);
                const int c8 = c + 4 * fq;
                if (sec == 0) *(u32x4*)(Q + (size_t)r * 1024 + c8) = w;
                else {
                    *(u32x4*)((sec == 1 ? KB : VB) + (size_t)kvrow * 1024 + c8) = w;
                    if (!lat) { if (sec == 1) { float* o = nk + orow + c; *(f32x4*)o = x1; *(f32x4*)(o + 16) = x2; }
                                else { float* o = nv + orow + c8; *(f32x4*)o = x1; *(f32x4*)(o + 4) = x2; } }
                }
            }
    }
};
struct EpiResid {
    float* X; const float* gate; const float* an; bf16_t* XA; float* ssp;
    static constexpr bool PERM = true;
    template <class Sched> __device__ __forceinline__ void prepare(const Sched&, LAS unsigned char*, int) const {}
    __device__ __forceinline__ void operator()(const AccT& acc, const GUnit& u, int ui, int wr, int wc, int fr, int fq) const {
        const int cbase = u.col0 + wc * 32 + 8 * fq;
        const int cnd = cond_of_row(u.row0);
        const float* g = gate + cnd * 6144;
        f32x4 gv[2][2];
#pragma unroll
        for (int bj = 0; bj < 2; ++bj)
#pragma unroll
            for (int n = 0; n < 2; ++n) gv[bj][n] = *(const f32x4*)(g + cbase + bj * 128 + n * 4);
        const float* anc = an + cnd * 1024 + cbase;
        const int slot = (u.col0 >> 8) * 4 + wc;
#pragma unroll
        for (int ai = 0; ai < 2; ++ai) {
#pragma unroll
            for (int mp = 0; mp < 2; ++mp) {
            f32x4 xo[2][2][2];
#pragma unroll
            for (int m2 = 0; m2 < 2; ++m2)
#pragma unroll
                for (int bj = 0; bj < 2; ++bj)
#pragma unroll
                    for (int n = 0; n < 2; ++n) xo[m2][bj][n] = *(const f32x4*)(X + (size_t)(u.row0 + ai * 128 + wr * 64 + (mp * 2 + m2) * 16 + fr) * 1024 + cbase + bj * 128 + n * 4);
#pragma unroll
            for (int m2 = 0; m2 < 2; ++m2) {
                const int m = mp * 2 + m2;
                const size_t ro = (size_t)(u.row0 + ai * 128 + wr * 64 + m * 16 + fr);
                float ss = 0.f;
#pragma unroll
                for (int bj = 0; bj < 2; ++bj) {
                    const f32x4 x0 = xo[m2][bj][0] + gv[bj][0] * acc[ai][bj][m][0], x1 = xo[m2][bj][1] + gv[bj][1] * acc[ai][bj][m][1];
                    *(f32x4*)(X + ro * 1024 + cbase + bj * 128) = x0; *(f32x4*)(X + ro * 1024 + cbase + bj * 128 + 4) = x1;
                    ss += ((x0[0] * x0[0] + x0[1] * x0[1]) + (x0[2] * x0[2] + x0[3] * x0[3])) + ((x1[0] * x1[0] + x1[1] * x1[1]) + (x1[2] * x1[2] + x1[3] * x1[3]));
                    if (an) { const f32x4 y0 = x0 * *(const f32x4*)(anc + bj * 128), y1 = x1 * *(const f32x4*)(anc + bj * 128 + 4); u32x4 w; w.x = cvt_pk_bf16(y0[0], y0[1]); w.y = cvt_pk_bf16(y0[2], y0[3]); w.z = cvt_pk_bf16(y1[0], y1[1]); w.w = cvt_pk_bf16(y1[2], y1[3]);
                        *(u32x4*)(XA + ro * 1024 + cbase + bj * 128) = w; }
                }
                ss += __shfl_xor(ss, 16); ss += __shfl_xor(ss, 32);
                if (fq == 0) ssp[ro * SSPN + slot] = ss;
            }
            }
            asm volatile("" ::: "memory");
        }
    }
};
struct EpiResid128 {
    bf16_t* X; const float* gate; const float* an; bf16_t* XA; float* ssp;
    static constexpr bool PERM = true;
    template <class Sched> __device__ __forceinline__ void prepare(const Sched&, LAS unsigned char*, int) const {}
    __device__ __forceinline__ void operator()(const AccH& acc, const GUnit& u, int ui, int wr, int wc, int fr, int fq) const {
        const int cbase = u.col0 + wc * 32 + 8 * fq;
        const int cnd = cond_of_row(u.row0);
        const float* g = gate + cnd * 6144;
        const f32x4 gv0 = *(const f32x4*)(g + cbase), gv1 = *(const f32x4*)(g + cbase + 4);
        f32x4 av0 = {0.f, 0.f, 0.f, 0.f}, av1 = av0;
        if (an) { av0 = *(const f32x4*)(an + cnd * 1024 + cbase); av1 = *(const f32x4*)(an + cnd * 1024 + cbase + 4); }
        const int slot = (u.col0 >> 7) * 4 + wc;
        u32x4 xo[2][4];
#pragma unroll
        for (int ai = 0; ai < 2; ++ai)
#pragma unroll
            for (int m = 0; m < 4; ++m) xo[ai][m] = *(const u32x4*)(X + (size_t)(u.row0 + ai * 128 + wr * 64 + m * 16 + fr) * 1024 + cbase);
#pragma unroll
        for (int ai = 0; ai < 2; ++ai)
#pragma unroll
            for (int m = 0; m < 4; ++m) {
                const size_t ro = (size_t)(u.row0 + ai * 128 + wr * 64 + m * 16 + fr);
                const u32x4 xw = xo[ai][m];
                const f32x4 xa = {bflo(xw.x), bfhi(xw.x), bflo(xw.y), bfhi(xw.y)}, xb = {bflo(xw.z), bfhi(xw.z), bflo(xw.w), bfhi(xw.w)};
                const f32x4 x0 = xa + gv0 * acc[ai][m][0], x1 = xb + gv1 * acc[ai][m][1];
                { u32x4 w; w.x = cvt_pk_bf16(x0[0], x0[1]); w.y = cvt_pk_bf16(x0[2], x0[3]); w.z = cvt_pk_bf16(x1[0], x1[1]); w.w = cvt_pk_bf16(x1[2], x1[3]); *(u32x4*)(X + ro * 1024 + cbase) = w; }
                float ss = ((x0[0] * x0[0] + x0[1] * x0[1]) + (x0[2] * x0[2] + x0[3] * x0[3])) + ((x1[0] * x1[0] + x1[1] * x1[1]) + (x1[2] * x1[2] + x1[3] * x1[3]));
                if (an) { const f32x4 y0 = x0 * av0, y1 = x1 * av1; u32x4 w; w.x = cvt_pk_bf16(y0[0], y0[1]); w.y = cvt_pk_bf16(y0[2], y0[3]); w.z = cvt_pk_bf16(y1[0], y1[1]); w.w = cvt_pk_bf16(y1[2], y1[3]);
                    *(u32x4*)(XA + ro * 1024 + cbase) = w; }
                ss += __shfl_xor(ss, 16); ss += __shfl_xor(ss, 32);
                if (fq == 0) ssp[ro * SSPN + slot] = ss;
            }
    }
};
struct EpiG128 {
    bf16_t* GH; const float* ssp; const float* sw; LAS unsigned char* lds;
    static constexpr bool PERM = true;
    template <class Sched> __device__ __forceinline__ void prepare(const Sched& S, LAS unsigned char* l, int tid) const { prep_rstd(l, ssp, S, false, tid); }
    __device__ __forceinline__ void operator()(const AccH& acc, const GUnit& u, int ui, int wr, int wc, int fr, int fq) const {
        const LAS float* R = (const LAS float*)(lds + RSTD_OFF) + ui * 256;
        const float* swc = sw + cond_of_row(u.row0) * 5120 + u.col0 + wc * 32 + 8 * fq;
        const f32x4 sv0 = *(const f32x4*)swc, sv1 = *(const f32x4*)(swc + 4);
        const int cbase = (u.col0 - 4096) + wc * 32 + 8 * fq;
#pragma unroll
        for (int ai = 0; ai < 2; ++ai)
#pragma unroll
            for (int m = 0; m < 4; ++m) {
                const int rl = ai * 128 + wr * 64 + m * 16 + fr; const float rs = R[rl];
                const f32x4 v0 = acc[ai][m][0] * rs + sv0, v1 = acc[ai][m][1] * rs + sv1;
                u32x4 w; w.x = cvt_pk_bf16(silu_f(v0[0]), silu_f(v0[1])); w.y = cvt_pk_bf16(silu_f(v0[2]), silu_f(v0[3])); w.z = cvt_pk_bf16(silu_f(v1[0]), silu_f(v1[1])); w.w = cvt_pk_bf16(silu_f(v1[2]), silu_f(v1[3]));
                *(u32x4*)(GH + (size_t)(u.row0 + rl) * 1024 + cbase) = w;
            }
    }
};
struct EpiFFN {
    bf16_t* ACT; const float* ssp; const float* sw; LAS unsigned char* lds;
    static constexpr bool PERM = true;
    template <class Sched> __device__ __forceinline__ void prepare(const Sched& S, LAS unsigned char* l, int tid) const { prep_rstd(l, ssp, S, false, tid); }
    __device__ __forceinline__ void operator()(const AccT& acc, const GUnit& u, int ui, int wr, int wc, int fr, int fq) const {
        const LAS float* R = (const LAS float*)(lds + RSTD_OFF) + ui * 256;
        const int abase = (u.col0 >> 1) + wc * 32 + 8 * fq;
        const float* swc = sw + cond_of_row(u.row0) * 5632 + u.col0 + wc * 32 + 8 * fq;
        f32x4 sv[2][2];
#pragma unroll
        for (int bj = 0; bj < 2; ++bj)
#pragma unroll
            for (int n = 0; n < 2; ++n) sv[bj][n] = *(const f32x4*)(swc + bj * 128 + n * 4);
#pragma unroll
        for (int ai = 0; ai < 2; ++ai)
#pragma unroll
            for (int m = 0; m < 4; ++m) {
                const int rl = ai * 128 + wr * 64 + m * 16 + fr;
                const float rs = R[rl];
                u32x4 w;
#pragma unroll
                for (int n = 0; n < 2; ++n) {
                    const f32x4 g = acc[ai][0][m][n] * rs + sv[0][n], up = acc[ai][1][m][n] * rs + sv[1][n];
                    w[2 * n] = cvt_pk_bf16(silu_f(g[0]) * up[0], silu_f(g[1]) * up[1]); w[2 * n + 1] = cvt_pk_bf16(silu_f(g[2]) * up[2], silu_f(g[3]) * up[3]);
                }
                *(u32x4*)(ACT + (size_t)(u.row0 + rl) * DFF + abase) = w;
            }
    }
};
__device__ __forceinline__ void quad_transpose(f32x4& v, int qi) {
#define QT_X1(x) __int_as_float(__builtin_amdgcn_update_dpp(0, __float_as_int(x), 0xB1, 0xF, 0xF, true))
#define QT_X2(x) __int_as_float(__builtin_amdgcn_update_dpp(0, __float_as_int(x), 0x4E, 0xF, 0xF, true))
    const bool o1 = qi & 1, o2 = qi & 2;
    { const float t0 = o1 ? v[0] : v[1], t1 = o1 ? v[2] : v[3]; const float r0 = QT_X1(t0), r1 = QT_X1(t1);
      if (o1) { v[0] = r0; v[2] = r1; } else { v[1] = r0; v[3] = r1; } }
    { const float t0 = o2 ? v[0] : v[2], t1 = o2 ? v[1] : v[3]; const float r0 = QT_X2(t0), r1 = QT_X2(t1);
      if (o2) { v[0] = r0; v[1] = r1; } else { v[2] = r0; v[3] = r1; } }
#undef QT_X1
#undef QT_X2
}
__device__ __forceinline__ void quad_transpose_pk(unsigned& p0, unsigned& p1, int qi) {
    const unsigned sel = (qi & 1) ? 0x03020706u : 0x05040100u;
    const unsigned n0 = (unsigned)__builtin_amdgcn_update_dpp(0, (int)p0, 0xB1, 0xF, 0xF, true), n1 = (unsigned)__builtin_amdgcn_update_dpp(0, (int)p1, 0xB1, 0xF, 0xF, true);
    const unsigned a0 = __builtin_amdgcn_perm(n0, p0, sel), a1 = __builtin_amdgcn_perm(n1, p1, sel);
    const bool hi2 = qi & 2;
    const unsigned send = hi2 ? a0 : a1;
    const unsigned recv = (unsigned)__builtin_amdgcn_update_dpp(0, (int)send, 0x4E, 0xF, 0xF, true);
    p0 = hi2 ? recv : a0; p1 = hi2 ? a1 : recv;
}
#define DPP_BC(x, N) __int_as_float(__builtin_amdgcn_update_dpp(0, __float_as_int(x), 0x150 + (N), 0xF, 0xF, true))
#define DPPM_SHR(x, N) __int_as_float(__builtin_amdgcn_update_dpp(0x3f800000, __float_as_int(x), 0x110 + (N), 0xF, 0xF, false))
#define DPPM_SHL(x, N) __int_as_float(__builtin_amdgcn_update_dpp(0x3f800000, __float_as_int(x), 0x100 + (N), 0xF, 0xF, false))
#define DPP_SHR(x, N) __int_as_float(__builtin_amdgcn_update_dpp(0, __float_as_int(x), 0x110 + (N), 0xF, 0xF, true))
#define DPP_SHL(x, N) __int_as_float(__builtin_amdgcn_update_dpp(0, __float_as_int(x), 0x100 + (N), 0xF, 0xF, true))
struct EpiHgrn {
    bf16_t* GH; bf16_t* QTF; bf16_t* KTF; bf16_t* QTB; bf16_t* KTB; bf16_t* KHTF; bf16_t* KHTB; bf16_t* VT; float* DDF; float* DDB; const float* lbv; const float* ssp; const float* sw; LAS unsigned char* lds;
    static constexpr bool PERM = false;
    template <class Sched> __device__ __forceinline__ void prepare(const Sched& S, LAS unsigned char* l, int tid) const { prep_rstd(l, ssp, S, false, tid); }
    __device__ __forceinline__ void operator()(const AccT& acc, const GUnit& u, int ui, int wr, int wc, int fr, int fq) const {
        const LAS float* R = (const LAS float*)(lds + RSTD_OFF) + ui * 256;
        const int t = u.col0 >> 8;
        const float* swc = sw + cond_of_row(u.row0) * 5120 + u.col0 + wc * 32 + 4 * fq;
        f32x4 sv[2][2];
#pragma unroll
        for (int bj = 0; bj < 2; ++bj)
#pragma unroll
            for (int n = 0; n < 2; ++n) sv[bj][n] = *(const f32x4*)(swc + bj * 128 + n * 16);
        if (t >= 16) {
            const int cbase = (u.col0 - 4096) + wc * 32 + 4 * fq;
#pragma unroll
            for (int ai = 0; ai < 2; ++ai)
#pragma unroll
                for (int m = 0; m < 4; ++m) {
                    const int rl = ai * 128 + wr * 64 + m * 16 + fr; const float rs = R[rl];
#pragma unroll
                    for (int bj = 0; bj < 2; ++bj)
#pragma unroll
                        for (int n = 0; n < 2; ++n) { const f32x4 v = acc[ai][bj][m][n] * rs + sv[bj][n];
                            u32x2 w; w.x = cvt_pk_bf16(silu_f(v[0]), silu_f(v[1])); w.y = cvt_pk_bf16(silu_f(v[2]), silu_f(v[3]));
                            *(u32x2*)(GH + (size_t)(u.row0 + rl) * 1024 + cbase + bj * 128 + n * 16) = w; }
                }
            return;
        }
        const int h = t >> 1, kk = (t & 1) * 64 + wc * 16 + 4 * fq, chg = t * 64 + wc * 16 + 4 * fq;
        const f32x4 lb0 = *(const f32x4*)(lbv + chg), lb1 = *(const f32x4*)(lbv + 1024 + chg);
        const int lane = fq * 16 + fr;
#pragma unroll 1
        for (int am = 0; am < 8; ++am) {
            const int ai = am >> 2, m = am & 3;
            f32x4 aq, av, azf, azb;
            switch (am) {
#define HG_CASE(I) case I: aq = acc[(I) >> 2][0][(I) & 3][0]; av = acc[(I) >> 2][0][(I) & 3][1]; azf = acc[(I) >> 2][1][(I) & 3][0]; azb = acc[(I) >> 2][1][(I) & 3][1]; break;
                HG_CASE(0) HG_CASE(1) HG_CASE(2) HG_CASE(3) HG_CASE(4) HG_CASE(5) HG_CASE(6) default: aq = acc[1][0][3][0]; av = acc[1][0][3][1]; azf = acc[1][1][3][0]; azb = acc[1][1][3][1]; break;
#undef HG_CASE
            }
            const int rl = ai * 128 + wr * 64 + m * 16 + fr; const float rs = R[rl];
            const int tok = u.row0 + rl; const size_t cg = (size_t)((tok >> 4) * 8 + h);
            const f32x4 q4 = aq * rs + sv[0][0], v4 = av * rs + sv[0][1], zf = azf * rs + sv[1][0], zb = azb * rs + sv[1][1];
            f32x4 q, kf, kb, bf, bb;
#pragma unroll
            for (int j = 0; j < 4; ++j) { q[j] = silu_f(q4[j]);
                const float ff = lb0[j] + (1.f - lb0[j]) * sigmoid_f(zf[j]), fb = lb1[j] + (1.f - lb1[j]) * sigmoid_f(zb[j]);
                kf[j] = 1.f - ff; kb[j] = 1.f - fb; bf[j] = ff; bb[j] = fb; }
#define HG_SCAN(DIR, X) asm volatile("s_nop 1\n" \
                HG_SC4(DIR, 1) HG_SC4(DIR, 2) HG_SC4(DIR, 4) HG_SC4(DIR, 8) : "+v"(X[0]), "+v"(X[1]), "+v"(X[2]), "+v"(X[3]))
#define HG_SC1(DIR, N, R) "v_mul_f32_dpp " R ", " R ", " R " " DIR ":" #N " row_mask:0xf bank_mask:0xf\n"
#define HG_SC4(DIR, N) HG_SC1(DIR, N, "%0") HG_SC1(DIR, N, "%1") HG_SC1(DIR, N, "%2") HG_SC1(DIR, N, "%3")
            { float x[4] = {bf[0], bf[1], bf[2], bf[3]}; HG_SCAN("row_shr", x); bf[0] = x[0]; bf[1] = x[1]; bf[2] = x[2]; bf[3] = x[3]; }
            { float y[4] = {bb[0], bb[1], bb[2], bb[3]}; HG_SCAN("row_shl", y); bb[0] = y[0]; bb[1] = y[1]; bb[2] = y[2]; bb[3] = y[3]; }
#undef HG_SCAN
#undef HG_SC1
#undef HG_SC4
            f32x4 qtf, ktf, khf, ddf, qtb, ktb, khb, ddb;
#pragma unroll
            for (int j = 0; j < 4; ++j) {
                const float ef = bf[j], eif = fast_rcp(ef), eb = bb[j], eib = fast_rcp(eb);
                ddf[j] = DPP_BC(ef, 15); ddb[j] = DPP_BC(eb, 0);
                qtf[j] = q[j] * ef; ktf[j] = kf[j] * eif; khf[j] = ktf[j] * ddf[j];
                qtb[j] = q[j] * eb; ktb[j] = kb[j] * eib; khb[j] = ktb[j] * ddb[j]; }
            bf16_t* rec = QTF + ((size_t)(tok * 8 + h) * 32 + (kk >> 2)) * 16;
            { u32x4 w; w.x = cvt_pk_bf16(qtf[0], qtf[1]); w.y = cvt_pk_bf16(qtf[2], qtf[3]); w.z = cvt_pk_bf16(ktf[0], ktf[1]); w.w = cvt_pk_bf16(ktf[2], ktf[3]); *(u32x4*)rec = w; }
            { u32x4 w; w.x = cvt_pk_bf16(qtb[0], qtb[1]); w.y = cvt_pk_bf16(qtb[2], qtb[3]); w.z = cvt_pk_bf16(ktb[0], ktb[1]); w.w = cvt_pk_bf16(ktb[2], ktb[3]); *(u32x4*)(rec + 8) = w; }
            const size_t to = (cg * 128 + kk + (fr & 3)) * 16 + (fr & ~3);
            { unsigned w0 = cvt_pk_bf16(khf[0], khf[1]), w1 = cvt_pk_bf16(khf[2], khf[3]); quad_transpose_pk(w0, w1, fr & 3); u32x2 w; w.x = w0; w.y = w1; *(u32x2*)(KHTF + to) = w; }
            { unsigned w0 = cvt_pk_bf16(khb[0], khb[1]), w1 = cvt_pk_bf16(khb[2], khb[3]); quad_transpose_pk(w0, w1, fr & 3); u32x2 w; w.x = w0; w.y = w1; *(u32x2*)(KHTB + to) = w; }
            { unsigned w0 = cvt_pk_bf16(v4[0], v4[1]), w1 = cvt_pk_bf16(v4[2], v4[3]); quad_transpose_pk(w0, w1, fr & 3); u32x2 w; w.x = w0; w.y = w1; *(u32x2*)(VT + to) = w; }
            if (fr == 15) *(f32x4*)(DDF + cg * 128 + kk) = ddf;
            if (fr == 0) *(f32x4*)(DDB + cg * 128 + kk) = ddb;
        }
    }
};
struct EpiFour1 {
    bf16_t* ZT; const float* ssp; const float* sw; LAS unsigned char* lds;
    static constexpr bool PERM = true;
    template <class Sched> __device__ __forceinline__ void prepare(const Sched& S, LAS unsigned char* l, int tid) const { prep_rstd(l, ssp, S, true, tid); }
    __device__ __forceinline__ void operator()(const AccT& acc, const GUnit& u, int ui, int wr, int wc, int fr, int fq) const {
        const LAS float* R = (const LAS float*)(lds + RSTD_OFF) + ui * 256;
        const int cs = u.row0 >> 10;
        const float* swc = sw + cond_of_row(u.col0) * 2048 + u.row0 + wr * 64 + fr;
#pragma unroll
        for (int bj = 0; bj < 2; ++bj) {
            const int tl = bj * 128 + wc * 32 + 8 * fq, tok = u.col0 + tl;
            const f32x4 rs0 = *(const LAS f32x4*)(R + tl), rs1 = *(const LAS f32x4*)(R + tl + 4);
            int off;
            if (tok < NCTX) off = (tok >> 8) * 512 + cs * 256 + (tok & 255);
            else { const int tt = tok - NCTX; off = 8192 + (tt >> 10) * 2048 + cs * 1024 + (tt & 1023); }
#pragma unroll
            for (int ai = 0; ai < 2; ++ai)
#pragma unroll
                for (int m = 0; m < 4; ++m) {
                    const int nrow = (u.row0 & 1023) + ai * 128 + wr * 64 + m * 16 + fr;
                    const float sh = swc[ai * 128 + m * 16];
                    const f32x4 v0 = acc[ai][bj][m][0] * rs0 + sh, v1 = acc[ai][bj][m][1] * rs1 + sh;
                    u32x4 w; w.x = cvt_pk_bf16(v0[0], v0[1]); w.y = cvt_pk_bf16(v0[2], v0[3]); w.z = cvt_pk_bf16(v1[0], v1[1]); w.w = cvt_pk_bf16(v1[2], v1[3]);
                    *(u32x4*)(ZT + (size_t)nrow * 16384 + off) = w;
                }
        }
    }
};
struct EpiBf16 {
    bf16_t* O; int ldc;
    static constexpr bool PERM = false;
    template <class Sched> __device__ __forceinline__ void prepare(const Sched&, LAS unsigned char*, int) const {}
    __device__ __forceinline__ void operator()(const AccT& acc, const GUnit& u, int ui, int wr, int wc, int fr, int fq) const {
        bf16_t* base = O + (size_t)u.aux;
        const int cbase = u.col0 + wc * 32 + 4 * fq;
#pragma unroll
        for (int ai = 0; ai < 2; ++ai)
#pragma unroll
            for (int m = 0; m < 4; ++m) {
                bf16_t* pr = base + (size_t)(u.row0 + ai * 128 + wr * 64 + m * 16 + fr) * ldc + cbase;
#pragma unroll
                for (int bj = 0; bj < 2; ++bj)
#pragma unroll
                    for (int n = 0; n < 2; ++n) { const f32x4 v = acc[ai][bj][m][n]; u32x2 w; w.x = cvt_pk_bf16(v[0], v[1]); w.y = cvt_pk_bf16(v[2], v[3]); *(u32x2*)(pr + bj * 128 + n * 16) = w; }
            }
    }
};
struct GenSched {
    const char* A; const char* A2; const char* B; int lda, ldb, nM, nN, nwg, G, c, nt, mode;
    __device__ __forceinline__ void init(int mode_, const void* A_, const void* A2_, int lda_, const void* B_, int ldb_, int M, int N, int K, int G_, int c_) {
        mode = mode_; A = (const char*)A_; A2 = (const char*)A2_; B = (const char*)B_; lda = lda_; ldb = ldb_; nM = M / 256; nN = N / 256; nwg = (mode_ == 0 || mode_ == 7 || mode_ == 8) ? nM * nN : mode_ == 1 ? 128 : mode_ == 2 ? 32 : mode_ == 5 ? 512 : 256; G = G_; c = c_; nt = K / 64; }
    __device__ __forceinline__ bool next(int i, GUnit& u) const {
        const int L = i * G + c; if (L >= nwg) return false;
        u.aux = 0;
        if (mode == 0 || mode == 7 || mode == 8) {
            if (mode == 7 && i > 0) return false;
            int half = 0; int wgid = L; if (mode == 8) { if (i > 0) return false; half = L & 1; wgid = 256 + (L >> 1); if (wgid >= nM * nN) return false; } { const int q = nwg / 8, r = nwg % 8, xcd = wgid % 8, off = wgid / 8; wgid = (xcd < r ? xcd * (q + 1) : r * (q + 1) + (xcd - r) * q) + off; }
            const int nig = 8 * nN, gid = wgid / nig, fm = gid * 8, gsz = (nM - fm) < 8 ? (nM - fm) : 8;
            const int pm = fm + ((wgid % nig) % gsz), pn = (wgid % nig) / gsz;
            u.A = A + (size_t)pm * 256 * lda * 2; u.B = B + (size_t)(pn * 256 + half * 128) * ldb * 2; u.nt = nt; u.row0 = pm * 256; u.col0 = pn * 256 + half * 128;
        } else if (mode == 1) {
            if (L < 64) { const int b = L >> 4, pm = (L >> 2) & 3, pn = L & 3;
                u.A = A + (size_t)pm * 256 * 2048 * 2; u.B = B + ((size_t)pn * 256 * 16384 + 8192 + b * 2048) * 2; u.nt = 32; u.row0 = NCTX + b * 1024 + pm * 256; u.col0 = pn * 256; }
            else { const int l = L - 64, b = l >> 2, pn = l & 3;
                u.A = A2; u.B = B + ((size_t)pn * 256 * 16384 + b * 512) * 2; u.nt = 8; u.row0 = b * 256; u.col0 = pn * 256; }
        } else if (mode == 5) {
            int wgid = L; { const int xcd = wgid % 8, off = wgid / 8; wgid = xcd * 64 + off; }
            const int gid = wgid >> 7, r = wgid & 127, pm = gid * 8 + (r & 7), pn = r >> 3;
            u.A = A + (size_t)pm * 256 * lda * 2; u.B = B + (size_t)pn * 256 * ldb * 2; u.nt = nt; u.row0 = pm * 256; u.col0 = pn * 256;
        } else if (mode == 6) {
            const int wgid = (L & 7) * 32 + (L >> 3), pm = wgid >> 3, pn = wgid & 7;
            u.A = A + (size_t)pm * 256 * lda * 2; u.B = B + (size_t)(4096 + pn * 128) * ldb * 2; u.nt = nt; u.row0 = pm * 256; u.col0 = 4096 + pn * 128;
        } else if (mode == 3) {
            const int wgid = (L & 7) * 32 + (L >> 3), pm = wgid >> 3, pn = wgid & 7;
            u.A = A + (size_t)pm * 256 * lda * 2; u.B = B + (size_t)pn * 128 * ldb * 2; u.nt = nt; u.row0 = pm * 256; u.col0 = pn * 128;
        } else if (mode == 4) {
            if (L < 128) { const int b = L >> 5, pm = (L >> 3) & 3, pn = L & 7;
                u.A = A + (size_t)pm * 256 * 2048 * 2; u.B = B + ((size_t)pn * 128 * 16384 + 8192 + b * 2048) * 2; u.nt = 32; u.row0 = NCTX + b * 1024 + pm * 256; u.col0 = pn * 128; }
            else { const int l = L - 128, b = l >> 3, pn = l & 7;
                u.A = A2; u.B = B + ((size_t)pn * 128 * 16384 + b * 512) * 2; u.nt = 8; u.row0 = b * 256; u.col0 = pn * 128; }
        } else {
            const int g = L >> 3, cs = (L >> 2) & 1, pm = L & 3;
            u.A = A + ((size_t)pm * 256 * 1024 + g * 256) * 2; u.B = B + (size_t)cs * 256 * 2; u.nt = nt;
            u.row0 = pm * 256; u.col0 = 0; u.aux = cs * 1024 * 1024 + g * 256;
        }
        return true;
    }
};
struct Args {
    const float* in[23];
    float* out; unsigned char* ws;
    int ph_lo, ph_hi; float lam_init0, lam_init1; int pad0, pad1;
};
typedef const __attribute__((address_space(4))) Args* ArgP;
enum { I_XP = 0, I_XS, I_CK, I_CV, I_ST, I_C, I_CCTX, I_WADA, I_BADA, I_GMIX, I_GFFN, I_WQKV, I_LAM, I_GSUB, I_WOA, I_WINR, I_LBL, I_GOUT, I_WOR, I_WFOUR, I_WFI, I_WFO, I_GFIN };

__device__ __forceinline__ void tr_load(const float* W, int N, int item, int lane, f32x4 (&v)[8]) {
    const int nblk = N / 32, kb = item / nblk, nb = item % nblk;
    const float* src = W + (size_t)(64 * kb + 8 * (lane >> 3)) * N + 32 * nb + (lane & 7) * 4;
#pragma unroll
    for (int i = 0; i < 8; ++i) v[i] = __builtin_nontemporal_load((const f32x4*)(src + (size_t)i * N));
}
template <class RowMap>
__device__ __forceinline__ void tr_finish(const f32x4 (&v)[8], int K, int N, bf16_t* WT, const RowMap& rowmap, int item, int lane) {
    const int nblk = N / 32, kb = item / nblk, nb = item % nblk, k0 = 64 * kb + 8 * (lane >> 3), n0 = 32 * nb + (lane & 7) * 4;
#pragma unroll
    for (int j = 0; j < 4; ++j) {
        u32x4 o; o.x = cvt_pk_bf16(v[0][j], v[1][j]); o.y = cvt_pk_bf16(v[2][j], v[3][j]); o.z = cvt_pk_bf16(v[4][j], v[5][j]); o.w = cvt_pk_bf16(v[6][j], v[7][j]);
        *(u32x4*)(WT + (size_t)rowmap(n0 + j) * K + k0) = o; }
}
template <class RowMap>
__device__ __forceinline__ void transpose_item(const float* W, int K, int N, bf16_t* WT, const RowMap& rowmap, LAS float* scr, int item, int lane) {
    f32x4 v[8]; tr_load(W, N, item, lane, v); tr_finish(v, K, N, WT, rowmap, item, lane);
}
struct RowHin { __device__ __forceinline__ int operator()(int s) const { const int sec = s >> 10, ch = s & 1023; if (sec == 2) return 4096 + ch;
    const int t = ch >> 6, cl = ch & 63, bj = sec >= 3 ? 1 : 0, n = (sec == 1 || sec == 4) ? 1 : 0; return 256 * t + 128 * bj + 32 * (cl >> 4) + 16 * n + (cl & 15); } };
struct RowQKV { __device__ __forceinline__ int operator()(int s) const { if (s < 2048) return s; const int p = s & 31; return (s & ~31) + 16 * ((p >> 2) & 1) + 4 * (p >> 3) + (p & 3); } };
struct RowId { __device__ __forceinline__ int operator()(int n) const { return n; } };
struct RowFFN { __device__ __forceinline__ int operator()(int s) const { const int n = s >= DFF ? 1 : 0, a = s - n * DFF; return 256 * (a >> 7) + 128 * n + (a & 127); } };

__device__ __forceinline__ void cache_convert(ArgP a, int j, int gw, int ngw, int lane) {
    bf16_t* KB = (bf16_t*)(a->ws + WS_KB); bf16_t* VB = (bf16_t*)(a->ws + WS_VB);
    for (int it = gw; it < 2 * 4 * 512; it += ngw) {
        const int kv = it >> 11, r = it & 2047, b = r >> 9, s = r & 511;
        const float* src = a->in[kv ? I_CV : I_CK] + ((size_t)(b * 2 + j) * 512 + s) * 1024;
        bf16_t* dst = (kv ? VB : KB) + (size_t)(NCTX + b * 1536 + s) * 1024;
#pragma unroll
        for (int q = 0; q < 2; ++q) { const f32x8 v = *(const f32x8*)(src + q * 512 + lane * 8);
            u32x4 w; w.x = cvt_pk_bf16(v[0], v[1]); w.y = cvt_pk_bf16(v[2], v[3]); w.z = cvt_pk_bf16(v[4], v[5]); w.w = cvt_pk_bf16(v[6], v[7]);
            if (kv) *(u32x4*)(dst + q * 512 + lane * 8) = w;
            else { const int d0 = q * 512 + lane * 8, p0 = d0 & 31, n = p0 >> 4, f0 = (p0 & 15) >> 2;
                bf16_t* g = dst + (d0 & ~31);
                u32x2 lo, hi; lo.x = w.x; lo.y = w.y; hi.x = w.z; hi.y = w.w;
                *(u32x2*)(g + 8 * f0 + 4 * n) = lo; *(u32x2*)(g + 8 * (f0 + 1) + 4 * n) = hi; } }
    }
}

__device__ __forceinline__ void deferred_convert(ArgP a, int set, LAS unsigned char* lds, int widx, int nw);
__device__ __forceinline__ void phase_prologue(ArgP a, LAS unsigned char* lds, int G, int bid) {
    const int tid = tid_opaque(), lane = tid & 63, wave = __builtin_amdgcn_readfirstlane(tid >> 6);
    const int gw = bid * NWAVES + wave, ngw = G * NWAVES, gt = bid * NTHREADS + tid, ngt = G * NTHREADS;
    {
        LAS float* SC = (LAS float*)lds;
        LAS float* RED = (LAS float*)(lds + 20480);
        for (int i = tid; i < 5 * 1024; i += NTHREADS) { const int cnd = i >> 10, k = i & 1023; const float x = cnd == 0 ? a->in[I_CCTX][k] : a->in[I_C][(cnd - 1) * 1024 + k]; SC[i] = silu_f(x); }
        __syncthreads();
        float* mod = (float*)(a->ws + WS_MOD);
        for (int it = bid; it < 4 * 48; it += G) {
            const int l = it / 48, cg = it % 48;
            const int kh = lane >> 5, c4 = (lane & 31) * 4;
            const float* w = a->in[I_WADA] + (size_t)l * 1024 * 6144 + (size_t)(wave * 128 + 64 * kh) * 6144 + cg * 128 + c4;
            f32x4 acc[5];
#pragma unroll
            for (int c = 0; c < 5; ++c) acc[c] = (f32x4){0.f, 0.f, 0.f, 0.f};
#pragma unroll 1
            for (int k0 = 0; k0 < 64; k0 += 16) {
                f32x4 wv[16];
#pragma unroll
                for (int kk = 0; kk < 16; ++kk) wv[kk] = __builtin_nontemporal_load((const f32x4*)(w + (size_t)(k0 + kk) * 6144));
#pragma unroll
                for (int c = 0; c < 5; ++c) {
#pragma unroll
                    for (int k4 = 0; k4 < 4; ++k4) { const f32x4 sc = *(const LAS f32x4*)(SC + c * 1024 + wave * 128 + 64 * kh + k0 + 4 * k4);
                        acc[c] += sc[0] * wv[4 * k4] + sc[1] * wv[4 * k4 + 1] + sc[2] * wv[4 * k4 + 2] + sc[3] * wv[4 * k4 + 3]; }
                }
            }
#pragma unroll
            for (int c = 0; c < 5; ++c) {
#pragma unroll
                for (int q = 0; q < 4; ++q) acc[c][q] += __shfl_xor(acc[c][q], 32);
                if (kh == 0) *(LAS f32x4*)(RED + (wave * 5 + c) * 128 + c4) = acc[c]; }
            __syncthreads();
            for (int i = tid; i < 5 * 128; i += NTHREADS) { const int c = i >> 7, col = i & 127; float s = 0.f;
#pragma unroll
                for (int wv2 = 0; wv2 < 8; ++wv2) s += RED[(wv2 * 5 + c) * 128 + col];
                mod[(size_t)(l * 5 + c) * 6144 + cg * 128 + col] = s + a->in[I_BADA][l * 6144 + cg * 128 + col]; }
            __syncthreads();
        }
    }
    if (bid >= 4 * 48) deferred_convert(a, 5, lds, (bid - 4 * 48) * NWAVES + wave, (G - 4 * 48) * NWAVES);
    deferred_convert(a, 6, lds, gw, ngw);
    {
        float* ropec = (float*)(a->ws + WS_ROPE); float* ropes = ropec + 1024;
        for (int i = gt; i < 1024; i += ngt) { const int pos = i >> 4, q = i & 15;
            float inv = (q & 3) == 0 ? 1.f : (q & 3) == 1 ? 0.56234132519f : (q & 3) == 2 ? 0.31622776602f : 0.17782794100f;
            inv *= (q >> 2) == 0 ? 1.f : (q >> 2) == 1 ? 0.1f : (q >> 2) == 2 ? 0.01f : 0.001f;
            const float ap = (float)pos * inv * 0.31830988618f;
            ropec[i] = cospif(ap); ropes[i] = sinpif(ap); }
        bf16_t* TC = (bf16_t*)(a->ws + WS_TC);
        for (int i = gt; i < 256 * 512; i += ngt) { const int c = i >> 9, k = i & 511, d = k & 255; const float ang = (float)((c * d) & 255) * (1.f / 128.f);
            const float v = (k < 256 ? cospif(ang) : sinpif(ang)) * 0.0625f; TC[c * 1024 + k] = (bf16_t)(cvt_pk_bf16(v, 0.f) & 0xffff); }
        bf16_t* C2 = (bf16_t*)(a->ws + WS_CS256);
        for (int i = gt; i < 256 * 512; i += ngt) { const int p = i >> 9, k = i & 511, t = k & 255; const float ang = (float)((p * t) & 255) * (1.f / 128.f);
            const float v = (k < 256 ? cospif(ang) : -sinpif(ang)) * 0.0625f; C2[p * 2048 + k] = (bf16_t)(cvt_pk_bf16(v, 0.f) & 0xffff); }
        bf16_t* C1 = (bf16_t*)(a->ws + WS_CS1024);
        for (int i = gt; i < 1024 * 2048; i += ngt) { const int p = i >> 11, k = i & 2047, t = k & 1023; const float ang = (float)((p * t) & 1023) * (1.f / 512.f);
            const float v = (k < 1024 ? cospif(ang) : -sinpif(ang)) * 0.03125f; C1[i] = (bf16_t)(cvt_pk_bf16(v, 0.f) & 0xffff); }
        float* lbv = (float*)(a->ws + WS_LBV);
        for (int i = gt; i < 2048; i += ngt) { const int d = i >> 10, k = i & 1023; const float* lg = a->in[I_LBL] + (size_t)d * 4096 + k;
            const float l0 = lg[0], l1 = lg[1024], l2 = lg[2048], l3 = lg[3072]; const float mx = fmaxf(fmaxf(l0, l1), fmaxf(l2, l3));
            const float e0 = __expf(l0 - mx), e1 = __expf(l1 - mx), e2 = __expf(l2 - mx), e3 = __expf(l3 - mx); lbv[i] = e1 / (e0 + e1 + e2 + e3); }
        if (gw < 2) { const int j = gw; const float* lp = a->in[I_LAM] + j * 256;
            float s1 = wave_sum(lp[lane] * lp[64 + lane]), s2 = wave_sum(lp[128 + lane] * lp[192 + lane]);
            if (lane == 0) ((float*)(a->ws + WS_LAM))[j] = __expf(s1) - __expf(s2) + (j == 0 ? a->lam_init0 : a->lam_init1); }
    }
    cache_convert(a, 0, gw, ngw, lane);
}

struct TrJob { const float* W; bf16_t* WT; int K, N, map, item; };
__device__ __forceinline__ bool tr_decode(ArgP a, int set, int it, TrJob& j) {
    constexpr int I_FI = 16 * 176, I_FO = 44 * 32, I_R = 16 * 160, I_O = 16 * 32, I_Q = 16 * 96;
    if (set == 3) {
        if (it < I_Q) { j.W = a->in[I_WQKV] + (size_t)1024 * 3072; j.WT = (bf16_t*)(a->ws + WS_WQKV) + (size_t)3072 * 1024; j.K = 1024; j.N = 3072; j.map = 3; j.item = it; return true; }
        it -= I_Q; if (it >= I_O) return false;
        j.W = a->in[I_WOA] + (size_t)1024 * 1024; j.WT = (bf16_t*)(a->ws + WS_WOA) + (size_t)1024 * 1024; j.K = 1024; j.N = 1024; j.map = 1; j.item = it; return true;
    }
    if (set == 6) {
        if (it < I_Q) { j.W = a->in[I_WQKV]; j.WT = (bf16_t*)(a->ws + WS_WQKV); j.K = 1024; j.N = 3072; j.map = 3; j.item = it; return true; }
        it -= I_Q;
        if (it < I_O) { j.W = a->in[I_WOA]; j.WT = (bf16_t*)(a->ws + WS_WOA); j.K = 1024; j.N = 1024; j.map = 1; j.item = it; return true; }
        it -= I_O;
        if (it < I_O) { j.W = a->in[I_WFOUR]; j.WT = (bf16_t*)(a->ws + WS_WFO); j.K = 1024; j.N = 1024; j.map = 1; j.item = it; return true; }
        it -= I_O;
        if (it < I_FI) { j.W = a->in[I_WFI]; j.WT = (bf16_t*)(a->ws + WS_WFI); j.K = 1024; j.N = 5632; j.map = 0; j.item = it; return true; }
        it -= I_FI; if (it >= I_FO) return false;
        j.W = a->in[I_WFO]; j.WT = (bf16_t*)(a->ws + WS_WFOUT); j.K = DFF; j.N = 1024; j.map = 1; j.item = it; return true;
    }
    if (set == 5) {
        if (it < I_R) { j.W = a->in[I_WINR]; j.WT = (bf16_t*)(a->ws + WS_WINR); j.K = 1024; j.N = 5120; j.map = 2; j.item = it; return true; }
        it -= I_R; if (it >= I_O) return false;
        j.W = a->in[I_WOR]; j.WT = (bf16_t*)(a->ws + WS_WOR); j.K = 1024; j.N = 1024; j.map = 1; j.item = it; return true;
    }
    const int l = set + 1;
    if (it < I_FI) { j.W = a->in[I_WFI] + (size_t)l * 1024 * 5632; j.WT = (bf16_t*)(a->ws + WS_WFI) + (size_t)l * 5632 * 1024; j.K = 1024; j.N = 5632; j.map = 0; j.item = it; return true; }
    it -= I_FI;
    if (it < I_FO) { j.W = a->in[I_WFO] + (size_t)l * DFF * 1024; j.WT = (bf16_t*)(a->ws + WS_WFOUT) + (size_t)l * 1024 * DFF; j.K = DFF; j.N = 1024; j.map = 1; j.item = it; return true; }
    return false;
}
__device__ __forceinline__ void deferred_convert(ArgP a, int set, LAS unsigned char* lds, int widx, int nw) {
    const int tid = tid_opaque(), lane = tid & 63, wave = __builtin_amdgcn_readfirstlane(tid >> 6);
    LAS float* scr = (LAS float*)(lds + wave * 16384);
    const int ni = set == 6 ? 16 * 96 + 2 * 16 * 32 + 16 * 176 + 44 * 32 : set == 5 ? 16 * 160 + 16 * 32 : set == 3 ? 16 * 96 + 16 * 32 : 16 * 176 + 44 * 32;
#define FW_FIN(v, j, ok) do { if (ok) { if (j.map == 0) tr_finish(v, j.K, j.N, j.WT, RowFFN(), j.item, lane); else if (j.map == 1) tr_finish(v, j.K, j.N, j.WT, RowId(), j.item, lane); \
        else if (j.map == 2) tr_finish(v, j.K, j.N, j.WT, RowHin(), j.item, lane); else tr_finish(v, j.K, j.N, j.WT, RowQKV(), j.item, lane); } } while (0)
    for (int it = widx; it < ni; it += 5 * nw) {
        f32x4 v0[8], v1[8], v2[8], v3[8], v4[8]; TrJob j0, j1, j2, j3, j4;
        const bool k0 = tr_decode(a, set, it, j0), k1 = tr_decode(a, set, it + nw, j1), k2 = tr_decode(a, set, it + 2 * nw, j2);
        const bool k3 = tr_decode(a, set, it + 3 * nw, j3), k4 = tr_decode(a, set, it + 4 * nw, j4);
        if (k0) tr_load(j0.W, j0.N, j0.item, lane, v0); if (k1) tr_load(j1.W, j1.N, j1.item, lane, v1); if (k2) tr_load(j2.W, j2.N, j2.item, lane, v2);
        if (k3) tr_load(j3.W, j3.N, j3.item, lane, v3); if (k4) tr_load(j4.W, j4.N, j4.item, lane, v4);
        FW_FIN(v0, j0, k0); FW_FIN(v1, j1, k1); FW_FIN(v2, j2, k2); FW_FIN(v3, j3, k3); FW_FIN(v4, j4, k4);
    }
#undef FW_FIN
}

__device__ __forceinline__ void phase_first_norm(ArgP a, int gw, int ngw, int lane) {
    bf16_t* X = (bf16_t*)(a->ws + WS_X); bf16_t* XA = (bf16_t*)(a->ws + WS_H); float* ssp = (float*)(a->ws + WS_SSP);
    const float* mod = (const float*)(a->ws + WS_MOD); const float* gm = a->in[I_GMIX];
    for (int r = gw; r < MTOK; r += ngw) {
        const float* xr = r < NCTX ? a->in[I_XP] + (size_t)r * 1024 : a->in[I_XS] + (size_t)(r - NCTX) * 1024;
        const float* sc = mod + (size_t)cond_of_row(r) * 6144 + 1024;
        float s = 0.f;
#pragma unroll
        for (int j = 0; j < 4; ++j) {
            const int c = j * 256 + lane * 4;
            const f32x4 v = *(const f32x4*)(xr + c); s += (v.x * v.x + v.y * v.y) + (v.z * v.z + v.w * v.w);
            const f32x4 y = v * (*(const f32x4*)(gm + c) * (1.f + *(const f32x4*)(sc + c)));
            u32x2 w; w.x = cvt_pk_bf16(y[0], y[1]); w.y = cvt_pk_bf16(y[2], y[3]);
            *(u32x2*)(XA + (size_t)r * 1024 + c) = w; { u32x2 xw; xw.x = cvt_pk_bf16(v[0], v[1]); xw.y = cvt_pk_bf16(v[2], v[3]); *(u32x2*)(X + (size_t)r * 1024 + c) = xw; }
        }
        s = wave_sum(s);
        if (lane < SSPN) ssp[(size_t)r * SSPN + lane] = lane == 0 ? s : 0.f;
    }
}
__device__ __forceinline__ void phase_final_rows(ArgP a, int row0, int wave, int lane) {
    const bf16_t* X = (const bf16_t*)(a->ws + WS_X); const float* g = a->in[I_GFIN]; const float* ssp = (const float*)(a->ws + WS_SSP) + 8ull * 8192 * SSPN;
    float sv[4];
#pragma unroll
    for (int q = 0; q < 4; ++q) { const int r = row0 + wave * 4 + q; sv[q] = lane < SSPN ? ssp[(size_t)r * SSPN + lane] : 0.f; }
#pragma unroll
    for (int q = 0; q < 4; ++q) {
        const int r = row0 + wave * 4 + q; const bf16_t* xr = X + (size_t)r * 1024;
        const float rstd = rsqrtf(wave_sum(sv[q]) * (1.f / 1024.f) + EPS);
#pragma unroll
        for (int j = 0; j < 4; ++j) { const int c = j * 256 + lane * 4; const u32x2 xw = *(const u32x2*)(xr + c); const f32x4 xv = {bflo(xw.x), bfhi(xw.x), bflo(xw.y), bfhi(xw.y)};
            *(f32x4*)(a->out + (size_t)r * 1024 + c) = xv * rstd * *(const f32x4*)(g + c); }
    }
}
__device__ __forceinline__ void phase_final(ArgP a, int gw, int ngw, int lane) {
    const bf16_t* X = (const bf16_t*)(a->ws + WS_X); const float* g = a->in[I_GFIN]; const float* ssp = (const float*)(a->ws + WS_SSP) + 8ull * 8192 * SSPN;
    for (int r = gw; r < MTOK; r += ngw) {
        const bf16_t* xr = X + (size_t)r * 1024;
        float s = lane < SSPN ? ssp[(size_t)r * SSPN + lane] : 0.f;
        const float rstd = rsqrtf(wave_sum(s) * (1.f / 1024.f) + EPS);
#pragma unroll
        for (int j = 0; j < 4; ++j) { const int c = j * 256 + lane * 4; const u32x2 xw = *(const u32x2*)(xr + c); const f32x4 xv = {bflo(xw.x), bfhi(xw.x), bflo(xw.y), bfhi(xw.y)};
            *(f32x4*)(a->out + (size_t)r * 1024 + c) = xv * rstd * *(const f32x4*)(g + c); }
    }
}
__device__ __forceinline__ void phase_an(ArgP a, int gt, int ngt) {
    float* an = (float*)(a->ws + WS_AN); const float* mod = (const float*)(a->ws + WS_MOD);
    for (int i = gt; i < 8 * 5 * 1024; i += ngt) { const int nidx = i / 5120, c = (i / 1024) % 5, k = i & 1023, l = nidx >> 1, wh = nidx & 1;
        an[i] = a->in[wh ? I_GFFN : I_GMIX][l * 1024 + k] * (1.f + mod[(size_t)(l * 5 + c) * 6144 + (wh ? 4 : 1) * 1024 + k]); }
}
__device__ __forceinline__ void phase_sw(ArgP a, LAS unsigned char* lds, unsigned mask, int gw, int ngw, int tid, int lane) {
    LAS float* SH = (LAS float*)lds;
    const float* mod = (const float*)(a->ws + WS_MOD); float* swb = (float*)(a->ws + WS_SW);
    for (int nidx = 0; nidx < 8; ++nidx) {
        if (!((mask >> nidx) & 1)) continue;
        const int l = nidx >> 1, wh = nidx & 1, N = sw_n(nidx);
        const bf16_t* W = nidx == 0 ? (const bf16_t*)(a->ws + WS_WQKV) : nidx == 6 ? (const bf16_t*)(a->ws + WS_WQKV) + 3072ull * 1024 : nidx == 2 ? (const bf16_t*)(a->ws + WS_WINR)
                        : nidx == 4 ? (const bf16_t*)(a->ws + WS_WCS) : (const bf16_t*)(a->ws + WS_WFI) + (size_t)l * 5632 * 1024;
        __syncthreads();
        for (int i = tid; i < 5 * 1024; i += NTHREADS) SH[i] = mod[(size_t)(l * 5 + (i >> 10)) * 6144 + (wh ? 3 : 0) * 1024 + (i & 1023)];
        __syncthreads();
        float* sw = swb + sw_off(nidx);
        for (int n0 = gw; n0 < N; n0 += 4 * ngw) {
            u32x4 wa[4], wb[4];
#pragma unroll
            for (int q = 0; q < 4; ++q) { const int n = n0 + q * ngw;
                if (n < N) { wa[q] = *(const u32x4*)(W + (size_t)n * 1024 + lane * 8); wb[q] = *(const u32x4*)(W + (size_t)n * 1024 + 512 + lane * 8); } }
#pragma unroll
            for (int q = 0; q < 4; ++q) { const int n = n0 + q * ngw;
                if (n < N) {
                    const u32x4 w0 = wa[q], w1 = wb[q];
                    float wf[16];
#pragma unroll
                    for (int i = 0; i < 4; ++i) { wf[2 * i] = bflo(w0[i]); wf[2 * i + 1] = bfhi(w0[i]); wf[8 + 2 * i] = bflo(w1[i]); wf[8 + 2 * i + 1] = bfhi(w1[i]); }
                    float acc[5];
#pragma unroll
                    for (int c = 0; c < 5; ++c) {
                        const f32x4 s0 = *(const LAS f32x4*)(SH + c * 1024 + lane * 8), s1 = *(const LAS f32x4*)(SH + c * 1024 + lane * 8 + 4);
                        const f32x4 s2 = *(const LAS f32x4*)(SH + c * 1024 + 512 + lane * 8), s3 = *(const LAS f32x4*)(SH + c * 1024 + 512 + lane * 8 + 4);
                        float t = 0.f;
#pragma unroll
                        for (int i = 0; i < 4; ++i) t += wf[i] * s0[i] + wf[4 + i] * s1[i] + wf[8 + i] * s2[i] + wf[12 + i] * s3[i];
                        acc[c] = wave_sum(t);
                    }
                    if (lane < 5) sw[(size_t)lane * N + n] = lane == 0 ? acc[0] : lane == 1 ? acc[1] : lane == 2 ? acc[2] : lane == 3 ? acc[3] : acc[4];
                } }
        }
    }
    __syncthreads();
}
__device__ __forceinline__ void phase_hgrn_final(ArgP a, int gw, int ngw, int lane) {
    const bf16_t* OF = (const bf16_t*)(a->ws + WS_OF); const bf16_t* OB = (const bf16_t*)(a->ws + WS_OB); const bf16_t* GH = (const bf16_t*)(a->ws + WS_GH);
    bf16_t* O = (bf16_t*)(a->ws + WS_O); const float* go = a->in[I_GOUT];
    for (int r = gw; r < MTOK; r += ngw) {
        const size_t off = (size_t)r * 1024 + lane * 16;
        u32x4 f0 = *(const u32x4*)(OF + off), f1 = *(const u32x4*)(OF + off + 8), b0 = *(const u32x4*)(OB + off), b1 = *(const u32x4*)(OB + off + 8);
        u32x4 g0 = *(const u32x4*)(GH + off), g1 = *(const u32x4*)(GH + off + 8);
        float o[16], gt[16];
#pragma unroll
        for (int i = 0; i < 4; ++i) { o[2 * i] = bflo(f0[i]) + bflo(b0[i]); o[2 * i + 1] = bfhi(f0[i]) + bfhi(b0[i]); o[8 + 2 * i] = bflo(f1[i]) + bflo(b1[i]); o[8 + 2 * i + 1] = bfhi(f1[i]) + bfhi(b1[i]);
            gt[2 * i] = bflo(g0[i]); gt[2 * i + 1] = bfhi(g0[i]); gt[8 + 2 * i] = bflo(g1[i]); gt[8 + 2 * i + 1] = bfhi(g1[i]); }
        float s = 0.f;
#pragma unroll
        for (int i = 0; i < 16; ++i) s += o[i] * o[i];
        s += __shfl_xor(s, 1); s += __shfl_xor(s, 2); s += __shfl_xor(s, 4);
        const float rstd = rsqrtf(s * (1.f / 128.f) + EPS);
        const int vc = (lane & 7) * 16;
        u32x4 w0, w1;
#pragma unroll
        for (int i = 0; i < 4; ++i) {
            w0[i] = cvt_pk_bf16(o[2 * i] * rstd * go[vc + 2 * i] * gt[2 * i], o[2 * i + 1] * rstd * go[vc + 2 * i + 1] * gt[2 * i + 1]);
            w1[i] = cvt_pk_bf16(o[8 + 2 * i] * rstd * go[vc + 8 + 2 * i] * gt[8 + 2 * i], o[8 + 2 * i + 1] * rstd * go[vc + 8 + 2 * i + 1] * gt[8 + 2 * i + 1]); }
        *(u32x4*)(O + off) = w0; *(u32x4*)(O + off + 8) = w1;
    }
}

namespace att {
constexpr int KVBLK = 64, LDQ = 1024;
constexpr float SCALE = 0.125f, THR = 8.f;
constexpr size_t SHM_V = KVBLK * 128 * 2, SHM_K = KVBLK * 128 * 2;
#define KSWZ(row, colB) ((row) * 256 + ((colB) ^ (((row) & 7) << 4)))
#define SBAR() __builtin_amdgcn_sched_barrier(0)
__device__ __forceinline__ int crow(int r, int hi) { return (r & 3) + 8 * (r >> 2) + 4 * hi; }
__device__ __forceinline__ unsigned cvtpk(float lo, float hi) { unsigned r; asm volatile("v_cvt_pk_bf16_f32 %0, %1, %2" : "=v"(r) : "v"(lo), "v"(hi)); return r; }
__device__ __forceinline__ void partialSM(f32x16& p0, f32x16& p1, float& m_reg, float& mn, float& alpha) {
  constexpr float C = SCALE * 1.4426950408889634f;
  float pmax = p0[0];
#pragma unroll
  for (int r = 1; r < 16; ++r) pmax = fmaxf(pmax, p0[r]);
#pragma unroll
  for (int r = 0; r < 16; ++r) pmax = fmaxf(pmax, p1[r]);
  { auto rr = __builtin_amdgcn_permlane32_swap(__float_as_uint(pmax), __float_as_uint(pmax), false, false);
    pmax = fmaxf(__uint_as_float(rr[0]), __uint_as_float(rr[1])); }
  if (__builtin_expect(__all(pmax - m_reg <= THR / SCALE), 1)) { mn = m_reg; alpha = 1.f; }
  else { mn = fmaxf(m_reg, pmax); alpha = __builtin_amdgcn_exp2f((m_reg - mn) * C); m_reg = mn; }
  float mnC = -mn * C;
#pragma unroll
  for (int r = 0; r < 16; ++r) p0[r] = fmaf(p0[r], C, mnC);
#pragma unroll
  for (int r = 0; r < 16; ++r) p1[r] = fmaf(p1[r], C, mnC);
#pragma unroll
  for (int r = 0; r < 16; ++r) p0[r] = __builtin_amdgcn_exp2f(p0[r]);
}
__device__ __forceinline__ void finishSM(f32x16& p0, f32x16& p1, float alpha, float& l_reg, bf16x8& pa0, bf16x8& pa1, bf16x8& pa2, bf16x8& pa3) {
#pragma unroll
  for (int r = 0; r < 16; ++r) p1[r] = __builtin_amdgcn_exp2f(p1[r]);
  float ps = 0;
#pragma unroll
  for (int r = 0; r < 16; ++r) ps += p0[r];
#pragma unroll
  for (int r = 0; r < 16; ++r) ps += p1[r];
  { auto rr = __builtin_amdgcn_permlane32_swap(__float_as_uint(ps), __float_as_uint(ps), false, false);
    ps = __uint_as_float(rr[0]) + __uint_as_float(rr[1]); }
  l_reg = l_reg * alpha + ps;
#define PK4(P, BASE, OUT) do { unsigned a0 = cvtpk(P[BASE + 0], P[BASE + 1]), a1 = cvtpk(P[BASE + 2], P[BASE + 3]);   \
    unsigned b0 = cvtpk(P[BASE + 4], P[BASE + 5]), b1 = cvtpk(P[BASE + 6], P[BASE + 7]);                              \
    auto r0 = __builtin_amdgcn_permlane32_swap(a0, b0, false, false); auto r1 = __builtin_amdgcn_permlane32_swap(a1, b1, false, false); \
    u32x4 w = {r0[0], r1[0], r0[1], r1[1]}; OUT = *reinterpret_cast<bf16x8*>(&w); } while (0)
  PK4(p0, 0, pa0); PK4(p0, 8, pa1); PK4(p1, 0, pa2); PK4(p1, 8, pa3);
#undef PK4
}
__device__ __forceinline__ void qkt(f32x16& p0, f32x16& p1, const bf16_t* Ks, const bf16x8* qr, int r32, int hi, int cc) {
  p0 = f32x16{}; p1 = f32x16{};
#pragma unroll
  for (int d0 = 0; d0 < 4; ++d0) { int cb = (cc * 64 + d0 * 16 + hi * 8) * 2;
    bf16x8 b0 = *reinterpret_cast<const bf16x8*>((const char*)Ks + KSWZ(r32, cb));
    bf16x8 b1 = *reinterpret_cast<const bf16x8*>((const char*)Ks + KSWZ(32 + r32, cb));
    p0 = __builtin_amdgcn_mfma_f32_32x32x16_bf16(b0, qr[d0], p0, 0, 0, 0);
    p1 = __builtin_amdgcn_mfma_f32_32x32x16_bf16(b1, qr[d0], p1, 0, 0, 0); }
}
__device__ __forceinline__ int v_st(int k, int c) { const int kk = (k & ~0xC) | ((k & 4) << 1) | ((k & 8) >> 1); return ((kk >> 3) * 4 + (c >> 5)) * 512 + ((kk & 7) * 32 + (c & 31)) * 2; }
__device__ __forceinline__ int v_rd_base(int lane) { return ((lane & 3) << 3) | (((lane >> 2) & 3) << 6) | (((lane >> 4) & 1) << 5) | (((lane >> 5) & 1) << 8); }
constexpr int v_rd_off(int d0, int ks, int half) { return d0 * 512 + ks * 4096 + half * 2048; }
template <int OFF> __device__ __forceinline__ s16x4 tr_read(int vb) {
  s16x4 r; asm volatile("ds_read_b64_tr_b16 %0, %1 offset:%2" : "=&v"(r) : "v"(vb), "i"(OFF) : "memory"); return r;
}
template <int D0> __device__ __forceinline__ void pv_one(f32x16& od, int vb, bf16x8 pa0, bf16x8 pa1, bf16x8 pa2, bf16x8 pa3) {
  const s16x4 l0 = tr_read<v_rd_off(D0, 0, 0)>(vb), h0 = tr_read<v_rd_off(D0, 0, 1)>(vb), l1 = tr_read<v_rd_off(D0, 1, 0)>(vb), h1 = tr_read<v_rd_off(D0, 1, 1)>(vb);
  const s16x4 l2 = tr_read<v_rd_off(D0, 2, 0)>(vb), h2 = tr_read<v_rd_off(D0, 2, 1)>(vb), l3 = tr_read<v_rd_off(D0, 3, 0)>(vb), h3 = tr_read<v_rd_off(D0, 3, 1)>(vb);
  asm volatile("s_waitcnt lgkmcnt(0)" ::: "memory"); SBAR();
#define PK(L, H) (bf16x8){L[0], L[1], L[2], L[3], H[0], H[1], H[2], H[3]}
  od = __builtin_amdgcn_mfma_f32_32x32x16_bf16(pa0, PK(l0, h0), od, 0, 0, 0);
  od = __builtin_amdgcn_mfma_f32_32x32x16_bf16(pa1, PK(l1, h1), od, 0, 0, 0);
  od = __builtin_amdgcn_mfma_f32_32x32x16_bf16(pa2, PK(l2, h2), od, 0, 0, 0);
  od = __builtin_amdgcn_mfma_f32_32x32x16_bf16(pa3, PK(l3, h3), od, 0, 0, 0);
#undef PK
}
__device__ __forceinline__ void pv_d0(f32x16* o, int vb, bf16x8 pa0, bf16x8 pa1, bf16x8 pa2, bf16x8 pa3) {
  pv_one<0>(o[0], vb, pa0, pa1, pa2, pa3); pv_one<1>(o[1], vb, pa0, pa1, pa2, pa3); pv_one<2>(o[2], vb, pa0, pa1, pa2, pa3); pv_one<3>(o[3], vb, pa0, pa1, pa2, pa3);
}
__device__ __forceinline__ void diff_attn_unit(const bf16_t* __restrict__ Qb, const bf16_t* __restrict__ Kh, const bf16_t* __restrict__ Vh, bf16_t* __restrict__ Ob,
                                               int seq, char* lds, float lam, const float* __restrict__ gsub, float oscale) {
  const int tid = tid_opaque(), wid = tid >> 6, lane = tid & 63, r32 = lane & 31, hi = lane >> 5;
  const int qblk = wid >> 1, cc = wid & 1;
  bf16_t* V_lds = (bf16_t*)lds; bf16_t* K_lds = (bf16_t*)(lds + 2 * SHM_V);
  float* ws = (float*)(lds + 2 * SHM_V + 2 * SHM_K) + wid * 64; float* li_l = ws; float* al_l = ws + 32;
  float m_reg = -1e30f, l_reg = 0; f32x16 o[4] = {}; bf16x8 qr[4];
  const bf16_t* Qw = Qb + (long)(qblk * 32 + r32) * LDQ + cc * 64 + hi * 8;
#pragma unroll
  for (int d0 = 0; d0 < 4; ++d0) qr[d0] = *reinterpret_cast<const bf16x8*>(Qw + d0 * 16);
  const int sr = tid >> 4, sc = (tid & 15) * 8, vst0 = v_st(sr, sc), vst1 = v_st(32 + sr, sc);
  const int vb0 = (int)(uintptr_t)V_lds + v_rd_base(lane);
  struct { bf16x8 vs0, vs1, ks0, ks1; } sr_[2];
#define SLOAD(i, k0) do { sr_[i].vs0 = *reinterpret_cast<const bf16x8*>(&Vh[(long)((k0) + sr) * LDQ + sc]); sr_[i].vs1 = *reinterpret_cast<const bf16x8*>(&Vh[(long)((k0) + 32 + sr) * LDQ + sc]); \
    sr_[i].ks0 = *reinterpret_cast<const bf16x8*>(&Kh[(long)((k0) + sr) * LDQ + sc]); sr_[i].ks1 = *reinterpret_cast<const bf16x8*>(&Kh[(long)((k0) + 32 + sr) * LDQ + sc]); } while (0)
#define SWRITE(b, i) do { *(bf16x8*)((char*)V_lds + (b) * SHM_V + vst0) = sr_[i].vs0;          \
    *(bf16x8*)((char*)V_lds + (b) * SHM_V + vst1) = sr_[i].vs1; int kc = sc * 2;               \
    *(bf16x8*)((char*)K_lds + (b) * SHM_K + KSWZ(sr, kc)) = sr_[i].ks0;                       \
    *(bf16x8*)((char*)K_lds + (b) * SHM_K + KSWZ(32 + sr, kc)) = sr_[i].ks1; } while (0)
#define SWAIT() asm volatile("s_waitcnt vmcnt(4)" ::: "memory")
#define RESC(a) do { if (__any((a) < 1.f)) { if (hi == 0) al_l[r32] = (a); asm volatile("s_waitcnt lgkmcnt(0)" ::: "memory"); \
    _Pragma("unroll") for (int d = 0; d < 4; ++d) _Pragma("unroll") for (int r = 0; r < 16; ++r) o[d][r] *= al_l[crow(r, hi)]; } } while (0)
  f32x16 pA0, pA1, pB0, pB1; float mnA, mnB, alA, alB; bf16x8 pa0, pa1, pa2, pa3; const int NT = seq / KVBLK;
  constexpr int SE = 0, SO = 1;
  SLOAD(SE, 0); asm volatile("s_waitcnt vmcnt(0)" ::: "memory"); SWRITE(0, SE); __syncthreads();
  qkt(pA0, pA1, K_lds, qr, r32, hi, cc); partialSM(pA0, pA1, m_reg, mnA, alA);
  SLOAD(SO, KVBLK); if (2 < NT) SLOAD(SE, 2 * KVBLK);
  SWAIT(); SWRITE(1, SO); __syncthreads();
  for (int j = 1; j + 1 < NT; j += 2) {
    SBAR(); qkt(pB0, pB1, (bf16_t*)((char*)K_lds + SHM_K), qr, r32, hi, cc);
    finishSM(pA0, pA1, alA, l_reg, pa0, pa1, pa2, pa3); SBAR();
    SLOAD(SO, (j + 2) * KVBLK); SBAR();
    pv_d0(o, vb0, pa0, pa1, pa2, pa3); partialSM(pB0, pB1, m_reg, mnB, alB);
    __syncthreads(); SWAIT(); SWRITE(0, SE);
    RESC(alB); __syncthreads();
    SBAR(); qkt(pA0, pA1, K_lds, qr, r32, hi, cc);
    finishSM(pB0, pB1, alB, l_reg, pa0, pa1, pa2, pa3); SBAR();
    if (j + 3 < NT) SLOAD(SE, (j + 3) * KVBLK); SBAR();
    pv_d0(o, vb0 + (int)SHM_V, pa0, pa1, pa2, pa3); partialSM(pA0, pA1, m_reg, mnA, alA);
    __syncthreads(); SWAIT(); SWRITE(1, SO);
    RESC(alA); __syncthreads();
  }
  SBAR(); qkt(pB0, pB1, (bf16_t*)((char*)K_lds + SHM_K), qr, r32, hi, cc);
  finishSM(pA0, pA1, alA, l_reg, pa0, pa1, pa2, pa3); SBAR();
  pv_d0(o, vb0, pa0, pa1, pa2, pa3); partialSM(pB0, pB1, m_reg, mnB, alB);
  __syncthreads(); RESC(alB);
  finishSM(pB0, pB1, alB, l_reg, pa0, pa1, pa2, pa3); SBAR();
  pv_d0(o, vb0 + (int)SHM_V, pa0, pa1, pa2, pa3);
  if (hi == 0) li_l[r32] = l_reg; asm volatile("s_waitcnt lgkmcnt(0)" ::: "memory");
  float rli[16];
#pragma unroll
  for (int r = 0; r < 16; ++r) rli[r] = __builtin_amdgcn_rcpf(li_l[crow(r, hi)]);
  __syncthreads();
  float* xch = (float*)lds + qblk * (32 * 128);
  if (cc == 1) {
#pragma unroll
    for (int r = 0; r < 16; ++r)
#pragma unroll
      for (int d0 = 0; d0 < 4; ++d0) xch[crow(r, hi) * 128 + d0 * 32 + r32] = lam * o[d0][r] * rli[r];
  }
  __syncthreads();
  if (cc == 0) {
    float gs[4];
#pragma unroll
    for (int d0 = 0; d0 < 4; ++d0) gs[d0] = gsub[d0 * 32 + r32] * oscale;
#pragma unroll
    for (int r = 0; r < 16; ++r) {
      float ss = 0.f;
#pragma unroll
      for (int d0 = 0; d0 < 4; ++d0) { const float v = o[d0][r] * rli[r] - xch[crow(r, hi) * 128 + d0 * 32 + r32]; o[d0][r] = v; ss += v * v; }
      ss += __shfl_xor(ss, 1); ss += __shfl_xor(ss, 2); ss += __shfl_xor(ss, 4); ss += __shfl_xor(ss, 8); ss += __shfl_xor(ss, 16);
      const float rs = rsqrtf(ss * (1.f / 128.f) + EPS);
      bf16_t* orow = Ob + (long)(qblk * 32 + crow(r, hi)) * LDQ;
#pragma unroll
      for (int d0 = 0; d0 < 4; ++d0) orow[d0 * 32 + r32] = (bf16_t)(cvtpk(o[d0][r] * rs * gs[d0], 0.f) & 0xffff);
    }
  }
  __syncthreads();
#undef SLOAD
#undef SWRITE
#undef SWAIT
#undef RESC
}
#undef KSWZ
#undef SBAR
constexpr int LDS_NEED = 2 * SHM_V + 2 * SHM_K + 8 * 64 * 4;
}

__device__ __forceinline__ void phase_attn(ArgP a, int j, char* lds, int G, int bid) {
    const bf16_t* Q = (const bf16_t*)(a->ws + WS_Q); const bf16_t* KB = (const bf16_t*)(a->ws + WS_KB); const bf16_t* VB = (const bf16_t*)(a->ws + WS_VB);
    bf16_t* O = (bf16_t*)(a->ws + WS_O);
    const float lam = ((const float*)(a->ws + WS_LAM))[j];
    const float oscale = 1.f - (j == 0 ? a->lam_init0 : a->lam_init1);
    const float* gsub = a->in[I_GSUB] + j * 128;
    for (int u0 = bid; u0 < 512; u0 += G) {
        const int u = (u0 & 256) + (u0 & 7) * 32 + ((u0 & 255) >> 3);
        int qrow, krow, seq, h;
        if (u < 256) { const int b = u >> 6; h = (u >> 3) & 7; const int qb = u & 7; qrow = NCTX + b * 1024 + qb * 128; krow = NCTX + b * 1536; seq = 1536; }
        else { const int v = u - 256, b = v >> 4; h = (v >> 1) & 7; const int qb = v & 1; qrow = b * 256 + qb * 128; krow = b * 256; seq = 256; }
        att::diff_attn_unit(Q + (size_t)qrow * 1024 + h * 128, KB + (size_t)krow * 1024 + h * 128, VB + (size_t)krow * 1024 + h * 128, O + (size_t)qrow * 1024 + h * 128,
                            seq, lds, lam, gsub, oscale);
    }
}

namespace hg {
constexpr int QT_OFF = 0, KT_OFF = 64 * 272, KHT_OFF = 2 * 64 * 272, VT_OFF = KHT_OFF + 128 * 144, DD_OFF = VT_OFF + 128 * 144, LDS_NEED = DD_OFF + 4 * 128 * 4;
__device__ __forceinline__ s16x4 pk4(f32x4 v) { u32x2 w; w.x = cvt_pk_bf16(v[0], v[1]); w.y = cvt_pk_bf16(v[2], v[3]); return __builtin_bit_cast(s16x4, w); }
struct Stage { u32x4 qk[4], kh[2], v[2], d; };
__device__ __forceinline__ void scan_unit(int tok0, int n, int h, int dir, int vbase, int nwv, const bf16_t* __restrict__ QK, const bf16_t* __restrict__ KHT, const bf16_t* __restrict__ VT,
                                          const float* __restrict__ DD, const float* __restrict__ s0, float* __restrict__ sout, bf16_t* __restrict__ Od, LAS unsigned char* lds) {
    const int tid = tid_opaque(), lane = tid & 63, wv = __builtin_amdgcn_readfirstlane(tid >> 6), l15 = lane & 15, g = lane >> 4;
    const bool act = wv < nwv;
    const int vc = vbase + 16 * wv + l15;
    f32x4 S[8];
#pragma unroll
    for (int i = 0; i < 8; ++i) {
        if (s0 && act) {
#pragma unroll
            for (int r = 0; r < 4; ++r) S[i][r] = s0[(size_t)(16 * i + 4 * g + r) * 128 + vc]; }
        else S[i] = (f32x4){0.f, 0.f, 0.f, 0.f};
    }
    const int nms = n >> 6;
    Stage st;
#define HG_LOAD(msn) do { const int tb_ = tok0 + (msn) * 64; \
        _Pragma("unroll") for (int i_ = 0; i_ < 4; ++i_) { const int p_ = tid + 512 * i_; \
            st.qk[i_] = *(const u32x4*)(QK + ((size_t)((tb_ + (p_ >> 5)) * 8 + h) * 32 + (p_ & 31)) * 16 + dir * 8); } \
        _Pragma("unroll") for (int i_ = 0; i_ < 2; ++i_) { const int p_ = tid + 512 * i_; \
            const size_t to_ = ((size_t)(((tb_ >> 4) + (p_ >> 8)) * 8 + h) * 128 + ((p_ & 255) >> 1)) * 16 + (p_ & 1) * 8; st.kh[i_] = *(const u32x4*)(KHT + to_); st.v[i_] = *(const u32x4*)(VT + to_); } \
        if (tid < 128) st.d = *(const u32x4*)(DD + (size_t)(((tb_ >> 4) + (tid >> 5)) * 8 + h) * 128 + (tid & 31) * 4); } while (0)
#define HG_STORE() do { \
        _Pragma("unroll") for (int i_ = 0; i_ < 4; ++i_) { const int p_ = tid + 512 * i_; u32x2 lo_, hi_; lo_.x = st.qk[i_].x; lo_.y = st.qk[i_].y; hi_.x = st.qk[i_].z; hi_.y = st.qk[i_].w; \
            *(LAS u32x2*)(lds + QT_OFF + (p_ >> 5) * 272 + (p_ & 31) * 8) = lo_; *(LAS u32x2*)(lds + KT_OFF + (p_ >> 5) * 272 + (p_ & 31) * 8) = hi_; } \
        _Pragma("unroll") for (int i_ = 0; i_ < 2; ++i_) { const int p_ = tid + 512 * i_; \
            const int lo2_ = ((p_ & 255) >> 1) * 144 + ((p_ >> 8) * 16 + (p_ & 1) * 8) * 2; *(LAS u32x4*)(lds + KHT_OFF + lo2_) = st.kh[i_]; *(LAS u32x4*)(lds + VT_OFF + lo2_) = st.v[i_]; } \
        if (tid < 128) *(LAS u32x4*)(lds + DD_OFF + ((tid >> 5) * 128 + (tid & 31) * 4) * 4) = st.d; } while (0)
    HG_LOAD(dir ? nms - 1 : 0);
    HG_STORE();
    __syncthreads();
    for (int ms = 0; ms < nms; ++ms) {
        const int msn = dir ? nms - 1 - ms : ms;
        if (ms + 1 < nms) HG_LOAD(dir ? msn - 1 : msn + 1);
        __builtin_amdgcn_sched_barrier(0);
        if (act) {
        s16x4 xb[4];
#pragma unroll
        for (int cp = 0; cp < 4; cp += 2) {
            bf16x8 ka[2][4], qb[2][4];
#pragma unroll
            for (int q = 0; q < 2; ++q)
#pragma unroll
                for (int kk = 0; kk < 4; ++kk) {
                    ka[q][kk] = *(const LAS bf16x8*)(lds + KT_OFF + ((cp + q) * 16 + l15) * 272 + kk * 64 + g * 16);
                    qb[q][kk] = *(const LAS bf16x8*)(lds + QT_OFF + ((cp + q) * 16 + l15) * 272 + kk * 64 + g * 16); }
            __builtin_amdgcn_sched_barrier(0);
            f32x4 X0 = {0.f, 0.f, 0.f, 0.f}, X1 = {0.f, 0.f, 0.f, 0.f};
#pragma unroll
            for (int kk = 0; kk < 4; ++kk) { X0 = __builtin_amdgcn_mfma_f32_16x16x32_bf16(ka[0][kk], qb[0][kk], X0, 0, 0, 0); X1 = __builtin_amdgcn_mfma_f32_16x16x32_bf16(ka[1][kk], qb[1][kk], X1, 0, 0, 0); }
#pragma unroll
            for (int r = 0; r < 4; ++r) if (dir ? (4 * g + r < l15) : (4 * g + r > l15)) { X0[r] = 0.f; X1[r] = 0.f; }
            xb[cp] = pk4(X0); xb[cp + 1] = pk4(X1);
            __builtin_amdgcn_sched_barrier(0);
        }
        f32x4 dvA[8], dvB[8]; s16x4 kaA[8], kaB[8], vbA, vbB;
#define HG_OPS(c_, DV, KA, VB) do { VB = *(const LAS s16x4*)(lds + VT_OFF + vc * 144 + ((c_) * 16 + 4 * g) * 2); \
            _Pragma("unroll") for (int i_ = 0; i_ < 8; ++i_) { DV[i_] = *(const LAS f32x4*)(lds + DD_OFF + ((c_) * 128 + 16 * i_ + 4 * g) * 4); \
                KA[i_] = *(const LAS s16x4*)(lds + KHT_OFF + (16 * i_ + l15) * 144 + ((c_) * 16 + 4 * g) * 2); } } while (0)
#define HG_CHUNK(c_, XB, DV, KA, VB) do { \
            f32x4 o0_ = {0.f, 0.f, 0.f, 0.f}, o1_ = {0.f, 0.f, 0.f, 0.f}; s16x4 sb_[8], qa_[8]; \
            _Pragma("unroll") for (int i_ = 0; i_ < 8; ++i_) { sb_[i_] = pk4(S[i_]); qa_[i_] = *(const LAS s16x4*)(lds + QT_OFF + ((c_) * 16 + l15) * 272 + (16 * i_ + 4 * g) * 2); } \
            _Pragma("unroll") for (int i_ = 0; i_ < 8; ++i_) S[i_] = __builtin_amdgcn_mfma_f32_16x16x16bf16_1k(KA[i_], VB, S[i_] * DV[i_], 0, 0, 0); \
            _Pragma("unroll") for (int i_ = 0; i_ < 8; i_ += 2) { o0_ = __builtin_amdgcn_mfma_f32_16x16x16bf16_1k(qa_[i_], sb_[i_], o0_, 0, 0, 0); o1_ = __builtin_amdgcn_mfma_f32_16x16x16bf16_1k(qa_[i_ + 1], sb_[i_ + 1], o1_, 0, 0, 0); } \
            o0_ = __builtin_amdgcn_mfma_f32_16x16x16bf16_1k(XB, VB, o0_, 0, 0, 0); \
            const f32x4 o_ = o0_ + o1_; \
            _Pragma("unroll") for (int r_ = 0; r_ < 4; ++r_) Od[(size_t)(tok0 + msn * 64 + (c_) * 16 + 4 * g + r_) * 1024 + h * 128 + vc] = (bf16_t)(cvt_pk_bf16(o_[r_], 0.f) & 0xffff); } while (0)
        const int c0 = dir ? 3 : 0, cs = dir ? -1 : 1;
        HG_OPS(c0, dvA, kaA, vbA); __builtin_amdgcn_sched_barrier(0);
        HG_OPS(c0 + cs, dvB, kaB, vbB); __builtin_amdgcn_sched_barrier(0);
        { const s16x4 x0 = dir ? xb[3] : xb[0]; HG_CHUNK(c0, x0, dvA, kaA, vbA); } __builtin_amdgcn_sched_barrier(0);
        HG_OPS(c0 + 2 * cs, dvA, kaA, vbA); __builtin_amdgcn_sched_barrier(0);
        { const s16x4 x1 = dir ? xb[2] : xb[1]; HG_CHUNK(c0 + cs, x1, dvB, kaB, vbB); } __builtin_amdgcn_sched_barrier(0);
        HG_OPS(c0 + 3 * cs, dvB, kaB, vbB); __builtin_amdgcn_sched_barrier(0);
        { const s16x4 x2 = dir ? xb[1] : xb[2]; HG_CHUNK(c0 + 2 * cs, x2, dvA, kaA, vbA); } __builtin_amdgcn_sched_barrier(0);
        { const s16x4 x3 = dir ? xb[0] : xb[3]; HG_CHUNK(c0 + 3 * cs, x3, dvB, kaB, vbB); }
#undef HG_OPS
#undef HG_CHUNK
        }
        __syncthreads();
        if (ms + 1 < nms) { HG_STORE(); }
        __syncthreads();
    }
#undef HG_LOAD
#undef HG_STORE
    if (sout && act) {
#pragma unroll
        for (int i = 0; i < 8; ++i)
#pragma unroll
            for (int r = 0; r < 4; ++r) sout[(size_t)(16 * i + 4 * g + r) * 128 + vc] = S[i][r];
    }
}
}

__device__ __forceinline__ void phase_scan(ArgP a, LAS unsigned char* lds, int G, int bid) {
    for (int i = 0;; ++i) {
        const int u0 = i * G + ((i & 1) ? (G - 1 - bid) : bid);
        if (u0 >= 384) break;
        const int u = (u0 & ~127) + (u0 & 7) * 16 + ((u0 & 127) >> 3);
        int tok0, n, h, dir, vbase = 0, nwv = 8; const float* s0 = nullptr; float* sout = nullptr;
        if (u < 128) { const int b = u >> 5; h = (u >> 2) & 7; dir = (u >> 1) & 1; vbase = (u & 1) * 64; nwv = 4; tok0 = NCTX + b * 1024; n = 1024; s0 = a->in[I_ST] + ((size_t)(b * 2 + dir) * 8 + h) * 16384; }
        else { const int v = u - 128, b = v >> 4; h = (v >> 1) & 7; dir = v & 1; tok0 = b * 256; n = 256; sout = a->out + OUT_NS + ((size_t)(b * 2 + dir) * 8 + h) * 16384; }
        hg::scan_unit(tok0, n, h, dir, vbase, nwv, (const bf16_t*)(a->ws + WS_QTF), (const bf16_t*)(a->ws + (dir ? WS_KHTB : WS_KHTF)),
                      (const bf16_t*)(a->ws + WS_VT), (const float*)(a->ws + (dir ? WS_DDB : WS_DDF)), s0, sout, (bf16_t*)(a->ws + (dir ? WS_OB : WS_OF)), lds);
    }
}

#ifndef PHMASK
#define PHMASK 0xFFFF
#endif
#ifndef REPMASK
#define REPMASK 0
#endif
#ifndef XBAR
#define XBAR 0
#endif
enum PhType { T_PRO = 0, T_NORM, T_QKV, T_ATTN, T_RES, T_FFN, T_HIN, T_SCAN, T_HFIN, T_F1, T_FINAL, T_FOLD };
struct PhDesc { int type, layer, sub; };
constexpr int NPH = 22;
__device__ __forceinline__ PhDesc phase_desc(int p) {
    switch (p) {
        case 0: return {T_PRO, 0, 0};
        case 1: return {T_FOLD, 0, 0};
        case 2: return {T_QKV, 0, 0}; case 3: return {T_ATTN, 0, 0}; case 4: return {T_RES, 0, 0}; case 5: return {T_FFN, 0, 0}; case 6: return {T_RES, 0, 2};
        case 7: return {T_HIN, 1, 0}; case 8: return {T_SCAN, 1, 0}; case 9: return {T_HFIN, 1, 0}; case 10: return {T_RES, 1, 1}; case 11: return {T_FFN, 1, 0}; case 12: return {T_RES, 1, 2};
        case 13: return {T_F1, 2, 0}; case 14: return {T_RES, 2, 3}; case 15: return {T_FFN, 2, 0}; case 16: return {T_RES, 2, 2};
        case 17: return {T_QKV, 3, 1}; case 18: return {T_ATTN, 3, 1}; case 19: return {T_RES, 3, 0}; case 20: return {T_FFN, 3, 0}; case 21: return {T_RES, 3, 2};
        default: return {T_FINAL, 0, 0};
    }
}

__global__ void __launch_bounds__(NTHREADS, 2) fwd_megakernel(Args a_unused) {
    extern __shared__ __attribute__((aligned(16))) unsigned char lds_raw[];
    LAS unsigned char* lds = (LAS unsigned char*)lds_raw;
    constexpr int G = 256; const int bid = blockIdx.x;
    ArgP a = (ArgP)__builtin_amdgcn_kernarg_segment_ptr();
    for (int u = threadIdx.x; u < (LDS_BYTES - LDSCTL_OFF) / 4; u += NTHREADS) ((LAS unsigned*)(lds + LDSCTL_OFF))[u] = 0u;
    __syncthreads();
    volatile LAS unsigned* MISC = (volatile LAS unsigned*)(lds + MISC_OFF);
    XcdBarrier bar = xcd_barrier_post((unsigned*)(a->ws + WS_CTL), MISC + 8);

    const int nrun = a->ph_hi < NPH ? a->ph_hi + 1 : NPH;
#if REPMASK
    for (int pj = 2 * a->ph_lo; pj < 2 * nrun; ++pj) {
        const int pi = pj >> 1, rep = pj & 1;
        const int ph = pi < a->ph_hi ? pi : NPH - 1;
        const PhDesc d = phase_desc(ph);
        if (rep && !((REPMASK >> d.type) & 1)) continue;
        if (pj > 2 * a->ph_lo) xcd_barrier(bar);
#else
    for (int pi = a->ph_lo; pi < nrun; ++pi) {
        const int rep = 0;
        const int ph = pi < a->ph_hi ? pi : NPH - 1;
        const PhDesc d = phase_desc(ph);
        if (pi > a->ph_lo) xcd_barrier(bar);
#endif
        for (int xb = 0; xb < XBAR; ++xb) xcd_barrier(bar);
#define PH_TID const int tid = tid_opaque(), lane = tid & 63, wave = __builtin_amdgcn_readfirstlane(tid >> 6), gw = bid * NWAVES + wave, ngw = G * NWAVES; (void)lane; (void)gw; (void)ngw
        asm volatile("" : "+s"(a));
        const int L = d.layer;
        switch (d.type) {
#if (PHMASK >> 0) & 1
        case T_PRO: phase_prologue(a, lds, G, bid);
            if (a->ph_hi < NPH) { PH_TID; for (size_t i = (size_t)bid * NTHREADS + tid; i < 29360128 / 4; i += (size_t)G * NTHREADS) ((f32x4*)a->out)[i] = (f32x4){0.f, 0.f, 0.f, 0.f}; }
            break;
#endif
#if (PHMASK >> 1) & 1
        case T_FOLD: {
            PH_TID;
            phase_an(a, bid * NTHREADS + tid, G * NTHREADS);
            phase_sw(a, lds, 0x03, gw, ngw, tid, lane);
            phase_first_norm(a, gw, ngw, lane);
        } break;
#endif
#if (PHMASK >> 2) & 1
        case T_NORM: break;
#endif
#if (PHMASK >> 3) & 1
        case T_QKV: {
            const int j = d.sub, nidx = 2 * L;
            if (j == 1) { PH_TID; cache_convert(a, 1, gw, ngw, lane); }
            const float* sspn = (const float*)(a->ws + WS_SSP) + (size_t)nidx * 8192 * SSPN; const float* swn = (const float*)(a->ws + WS_SW) + sw_off(nidx);
            { GenSched S; S.init(7, a->ws + WS_H, nullptr, 1024, a->ws + WS_WQKV + (size_t)j * 3072 * 1024 * 2, 1024, MTOK, 3072, 1024, G, bid);
              EpiQKV E{(bf16_t*)(a->ws + WS_Q), (bf16_t*)(a->ws + WS_KB), (bf16_t*)(a->ws + WS_VB), a->out + OUT_NK + (size_t)j * 256 * 1024, a->out + OUT_NV + (size_t)j * 256 * 1024,
                       (const float*)(a->ws + WS_ROPE), (const float*)(a->ws + WS_ROPE) + 1024, sspn, swn, lds};
              pg8::gemm_phase(lds, 1024, 1024, S, E); }
            { GenSched S; S.init(8, a->ws + WS_H, nullptr, 1024, a->ws + WS_WQKV + (size_t)j * 3072 * 1024 * 2, 1024, MTOK, 3072, 1024, G, bid);
              EpiQKV128 E{(bf16_t*)(a->ws + WS_Q), (bf16_t*)(a->ws + WS_KB), (bf16_t*)(a->ws + WS_VB), a->out + OUT_NK + (size_t)j * 256 * 1024, a->out + OUT_NV + (size_t)j * 256 * 1024,
                          (const float*)(a->ws + WS_ROPE), (const float*)(a->ws + WS_ROPE) + 1024, sspn, swn, lds};
              pg8::gemm_phase_n128(lds, 1024, 1024, S, E); }
        } break;
#endif
#if (PHMASK >> 4) & 1
        case T_ATTN: phase_attn(a, d.sub, (char*)lds_raw, G, bid); break;
#endif
#if (PHMASK >> 5) & 1
        case T_RES: {
            const int nn = d.sub == 2 ? 2 * L + 2 : 2 * L + 1;
            EpiResid128 E{(bf16_t*)(a->ws + WS_X), (float*)(a->ws + WS_MOD) + (size_t)L * 5 * 6144 + (d.sub == 2 ? 5 : 2) * 1024,
                          nn < 8 ? (const float*)(a->ws + WS_AN) + nn * 5120 : nullptr, (bf16_t*)(a->ws + WS_H), (float*)(a->ws + WS_SSP) + (size_t)nn * 8192 * SSPN};
            GenSched S; int lda, ldb;
            if (d.sub == 3) { lda = 2048; ldb = 16384; S.init(4, a->ws + WS_CS1024, a->ws + WS_CS256, lda, a->ws + WS_ZT, ldb, 0, 0, 2048, G, bid); }
            else if (d.sub == 2) { lda = DFF; ldb = DFF; S.init(3, a->ws + WS_ACT, nullptr, lda, a->ws + WS_WFOUT + (size_t)L * 1024 * DFF * 2, ldb, MTOK, 1024, DFF, G, bid); }
            else { lda = 1024; ldb = 1024; const unsigned char* w = d.sub == 0 ? a->ws + WS_WOA + (size_t)(L == 0 ? 0 : 1) * 1024 * 1024 * 2 : a->ws + WS_WOR;
                S.init(3, a->ws + WS_O, nullptr, lda, w, ldb, MTOK, 1024, 1024, G, bid); }
            pg8::gemm_phase_n128(lds, lda, ldb, S, E);
            if (d.sub == 3 && bid >= 128) { PH_TID; deferred_convert(a, 3, lds, (bid - 128) * NWAVES + wave, 128 * NWAVES); }
            if (d.sub == 2 && L == 3) {
                PH_TID;
                const int wgid = (bid & 7) * 32 + (bid >> 3), pm = wgid >> 3, pn = wgid & 7;
                unsigned* barw = (unsigned*)(a->ws + WS_CTL); unsigned* cnt = barw + 12288 + pm * 16;
                if (tid == 0) { __builtin_amdgcn_fence(__ATOMIC_RELEASE, "agent"); asm volatile("s_waitcnt vmcnt(0)" ::: "memory"); (void)xb_add(cnt, 1u);
                    XB_SPIN(xb_ld(cnt) < 8u, barw); __builtin_amdgcn_fence(__ATOMIC_ACQUIRE, "agent"); }
                __syncthreads();
                phase_final_rows(a, pm * 256 + pn * 32, wave, lane);
            }
            if (d.sub == 2 && L < 3) { PH_TID; phase_sw(a, lds, L == 0 ? 0x0Cu : L == 1 ? 0x30u : 0xC0u, gw, ngw, tid, lane); }
        } break;
#endif
#if (PHMASK >> 6) & 1
        case T_FFN: {
            const int nidx = 2 * L + 1;
            GenSched S; S.init(0, a->ws + WS_H, nullptr, 1024, a->ws + WS_WFI + (size_t)L * 5632 * 1024 * 2, 1024, MTOK, 5632, 1024, G, bid);
            EpiFFN E{(bf16_t*)(a->ws + WS_ACT), (const float*)(a->ws + WS_SSP) + (size_t)nidx * 8192 * SSPN, (const float*)(a->ws + WS_SW) + sw_off(nidx), lds};
            pg8::gemm_phase(lds, 1024, 1024, S, E);
            if (bid >= 704 - 2 * G && L == 0) {
                GenSched S2; S2.init(2, a->ws + WS_WFO, nullptr, 1024, a->ws + WS_TC, 1024, 1024, 256, a->ph_hi > 0 ? 256 : 320, G, bid - (704 - 2 * G));
                EpiBf16 E2{(bf16_t*)(a->ws + WS_WCS), 1024};
                pg8::gemm_phase(lds, 1024, 1024, S2, E2); }
            if (bid >= 704 - 2 * G && L < 3) { PH_TID; deferred_convert(a, L, lds, (bid - (704 - 2 * G)) * NWAVES + wave, (3 * G - 704) * NWAVES); }
        } break;
#endif
#if (PHMASK >> 7) & 1
        case T_HIN: {
            { GenSched S; S.init(5, a->ws + WS_H, nullptr, 1024, a->ws + WS_WINR, 1024, MTOK, 4096, 1024, G, bid);
              EpiHgrn E{(bf16_t*)(a->ws + WS_GH), (bf16_t*)(a->ws + WS_QTF), (bf16_t*)(a->ws + WS_KTF), (bf16_t*)(a->ws + WS_QTB), (bf16_t*)(a->ws + WS_KTB), (bf16_t*)(a->ws + WS_KHTF), (bf16_t*)(a->ws + WS_KHTB),
                        (bf16_t*)(a->ws + WS_VT), (float*)(a->ws + WS_DDF), (float*)(a->ws + WS_DDB), (const float*)(a->ws + WS_LBV), (const float*)(a->ws + WS_SSP) + 2ull * 8192 * SSPN, (const float*)(a->ws + WS_SW) + sw_off(2), lds};
              pg8::gemm_phase(lds, 1024, 1024, S, E); }
            { GenSched S; S.init(6, a->ws + WS_H, nullptr, 1024, a->ws + WS_WINR, 1024, MTOK, 1024, 1024, G, bid);
              EpiG128 E{(bf16_t*)(a->ws + WS_GH), (const float*)(a->ws + WS_SSP) + 2ull * 8192 * SSPN, (const float*)(a->ws + WS_SW) + sw_off(2), lds};
              pg8::gemm_phase_n128(lds, 1024, 1024, S, E); }
        } break;
#endif
#if (PHMASK >> 8) & 1
        case T_SCAN: phase_scan(a, lds, G, bid); break;
#endif
#if (PHMASK >> 9) & 1
        case T_HFIN: { PH_TID; phase_hgrn_final(a, gw, ngw, lane); } break;
#endif
#if (PHMASK >> 10) & 1
        case T_F1: {
            GenSched S; S.init(0, a->ws + WS_WCS, nullptr, 1024, a->ws + WS_H, 1024, 2048, MTOK, 1024, G, bid);
            EpiFour1 E{(bf16_t*)(a->ws + WS_ZT), (const float*)(a->ws + WS_SSP) + 4ull * 8192 * SSPN, (const float*)(a->ws + WS_SW) + sw_off(4), lds};
            pg8::gemm_phase(lds, 1024, 1024, S, E);
        } break;
#endif
        default: { PH_TID; phase_final(a, gw, ngw, lane); } break;
        }
    }
}

extern "C" void kernel_launch(void* const* d_in, const int* in_sizes, int n_in, void* d_out, int out_size, void* d_ws, size_t ws_size, hipStream_t stream) {
    static int grid = 0;
    if (grid == 0) {
        if (n_in != 23 || out_size != 29360128 || ws_size < WS_END2) {
            fprintf(stderr, "kernel_launch: unexpected shapes: n_in %d out %d ws %zu (need >= %zu); nothing launched\n", n_in, out_size, ws_size, (size_t)WS_END); grid = -1; return; }
        int dev = 0, cus = 0, per_cu = 0;
        if (hipGetDevice(&dev) != hipSuccess || hipDeviceGetAttribute(&cus, hipDeviceAttributeMultiprocessorCount, dev) != hipSuccess) { fprintf(stderr, "kernel_launch: device query failed\n"); grid = -1; return; }
        if (hipFuncSetAttribute((const void*)fwd_megakernel, hipFuncAttributeMaxDynamicSharedMemorySize, LDS_BYTES) != hipSuccess) { fprintf(stderr, "kernel_launch: hipFuncSetAttribute failed\n"); grid = -1; return; }
        if (hipOccupancyMaxActiveBlocksPerMultiprocessor(&per_cu, (const void*)fwd_megakernel, NTHREADS, LDS_BYTES) != hipSuccess || per_cu < 1) {
            fprintf(stderr, "kernel_launch: occupancy query reports %d workgroups per CU; nothing launched\n", per_cu); (void)hipGetLastError(); grid = -1; return; }
        if (cus < 256) { fprintf(stderr, "kernel_launch: needs >= 256 CUs (have %d); nothing launched\n", cus); grid = -1; return; }
        grid = 256;
    }
    if (grid < 0) return;
    (void)hipMemsetAsync((char*)d_ws + WS_CTL, 0, CTL_BYTES, stream);
    Args a{};
    for (int i = 0; i < 23; ++i) a.in[i] = (const float*)d_in[i];
    a.out = (float*)d_out; a.ws = (unsigned char*)d_ws;
    a.lam_init0 = 0.2f; a.lam_init1 = (float)(0.8 - 0.6 * 0.40656965974059917);
    a.ph_lo = 0; a.ph_hi = NPH;
    hipLaunchKernelGGL(fwd_megakernel, dim3(grid), dim3(NTHREADS), LDS_BYTES, stream, a);
    const hipError_t le = hipPeekAtLastError();
    if (le != hipSuccess) fprintf(stderr, "kernel_launch: launch failed: %s\n", hipGetErrorName(le));
}
```

```cpp
#include <hip/hip_runtime.h>
#include <cstdio>
#include <cstdint>

#define LAS __attribute__((address_space(3)))
#define GAS __attribute__((address_space(1)))
typedef unsigned short bf16_t;
typedef short bf16x8 __attribute__((ext_vector_type(8)));
typedef short s16x4 __attribute__((ext_vector_type(4)));
typedef float f32x2 __attribute__((ext_vector_type(2)));
typedef float f32x4 __attribute__((ext_vector_type(4)));
typedef float f32x8 __attribute__((ext_vector_type(8)));
typedef float f32x16 __attribute__((ext_vector_type(16)));
typedef unsigned u32x2 __attribute__((ext_vector_type(2)));
typedef unsigned u32x4 __attribute__((ext_vector_type(4)));

constexpr int DM = 1024, MTOK = 8192, NCTX = 4096, DFF = 2816, NKV = 4096 + 4 * 1536;
constexpr float EPS = 1e-6f;
constexpr int NWAVES = 8, NTHREADS = 512;

constexpr size_t al256(size_t x) { return (x + 255) / 256 * 256; }
constexpr size_t WS_CTL = 0, CTL_BYTES = 65536;
constexpr size_t WS_MOD = WS_CTL + CTL_BYTES;
constexpr size_t WS_ROPE = WS_MOD + al256(4 * 5 * 6144 * 4);
constexpr size_t WS_LBV = WS_ROPE + 8192;
constexpr size_t WS_LAM = WS_LBV + 8192;
constexpr size_t WS_AN = WS_LAM + 256;
constexpr size_t WS_SW = WS_AN + 8 * 5 * 1024 * 4;
constexpr size_t WS_SSP = WS_SW + al256(35840 * 5 * 4);
constexpr int SSPN = 32;
constexpr size_t WS_TC = WS_SSP + 9ull * 8192 * SSPN * 4;
constexpr size_t WS_CS256 = WS_TC + 256 * 1024 * 2;
constexpr size_t WS_CS1024 = WS_CS256 + 256 * 2048 * 2;
constexpr size_t WS_WQKV = WS_CS1024 + 1024 * 2048 * 2;
constexpr size_t WS_WOA = WS_WQKV + 2ull * 3072 * 1024 * 2;
constexpr size_t WS_WINR = WS_WOA + 2ull * 1024 * 1024 * 2;
constexpr size_t WS_WOR = WS_WINR + 5120ull * 1024 * 2;
constexpr size_t WS_WFO = WS_WOR + 1024ull * 1024 * 2;
constexpr size_t WS_WCS = WS_WFO + 1024ull * 1024 * 2;
constexpr size_t WS_WFI = WS_WCS + 2048ull * 1024 * 2;
constexpr size_t WS_WFOUT = WS_WFI + 4ull * 5632 * 1024 * 2;
constexpr size_t WS_X = WS_WFOUT + 4ull * 1024 * 2816 * 2;
constexpr size_t WS_H = WS_X + 8192ull * 1024 * 4;
constexpr size_t WS_O = WS_H + 8192ull * 1024 * 2;
constexpr size_t WS_SCR = WS_O + 8192ull * 1024 * 2;
constexpr size_t SZ_TOK = 8192ull * 1024 * 2;
constexpr size_t WS_Q = WS_SCR, WS_KB = WS_Q + SZ_TOK, WS_VB = WS_KB + (size_t)NKV * 1024 * 2;
constexpr size_t WS_GH = WS_SCR, WS_QTF = WS_GH + SZ_TOK, WS_KTF = WS_QTF + SZ_TOK, WS_QTB = WS_KTF + SZ_TOK, WS_KTB = WS_QTB + SZ_TOK, WS_KHTF = WS_KTB + SZ_TOK, WS_KHTB = WS_KHTF + SZ_TOK,
                 WS_VT = WS_KHTB + SZ_TOK, WS_OF = WS_VT + SZ_TOK, WS_OB = WS_OF + SZ_TOK, WS_DDF = WS_OB + SZ_TOK, WS_DDB = WS_DDF + 512ull * 8 * 128 * 4;
constexpr size_t WS_ZT = WS_SCR;
constexpr size_t WS_ACT = WS_SCR;
constexpr size_t WS_END = WS_DDB + 512ull * 8 * 128 * 4;
constexpr size_t WS_END2 = WS_END;
__host__ __device__ constexpr int sw_n(int nidx) { return nidx == 0 || nidx == 6 ? 3072 : nidx == 2 ? 5120 : nidx == 4 ? 2048 : 5632; }
__host__ __device__ constexpr int sw_off(int nidx) { int o = 0; for (int i = 0; i < nidx; ++i) o += 5 * sw_n(i); return o; }

constexpr size_t OUT_YP = 0, OUT_YS = 4194304, OUT_NK = 8388608, OUT_NV = 16777216, OUT_NS = 25165824;

constexpr int RING_BYTES = 131072;
constexpr int LDSCTL_OFF = RING_BYTES, MISC_OFF = LDSCTL_OFF + 320, RSTD_OFF = LDSCTL_OFF + 1024;
constexpr int LDS_BYTES = 147456;

typedef __bf16 bf16x2_t __attribute__((ext_vector_type(2)));
__device__ __forceinline__ unsigned cvt_pk_bf16(float lo, float hi) { f32x2 v = {lo, hi}; bf16x2_t b = __builtin_convertvector(v, bf16x2_t); return __builtin_bit_cast(unsigned, b); }
__device__ __forceinline__ float bf2f(unsigned short b) { return __uint_as_float((unsigned)b << 16); }
__device__ __forceinline__ float bflo(unsigned w) { return __uint_as_float(w << 16); }
__device__ __forceinline__ float bfhi(unsigned w) { return __uint_as_float(w & 0xffff0000u); }
__device__ __forceinline__ float fast_rcp(float x) { return __builtin_amdgcn_rcpf(x); }
__device__ __forceinline__ float silu_f(float x) { return x * fast_rcp(1.f + __expf(-x)); }
__device__ __forceinline__ float sigmoid_f(float x) { return fast_rcp(1.f + __expf(-x)); }
__device__ __forceinline__ float wave_sum(float v) {
#pragma unroll
    for (int o = 1; o < 64; o <<= 1) v += __shfl_xor(v, o);
    return v;
}
__device__ __forceinline__ int tid_opaque() { int t = threadIdx.x; asm volatile("" : "+v"(t)); return t; }
__device__ __forceinline__ int cond_of_row(int r) { return r < NCTX ? 0 : 1 + ((r - NCTX) >> 10); }
#define LDS_WAIT() asm volatile("s_waitcnt lgkmcnt(0)" ::: "memory")
#define VM_WAIT() asm volatile("s_waitcnt vmcnt(0)" ::: "memory")

#define XB_TMO      128
#define XB_XCNT(j)  (256  + 64 * (j))
#define XB_XSUB(j)  (1280 + 64 * (j))
#define XB_XGEN(j)  (2304 + 64 * (j))
#define XB_TOP      3328
#define XB_TOPGEN   3392
#define XCD_BAR_WORDS 3456
#define XB_SPIN_CAP (1u << 22)
__device__ __forceinline__ unsigned xb_ld(unsigned* p)              { return __hip_atomic_load(p, __ATOMIC_RELAXED, __HIP_MEMORY_SCOPE_AGENT); }
__device__ __forceinline__ unsigned xb_add(unsigned* p, unsigned v) { return __hip_atomic_fetch_add(p, v, __ATOMIC_RELAXED, __HIP_MEMORY_SCOPE_AGENT); }
__device__ __forceinline__ unsigned xb_xcc_id() { return (unsigned)__builtin_amdgcn_s_getreg((3 << 11) | 20) & 0xFu; }
#define XB_SPIN(cond, bar) do { unsigned _sp = 0; while (cond) { __builtin_amdgcn_s_sleep(1); \
    if ((++_sp & 255u) == 0u) { if (xb_ld(&(bar)[XB_TMO])) break; if (_sp > XB_SPIN_CAP) { atomicAdd(&(bar)[XB_TMO], 1u); break; } } } } while (0)
struct XcdBarrier { unsigned* bar; unsigned x; volatile LAS unsigned* st; };
__device__ __forceinline__ XcdBarrier xcd_barrier_post(unsigned* bar, volatile LAS unsigned* st) {
    XcdBarrier b; b.bar = bar; b.x = xb_xcc_id(); b.st = st;
    if (threadIdx.x == 0) (void)xb_add(&bar[XB_XCNT(b.x)], 1u);
    return b;
}
__device__ __forceinline__ void xcd_barrier_complete(unsigned* bar, unsigned x, unsigned& nloc, unsigned& nx) {
    const unsigned G = gridDim.x * gridDim.y * gridDim.z;
    unsigned sum, cnt, mine, sp = 0u;
    for (;;) {
        sum = 0u; cnt = 0u; mine = 0u;
#pragma unroll
        for (unsigned j = 0; j < 16; ++j) { const unsigned c = xb_ld(&bar[XB_XCNT(j)]); sum += c; cnt += (c > 0u) ? 1u : 0u; mine = (j == x) ? c : mine; }
        if (sum == G) break;
        __builtin_amdgcn_s_sleep(1);
        if ((++sp & 255u) == 0u) { if (xb_ld(&bar[XB_TMO])) break; if (sp > XB_SPIN_CAP) { atomicAdd(&bar[XB_TMO], 1u); break; } }
    }
    nloc = mine > 0u ? mine : 1u; nx = cnt > 0u ? cnt : 1u;
}
__device__ __forceinline__ void xcd_barrier(const XcdBarrier& b) {
    asm volatile("s_waitcnt vmcnt(0)" ::: "memory");
    __syncthreads();
    if (threadIdx.x == 0) {
        unsigned* bar = b.bar;
        __builtin_amdgcn_s_waitcnt(0);
        unsigned nloc = b.st[0], nx = b.st[1];
        if (nloc == 0u) { xcd_barrier_complete(bar, b.x, nloc, nx); b.st[0] = nloc; b.st[1] = nx; }
        const unsigned old = xb_add(&bar[XB_XSUB(b.x)], 1u);
        const unsigned gen = old / nloc;
        if (old + 1u == (gen + 1u) * nloc) {
            __builtin_amdgcn_fence(__ATOMIC_RELEASE, "agent");
            asm volatile("s_waitcnt vmcnt(0)" ::: "memory");
            const unsigned og = xb_add(&bar[XB_TOP], 1u);
            const unsigned tg = og / nx;
            asm volatile("buffer_inv sc1" ::: "memory");
            if (og + 1u == (tg + 1u) * nx) xb_add(&bar[XB_TOPGEN], 1u);
            else XB_SPIN(xb_ld(&bar[XB_TOPGEN]) == tg, bar);
            xb_add(&bar[XB_XGEN(b.x)], 1u);
            asm volatile("s_waitcnt vmcnt(0)" ::: "memory");
        } else {
            asm volatile("buffer_inv sc1" ::: "memory");
            XB_SPIN(xb_ld(&bar[XB_XGEN(b.x)]) == gen, bar);
            asm volatile("s_waitcnt vmcnt(0)" ::: "memory");
        }
    }
    __syncthreads();
}

namespace pg8 {
constexpr int BM = 256, BK = 64, HALF = 128, HTB = HALF * BK * 2, NXCD = 8, WGM = 8;
__host__ __device__ __forceinline__ int lds_byte(int r, int c) { const int st = (r >> 4) * 2 + (c >> 5), rr = r & 15, cc = c & 31, ob = rr * 64 + cc * 2; return st * 1024 + (ob ^ (((ob >> 9) & 1) << 5)); }
__host__ __device__ __forceinline__ int perm32(int rho) { const int n = rho >> 4, i = rho & 15; return 8 * (i >> 2) + 4 * n + (i & 3); }
__host__ __device__ __forceinline__ void stage_rc(int b, int& R, int& C) { const int st = b / 1024, sb = b % 1024, swz = sb ^ (((sb >> 9) & 1) << 5); R = (st >> 1) * 16 + swz / 64; C = (st & 1) * 32 + (swz % 64) / 2; }

struct GUnit { const char* A; const char* B; int nt; int row0; int col0; int aux; };

template <class Epi, class Sched>
__device__ __forceinline__ void gemm_phase(LAS unsigned char* lds, const int lda, const int ldb, const Sched& S, const Epi& E) {
    const int tid = tid_opaque(), wid = __builtin_amdgcn_readfirstlane(tid >> 6), lane = tid & 63, wr = wid >> 2, wc = wid & 3, fr = lane & 15, fq = lane >> 4;
    unsigned voffA[2], voffB[2];
#pragma unroll
    for (int i = 0; i < 2; ++i) { int R, C; stage_rc(tid * 16 + i * 8192, R, C); const int Rb = Epi::PERM ? ((R & ~31) + perm32(R & 31)) : R; voffA[i] = (unsigned)(R * lda + C) * 2u; voffB[i] = (unsigned)(Rb * ldb + C) * 2u; }
    const size_t kstep = (size_t)(BK * 2);
    const size_t hstepA = (size_t)HALF * lda * 2, hstepB = (size_t)HALF * ldb * 2;
    const unsigned ldsw = (unsigned)wid * 1024u;
    const int aoff = lds_byte(wr * 64 + fr, fq * 8), boff = lds_byte(wc * 32 + fr, fq * 8);
#define PG8_SA(b, h) (((b) * 2 + (h)) * HTB)
#define PG8_SB(b, h) ((4 + (b) * 2 + (h)) * HTB)
#define PG8_STAGE(bufoff, gbase, voff) do { _Pragma("unroll") for (int _i = 0; _i < 2; ++_i) \
        __builtin_amdgcn_global_load_lds((const unsigned*)((const char*)(gbase) + (voff)[_i]), (LAS unsigned*)(lds + (bufoff) + ldsw + _i * 8192), 16, 0, 0); } while (0)
#define PG8_LDA(dst, b, h) do { _Pragma("unroll") for (int m = 0; m < 4; ++m) _Pragma("unroll") for (int k = 0; k < 2; ++k) dst[m][k] = *(const LAS bf16x8*)(lds + PG8_SA(b, h) + aoff + m * 2048 + k * 1024); } while (0)
#define PG8_LDB(dst, b, h) do { _Pragma("unroll") for (int n = 0; n < 2; ++n) _Pragma("unroll") for (int k = 0; k < 2; ++k) dst[n][k] = *(const LAS bf16x8*)(lds + PG8_SB(b, h) + boff + n * 2048 + k * 1024); } while (0)
#define PG8_MMA(ai, bj, At, Bt) do { __builtin_amdgcn_s_setprio(1); _Pragma("unroll") for (int m = 0; m < 4; ++m) _Pragma("unroll") for (int n = 0; n < 2; ++n) _Pragma("unroll") for (int k = 0; k < 2; ++k) \
        acc[ai][bj][m][n] = __builtin_amdgcn_mfma_f32_16x16x32_bf16(Bt[n][k], At[m][k], acc[ai][bj][m][n], 0, 0, 0); __builtin_amdgcn_s_setprio(0); } while (0)
#define PG8_WAIT_V(n) asm volatile("s_waitcnt vmcnt(" #n ")" ::: "memory")
#define PG8_WAIT_L(n) asm volatile("s_waitcnt lgkmcnt(" #n ")" ::: "memory")
#define PG8_BAR __builtin_amdgcn_s_barrier()
#define PG8_SCHED __builtin_amdgcn_sched_barrier(0)
    GUnit cur, nxt; int ui = 0;
    if (!S.next(0, cur)) return;
    E.prepare(S, lds, tid);
    f32x4 acc[2][2][4][2];
#pragma unroll
    for (int a = 0; a < 2; ++a)
#pragma unroll
        for (int b = 0; b < 2; ++b)
#pragma unroll
            for (int m = 0; m < 4; ++m)
#pragma unroll
                for (int n = 0; n < 2; ++n) acc[a][b][m][n] = (f32x4){0.f, 0.f, 0.f, 0.f};
    bf16x8 At[4][2], B0[2][2], B1[2][2];
    const char* cA = cur.A; const char* cB = cur.B;
    PG8_STAGE(PG8_SB(0, 0), cB, voffB); PG8_STAGE(PG8_SB(0, 1), cB + hstepB, voffB); PG8_STAGE(PG8_SA(0, 0), cA, voffA); PG8_STAGE(PG8_SA(0, 1), cA + hstepA, voffA);
    if (wr == 1) PG8_BAR;
    PG8_WAIT_V(2); PG8_BAR;
    PG8_STAGE(PG8_SB(1, 0), cB + kstep, voffB); PG8_STAGE(PG8_SA(1, 0), cA + kstep, voffA); PG8_STAGE(PG8_SB(1, 1), cB + hstepB + kstep, voffB);
    PG8_WAIT_V(6); PG8_BAR;
    for (;;) {
        const bool has_next = S.next(ui + 1, nxt);
        const char* nA = has_next ? nxt.A : cA; const char* nB = has_next ? nxt.B : cB;
        const int nt = cur.nt;
        for (int t = 0; t < nt; t += 2) {
            const bool last = (t == nt - 2);
            const char* a1 = cA + (size_t)(t + 1) * kstep;
            const char* a2 = last ? nA : cA + (size_t)(t + 2) * kstep; const char* b2 = last ? nB : cB + (size_t)(t + 2) * kstep;
            const char* a3 = a2 + kstep; const char* b3 = b2 + kstep;
            PG8_LDB(B0, 0, 0); PG8_LDB(B1, 0, 1); PG8_SCHED; PG8_LDA(At, 0, 0); PG8_STAGE(PG8_SA(1, 1), a1 + hstepA, voffA);
            PG8_WAIT_V(8); PG8_WAIT_L(0); PG8_BAR; PG8_MMA(0, 0, At, B0); PG8_MMA(0, 1, At, B1); PG8_BAR; PG8_SCHED;
            PG8_LDA(At, 0, 1); PG8_STAGE(PG8_SB(0, 0), b2, voffB); PG8_STAGE(PG8_SB(0, 1), b2 + hstepB, voffB); PG8_STAGE(PG8_SA(0, 0), a2, voffA);
            PG8_WAIT_V(8); PG8_WAIT_L(0); PG8_BAR; PG8_MMA(1, 0, At, B0); PG8_MMA(1, 1, At, B1); PG8_BAR; PG8_SCHED;
            PG8_LDB(B0, 1, 0); PG8_LDB(B1, 1, 1); PG8_SCHED; PG8_LDA(At, 1, 0); PG8_STAGE(PG8_SA(0, 1), a2 + hstepA, voffA);
            PG8_WAIT_V(8); PG8_WAIT_L(0); PG8_BAR; PG8_MMA(0, 0, At, B0); PG8_MMA(0, 1, At, B1); PG8_BAR; PG8_SCHED;
            PG8_LDA(At, 1, 1); PG8_STAGE(PG8_SB(1, 0), b3, voffB); PG8_STAGE(PG8_SB(1, 1), b3 + hstepB, voffB); PG8_STAGE(PG8_SA(1, 0), a3, voffA);
            PG8_WAIT_V(8); PG8_WAIT_L(0); PG8_BAR; PG8_MMA(1, 0, At, B0); PG8_MMA(1, 1, At, B1); PG8_BAR; PG8_SCHED;
        }
        if (wr == 0) PG8_BAR;
        E(acc, cur, ui, wr, wc, fr, fq);
        if (!has_next) break;
#pragma unroll
        for (int a = 0; a < 2; ++a)
#pragma unroll
            for (int b = 0; b < 2; ++b)
#pragma unroll
                for (int m = 0; m < 4; ++m)
#pragma unroll
                    for (int n = 0; n < 2; ++n) acc[a][b][m][n] = (f32x4){0.f, 0.f, 0.f, 0.f};
        cur = nxt; cA = nA; cB = nB; ++ui;
        if (wr == 1) PG8_BAR;
    }
    PG8_WAIT_V(0);
    PG8_BAR;
#undef PG8_SA
#undef PG8_SB
#undef PG8_STAGE
#undef PG8_LDA
#undef PG8_LDB
#undef PG8_MMA
#undef PG8_WAIT_V
#undef PG8_WAIT_L
#undef PG8_BAR
#undef PG8_SCHED
}

template <class Epi, class Sched>
__device__ __forceinline__ void gemm_phase_n128(LAS unsigned char* lds, const int lda, const int ldb, const Sched& S, const Epi& E) {
    const int tid = tid_opaque(), wid = __builtin_amdgcn_readfirstlane(tid >> 6), lane = tid & 63, wr = wid >> 2, wc = wid & 3, fr = lane & 15, fq = lane >> 4;
    unsigned voffA[2], voffB[2];
#pragma unroll
    for (int i = 0; i < 2; ++i) { int R, C; stage_rc(tid * 16 + i * 8192, R, C); const int Rb = Epi::PERM ? ((R & ~31) + perm32(R & 31)) : R; voffA[i] = (unsigned)(R * lda + C) * 2u; voffB[i] = (unsigned)(Rb * ldb + C) * 2u; }
    const size_t kstep = (size_t)(BK * 2);
    const size_t hstepA = (size_t)HALF * lda * 2;
    const unsigned ldsw = (unsigned)wid * 1024u;
    const int aoff = lds_byte(wr * 64 + fr, fq * 8), boff = lds_byte(wc * 32 + fr, fq * 8);
#define N1_SA(b, h) (((b) * 2 + (h)) * HTB)
#define N1_SB(b) ((4 + (b)) * HTB)
#define N1_STAGE(bufoff, gbase, voff) do { _Pragma("unroll") for (int _i = 0; _i < 2; ++_i) \
        __builtin_amdgcn_global_load_lds((const unsigned*)((const char*)(gbase) + (voff)[_i]), (LAS unsigned*)(lds + (bufoff) + ldsw + _i * 8192), 16, 0, 0); } while (0)
#define N1_LDA(dst, b, h) do { _Pragma("unroll") for (int m = 0; m < 4; ++m) _Pragma("unroll") for (int k = 0; k < 2; ++k) dst[m][k] = *(const LAS bf16x8*)(lds + N1_SA(b, h) + aoff + m * 2048 + k * 1024); } while (0)
#define N1_LDB(dst, b) do { _Pragma("unroll") for (int n = 0; n < 2; ++n) _Pragma("unroll") for (int k = 0; k < 2; ++k) dst[n][k] = *(const LAS bf16x8*)(lds + N1_SB(b) + boff + n * 2048 + k * 1024); } while (0)
#define N1_MMA(ai, At, Bt) do { __builtin_amdgcn_s_setprio(1); _Pragma("unroll") for (int m = 0; m < 4; ++m) _Pragma("unroll") for (int n = 0; n < 2; ++n) _Pragma("unroll") for (int k = 0; k < 2; ++k) \
        acc[ai][m][n] = __builtin_amdgcn_mfma_f32_16x16x32_bf16(Bt[n][k], At[m][k], acc[ai][m][n], 0, 0, 0); __builtin_amdgcn_s_setprio(0); } while (0)
#define N1_WAIT_V(n) asm volatile("s_waitcnt vmcnt(" #n ")" ::: "memory")
#define N1_WAIT_L(n) asm volatile("s_waitcnt lgkmcnt(" #n ")" ::: "memory")
#define N1_BAR __builtin_amdgcn_s_barrier()
#define N1_SCHED __builtin_amdgcn_sched_barrier(0)
    GUnit cur, nxt; int ui = 0;
    if (!S.next(0, cur)) return;
    E.prepare(S, lds, tid);
    f32x4 acc[2][4][2];
#pragma unroll
    for (int x = 0; x < 2; ++x)
#pragma unroll
        for (int m = 0; m < 4; ++m)
#pragma unroll
            for (int n = 0; n < 2; ++n) acc[x][m][n] = (f32x4){0.f, 0.f, 0.f, 0.f};
    bf16x8 At[4][2], B0[2][2];
    const char* cA = cur.A; const char* cB = cur.B;
    N1_STAGE(N1_SB(0), cB, voffB); N1_STAGE(N1_SA(0, 0), cA, voffA); N1_STAGE(N1_SA(0, 1), cA + hstepA, voffA);
    if (wr == 1) N1_BAR;
    N1_WAIT_V(0); N1_BAR;
    N1_STAGE(N1_SB(1), cB + kstep, voffB); N1_STAGE(N1_SA(1, 0), cA + kstep, voffA);
    N1_BAR;
    for (;;) {
        const bool has_next = S.next(ui + 1, nxt);
        const char* nA = has_next ? nxt.A : cA; const char* nB = has_next ? nxt.B : cB;
        const int nt = cur.nt;
        for (int t = 0; t < nt; t += 2) {
            const bool last = (t == nt - 2);
            const char* a1 = cA + (size_t)(t + 1) * kstep;
            const char* a2 = last ? nA : cA + (size_t)(t + 2) * kstep; const char* b2 = last ? nB : cB + (size_t)(t + 2) * kstep;
            const char* a3 = a2 + kstep; const char* b3 = b2 + kstep;
            N1_LDB(B0, 0); N1_SCHED; N1_LDA(At, 0, 0); N1_STAGE(N1_SA(1, 1), a1 + hstepA, voffA);
            N1_WAIT_V(6); N1_WAIT_L(0); N1_BAR; N1_MMA(0, At, B0); N1_BAR; N1_SCHED;
            N1_LDA(At, 0, 1); N1_STAGE(N1_SA(0, 0), a2, voffA); N1_STAGE(N1_SB(0), b2, voffB);
            N1_WAIT_V(6); N1_WAIT_L(0); N1_BAR; N1_MMA(1, At, B0); N1_BAR; N1_SCHED;
            N1_LDB(B0, 1); N1_SCHED; N1_LDA(At, 1, 0); N1_STAGE(N1_SA(0, 1), a2 + hstepA, voffA);
            N1_WAIT_V(6); N1_WAIT_L(0); N1_BAR; N1_MMA(0, At, B0); N1_BAR; N1_SCHED;
            N1_LDA(At, 1, 1); N1_STAGE(N1_SA(1, 0), a3, voffA); N1_STAGE(N1_SB(1), b3, voffB);
            N1_WAIT_V(6); N1_WAIT_L(0); N1_BAR; N1_MMA(1, At, B0); N1_BAR; N1_SCHED;
        }
        if (wr == 0) N1_BAR;
        E(acc, cur, ui, wr, wc, fr, fq);
        if (!has_next) break;
#pragma unroll
        for (int x = 0; x < 2; ++x)
#pragma unroll
            for (int m = 0; m < 4; ++m)
#pragma unroll
                for (int n = 0; n < 2; ++n) acc[x][m][n] = (f32x4){0.f, 0.f, 0.f, 0.f};
        cur = nxt; cA = nA; cB = nB; ++ui;
        if (wr == 1) N1_BAR;
    }
    N1_WAIT_V(0);
    N1_BAR;
#undef N1_SA
#undef N1_SB
#undef N1_STAGE
#undef N1_LDA
#undef N1_LDB
#undef N1_MMA
#undef N1_WAIT_V
#undef N1_WAIT_L
#undef N1_BAR
#undef N1_SCHED
}
}
using pg8::GUnit;
typedef f32x4 AccT[2][2][4][2];
typedef f32x4 AccH[2][4][2];

template <class Sched> __device__ __forceinline__ void prep_rstd(LAS unsigned char* lds, const float* ssp, const Sched& S, bool cols, int tid) {
    LAS float* R = (LAS float*)(lds + RSTD_OFF);
    if (tid < 256) {
        f32x4 p[3][8]; bool ok[3];
#pragma unroll
        for (int i = 0; i < 3; ++i) { GUnit u; ok[i] = S.next(i, u);
            if (ok[i]) { const f32x4* q = (const f32x4*)(ssp + (size_t)((cols ? u.col0 : u.row0) + tid) * SSPN);
#pragma unroll
                for (int k = 0; k < 8; ++k) p[i][k] = q[k]; } }
#pragma unroll
        for (int i = 0; i < 3; ++i) if (ok[i]) { const f32x4 s4 = ((p[i][0] + p[i][1]) + (p[i][2] + p[i][3])) + ((p[i][4] + p[i][5]) + (p[i][6] + p[i][7]));
            R[i * 256 + tid] = rsqrtf(((s4[0] + s4[1]) + (s4[2] + s4[3])) * (1.f / 1024.f) + EPS); }
    }
    LDS_WAIT(); __builtin_amdgcn_s_barrier(); asm volatile("" ::: "memory");
}
struct EpiQKV {
    bf16_t* Q; bf16_t* KB; bf16_t* VB; float* nk; float* nv; const float* ropec; const float* ropes; const float* ssp; const float* sw; LAS unsigned char* lds;
    static constexpr bool PERM = false;
    template <class Sched> __device__ __forceinline__ void prepare(const Sched& S, LAS unsigned char* l, int tid) const { prep_rstd(l, ssp, S, false, tid); }
    __device__ __forceinline__ void operator()(const AccT& acc, const GUnit& u, int ui, int wr, int wc, int fr, int fq) const {
        const LAS float* R = (const LAS float*)(lds + RSTD_OFF) + ui * 256;
        const int sec = u.col0 >> 10;
        const bool lat = u.row0 >= NCTX;
        const int cbase = (u.col0 & 1023) + wc * 32 + 4 * fq;
        const float* swc = sw + cond_of_row(u.row0) * 3072 + u.col0 + wc * 32 + 4 * fq;
        f32x4 sv[2][2];
#pragma unroll
        for (int bj = 0; bj < 2; ++bj)
#pragma unroll
            for (int n = 0; n < 2; ++n) sv[bj][n] = *(const f32x4*)(swc + bj * 128 + n * 16);
#pragma unroll
        for (int ai = 0; ai < 2; ++ai)
#pragma unroll
            for (int m = 0; m < 4; ++m) {
                const int rl = ai * 128 + wr * 64 + m * 16 + fr, r = u.row0 + rl;
                const float rs = R[rl];
                int t = 0, kvrow = r; size_t orow = 0;
                if (lat) { const int rr = r - NCTX; t = rr & 1023; kvrow = NCTX + (rr >> 10) * 1536 + 512 + t; }
                else { const int b = r >> 8; orow = ((size_t)(b * 2) * 256 + (r & 255)) * 1024; }
                f32x4 cs = {1.f, 1.f, 1.f, 1.f}, sn = {0.f, 0.f, 0.f, 0.f};
                if (lat && sec < 2) { const int pos = (wc & 1) ? (t & 63) : (t >> 6); cs = *(const f32x4*)(ropec + pos * 16 + 4 * fq); sn = *(const f32x4*)(ropes + pos * 16 + 4 * fq); }
#pragma unroll
                for (int bj = 0; bj < 2; ++bj) {
                    f32x4 x1 = acc[ai][bj][m][0] * rs + sv[bj][0], x2 = acc[ai][bj][m][1] * rs + sv[bj][1];
                    const int c = cbase + bj * 128;
                    if (sec < 2) { const f32x4 y1 = x1 * cs - x2 * sn, y2 = x2 * cs + x1 * sn; x1 = y1; x2 = y2; }
                    u32x4 w; w.x = cvt_pk_bf16(x1[0], x1[1]); w.y = cvt_pk_bf16(x1[2], x1[3]); w.z = cvt_pk_bf16(x2[0], x2[1]); w.w = cvt_pk_bf16(x2[2], x2[3]);
                    const int c8 = c + 4 * fq;
                    if (sec == 0) *(u32x4*)(Q + (size_t)r * 1024 + c8) = w;
                    else {
                        *(u32x4*)((sec == 1 ? KB : VB) + (size_t)kvrow * 1024 + c8) = w;
                        if (!lat) { if (sec == 1) { float* o = nk + orow + c; *(f32x4*)o = x1; *(f32x4*)(o + 16) = x2; }
                                    else { float* o = nv + orow + c8; *(f32x4*)o = x1; *(f32x4*)(o + 4) = x2; } }
                    }
                }
            }
    }
};
struct EpiQKV128 {
    bf16_t* Q; bf16_t* KB; bf16_t* VB; float* nk; float* nv; const float* ropec; const float* ropes; const float* ssp; const float* sw; LAS unsigned char* lds;
    static constexpr bool PERM = false;
    template <class Sched> __device__ __forceinline__ void prepare(const Sched& S, LAS unsigned char* l, int tid) const { prep_rstd(l, ssp, S, false, tid); }
    __device__ __forceinline__ void operator()(const AccH& acc, const GUnit& u, int ui, int wr, int wc, int fr, int fq) const {
        const LAS float* R = (const LAS float*)(lds + RSTD_OFF) + ui * 256;
        const int sec = u.col0 >> 10;
        const bool lat = u.row0 >= NCTX;
        const int c = (u.col0 & 1023) + wc * 32 + 4 * fq;
        const float* swc = sw + cond_of_row(u.row0) * 3072 + u.col0 + wc * 32 + 4 * fq;
        const f32x4 sv0 = *(const f32x4*)swc, sv1 = *(const f32x4*)(swc + 16);
#pragma unroll
        for (int ai = 0; ai < 2; ++ai)
#pragma unroll
            for (int m = 0; m < 4; ++m) {
                const int rl = ai * 128 + wr * 64 + m * 16 + fr, r = u.row0 + rl;
                const float rs = R[rl];
                int t = 0, kvrow = r; size_t orow = 0;
                if (lat) { const int rr = r - NCTX; t = rr & 1023; kvrow = NCTX + (rr >> 10) * 1536 + 512 + t; }
                else { const int b = r >> 8; orow = ((size_t)(b * 2) * 256 + (r & 255)) * 1024; }
                f32x4 cs = {1.f, 1.f, 1.f, 1.f}, sn = {0.f, 0.f, 0.f, 0.f};
                if (lat && sec < 2) { const int pos = (wc & 1) ? (t & 63) : (t >> 6); cs = *(const f32x4*)(ropec + pos * 16 + 4 * fq); sn = *(const f32x4*)(ropes + pos * 16 + 4 * fq); }
                f32x4 x1 = acc[ai][m][0] * rs + sv0, x2 = acc[ai][m][1] * rs + sv1;
                if (sec < 2) { const f32x4 y1 = x1 * cs - x2 * sn, y2 = x2 * cs + x1 * sn; x1 = y1; x2 = y2; }
                u32x4 w; w.x = cvt_pk_bf16(x1[0], x1[1]); w.y = cvt_pk_bf16(x1[2], x1[3]); w.z = cvt_pk_bf16(x2[0], x2[1]); w.w = cvt_pk_bf16(x2[2], x2[3]);
                const int c8 = c + 4 * fq;
                if (sec == 0) *(u32x4*)(Q + (size_t)r * 1024 + c8) = w;
                else {
                    *(u32x4*)((sec == 1 ? KB : VB) + (size_t)kvrow * 1024 + c8) = w;
                    if (!lat) { if (sec == 1) { float* o = nk + orow + c; *(f32x4*)o = x1; *(f32x4*)(o + 16) = x2; }
                                else { float* o = nv + orow + c8; *(f32x4*)o = x1; *(f32x4*)(o + 4) = x2; } }
                }
            }
    }
};
struct EpiResid {
    float* X; const float* gate; const float* an; bf16_t* XA; float* ssp;
    static constexpr bool PERM = true;
    template <class Sched> __device__ __forceinline__ void prepare(const Sched&, LAS unsigned char*, int) const {}
    __device__ __forceinline__ void operator()(const AccT& acc, const GUnit& u, int ui, int wr, int wc, int fr, int fq) const {
        const int cbase = u.col0 + wc * 32 + 8 * fq;
        const int cnd = cond_of_row(u.row0);
        const float* g = gate + cnd * 6144;
        f32x4 gv[2][2];
#pragma unroll
        for (int bj = 0; bj < 2; ++bj)
#pragma unroll
            for (int n = 0; n < 2; ++n) gv[bj][n] = *(const f32x4*)(g + cbase + bj * 128 + n * 4);
        const float* anc = an + cnd * 1024 + cbase;
        const int slot = (u.col0 >> 8) * 4 + wc;
#pragma unroll
        for (int ai = 0; ai < 2; ++ai) {
#pragma unroll
            for (int mp = 0; mp < 2; ++mp) {
            f32x4 xo[2][2][2];
#pragma unroll
            for (int m2 = 0; m2 < 2; ++m2)
#pragma unroll
                for (int bj = 0; bj < 2; ++bj)
#pragma unroll
                    for (int n = 0; n < 2; ++n) xo[m2][bj][n] = *(const f32x4*)(X + (size_t)(u.row0 + ai * 128 + wr * 64 + (mp * 2 + m2) * 16 + fr) * 1024 + cbase + bj * 128 + n * 4);
#pragma unroll
            for (int m2 = 0; m2 < 2; ++m2) {
                const int m = mp * 2 + m2;
                const size_t ro = (size_t)(u.row0 + ai * 128 + wr * 64 + m * 16 + fr);
                float ss = 0.f;
#pragma unroll
                for (int bj = 0; bj < 2; ++bj) {
                    const f32x4 x0 = xo[m2][bj][0] + gv[bj][0] * acc[ai][bj][m][0], x1 = xo[m2][bj][1] + gv[bj][1] * acc[ai][bj][m][1];
                    *(f32x4*)(X + ro * 1024 + cbase + bj * 128) = x0; *(f32x4*)(X + ro * 1024 + cbase + bj * 128 + 4) = x1;
                    ss += ((x0[0] * x0[0] + x0[1] * x0[1]) + (x0[2] * x0[2] + x0[3] * x0[3])) + ((x1[0] * x1[0] + x1[1] * x1[1]) + (x1[2] * x1[2] + x1[3] * x1[3]));
                    if (an) { const f32x4 y0 = x0 * *(const f32x4*)(anc + bj * 128), y1 = x1 * *(const f32x4*)(anc + bj * 128 + 4); u32x4 w; w.x = cvt_pk_bf16(y0[0], y0[1]); w.y = cvt_pk_bf16(y0[2], y0[3]); w.z = cvt_pk_bf16(y1[0], y1[1]); w.w = cvt_pk_bf16(y1[2], y1[3]);
                        *(u32x4*)(XA + ro * 1024 + cbase + bj * 128) = w; }
                }
                ss += __shfl_xor(ss, 16); ss += __shfl_xor(ss, 32);
                if (fq == 0) ssp[ro * SSPN + slot] = ss;
            }
            }
            asm volatile("" ::: "memory");
        }
    }
};
struct EpiResid128 {
    bf16_t* X; const float* gate; const float* an; bf16_t* XA; float* ssp;
    static constexpr bool PERM = true;
    template <class Sched> __device__ __forceinline__ void prepare(const Sched&, LAS unsigned char*, int) const {}
    __device__ __forceinline__ void operator()(const AccH& acc, const GUnit& u, int ui, int wr, int wc, int fr, int fq) const {
        const int cbase = u.col0 + wc * 32 + 8 * fq;
        const int cnd = cond_of_row(u.row0);
        const float* g = gate + cnd * 6144;
        const f32x4 gv0 = *(const f32x4*)(g + cbase), gv1 = *(const f32x4*)(g + cbase + 4);
        f32x4 av0 = {0.f, 0.f, 0.f, 0.f}, av1 = av0;
        if (an) { av0 = *(const f32x4*)(an + cnd * 1024 + cbase); av1 = *(const f32x4*)(an + cnd * 1024 + cbase + 4); }
        const int slot = (u.col0 >> 7) * 4 + wc;
        u32x4 xo[2][4];
#pragma unroll
        for (int ai = 0; ai < 2; ++ai)
#pragma unroll
            for (int m = 0; m < 4; ++m) xo[ai][m] = *(const u32x4*)(X + (size_t)(u.row0 + ai * 128 + wr * 64 + m * 16 + fr) * 1024 + cbase);
#pragma unroll
        for (int ai = 0; ai < 2; ++ai)
#pragma unroll
            for (int m = 0; m < 4; ++m) {
                const size_t ro = (size_t)(u.row0 + ai * 128 + wr * 64 + m * 16 + fr);
                const u32x4 xw = xo[ai][m];
                const f32x4 xa = {bflo(xw.x), bfhi(xw.x), bflo(xw.y), bfhi(xw.y)}, xb = {bflo(xw.z), bfhi(xw.z), bflo(xw.w), bfhi(xw.w)};
                const f32x4 x0 = xa + gv0 * acc[ai][m][0], x1 = xb + gv1 * acc[ai][m][1];
                { u32x4 w; w.x = cvt_pk_bf16(x0[0], x0[1]); w.y = cvt_pk_bf16(x0[2], x0[3]); w.z = cvt_pk_bf16(x1[0], x1[1]); w.w = cvt_pk_bf16(x1[2], x1[3]); *(u32x4*)(X + ro * 1024 + cbase) = w; }
                float ss = ((x0[0] * x0[0] + x0[1] * x0[1]) + (x0[2] * x0[2] + x0[3] * x0[3])) + ((x1[0] * x1[0] + x1[1] * x1[1]) + (x1[2] * x1[2] + x1[3] * x1[3]));
                if (an) { const f32x4 y0 = x0 * av0, y1 = x1 * av1; u32x4 w; w.x = cvt_pk_bf16(y0[0], y0[1]); w.y = cvt_pk_bf16(y0[2], y0[3]); w.z = cvt_pk_bf16(y1[0], y1[1]); w.w = cvt_pk_bf16(y1[2], y1[3]);
                    *(u32x4*)(XA + ro * 1024 + cbase) = w; }
                ss += __shfl_xor(ss, 16); ss += __shfl_xor(ss, 32);
                if (fq == 0) ssp[ro * SSPN + slot] = ss;
            }
    }
};
struct EpiG128 {
    bf16_t* GH; const float* ssp; const float* sw; LAS unsigned char* lds;
    static constexpr bool PERM = true;
    template <class Sched> __device__ __forceinline__ void prepare(const Sched& S, LAS unsigned char* l, int tid) const { prep_rstd(l, ssp, S, false, tid); }
    __device__ __forceinline__ void operator()(const AccH& acc, const GUnit& u, int ui, int wr, int wc, int fr, int fq) const {
        const LAS float* R = (const LAS float*)(lds + RSTD_OFF) + ui * 256;
        const float* swc = sw + cond_of_row(u.row0) * 5120 + u.col0 + wc * 32 + 8 * fq;
        const f32x4 sv0 = *(const f32x4*)swc, sv1 = *(const f32x4*)(swc + 4);
        const int cbase = (u.col0 - 4096) + wc * 32 + 8 * fq;
#pragma unroll
        for (int ai = 0; ai < 2; ++ai)
#pragma unroll
            for (int m = 0; m < 4; ++m) {
                const int rl = ai * 128 + wr * 64 + m * 16 + fr; const float rs = R[rl];
                const f32x4 v0 = acc[ai][m][0] * rs + sv0, v1 = acc[ai][m][1] * rs + sv1;
                u32x4 w; w.x = cvt_pk_bf16(silu_f(v0[0]), silu_f(v0[1])); w.y = cvt_pk_bf16(silu_f(v0[2]), silu_f(v0[3])); w.z = cvt_pk_bf16(silu_f(v1[0]), silu_f(v1[1])); w.w = cvt_pk_bf16(silu_f(v1[2]), silu_f(v1[3]));
                *(u32x4*)(GH + (size_t)(u.row0 + rl) * 1024 + cbase) = w;
            }
    }
};
struct EpiFFN {
    bf16_t* ACT; const float* ssp; const float* sw; LAS unsigned char* lds;
    static constexpr bool PERM = true;
    template <class Sched> __device__ __forceinline__ void prepare(const Sched& S, LAS unsigned char* l, int tid) const { prep_rstd(l, ssp, S, false, tid); }
    __device__ __forceinline__ void operator()(const AccT& acc, const GUnit& u, int ui, int wr, int wc, int fr, int fq) const {
        const LAS float* R = (const LAS float*)(lds + RSTD_OFF) + ui * 256;
        const int abase = (u.col0 >> 1) + wc * 32 + 8 * fq;
        const float* swc = sw + cond_of_row(u.row0) * 5632 + u.col0 + wc * 32 + 8 * fq;
        f32x4 sv[2][2];
#pragma unroll
        for (int bj = 0; bj < 2; ++bj)
#pragma unroll
            for (int n = 0; n < 2; ++n) sv[bj][n] = *(const f32x4*)(swc + bj * 128 + n * 4);
#pragma unroll
        for (int ai = 0; ai < 2; ++ai)
#pragma unroll
            for (int m = 0; m < 4; ++m) {
                const int rl = ai * 128 + wr * 64 + m * 16 + fr;
                const float rs = R[rl];
                u32x4 w;
#pragma unroll
                for (int n = 0; n < 2; ++n) {
                    const f32x4 g = acc[ai][0][m][n] * rs + sv[0][n], up = acc[ai][1][m][n] * rs + sv[1][n];
                    w[2 * n] = cvt_pk_bf16(silu_f(g[0]) * up[0], silu_f(g[1]) * up[1]); w[2 * n + 1] = cvt_pk_bf16(silu_f(g[2]) * up[2], silu_f(g[3]) * up[3]);
                }
                *(u32x4*)(ACT + (size_t)(u.row0 + rl) * DFF + abase) = w;
            }
    }
};
__device__ __forceinline__ void quad_transpose(f32x4& v, int qi) {
#define QT_X1(x) __int_as_float(__builtin_amdgcn_update_dpp(0, __float_as_int(x), 0xB1, 0xF, 0xF, true))
#define QT_X2(x) __int_as_float(__builtin_amdgcn_update_dpp(0, __float_as_int(x), 0x4E, 0xF, 0xF, true))
    const bool o1 = qi & 1, o2 = qi & 2;
    { const float t0 = o1 ? v[0] : v[1], t1 = o1 ? v[2] : v[3]; const float r0 = QT_X1(t0), r1 = QT_X1(t1);
      if (o1) { v[0] = r0; v[2] = r1; } else { v[1] = r0; v[3] = r1; } }
    { const float t0 = o2 ? v[0] : v[2], t1 = o2 ? v[1] : v[3]; const float r0 = QT_X2(t0), r1 = QT_X2(t1);
      if (o2) { v[0] = r0; v[1] = r1; } else { v[2] = r0; v[3] = r1; } }
#undef QT_X1
#undef QT_X2
}
__device__ __forceinline__ void quad_transpose_pk(unsigned& p0, unsigned& p1, int qi) {
    const unsigned sel = (qi & 1) ? 0x03020706u : 0x05040100u;
    const unsigned n0 = (unsigned)__builtin_amdgcn_update_dpp(0, (int)p0, 0xB1, 0xF, 0xF, true), n1 = (unsigned)__builtin_amdgcn_update_dpp(0, (int)p1, 0xB1, 0xF, 0xF, true);
    const unsigned a0 = __builtin_amdgcn_perm(n0, p0, sel), a1 = __builtin_amdgcn_perm(n1, p1, sel);
    const bool hi2 = qi & 2;
    const unsigned send = hi2 ? a0 : a1;
    const unsigned recv = (unsigned)__builtin_amdgcn_update_dpp(0, (int)send, 0x4E, 0xF, 0xF, true);
    p0 = hi2 ? recv : a0; p1 = hi2 ? a1 : recv;
}
#define DPP_BC(x, N) __int_as_float(__builtin_amdgcn_update_dpp(0, __float_as_int(x), 0x150 + (N), 0xF, 0xF, true))
#define DPPM_SHR(x, N) __int_as_float(__builtin_amdgcn_update_dpp(0x3f800000, __float_as_int(x), 0x110 + (N), 0xF, 0xF, false))
#define DPPM_SHL(x, N) __int_as_float(__builtin_amdgcn_update_dpp(0x3f800000, __float_as_int(x), 0x100 + (N), 0xF, 0xF, false))
#define DPP_SHR(x, N) __int_as_float(__builtin_amdgcn_update_dpp(0, __float_as_int(x), 0x110 + (N), 0xF, 0xF, true))
#define DPP_SHL(x, N) __int_as_float(__builtin_amdgcn_update_dpp(0, __float_as_int(x), 0x100 + (N), 0xF, 0xF, true))
struct EpiHgrn {
    bf16_t* GH; bf16_t* QTF; bf16_t* KTF; bf16_t* QTB; bf16_t* KTB; bf16_t* KHTF; bf16_t* KHTB; bf16_t* VT; float* DDF; float* DDB; const float* lbv; const float* ssp; const float* sw; LAS unsigned char* lds;
    static constexpr bool PERM = false;
    template <class Sched> __device__ __forceinline__ void prepare(const Sched& S, LAS unsigned char* l, int tid) const { prep_rstd(l, ssp, S, false, tid); }
    __device__ __forceinline__ void operator()(const AccT& acc, const GUnit& u, int ui, int wr, int wc, int fr, int fq) const {
        const LAS float* R = (const LAS float*)(lds + RSTD_OFF) + ui * 256;
        const int t = u.col0 >> 8;
        const float* swc = sw + cond_of_row(u.row0) * 5120 + u.col0 + wc * 32 + 4 * fq;
        f32x4 sv[2][2];
#pragma unroll
        for (int bj = 0; bj < 2; ++bj)
#pragma unroll
            for (int n = 0; n < 2; ++n) sv[bj][n] = *(const f32x4*)(swc + bj * 128 + n * 16);
        if (t >= 16) {
            const int cbase = (u.col0 - 4096) + wc * 32 + 4 * fq;
#pragma unroll
            for (int ai = 0; ai < 2; ++ai)
#pragma unroll
                for (int m = 0; m < 4; ++m) {
                    const int rl = ai * 128 + wr * 64 + m * 16 + fr; const float rs = R[rl];
#pragma unroll
                    for (int bj = 0; bj < 2; ++bj)
#pragma unroll
                        for (int n = 0; n < 2; ++n) { const f32x4 v = acc[ai][bj][m][n] * rs + sv[bj][n];
                            u32x2 w; w.x = cvt_pk_bf16(silu_f(v[0]), silu_f(v[1])); w.y = cvt_pk_bf16(silu_f(v[2]), silu_f(v[3]));
                            *(u32x2*)(GH + (size_t)(u.row0 + rl) * 1024 + cbase + bj * 128 + n * 16) = w; }
                }
            return;
        }
        const int h = t >> 1, kk = (t & 1) * 64 + wc * 16 + 4 * fq, chg = t * 64 + wc * 16 + 4 * fq;
        const f32x4 lb0 = *(const f32x4*)(lbv + chg), lb1 = *(const f32x4*)(lbv + 1024 + chg);
        const int lane = fq * 16 + fr;
#pragma unroll 1
        for (int am = 0; am < 8; ++am) {
            const int ai = am >> 2, m = am & 3;
            f32x4 aq, av, azf, azb;
            switch (am) {
#define HG_CASE(I) case I: aq = acc[(I) >> 2][0][(I) & 3][0]; av = acc[(I) >> 2][0][(I) & 3][1]; azf = acc[(I) >> 2][1][(I) & 3][0]; azb = acc[(I) >> 2][1][(I) & 3][1]; break;
                HG_CASE(0) HG_CASE(1) HG_CASE(2) HG_CASE(3) HG_CASE(4) HG_CASE(5) HG_CASE(6) default: aq = acc[1][0][3][0]; av = acc[1][0][3][1]; azf = acc[1][1][3][0]; azb = acc[1][1][3][1]; break;
#undef HG_CASE
            }
            const int rl = ai * 128 + wr * 64 + m * 16 + fr; const float rs = R[rl];
            const int tok = u.row0 + rl; const size_t cg = (size_t)((tok >> 4) * 8 + h);
            const f32x4 q4 = aq * rs + sv[0][0], v4 = av * rs + sv[0][1], zf = azf * rs + sv[1][0], zb = azb * rs + sv[1][1];
            f32x4 q, kf, kb, bf, bb;
#pragma unroll
            for (int j = 0; j < 4; ++j) { q[j] = silu_f(q4[j]);
                const float ff = lb0[j] + (1.f - lb0[j]) * sigmoid_f(zf[j]), fb = lb1[j] + (1.f - lb1[j]) * sigmoid_f(zb[j]);
                kf[j] = 1.f - ff; kb[j] = 1.f - fb; bf[j] = ff; bb[j] = fb; }
#define HG_SCAN(DIR, X) asm volatile("s_nop 1\n" \
                HG_SC4(DIR, 1) HG_SC4(DIR, 2) HG_SC4(DIR, 4) HG_SC4(DIR, 8) : "+v"(X[0]), "+v"(X[1]), "+v"(X[2]), "+v"(X[3]))
#define HG_SC1(DIR, N, R) "v_mul_f32_dpp " R ", " R ", " R " " DIR ":" #N " row_mask:0xf bank_mask:0xf\n"
#define HG_SC4(DIR, N) HG_SC1(DIR, N, "%0") HG_SC1(DIR, N, "%1") HG_SC1(DIR, N, "%2") HG_SC1(DIR, N, "%3")
            { float x[4] = {bf[0], bf[1], bf[2], bf[3]}; HG_SCAN("row_shr", x); bf[0] = x[0]; bf[1] = x[1]; bf[2] = x[2]; bf[3] = x[3]; }
            { float y[4] = {bb[0], bb[1], bb[2], bb[3]}; HG_SCAN("row_shl", y); bb[0] = y[0]; bb[1] = y[1]; bb[2] = y[2]; bb[3] = y[3]; }
#undef HG_SCAN
#undef HG_SC1
#undef HG_SC4
            f32x4 qtf, ktf, khf, ddf, qtb, ktb, khb, ddb;
#pragma unroll
            for (int j = 0; j < 4; ++j) {
                const float ef = bf[j], eif = fast_rcp(ef), eb = bb[j], eib = fast_rcp(eb);
                ddf[j] = DPP_BC(ef, 15); ddb[j] = DPP_BC(eb, 0);
                qtf[j] = q[j] * ef; ktf[j] = kf[j] * eif; khf[j] = ktf[j] * ddf[j];
                qtb[j] = q[j] * eb; ktb[j] = kb[j] * eib; khb[j] = ktb[j] * ddb[j]; }
            bf16_t* rec = QTF + ((size_t)(tok * 8 + h) * 32 + (kk >> 2)) * 16;
            { u32x4 w; w.x = cvt_pk_bf16(qtf[0], qtf[1]); w.y = cvt_pk_bf16(qtf[2], qtf[3]); w.z = cvt_pk_bf16(ktf[0], ktf[1]); w.w = cvt_pk_bf16(ktf[2], ktf[3]); *(u32x4*)rec = w; }
            { u32x4 w; w.x = cvt_pk_bf16(qtb[0], qtb[1]); w.y = cvt_pk_bf16(qtb[2], qtb[3]); w.z = cvt_pk_bf16(ktb[0], ktb[1]); w.w = cvt_pk_bf16(ktb[2], ktb[3]); *(u32x4*)(rec + 8) = w; }
            const size_t to = (cg * 128 + kk + (fr & 3)) * 16 + (fr & ~3);
            { unsigned w0 = cvt_pk_bf16(khf[0], khf[1]), w1 = cvt_pk_bf16(khf[2], khf[3]); quad_transpose_pk(w0, w1, fr & 3); u32x2 w; w.x = w0; w.y = w1; *(u32x2*)(KHTF + to) = w; }
            { unsigned w0 = cvt_pk_bf16(khb[0], khb[1]), w1 = cvt_pk_bf16(khb[2], khb[3]); quad_transpose_pk(w0, w1, fr & 3); u32x2 w; w.x = w0; w.y = w1; *(u32x2*)(KHTB + to) = w; }
            { unsigned w0 = cvt_pk_bf16(v4[0], v4[1]), w1 = cvt_pk_bf16(v4[2], v4[3]); quad_transpose_pk(w0, w1, fr & 3); u32x2 w; w.x = w0; w.y = w1; *(u32x2*)(VT + to) = w; }
            if (fr == 15) *(f32x4*)(DDF + cg * 128 + kk) = ddf;
            if (fr == 0) *(f32x4*)(DDB + cg * 128 + kk) = ddb;
        }
    }
};
struct EpiFour1 {
    bf16_t* ZT; const float* ssp; const float* sw; LAS unsigned char* lds;
    static constexpr bool PERM = true;
    template <class Sched> __device__ __forceinline__ void prepare(const Sched& S, LAS unsigned char* l, int tid) const { prep_rstd(l, ssp, S, true, tid); }
    __device__ __forceinline__ void operator()(const AccT& acc, const GUnit& u, int ui, int wr, int wc, int fr, int fq) const {
        const LAS float* R = (const LAS float*)(lds + RSTD_OFF) + ui * 256;
        const int cs = u.row0 >> 10;
        const float* swc = sw + cond_of_row(u.col0) * 2048 + u.row0 + wr * 64 + fr;
#pragma unroll
        for (int bj = 0; bj < 2; ++bj) {
            const int tl = bj * 128 + wc * 32 + 8 * fq, tok = u.col0 + tl;
            const f32x4 rs0 = *(const LAS f32x4*)(R + tl), rs1 = *(const LAS f32x4*)(R + tl + 4);
            int off;
            if (tok < NCTX) off = (tok >> 8) * 512 + cs * 256 + (tok & 255);
            else { const int tt = tok - NCTX; off = 8192 + (tt >> 10) * 2048 + cs * 1024 + (tt & 1023); }
#pragma unroll
            for (int ai = 0; ai < 2; ++ai)
#pragma unroll
                for (int m = 0; m < 4; ++m) {
                    const int nrow = (u.row0 & 1023) + ai * 128 + wr * 64 + m * 16 + fr;
                    const float sh = swc[ai * 128 + m * 16];
                    const f32x4 v0 = acc[ai][bj][m][0] * rs0 + sh, v1 = acc[ai][bj][m][1] * rs1 + sh;
                    u32x4 w; w.x = cvt_pk_bf16(v0[0], v0[1]); w.y = cvt_pk_bf16(v0[2], v0[3]); w.z = cvt_pk_bf16(v1[0], v1[1]); w.w = cvt_pk_bf16(v1[2], v1[3]);
                    *(u32x4*)(ZT + (size_t)nrow * 16384 + off) = w;
                }
        }
    }
};
struct EpiBf16 {
    bf16_t* O; int ldc;
    static constexpr bool PERM = false;
    template <class Sched> __device__ __forceinline__ void prepare(const Sched&, LAS unsigned char*, int) const {}
    __device__ __forceinline__ void operator()(const AccT& acc, const GUnit& u, int ui, int wr, int wc, int fr, int fq) const {
        bf16_t* base = O + (size_t)u.aux;
        const int cbase = u.col0 + wc * 32 + 4 * fq;
#pragma unroll
        for (int ai = 0; ai < 2; ++ai)
#pragma unroll
            for (int m = 0; m < 4; ++m) {
                bf16_t* pr = base + (size_t)(u.row0 + ai * 128 + wr * 64 + m * 16 + fr) * ldc + cbase;
#pragma unroll
                for (int bj = 0; bj < 2; ++bj)
#pragma unroll
                    for (int n = 0; n < 2; ++n) { const f32x4 v = acc[ai][bj][m][n]; u32x2 w; w.x = cvt_pk_bf16(v[0], v[1]); w.y = cvt_pk_bf16(v[2], v[3]); *(u32x2*)(pr + bj * 128 + n * 16) = w; }
            }
    }
};
struct GenSched {
    const char* A; const char* A2; const char* B; int lda, ldb, nM, nN, nwg, G, c, nt, mode;
    __device__ __forceinline__ void init(int mode_, const void* A_, const void* A2_, int lda_, const void* B_, int ldb_, int M, int N, int K, int G_, int c_) {
        mode = mode_; A = (const char*)A_; A2 = (const char*)A2_; B = (const char*)B_; lda = lda_; ldb = ldb_; nM = M / 256; nN = N / 256; nwg = (mode_ == 0 || mode_ == 7 || mode_ == 8) ? nM * nN : mode_ == 1 ? 128 : mode_ == 2 ? 32 : mode_ == 5 ? 512 : 256; G = G_; c = c_; nt = K / 64; }
    __device__ __forceinline__ bool next(int i, GUnit& u) const {
        const int L = i * G + c; if (L >= nwg) return false;
        u.aux = 0;
        if (mode == 0 || mode == 7 || mode == 8) {
            if (mode == 7 && i > 0) return false;
            int half = 0; int wgid = L; if (mode == 8) { if (i > 0) return false; half = L & 1; wgid = 256 + (L >> 1); if (wgid >= nM * nN) return false; } { const int q = nwg / 8, r = nwg % 8, xcd = wgid % 8, off = wgid / 8; wgid = (xcd < r ? xcd * (q + 1) : r * (q + 1) + (xcd - r) * q) + off; }
            const int nig = 8 * nN, gid = wgid / nig, fm = gid * 8, gsz = (nM - fm) < 8 ? (nM - fm) : 8;
            const int pm = fm + ((wgid % nig) % gsz), pn = (wgid % nig) / gsz;
            u.A = A + (size_t)pm * 256 * lda * 2; u.B = B + (size_t)(pn * 256 + half * 128) * ldb * 2; u.nt = nt; u.row0 = pm * 256; u.col0 = pn * 256 + half * 128;
        } else if (mode == 1) {
            if (L < 64) { const int b = L >> 4, pm = (L >> 2) & 3, pn = L & 3;
                u.A = A + (size_t)pm * 256 * 2048 * 2; u.B = B + ((size_t)pn * 256 * 16384 + 8192 + b * 2048) * 2; u.nt = 32; u.row0 = NCTX + b * 1024 + pm * 256; u.col0 = pn * 256; }
            else { const int l = L - 64, b = l >> 2, pn = l & 3;
                u.A = A2; u.B = B + ((size_t)pn * 256 * 16384 + b * 512) * 2; u.nt = 8; u.row0 = b * 256; u.col0 = pn * 256; }
        } else if (mode == 5) {
            int wgid = L; { const int xcd = wgid % 8, off = wgid / 8; wgid = xcd * 64 + off; }
            const int gid = wgid >> 7, r = wgid & 127, pm = gid * 8 + (r & 7), pn = r >> 3;
            u.A = A + (size_t)pm * 256 * lda * 2; u.B = B + (size_t)pn * 256 * ldb * 2; u.nt = nt; u.row0 = pm * 256; u.col0 = pn * 256;
        } else if (mode == 6) {
            const int wgid = (L & 7) * 32 + (L >> 3), pm = wgid >> 3, pn = wgid & 7;
            u.A = A + (size_t)pm * 256 * lda * 2; u.B = B + (size_t)(4096 + pn * 128) * ldb * 2; u.nt = nt; u.row0 = pm * 256; u.col0 = 4096 + pn * 128;
        } else if (mode == 3) {
            const int wgid = (L & 7) * 32 + (L >> 3), pm = wgid >> 3, pn = wgid & 7;
            u.A = A + (size_t)pm * 256 * lda * 2; u.B = B + (size_t)pn * 128 * ldb * 2; u.nt = nt; u.row0 = pm * 256; u.col0 = pn * 128;
        } else if (mode == 4) {
            if (L < 128) { const int b = L >> 5, pm = (L >> 3) & 3, pn = L & 7;
                u.A = A + (size_t)pm * 256 * 2048 * 2; u.B = B + ((size_t)pn * 128 * 16384 + 8192 + b * 2048) * 2; u.nt = 32; u.row0 = NCTX + b * 1024 + pm * 256; u.col0 = pn * 128; }
            else { const int l = L - 128, b = l >> 3, pn = l & 7;
                u.A = A2; u.B = B + ((size_t)pn * 128 * 16384 + b * 512) * 2; u.nt = 8; u.row0 = b * 256; u.col0 = pn * 128; }
        } else {
            const int g = L >> 3, cs = (L >> 2) & 1, pm = L & 3;
            u.A = A + ((size_t)pm * 256 * 1024 + g * 256) * 2; u.B = B + (size_t)cs * 256 * 2; u.nt = nt;
            u.row0 = pm * 256; u.col0 = 0; u.aux = cs * 1024 * 1024 + g * 256;
        }
        return true;
    }
};
struct Args {
    const float* in[23];
    float* out; unsigned char* ws;
    int ph_lo, ph_hi; float lam_init0, lam_init1; int pad0, pad1;
};
typedef const __attribute__((address_space(4))) Args* ArgP;
enum { I_XP = 0, I_XS, I_CK, I_CV, I_ST, I_C, I_CCTX, I_WADA, I_BADA, I_GMIX, I_GFFN, I_WQKV, I_LAM, I_GSUB, I_WOA, I_WINR, I_LBL, I_GOUT, I_WOR, I_WFOUR, I_WFI, I_WFO, I_GFIN };

__device__ __forceinline__ void tr_load(const float* W, int N, int item, int lane, f32x4 (&v)[8]) {
    const int nblk = N / 32, kb = item / nblk, nb = item % nblk;
    const float* src = W + (size_t)(64 * kb + 8 * (lane >> 3)) * N + 32 * nb + (lane & 7) * 4;
#pragma unroll
    for (int i = 0; i < 8; ++i) v[i] = __builtin_nontemporal_load((const f32x4*)(src + (size_t)i * N));
}
template <class RowMap>
__device__ __forceinline__ void tr_finish(const f32x4 (&v)[8], int K, int N, bf16_t* WT, const RowMap& rowmap, int item, int lane) {
    const int nblk = N / 32, kb = item / nblk, nb = item % nblk, k0 = 64 * kb + 8 * (lane >> 3), n0 = 32 * nb + (lane & 7) * 4;
#pragma unroll
    for (int j = 0; j < 4; ++j) {
        u32x4 o; o.x = cvt_pk_bf16(v[0][j], v[1][j]); o.y = cvt_pk_bf16(v[2][j], v[3][j]); o.z = cvt_pk_bf16(v[4][j], v[5][j]); o.w = cvt_pk_bf16(v[6][j], v[7][j]);
        *(u32x4*)(WT + (size_t)rowmap(n0 + j) * K + k0) = o; }
}
template <class RowMap>
__device__ __forceinline__ void transpose_item(const float* W, int K, int N, bf16_t* WT, const RowMap& rowmap, LAS float* scr, int item, int lane) {
    f32x4 v[8]; tr_load(W, N, item, lane, v); tr_finish(v, K, N, WT, rowmap, item, lane);
}
struct RowHin { __device__ __forceinline__ int operator()(int s) const { const int sec = s >> 10, ch = s & 1023; if (sec == 2) return 4096 + ch;
    const int t = ch >> 6, cl = ch & 63, bj = sec >= 3 ? 1 : 0, n = (sec == 1 || sec == 4) ? 1 : 0; return 256 * t + 128 * bj + 32 * (cl >> 4) + 16 * n + (cl & 15); } };
struct RowQKV { __device__ __forceinline__ int operator()(int s) const { if (s < 2048) return s; const int p = s & 31; return (s & ~31) + 16 * ((p >> 2) & 1) + 4 * (p >> 3) + (p & 3); } };
struct RowId { __device__ __forceinline__ int operator()(int n) const { return n; } };
struct RowFFN { __device__ __forceinline__ int operator()(int s) const { const int n = s >= DFF ? 1 : 0, a = s - n * DFF; return 256 * (a >> 7) + 128 * n + (a & 127); } };

__device__ __forceinline__ void cache_convert(ArgP a, int j, int gw, int ngw, int lane) {
    bf16_t* KB = (bf16_t*)(a->ws + WS_KB); bf16_t* VB = (bf16_t*)(a->ws + WS_VB);
    for (int it = gw; it < 2 * 4 * 512; it += ngw) {
        const int kv = it >> 11, r = it & 2047, b = r >> 9, s = r & 511;
        const float* src = a->in[kv ? I_CV : I_CK] + ((size_t)(b * 2 + j) * 512 + s) * 1024;
        bf16_t* dst = (kv ? VB : KB) + (size_t)(NCTX + b * 1536 + s) * 1024;
#pragma unroll
        for (int q = 0; q < 2; ++q) { const f32x8 v = *(const f32x8*)(src + q * 512 + lane * 8);
            u32x4 w; w.x = cvt_pk_bf16(v[0], v[1]); w.y = cvt_pk_bf16(v[2], v[3]); w.z = cvt_pk_bf16(v[4], v[5]); w.w = cvt_pk_bf16(v[6], v[7]);
            if (kv) *(u32x4*)(dst + q * 512 + lane * 8) = w;
            else { const int d0 = q * 512 + lane * 8, p0 = d0 & 31, n = p0 >> 4, f0 = (p0 & 15) >> 2;
                bf16_t* g = dst + (d0 & ~31);
                u32x2 lo, hi; lo.x = w.x; lo.y = w.y; hi.x = w.z; hi.y = w.w;
                *(u32x2*)(g + 8 * f0 + 4 * n) = lo; *(u32x2*)(g + 8 * (f0 + 1) + 4 * n) = hi; } }
    }
}

__device__ __forceinline__ void deferred_convert(ArgP a, int set, LAS unsigned char* lds, int widx, int nw);
__device__ __forceinline__ void phase_prologue(ArgP a, LAS unsigned char* lds, int G, int bid) {
    const int tid = tid_opaque(), lane = tid & 63, wave = __builtin_amdgcn_readfirstlane(tid >> 6);
    const int gw = bid * NWAVES + wave, ngw = G * NWAVES, gt = bid * NTHREADS + tid, ngt = G * NTHREADS;
    {
        LAS float* SC = (LAS float*)lds;
        LAS float* RED = (LAS float*)(lds + 20480);
        for (int i = tid; i < 5 * 1024; i += NTHREADS) { const int cnd = i >> 10, k = i & 1023; const float x = cnd == 0 ? a->in[I_CCTX][k] : a->in[I_C][(cnd - 1) * 1024 + k]; SC[i] = silu_f(x); }
        __syncthreads();
        float* mod = (float*)(a->ws + WS_MOD);
        for (int it = bid; it < 4 * 48; it += G) {
            const int l = it / 48, cg = it % 48;
            const int kh = lane >> 5, c4 = (lane & 31) * 4;
            const float* w = a->in[I_WADA] + (size_t)l * 1024 * 6144 + (size_t)(wave * 128 + 64 * kh) * 6144 + cg * 128 + c4;
            f32x4 acc[5];
#pragma unroll
            for (int c = 0; c < 5; ++c) acc[c] = (f32x4){0.f, 0.f, 0.f, 0.f};
#pragma unroll 1
            for (int k0 = 0; k0 < 64; k0 += 16) {
                f32x4 wv[16];
#pragma unroll
                for (int kk = 0; kk < 16; ++kk) wv[kk] = __builtin_nontemporal_load((const f32x4*)(w + (size_t)(k0 + kk) * 6144));
#pragma unroll
                for (int c = 0; c < 5; ++c) {
#pragma unroll
                    for (int k4 = 0; k4 < 4; ++k4) { const f32x4 sc = *(const LAS f32x4*)(SC + c * 1024 + wave * 128 + 64 * kh + k0 + 4 * k4);
                        acc[c] += sc[0] * wv[4 * k4] + sc[1] * wv[4 * k4 + 1] + sc[2] * wv[4 * k4 + 2] + sc[3] * wv[4 * k4 + 3]; }
                }
            }
#pragma unroll
            for (int c = 0; c < 5; ++c) {
#pragma unroll
                for (int q = 0; q < 4; ++q) acc[c][q] += __shfl_xor(acc[c][q], 32);
                if (kh == 0) *(LAS f32x4*)(RED + (wave * 5 + c) * 128 + c4) = acc[c]; }
            __syncthreads();
            for (int i = tid; i < 5 * 128; i += NTHREADS) { const int c = i >> 7, col = i & 127; float s = 0.f;
#pragma unroll
                for (int wv2 = 0; wv2 < 8; ++wv2) s += RED[(wv2 * 5 + c) * 128 + col];
                mod[(size_t)(l * 5 + c) * 6144 + cg * 128 + col] = s + a->in[I_BADA][l * 6144 + cg * 128 + col]; }
            __syncthreads();
        }
    }
    if (bid >= 4 * 48) deferred_convert(a, 5, lds, (bid - 4 * 48) * NWAVES + wave, (G - 4 * 48) * NWAVES);
    deferred_convert(a, 6, lds, gw, ngw);
    {
        float* ropec = (float*)(a->ws + WS_ROPE); float* ropes = ropec + 1024;
        for (int i = gt; i < 1024; i += ngt) { const int pos = i >> 4, q = i & 15;
            float inv = (q & 3) == 0 ? 1.f : (q & 3) == 1 ? 0.56234132519f : (q & 3) == 2 ? 0.31622776602f : 0.17782794100f;
            inv *= (q >> 2) == 0 ? 1.f : (q >> 2) == 1 ? 0.1f : (q >> 2) == 2 ? 0.01f : 0.001f;
            const float ap = (float)pos * inv * 0.31830988618f;
            ropec[i] = cospif(ap); ropes[i] = sinpif(ap); }
        bf16_t* TC = (bf16_t*)(a->ws + WS_TC);
        for (int i = gt; i < 256 * 512; i += ngt) { const int c = i >> 9, k = i & 511, d = k & 255; const float ang = (float)((c * d) & 255) * (1.f / 128.f);
            const float v = (k < 256 ? cospif(ang) : sinpif(ang)) * 0.0625f; TC[c * 1024 + k] = (bf16_t)(cvt_pk_bf16(v, 0.f) & 0xffff); }
        bf16_t* C2 = (bf16_t*)(a->ws + WS_CS256);
        for (int i = gt; i < 256 * 512; i += ngt) { const int p = i >> 9, k = i & 511, t = k & 255; const float ang = (float)((p * t) & 255) * (1.f / 128.f);
            const float v = (k < 256 ? cospif(ang) : -sinpif(ang)) * 0.0625f; C2[p * 2048 + k] = (bf16_t)(cvt_pk_bf16(v, 0.f) & 0xffff); }
        bf16_t* C1 = (bf16_t*)(a->ws + WS_CS1024);
        for (int i = gt; i < 1024 * 2048; i += ngt) { const int p = i >> 11, k = i & 2047, t = k & 1023; const float ang = (float)((p * t) & 1023) * (1.f / 512.f);
            const float v = (k < 1024 ? cospif(ang) : -sinpif(ang)) * 0.03125f; C1[i] = (bf16_t)(cvt_pk_bf16(v, 0.f) & 0xffff); }
        float* lbv = (float*)(a->ws + WS_LBV);
        for (int i = gt; i < 2048; i += ngt) { const int d = i >> 10, k = i & 1023; const float* lg = a->in[I_LBL] + (size_t)d * 4096 + k;
            const float l0 = lg[0], l1 = lg[1024], l2 = lg[2048], l3 = lg[3072]; const float mx = fmaxf(fmaxf(l0, l1), fmaxf(l2, l3));
            const float e0 = __expf(l0 - mx), e1 = __expf(l1 - mx), e2 = __expf(l2 - mx), e3 = __expf(l3 - mx); lbv[i] = e1 / (e0 + e1 + e2 + e3); }
        if (gw < 2) { const int j = gw; const float* lp = a->in[I_LAM] + j * 256;
            float s1 = wave_sum(lp[lane] * lp[64 + lane]), s2 = wave_sum(lp[128 + lane] * lp[192 + lane]);
            if (lane == 0) ((float*)(a->ws + WS_LAM))[j] = __expf(s1) - __expf(s2) + (j == 0 ? a->lam_init0 : a->lam_init1); }
    }
    cache_convert(a, 0, gw, ngw, lane);
}

struct TrJob { const float* W; bf16_t* WT; int K, N, map, item; };
__device__ __forceinline__ bool tr_decode(ArgP a, int set, int it, TrJob& j) {
    constexpr int I_FI = 16 * 176, I_FO = 44 * 32, I_R = 16 * 160, I_O = 16 * 32, I_Q = 16 * 96;
    if (set == 3) {
        if (it < I_Q) { j.W = a->in[I_WQKV] + (size_t)1024 * 3072; j.WT = (bf16_t*)(a->ws + WS_WQKV) + (size_t)3072 * 1024; j.K = 1024; j.N = 3072; j.map = 3; j.item = it; return true; }
        it -= I_Q; if (it >= I_O) return false;
        j.W = a->in[I_WOA] + (size_t)1024 * 1024; j.WT = (bf16_t*)(a->ws + WS_WOA) + (size_t)1024 * 1024; j.K = 1024; j.N = 1024; j.map = 1; j.item = it; return true;
    }
    if (set == 6) {
        if (it < I_Q) { j.W = a->in[I_WQKV]; j.WT = (bf16_t*)(a->ws + WS_WQKV); j.K = 1024; j.N = 3072; j.map = 3; j.item = it; return true; }
        it -= I_Q;
        if (it < I_O) { j.W = a->in[I_WOA]; j.WT = (bf16_t*)(a->ws + WS_WOA); j.K = 1024; j.N = 1024; j.map = 1; j.item = it; return true; }
        it -= I_O;
        if (it < I_O) { j.W = a->in[I_WFOUR]; j.WT = (bf16_t*)(a->ws + WS_WFO); j.K = 1024; j.N = 1024; j.map = 1; j.item = it; return true; }
        it -= I_O;
        if (it < I_FI) { j.W = a->in[I_WFI]; j.WT = (bf16_t*)(a->ws + WS_WFI); j.K = 1024; j.N = 5632; j.map = 0; j.item = it; return true; }
        it -= I_FI; if (it >= I_FO) return false;
        j.W = a->in[I_WFO]; j.WT = (bf16_t*)(a->ws + WS_WFOUT); j.K = DFF; j.N = 1024; j.map = 1; j.item = it; return true;
    }
    if (set == 5) {
        if (it < I_R) { j.W = a->in[I_WINR]; j.WT = (bf16_t*)(a->ws + WS_WINR); j.K = 1024; j.N = 5120; j.map = 2; j.item = it; return true; }
        it -= I_R; if (it >= I_O) return false;
        j.W = a->in[I_WOR]; j.WT = (bf16_t*)(a->ws + WS_WOR); j.K = 1024; j.N = 1024; j.map = 1; j.item = it; return true;
    }
    const int l = set + 1;
    if (it < I_FI) { j.W = a->in[I_WFI] + (size_t)l * 1024 * 5632; j.WT = (bf16_t*)(a->ws + WS_WFI) + (size_t)l * 5632 * 1024; j.K = 1024; j.N = 5632; j.map = 0; j.item = it; return true; }
    it -= I_FI;
    if (it < I_FO) { j.W = a->in[I_WFO] + (size_t)l * DFF * 1024; j.WT = (bf16_t*)(a->ws + WS_WFOUT) + (size_t)l * 1024 * DFF; j.K = DFF; j.N = 1024; j.map = 1; j.item = it; return true; }
    return false;
}
__device__ __forceinline__ void deferred_convert(ArgP a, int set, LAS unsigned char* lds, int widx, int nw) {
    const int tid = tid_opaque(), lane = tid & 63, wave = __builtin_amdgcn_readfirstlane(tid >> 6);
    LAS float* scr = (LAS float*)(lds + wave * 16384);
    const int ni = set == 6 ? 16 * 96 + 2 * 16 * 32 + 16 * 176 + 44 * 32 : set == 5 ? 16 * 160 + 16 * 32 : set == 3 ? 16 * 96 + 16 * 32 : 16 * 176 + 44 * 32;
#define FW_FIN(v, j, ok) do { if (ok) { if (j.map == 0) tr_finish(v, j.K, j.N, j.WT, RowFFN(), j.item, lane); else if (j.map == 1) tr_finish(v, j.K, j.N, j.WT, RowId(), j.item, lane); \
        else if (j.map == 2) tr_finish(v, j.K, j.N, j.WT, RowHin(), j.item, lane); else tr_finish(v, j.K, j.N, j.WT, RowQKV(), j.item, lane); } } while (0)
    for (int it = widx; it < ni; it += 5 * nw) {
        f32x4 v0[8], v1[8], v2[8], v3[8], v4[8]; TrJob j0, j1, j2, j3, j4;
        const bool k0 = tr_decode(a, set, it, j0), k1 = tr_decode(a, set, it + nw, j1), k2 = tr_decode(a, set, it + 2 * nw, j2);
        const bool k3 = tr_decode(a, set, it + 3 * nw, j3), k4 = tr_decode(a, set, it + 4 * nw, j4);
        if (k0) tr_load(j0.W, j0.N, j0.item, lane, v0); if (k1) tr_load(j1.W, j1.N, j1.item, lane, v1); if (k2) tr_load(j2.W, j2.N, j2.item, lane, v2);
        if (k3) tr_load(j3.W, j3.N, j3.item, lane, v3); if (k4) tr_load(j4.W, j4.N, j4.item, lane, v4);
        FW_FIN(v0, j0, k0); FW_FIN(v1, j1, k1); FW_FIN(v2, j2, k2); FW_FIN(v3, j3, k3); FW_FIN(v4, j4, k4);
    }
#undef FW_FIN
}

__device__ __forceinline__ void phase_first_norm(ArgP a, int gw, int ngw, int lane) {
    bf16_t* X = (bf16_t*)(a->ws + WS_X); bf16_t* XA = (bf16_t*)(a->ws + WS_H); float* ssp = (float*)(a->ws + WS_SSP);
    const float* mod = (const float*)(a->ws + WS_MOD); const float* gm = a->in[I_GMIX];
    for (int r = gw; r < MTOK; r += ngw) {
        const float* xr = r < NCTX ? a->in[I_XP] + (size_t)r * 1024 : a->in[I_XS] + (size_t)(r - NCTX) * 1024;
        const float* sc = mod + (size_t)cond_of_row(r) * 6144 + 1024;
        float s = 0.f;
#pragma unroll
        for (int j = 0; j < 4; ++j) {
            const int c = j * 256 + lane * 4;
            const f32x4 v = *(const f32x4*)(xr + c); s += (v.x * v.x + v.y * v.y) + (v.z * v.z + v.w * v.w);
            const f32x4 y = v * (*(const f32x4*)(gm + c) * (1.f + *(const f32x4*)(sc + c)));
            u32x2 w; w.x = cvt_pk_bf16(y[0], y[1]); w.y = cvt_pk_bf16(y[2], y[3]);
            *(u32x2*)(XA + (size_t)r * 1024 + c) = w; { u32x2 xw; xw.x = cvt_pk_bf16(v[0], v[1]); xw.y = cvt_pk_bf16(v[2], v[3]); *(u32x2*)(X + (size_t)r * 1024 + c) = xw; }
        }
        s = wave_sum(s);
        if (lane < SSPN) ssp[(size_t)r * SSPN + lane] = lane == 0 ? s : 0.f;
    }
}
__device__ __forceinline__ void phase_final(ArgP a, int gw, int ngw, int lane) {
    const bf16_t* X = (const bf16_t*)(a->ws + WS_X); const float* g = a->in[I_GFIN]; const float* ssp = (const float*)(a->ws + WS_SSP) + 8ull * 8192 * SSPN;
    for (int r = gw; r < MTOK; r += ngw) {
        const bf16_t* xr = X + (size_t)r * 1024;
        float s = lane < SSPN ? ssp[(size_t)r * SSPN + lane] : 0.f;
        const float rstd = rsqrtf(wave_sum(s) * (1.f / 1024.f) + EPS);
#pragma unroll
        for (int j = 0; j < 4; ++j) { const int c = j * 256 + lane * 4; const u32x2 xw = *(const u32x2*)(xr + c); const f32x4 xv = {bflo(xw.x), bfhi(xw.x), bflo(xw.y), bfhi(xw.y)};
            *(f32x4*)(a->out + (size_t)r * 1024 + c) = xv * rstd * *(const f32x4*)(g + c); }
    }
}
__device__ __forceinline__ void phase_an(ArgP a, int gt, int ngt) {
    float* an = (float*)(a->ws + WS_AN); const float* mod = (const float*)(a->ws + WS_MOD);
    for (int i = gt; i < 8 * 5 * 1024; i += ngt) { const int nidx = i / 5120, c = (i / 1024) % 5, k = i & 1023, l = nidx >> 1, wh = nidx & 1;
        an[i] = a->in[wh ? I_GFFN : I_GMIX][l * 1024 + k] * (1.f + mod[(size_t)(l * 5 + c) * 6144 + (wh ? 4 : 1) * 1024 + k]); }
}
__device__ __forceinline__ void phase_sw(ArgP a, LAS unsigned char* lds, unsigned mask, int gw, int ngw, int tid, int lane) {
    LAS float* SH = (LAS float*)lds;
    const float* mod = (const float*)(a->ws + WS_MOD); float* swb = (float*)(a->ws + WS_SW);
    for (int nidx = 0; nidx < 8; ++nidx) {
        if (!((mask >> nidx) & 1)) continue;
        const int l = nidx >> 1, wh = nidx & 1, N = sw_n(nidx);
        const bf16_t* W = nidx == 0 ? (const bf16_t*)(a->ws + WS_WQKV) : nidx == 6 ? (const bf16_t*)(a->ws + WS_WQKV) + 3072ull * 1024 : nidx == 2 ? (const bf16_t*)(a->ws + WS_WINR)
                        : nidx == 4 ? (const bf16_t*)(a->ws + WS_WCS) : (const bf16_t*)(a->ws + WS_WFI) + (size_t)l * 5632 * 1024;
        __syncthreads();
        for (int i = tid; i < 5 * 1024; i += NTHREADS) SH[i] = mod[(size_t)(l * 5 + (i >> 10)) * 6144 + (wh ? 3 : 0) * 1024 + (i & 1023)];
        __syncthreads();
        float* sw = swb + sw_off(nidx);
        for (int n0 = gw; n0 < N; n0 += 4 * ngw) {
            u32x4 wa[4], wb[4];
#pragma unroll
            for (int q = 0; q < 4; ++q) { const int n = n0 + q * ngw;
                if (n < N) { wa[q] = *(const u32x4*)(W + (size_t)n * 1024 + lane * 8); wb[q] = *(const u32x4*)(W + (size_t)n * 1024 + 512 + lane * 8); } }
#pragma unroll
            for (int q = 0; q < 4; ++q) { const int n = n0 + q * ngw;
                if (n < N) {
                    const u32x4 w0 = wa[q], w1 = wb[q];
                    float wf[16];
#pragma unroll
                    for (int i = 0; i < 4; ++i) { wf[2 * i] = bflo(w0[i]); wf[2 * i + 1] = bfhi(w0[i]); wf[8 + 2 * i] = bflo(w1[i]); wf[8 + 2 * i + 1] = bfhi(w1[i]); }
                    float acc[5];
#pragma unroll
                    for (int c = 0; c < 5; ++c) {
                        const f32x4 s0 = *(const LAS f32x4*)(SH + c * 1024 + lane * 8), s1 = *(const LAS f32x4*)(SH + c * 1024 + lane * 8 + 4);
                        const f32x4 s2 = *(const LAS f32x4*)(SH + c * 1024 + 512 + lane * 8), s3 = *(const LAS f32x4*)(SH + c * 1024 + 512 + lane * 8 + 4);
                        float t = 0.f;
#pragma unroll
                        for (int i = 0; i < 4; ++i) t += wf[i] * s0[i] + wf[4 + i] * s1[i] + wf[8 + i] * s2[i] + wf[12 + i] * s3[i];
                        acc[c] = wave_sum(t);
                    }
                    if (lane < 5) sw[(size_t)lane * N + n] = lane == 0 ? acc[0] : lane == 1 ? acc[1] : lane == 2 ? acc[2] : lane == 3 ? acc[3] : acc[4];
                } }
        }
    }
    __syncthreads();
}
__device__ __forceinline__ void phase_hgrn_final(ArgP a, int gw, int ngw, int lane) {
    const bf16_t* OF = (const bf16_t*)(a->ws + WS_OF); const bf16_t* OB = (const bf16_t*)(a->ws + WS_OB); const bf16_t* GH = (const bf16_t*)(a->ws + WS_GH);
    bf16_t* O = (bf16_t*)(a->ws + WS_O); const float* go = a->in[I_GOUT];
    for (int r = gw; r < MTOK; r += ngw) {
        const size_t off = (size_t)r * 1024 + lane * 16;
        u32x4 f0 = *(const u32x4*)(OF + off), f1 = *(const u32x4*)(OF + off + 8), b0 = *(const u32x4*)(OB + off), b1 = *(const u32x4*)(OB + off + 8);
        u32x4 g0 = *(const u32x4*)(GH + off), g1 = *(const u32x4*)(GH + off + 8);
        float o[16], gt[16];
#pragma unroll
        for (int i = 0; i < 4; ++i) { o[2 * i] = bflo(f0[i]) + bflo(b0[i]); o[2 * i + 1] = bfhi(f0[i]) + bfhi(b0[i]); o[8 + 2 * i] = bflo(f1[i]) + bflo(b1[i]); o[8 + 2 * i + 1] = bfhi(f1[i]) + bfhi(b1[i]);
            gt[2 * i] = bflo(g0[i]); gt[2 * i + 1] = bfhi(g0[i]); gt[8 + 2 * i] = bflo(g1[i]); gt[8 + 2 * i + 1] = bfhi(g1[i]); }
        float s = 0.f;
#pragma unroll
        for (int i = 0; i < 16; ++i) s += o[i] * o[i];
        s += __shfl_xor(s, 1); s += __shfl_xor(s, 2); s += __shfl_xor(s, 4);
        const float rstd = rsqrtf(s * (1.f / 128.f) + EPS);
        const int vc = (lane & 7) * 16;
        u32x4 w0, w1;
#pragma unroll
        for (int i = 0; i < 4; ++i) {
            w0[i] = cvt_pk_bf16(o[2 * i] * rstd * go[vc + 2 * i] * gt[2 * i], o[2 * i + 1] * rstd * go[vc + 2 * i + 1] * gt[2 * i + 1]);
            w1[i] = cvt_pk_bf16(o[8 + 2 * i] * rstd * go[vc + 8 + 2 * i] * gt[8 + 2 * i], o[8 + 2 * i + 1] * rstd * go[vc + 8 + 2 * i + 1] * gt[8 + 2 * i + 1]); }
        *(u32x4*)(O + off) = w0; *(u32x4*)(O + off + 8) = w1;
    }
}

namespace att {
constexpr int KVBLK = 64, LDQ = 1024;
constexpr float SCALE = 0.125f, THR = 8.f;
constexpr size_t SHM_V = KVBLK * 128 * 2, SHM_K = KVBLK * 128 * 2;
#define KSWZ(row, colB) ((row) * 256 + ((colB) ^ (((row) & 7) << 4)))
#define SBAR() __builtin_amdgcn_sched_barrier(0)
__device__ __forceinline__ int crow(int r, int hi) { return (r & 3) + 8 * (r >> 2) + 4 * hi; }
__device__ __forceinline__ unsigned cvtpk(float lo, float hi) { unsigned r; asm volatile("v_cvt_pk_bf16_f32 %0, %1, %2" : "=v"(r) : "v"(lo), "v"(hi)); return r; }
__device__ __forceinline__ void partialSM(f32x16& p0, f32x16& p1, float& m_reg, float& mn, float& alpha) {
  constexpr float C = SCALE * 1.4426950408889634f;
  float pmax = p0[0];
#pragma unroll
  for (int r = 1; r < 16; ++r) pmax = fmaxf(pmax, p0[r]);
#pragma unroll
  for (int r = 0; r < 16; ++r) pmax = fmaxf(pmax, p1[r]);
  { auto rr = __builtin_amdgcn_permlane32_swap(__float_as_uint(pmax), __float_as_uint(pmax), false, false);
    pmax = fmaxf(__uint_as_float(rr[0]), __uint_as_float(rr[1])); }
  if (__builtin_expect(__all(pmax - m_reg <= THR / SCALE), 1)) { mn = m_reg; alpha = 1.f; }
  else { mn = fmaxf(m_reg, pmax); alpha = __builtin_amdgcn_exp2f((m_reg - mn) * C); m_reg = mn; }
  float mnC = -mn * C;
#pragma unroll
  for (int r = 0; r < 16; ++r) p0[r] = fmaf(p0[r], C, mnC);
#pragma unroll
  for (int r = 0; r < 16; ++r) p1[r] = fmaf(p1[r], C, mnC);
#pragma unroll
  for (int r = 0; r < 16; ++r) p0[r] = __builtin_amdgcn_exp2f(p0[r]);
}
__device__ __forceinline__ void finishSM(f32x16& p0, f32x16& p1, float alpha, float& l_reg, bf16x8& pa0, bf16x8& pa1, bf16x8& pa2, bf16x8& pa3) {
#pragma unroll
  for (int r = 0; r < 16; ++r) p1[r] = __builtin_amdgcn_exp2f(p1[r]);
  float ps = 0;
#pragma unroll
  for (int r = 0; r < 16; ++r) ps += p0[r];
#pragma unroll
  for (int r = 0; r < 16; ++r) ps += p1[r];
  { auto rr = __builtin_amdgcn_permlane32_swap(__float_as_uint(ps), __float_as_uint(ps), false, false);
    ps = __uint_as_float(rr[0]) + __uint_as_float(rr[1]); }
  l_reg = l_reg * alpha + ps;
#define PK4(P, BASE, OUT) do { unsigned a0 = cvtpk(P[BASE + 0], P[BASE + 1]), a1 = cvtpk(P[BASE + 2], P[BASE + 3]);   \
    unsigned b0 = cvtpk(P[BASE + 4], P[BASE + 5]), b1 = cvtpk(P[BASE + 6], P[BASE + 7]);                              \
    auto r0 = __builtin_amdgcn_permlane32_swap(a0, b0, false, false); auto r1 = __builtin_amdgcn_permlane32_swap(a1, b1, false, false); \
    u32x4 w = {r0[0], r1[0], r0[1], r1[1]}; OUT = *reinterpret_cast<bf16x8*>(&w); } while (0)
  PK4(p0, 0, pa0); PK4(p0, 8, pa1); PK4(p1, 0, pa2); PK4(p1, 8, pa3);
#undef PK4
}
__device__ __forceinline__ void qkt(f32x16& p0, f32x16& p1, const bf16_t* Ks, const bf16x8* qr, int r32, int hi, int cc) {
  p0 = f32x16{}; p1 = f32x16{};
#pragma unroll
  for (int d0 = 0; d0 < 4; ++d0) { int cb = (cc * 64 + d0 * 16 + hi * 8) * 2;
    bf16x8 b0 = *reinterpret_cast<const bf16x8*>((const char*)Ks + KSWZ(r32, cb));
    bf16x8 b1 = *reinterpret_cast<const bf16x8*>((const char*)Ks + KSWZ(32 + r32, cb));
    p0 = __builtin_amdgcn_mfma_f32_32x32x16_bf16(b0, qr[d0], p0, 0, 0, 0);
    p1 = __builtin_amdgcn_mfma_f32_32x32x16_bf16(b1, qr[d0], p1, 0, 0, 0); }
}
__device__ __forceinline__ int v_st(int k, int c) { const int kk = (k & ~0xC) | ((k & 4) << 1) | ((k & 8) >> 1); return ((kk >> 3) * 4 + (c >> 5)) * 512 + ((kk & 7) * 32 + (c & 31)) * 2; }
__device__ __forceinline__ int v_rd_base(int lane) { return ((lane & 3) << 3) | (((lane >> 2) & 3) << 6) | (((lane >> 4) & 1) << 5) | (((lane >> 5) & 1) << 8); }
constexpr int v_rd_off(int d0, int ks, int half) { return d0 * 512 + ks * 4096 + half * 2048; }
template <int OFF> __device__ __forceinline__ s16x4 tr_read(int vb) {
  s16x4 r; asm volatile("ds_read_b64_tr_b16 %0, %1 offset:%2" : "=&v"(r) : "v"(vb), "i"(OFF) : "memory"); return r;
}
template <int D0> __device__ __forceinline__ void pv_one(f32x16& od, int vb, bf16x8 pa0, bf16x8 pa1, bf16x8 pa2, bf16x8 pa3) {
  const s16x4 l0 = tr_read<v_rd_off(D0, 0, 0)>(vb), h0 = tr_read<v_rd_off(D0, 0, 1)>(vb), l1 = tr_read<v_rd_off(D0, 1, 0)>(vb), h1 = tr_read<v_rd_off(D0, 1, 1)>(vb);
  const s16x4 l2 = tr_read<v_rd_off(D0, 2, 0)>(vb), h2 = tr_read<v_rd_off(D0, 2, 1)>(vb), l3 = tr_read<v_rd_off(D0, 3, 0)>(vb), h3 = tr_read<v_rd_off(D0, 3, 1)>(vb);
  asm volatile("s_waitcnt lgkmcnt(0)" ::: "memory"); SBAR();
#define PK(L, H) (bf16x8){L[0], L[1], L[2], L[3], H[0], H[1], H[2], H[3]}
  od = __builtin_amdgcn_mfma_f32_32x32x16_bf16(pa0, PK(l0, h0), od, 0, 0, 0);
  od = __builtin_amdgcn_mfma_f32_32x32x16_bf16(pa1, PK(l1, h1), od, 0, 0, 0);
  od = __builtin_amdgcn_mfma_f32_32x32x16_bf16(pa2, PK(l2, h2), od, 0, 0, 0);
  od = __builtin_amdgcn_mfma_f32_32x32x16_bf16(pa3, PK(l3, h3), od, 0, 0, 0);
#undef PK
}
__device__ __forceinline__ void pv_d0(f32x16* o, int vb, bf16x8 pa0, bf16x8 pa1, bf16x8 pa2, bf16x8 pa3) {
  pv_one<0>(o[0], vb, pa0, pa1, pa2, pa3); pv_one<1>(o[1], vb, pa0, pa1, pa2, pa3); pv_one<2>(o[2], vb, pa0, pa1, pa2, pa3); pv_one<3>(o[3], vb, pa0, pa1, pa2, pa3);
}
__device__ __forceinline__ void diff_attn_unit(const bf16_t* __restrict__ Qb, const bf16_t* __restrict__ Kh, const bf16_t* __restrict__ Vh, bf16_t* __restrict__ Ob,
                                               int seq, char* lds, float lam, const float* __restrict__ gsub, float oscale) {
  const int tid = tid_opaque(), wid = tid >> 6, lane = tid & 63, r32 = lane & 31, hi = lane >> 5;
  const int qblk = wid >> 1, cc = wid & 1;
  bf16_t* V_lds = (bf16_t*)lds; bf16_t* K_lds = (bf16_t*)(lds + 2 * SHM_V);
  float* ws = (float*)(lds + 2 * SHM_V + 2 * SHM_K) + wid * 64; float* li_l = ws; float* al_l = ws + 32;
  float m_reg = -1e30f, l_reg = 0; f32x16 o[4] = {}; bf16x8 qr[4];
  const bf16_t* Qw = Qb + (long)(qblk * 32 + r32) * LDQ + cc * 64 + hi * 8;
#pragma unroll
  for (int d0 = 0; d0 < 4; ++d0) qr[d0] = *reinterpret_cast<const bf16x8*>(Qw + d0 * 16);
  const int sr = tid >> 4, sc = (tid & 15) * 8, vst0 = v_st(sr, sc), vst1 = v_st(32 + sr, sc);
  const int vb0 = (int)(uintptr_t)V_lds + v_rd_base(lane);
  struct { bf16x8 vs0, vs1, ks0, ks1; } sr_[2];
#define SLOAD(i, k0) do { sr_[i].vs0 = *reinterpret_cast<const bf16x8*>(&Vh[(long)((k0) + sr) * LDQ + sc]); sr_[i].vs1 = *reinterpret_cast<const bf16x8*>(&Vh[(long)((k0) + 32 + sr) * LDQ + sc]); \
    sr_[i].ks0 = *reinterpret_cast<const bf16x8*>(&Kh[(long)((k0) + sr) * LDQ + sc]); sr_[i].ks1 = *reinterpret_cast<const bf16x8*>(&Kh[(long)((k0) + 32 + sr) * LDQ + sc]); } while (0)
#define SWRITE(b, i) do { *(bf16x8*)((char*)V_lds + (b) * SHM_V + vst0) = sr_[i].vs0;          \
    *(bf16x8*)((char*)V_lds + (b) * SHM_V + vst1) = sr_[i].vs1; int kc = sc * 2;               \
    *(bf16x8*)((char*)K_lds + (b) * SHM_K + KSWZ(sr, kc)) = sr_[i].ks0;                       \
    *(bf16x8*)((char*)K_lds + (b) * SHM_K + KSWZ(32 + sr, kc)) = sr_[i].ks1; } while (0)
#define SWAIT() asm volatile("s_waitcnt vmcnt(4)" ::: "memory")
#define RESC(a) do { if (__any((a) < 1.f)) { if (hi == 0) al_l[r32] = (a); asm volatile("s_waitcnt lgkmcnt(0)" ::: "memory"); \
    _Pragma("unroll") for (int d = 0; d < 4; ++d) _Pragma("unroll") for (int r = 0; r < 16; ++r) o[d][r] *= al_l[crow(r, hi)]; } } while (0)
  f32x16 pA0, pA1, pB0, pB1; float mnA, mnB, alA, alB; bf16x8 pa0, pa1, pa2, pa3; const int NT = seq / KVBLK;
  constexpr int SE = 0, SO = 1;
  SLOAD(SE, 0); asm volatile("s_waitcnt vmcnt(0)" ::: "memory"); SWRITE(0, SE); __syncthreads();
  qkt(pA0, pA1, K_lds, qr, r32, hi, cc); partialSM(pA0, pA1, m_reg, mnA, alA);
  SLOAD(SO, KVBLK); if (2 < NT) SLOAD(SE, 2 * KVBLK);
  SWAIT(); SWRITE(1, SO); __syncthreads();
  for (int j = 1; j + 1 < NT; j += 2) {
    SBAR(); qkt(pB0, pB1, (bf16_t*)((char*)K_lds + SHM_K), qr, r32, hi, cc);
    finishSM(pA0, pA1, alA, l_reg, pa0, pa1, pa2, pa3); SBAR();
    SLOAD(SO, (j + 2) * KVBLK); SBAR();
    pv_d0(o, vb0, pa0, pa1, pa2, pa3); partialSM(pB0, pB1, m_reg, mnB, alB);
    __syncthreads(); SWAIT(); SWRITE(0, SE);
    RESC(alB); __syncthreads();
    SBAR(); qkt(pA0, pA1, K_lds, qr, r32, hi, cc);
    finishSM(pB0, pB1, alB, l_reg, pa0, pa1, pa2, pa3); SBAR();
    if (j + 3 < NT) SLOAD(SE, (j + 3) * KVBLK); SBAR();
    pv_d0(o, vb0 + (int)SHM_V, pa0, pa1, pa2, pa3); partialSM(pA0, pA1, m_reg, mnA, alA);
    __syncthreads(); SWAIT(); SWRITE(1, SO);
    RESC(alA); __syncthreads();
  }
  SBAR(); qkt(pB0, pB1, (bf16_t*)((char*)K_lds + SHM_K), qr, r32, hi, cc);
  finishSM(pA0, pA1, alA, l_reg, pa0, pa1, pa2, pa3); SBAR();
  pv_d0(o, vb0, pa0, pa1, pa2, pa3); partialSM(pB0, pB1, m_reg, mnB, alB);
  __syncthreads(); RESC(alB);
  finishSM(pB0, pB1, alB, l_reg, pa0, pa1, pa2, pa3); SBAR();
  pv_d0(o, vb0 + (int)SHM_V, pa0, pa1, pa2, pa3);
  if (hi == 0) li_l[r32] = l_reg; asm volatile("s_waitcnt lgkmcnt(0)" ::: "memory");
  float rli[16];
#pragma unroll
  for (int r = 0; r < 16; ++r) rli[r] = __builtin_amdgcn_rcpf(li_l[crow(r, hi)]);
  __syncthreads();
  float* xch = (float*)lds + qblk * (32 * 128);
  if (cc == 1) {
#pragma unroll
    for (int r = 0; r < 16; ++r)
#pragma unroll
      for (int d0 = 0; d0 < 4; ++d0) xch[crow(r, hi) * 128 + d0 * 32 + r32] = lam * o[d0][r] * rli[r];
  }
  __syncthreads();
  if (cc == 0) {
    float gs[4];
#pragma unroll
    for (int d0 = 0; d0 < 4; ++d0) gs[d0] = gsub[d0 * 32 + r32] * oscale;
#pragma unroll
    for (int r = 0; r < 16; ++r) {
      float ss = 0.f;
#pragma unroll
      for (int d0 = 0; d0 < 4; ++d0) { const float v = o[d0][r] * rli[r] - xch[crow(r, hi) * 128 + d0 * 32 + r32]; o[d0][r] = v; ss += v * v; }
      ss += __shfl_xor(ss, 1); ss += __shfl_xor(ss, 2); ss += __shfl_xor(ss, 4); ss += __shfl_xor(ss, 8); ss += __shfl_xor(ss, 16);
      const float rs = rsqrtf(ss * (1.f / 128.f) + EPS);
      bf16_t* orow = Ob + (long)(qblk * 32 + crow(r, hi)) * LDQ;
#pragma unroll
      for (int d0 = 0; d0 < 4; ++d0) orow[d0 * 32 + r32] = (bf16_t)(cvtpk(o[d0][r] * rs * gs[d0], 0.f) & 0xffff);
    }
  }
  __syncthreads();
#undef SLOAD
#undef SWRITE
#undef SWAIT
#undef RESC
}
#undef KSWZ
#undef SBAR
constexpr int LDS_NEED = 2 * SHM_V + 2 * SHM_K + 8 * 64 * 4;
}

__device__ __forceinline__ void phase_attn(ArgP a, int j, char* lds, int G, int bid) {
    const bf16_t* Q = (const bf16_t*)(a->ws + WS_Q); const bf16_t* KB = (const bf16_t*)(a->ws + WS_KB); const bf16_t* VB = (const bf16_t*)(a->ws + WS_VB);
    bf16_t* O = (bf16_t*)(a->ws + WS_O);
    const float lam = ((const float*)(a->ws + WS_LAM))[j];
    const float oscale = 1.f - (j == 0 ? a->lam_init0 : a->lam_init1);
    const float* gsub = a->in[I_GSUB] + j * 128;
    for (int u0 = bid; u0 < 512; u0 += G) {
        const int u = (u0 & 256) + (u0 & 7) * 32 + ((u0 & 255) >> 3);
        int qrow, krow, seq, h;
        if (u < 256) { const int b = u >> 6; h = (u >> 3) & 7; const int qb = u & 7; qrow = NCTX + b * 1024 + qb * 128; krow = NCTX + b * 1536; seq = 1536; }
        else { const int v = u - 256, b = v >> 4; h = (v >> 1) & 7; const int qb = v & 1; qrow = b * 256 + qb * 128; krow = b * 256; seq = 256; }
        att::diff_attn_unit(Q + (size_t)qrow * 1024 + h * 128, KB + (size_t)krow * 1024 + h * 128, VB + (size_t)krow * 1024 + h * 128, O + (size_t)qrow * 1024 + h * 128,
                            seq, lds, lam, gsub, oscale);
    }
}

namespace hg {
constexpr int QT_OFF = 0, KT_OFF = 64 * 272, KHT_OFF = 2 * 64 * 272, VT_OFF = KHT_OFF + 128 * 144, DD_OFF = VT_OFF + 128 * 144, LDS_NEED = DD_OFF + 4 * 128 * 4;
__device__ __forceinline__ s16x4 pk4(f32x4 v) { u32x2 w; w.x = cvt_pk_bf16(v[0], v[1]); w.y = cvt_pk_bf16(v[2], v[3]); return __builtin_bit_cast(s16x4, w); }
struct Stage { u32x4 qk[4], kh[2], v[2], d; };
__device__ __forceinline__ void scan_unit(int tok0, int n, int h, int dir, int vbase, int nwv, const bf16_t* __restrict__ QK, const bf16_t* __restrict__ KHT, const bf16_t* __restrict__ VT,
                                          const float* __restrict__ DD, const float* __restrict__ s0, float* __restrict__ sout, bf16_t* __restrict__ Od, LAS unsigned char* lds) {
    const int tid = tid_opaque(), lane = tid & 63, wv = __builtin_amdgcn_readfirstlane(tid >> 6), l15 = lane & 15, g = lane >> 4;
    const bool act = wv < nwv;
    const int vc = vbase + 16 * wv + l15;
    f32x4 S[8];
#pragma unroll
    for (int i = 0; i < 8; ++i) {
        if (s0 && act) {
#pragma unroll
            for (int r = 0; r < 4; ++r) S[i][r] = s0[(size_t)(16 * i + 4 * g + r) * 128 + vc]; }
        else S[i] = (f32x4){0.f, 0.f, 0.f, 0.f};
    }
    const int nms = n >> 6;
    Stage st;
#define HG_LOAD(msn) do { const int tb_ = tok0 + (msn) * 64; \
        _Pragma("unroll") for (int i_ = 0; i_ < 4; ++i_) { const int p_ = tid + 512 * i_; \
            st.qk[i_] = *(const u32x4*)(QK + ((size_t)((tb_ + (p_ >> 5)) * 8 + h) * 32 + (p_ & 31)) * 16 + dir * 8); } \
        _Pragma("unroll") for (int i_ = 0; i_ < 2; ++i_) { const int p_ = tid + 512 * i_; \
            const size_t to_ = ((size_t)(((tb_ >> 4) + (p_ >> 8)) * 8 + h) * 128 + ((p_ & 255) >> 1)) * 16 + (p_ & 1) * 8; st.kh[i_] = *(const u32x4*)(KHT + to_); st.v[i_] = *(const u32x4*)(VT + to_); } \
        if (tid < 128) st.d = *(const u32x4*)(DD + (size_t)(((tb_ >> 4) + (tid >> 5)) * 8 + h) * 128 + (tid & 31) * 4); } while (0)
#define HG_STORE() do { \
        _Pragma("unroll") for (int i_ = 0; i_ < 4; ++i_) { const int p_ = tid + 512 * i_; u32x2 lo_, hi_; lo_.x = st.qk[i_].x; lo_.y = st.qk[i_].y; hi_.x = st.qk[i_].z; hi_.y = st.qk[i_].w; \
            *(LAS u32x2*)(lds + QT_OFF + (p_ >> 5) * 272 + (p_ & 31) * 8) = lo_; *(LAS u32x2*)(lds + KT_OFF + (p_ >> 5) * 272 + (p_ & 31) * 8) = hi_; } \
        _Pragma("unroll") for (int i_ = 0; i_ < 2; ++i_) { const int p_ = tid + 512 * i_; \
            const int lo2_ = ((p_ & 255) >> 1) * 144 + ((p_ >> 8) * 16 + (p_ & 1) * 8) * 2; *(LAS u32x4*)(lds + KHT_OFF + lo2_) = st.kh[i_]; *(LAS u32x4*)(lds + VT_OFF + lo2_) = st.v[i_]; } \
        if (tid < 128) *(LAS u32x4*)(lds + DD_OFF + ((tid >> 5) * 128 + (tid & 31) * 4) * 4) = st.d; } while (0)
    HG_LOAD(dir ? nms - 1 : 0);
    HG_STORE();
    __syncthreads();
    for (int ms = 0; ms < nms; ++ms) {
        const int msn = dir ? nms - 1 - ms : ms;
        if (ms + 1 < nms) HG_LOAD(dir ? msn - 1 : msn + 1);
        __builtin_amdgcn_sched_barrier(0);
        if (act) {
        s16x4 xb[4];
#pragma unroll
        for (int cp = 0; cp < 4; cp += 2) {
            bf16x8 ka[2][4], qb[2][4];
#pragma unroll
            for (int q = 0; q < 2; ++q)
#pragma unroll
                for (int kk = 0; kk < 4; ++kk) {
                    ka[q][kk] = *(const LAS bf16x8*)(lds + KT_OFF + ((cp + q) * 16 + l15) * 272 + kk * 64 + g * 16);
                    qb[q][kk] = *(const LAS bf16x8*)(lds + QT_OFF + ((cp + q) * 16 + l15) * 272 + kk * 64 + g * 16); }
            __builtin_amdgcn_sched_barrier(0);
            f32x4 X0 = {0.f, 0.f, 0.f, 0.f}, X1 = {0.f, 0.f, 0.f, 0.f};
#pragma unroll
            for (int kk = 0; kk < 4; ++kk) { X0 = __builtin_amdgcn_mfma_f32_16x16x32_bf16(ka[0][kk], qb[0][kk], X0, 0, 0, 0); X1 = __builtin_amdgcn_mfma_f32_16x16x32_bf16(ka[1][kk], qb[1][kk], X1, 0, 0, 0); }
#pragma unroll
            for (int r = 0; r < 4; ++r) if (dir ? (4 * g + r < l15) : (4 * g + r > l15)) { X0[r] = 0.f; X1[r] = 0.f; }
            xb[cp] = pk4(X0); xb[cp + 1] = pk4(X1);
            __builtin_amdgcn_sched_barrier(0);
        }
        f32x4 dvA[8], dvB[8]; s16x4 kaA[8], kaB[8], vbA, vbB;
#define HG_OPS(c_, DV, KA, VB) do { VB = *(const LAS s16x4*)(lds + VT_OFF + vc * 144 + ((c_) * 16 + 4 * g) * 2); \
            _Pragma("unroll") for (int i_ = 0; i_ < 8; ++i_) { DV[i_] = *(const LAS f32x4*)(lds + DD_OFF + ((c_) * 128 + 16 * i_ + 4 * g) * 4); \
                KA[i_] = *(const LAS s16x4*)(lds + KHT_OFF + (16 * i_ + l15) * 144 + ((c_) * 16 + 4 * g) * 2); } } while (0)
#define HG_CHUNK(c_, XB, DV, KA, VB) do { \
            f32x4 o0_ = {0.f, 0.f, 0.f, 0.f}, o1_ = {0.f, 0.f, 0.f, 0.f}; s16x4 sb_[8], qa_[8]; \
            _Pragma("unroll") for (int i_ = 0; i_ < 8; ++i_) { sb_[i_] = pk4(S[i_]); qa_[i_] = *(const LAS s16x4*)(lds + QT_OFF + ((c_) * 16 + l15) * 272 + (16 * i_ + 4 * g) * 2); } \
            _Pragma("unroll") for (int i_ = 0; i_ < 8; ++i_) S[i_] = __builtin_amdgcn_mfma_f32_16x16x16bf16_1k(KA[i_], VB, S[i_] * DV[i_], 0, 0, 0); \
            _Pragma("unroll") for (int i_ = 0; i_ < 8; i_ += 2) { o0_ = __builtin_amdgcn_mfma_f32_16x16x16bf16_1k(qa_[i_], sb_[i_], o0_, 0, 0, 0); o1_ = __builtin_amdgcn_mfma_f32_16x16x16bf16_1k(qa_[i_ + 1], sb_[i_ + 1], o1_, 0, 0, 0); } \
            o0_ = __builtin_amdgcn_mfma_f32_16x16x16bf16_1k(XB, VB, o0_, 0, 0, 0); \
            const f32x4 o_ = o0_ + o1_; \
            _Pragma("unroll") for (int r_ = 0; r_ < 4; ++r_) Od[(size_t)(tok0 + msn * 64 + (c_) * 16 + 4 * g + r_) * 1024 + h * 128 + vc] = (bf16_t)(cvt_pk_bf16(o_[r_], 0.f) & 0xffff); } while (0)
        const int c0 = dir ? 3 : 0, cs = dir ? -1 : 1;
        HG_OPS(c0, dvA, kaA, vbA); __builtin_amdgcn_sched_barrier(0);
        HG_OPS(c0 + cs, dvB, kaB, vbB); __builtin_amdgcn_sched_barrier(0);
        { const s16x4 x0 = dir ? xb[3] : xb[0]; HG_CHUNK(c0, x0, dvA, kaA, vbA); } __builtin_amdgcn_sched_barrier(0);
        HG_OPS(c0 + 2 * cs, dvA, kaA, vbA); __builtin_amdgcn_sched_barrier(0);
        { const s16x4 x1 = dir ? xb[2] : xb[1]; HG_CHUNK(c0 + cs, x1, dvB, kaB, vbB); } __builtin_amdgcn_sched_barrier(0);
        HG_OPS(c0 + 3 * cs, dvB, kaB, vbB); __builtin_amdgcn_sched_barrier(0);
        { const s16x4 x2 = dir ? xb[1] : xb[2]; HG_CHUNK(c0 + 2 * cs, x2, dvA, kaA, vbA); } __builtin_amdgcn_sched_barrier(0);
        { const s16x4 x3 = dir ? xb[0] : xb[3]; HG_CHUNK(c0 + 3 * cs, x3, dvB, kaB, vbB); }
#undef HG_OPS
#undef HG_CHUNK
        }
        __syncthreads();
        if (ms + 1 < nms) { HG_STORE(); }
        __syncthreads();
    }
#undef HG_LOAD
#undef HG_STORE
    if (sout && act) {
#pragma unroll
        for (int i = 0; i < 8; ++i)
#pragma unroll
            for (int r = 0; r < 4; ++r) sout[(size_t)(16 * i + 4 * g + r) * 128 + vc] = S[i][r];
    }
}
}

__device__ __forceinline__ void phase_scan(ArgP a, LAS unsigned char* lds, int G, int bid) {
    for (int i = 0;; ++i) {
        const int u0 = i * G + ((i & 1) ? (G - 1 - bid) : bid);
        if (u0 >= 384) break;
        const int u = (u0 & ~127) + (u0 & 7) * 16 + ((u0 & 127) >> 3);
        int tok0, n, h, dir, vbase = 0, nwv = 8; const float* s0 = nullptr; float* sout = nullptr;
        if (u < 128) { const int b = u >> 5; h = (u >> 2) & 7; dir = (u >> 1) & 1; vbase = (u & 1) * 64; nwv = 4; tok0 = NCTX + b * 1024; n = 1024; s0 = a->in[I_ST] + ((size_t)(b * 2 + dir) * 8 + h) * 16384; }
        else { const int v = u - 128, b = v >> 4; h = (v >> 1) & 7; dir = v & 1; tok0 = b * 256; n = 256; sout = a->out + OUT_NS + ((size_t)(b * 2 + dir) * 8 + h) * 16384; }
        hg::scan_unit(tok0, n, h, dir, vbase, nwv, (const bf16_t*)(a->ws + WS_QTF), (const bf16_t*)(a->ws + (dir ? WS_KHTB : WS_KHTF)),
                      (const bf16_t*)(a->ws + WS_VT), (const float*)(a->ws + (dir ? WS_DDB : WS_DDF)), s0, sout, (bf16_t*)(a->ws + (dir ? WS_OB : WS_OF)), lds);
    }
}

#ifndef PHMASK
#define PHMASK 0xFFFF
#endif
#ifndef REPMASK
#define REPMASK 0
#endif
#ifndef XBAR
#define XBAR 0
#endif
enum PhType { T_PRO = 0, T_NORM, T_QKV, T_ATTN, T_RES, T_FFN, T_HIN, T_SCAN, T_HFIN, T_F1, T_FINAL, T_FOLD };
struct PhDesc { int type, layer, sub; };
constexpr int NPH = 23;
__device__ __forceinline__ PhDesc phase_desc(int p) {
    switch (p) {
        case 0: return {T_PRO, 0, 0};
        case 1: return {T_FOLD, 0, 0};
        case 2: return {T_QKV, 0, 0}; case 3: return {T_ATTN, 0, 0}; case 4: return {T_RES, 0, 0}; case 5: return {T_FFN, 0, 0}; case 6: return {T_RES, 0, 2};
        case 7: return {T_HIN, 1, 0}; case 8: return {T_SCAN, 1, 0}; case 9: return {T_HFIN, 1, 0}; case 10: return {T_RES, 1, 1}; case 11: return {T_FFN, 1, 0}; case 12: return {T_RES, 1, 2};
        case 13: return {T_F1, 2, 0}; case 14: return {T_RES, 2, 3}; case 15: return {T_FFN, 2, 0}; case 16: return {T_RES, 2, 2};
        case 17: return {T_QKV, 3, 1}; case 18: return {T_ATTN, 3, 1}; case 19: return {T_RES, 3, 0}; case 20: return {T_FFN, 3, 0}; case 21: return {T_RES, 3, 2};
        default: return {T_FINAL, 0, 0};
    }
}

__global__ void __launch_bounds__(NTHREADS, 2) fwd_megakernel(Args a_unused) {
    extern __shared__ __attribute__((aligned(16))) unsigned char lds_raw[];
    LAS unsigned char* lds = (LAS unsigned char*)lds_raw;
    constexpr int G = 256; const int bid = blockIdx.x;
    ArgP a = (ArgP)__builtin_amdgcn_kernarg_segment_ptr();
    for (int u = threadIdx.x; u < (LDS_BYTES - LDSCTL_OFF) / 4; u += NTHREADS) ((LAS unsigned*)(lds + LDSCTL_OFF))[u] = 0u;
    __syncthreads();
    volatile LAS unsigned* MISC = (volatile LAS unsigned*)(lds + MISC_OFF);
    XcdBarrier bar = xcd_barrier_post((unsigned*)(a->ws + WS_CTL), MISC + 8);

    const int nrun = a->ph_hi < NPH ? a->ph_hi + 1 : NPH;
#if REPMASK
    for (int pj = 2 * a->ph_lo; pj < 2 * nrun; ++pj) {
        const int pi = pj >> 1, rep = pj & 1;
        const int ph = pi < a->ph_hi ? pi : NPH - 1;
        const PhDesc d = phase_desc(ph);
        if (rep && !((REPMASK >> d.type) & 1)) continue;
        if (pj > 2 * a->ph_lo) xcd_barrier(bar);
#else
    for (int pi = a->ph_lo; pi < nrun; ++pi) {
        const int rep = 0;
        const int ph = pi < a->ph_hi ? pi : NPH - 1;
        const PhDesc d = phase_desc(ph);
        if (pi > a->ph_lo) xcd_barrier(bar);
#endif
        for (int xb = 0; xb < XBAR; ++xb) xcd_barrier(bar);
#define PH_TID const int tid = tid_opaque(), lane = tid & 63, wave = __builtin_amdgcn_readfirstlane(tid >> 6), gw = bid * NWAVES + wave, ngw = G * NWAVES; (void)lane; (void)gw; (void)ngw
        asm volatile("" : "+s"(a));
        const int L = d.layer;
        switch (d.type) {
#if (PHMASK >> 0) & 1
        case T_PRO: phase_prologue(a, lds, G, bid);
            if (a->ph_hi < NPH) { PH_TID; for (size_t i = (size_t)bid * NTHREADS + tid; i < 29360128 / 4; i += (size_t)G * NTHREADS) ((f32x4*)a->out)[i] = (f32x4){0.f, 0.f, 0.f, 0.f}; }
            break;
#endif
#if (PHMASK >> 1) & 1
        case T_FOLD: {
            PH_TID;
            phase_an(a, bid * NTHREADS + tid, G * NTHREADS);
            phase_sw(a, lds, 0x03, gw, ngw, tid, lane);
            phase_first_norm(a, gw, ngw, lane);
        } break;
#endif
#if (PHMASK >> 2) & 1
        case T_NORM: break;
#endif
#if (PHMASK >> 3) & 1
        case T_QKV: {
            const int j = d.sub, nidx = 2 * L;
            if (j == 1) { PH_TID; cache_convert(a, 1, gw, ngw, lane); }
            const float* sspn = (const float*)(a->ws + WS_SSP) + (size_t)nidx * 8192 * SSPN; const float* swn = (const float*)(a->ws + WS_SW) + sw_off(nidx);
            { GenSched S; S.init(7, a->ws + WS_H, nullptr, 1024, a->ws + WS_WQKV + (size_t)j * 3072 * 1024 * 2, 1024, MTOK, 3072, 1024, G, bid);
              EpiQKV E{(bf16_t*)(a->ws + WS_Q), (bf16_t*)(a->ws + WS_KB), (bf16_t*)(a->ws + WS_VB), a->out + OUT_NK + (size_t)j * 256 * 1024, a->out + OUT_NV + (size_t)j * 256 * 1024,
                       (const float*)(a->ws + WS_ROPE), (const float*)(a->ws + WS_ROPE) + 1024, sspn, swn, lds};
              pg8::gemm_phase(lds, 1024, 1024, S, E); }
            { GenSched S; S.init(8, a->ws + WS_H, nullptr, 1024, a->ws + WS_WQKV + (size_t)j * 3072 * 1024 * 2, 1024, MTOK, 3072, 1024, G, bid);
              EpiQKV128 E{(bf16_t*)(a->ws + WS_Q), (bf16_t*)(a->ws + WS_KB), (bf16_t*)(a->ws + WS_VB), a->out + OUT_NK + (size_t)j * 256 * 1024, a->out + OUT_NV + (size_t)j * 256 * 1024,
                          (const float*)(a->ws + WS_ROPE), (const float*)(a->ws + WS_ROPE) + 1024, sspn, swn, lds};
              pg8::gemm_phase_n128(lds, 1024, 1024, S, E); }
        } break;
#endif
#if (PHMASK >> 4) & 1
        case T_ATTN: phase_attn(a, d.sub, (char*)lds_raw, G, bid); break;
#endif
#if (PHMASK >> 5) & 1
        case T_RES: {
            const int nn = d.sub == 2 ? 2 * L + 2 : 2 * L + 1;
            EpiResid128 E{(bf16_t*)(a->ws + WS_X), (float*)(a->ws + WS_MOD) + (size_t)L * 5 * 6144 + (d.sub == 2 ? 5 : 2) * 1024,
                          nn < 8 ? (const float*)(a->ws + WS_AN) + nn * 5120 : nullptr, (bf16_t*)(a->ws + WS_H), (float*)(a->ws + WS_SSP) + (size_t)nn * 8192 * SSPN};
            GenSched S; int lda, ldb;
            if (d.sub == 3) { lda = 2048; ldb = 16384; S.init(4, a->ws + WS_CS1024, a->ws + WS_CS256, lda, a->ws + WS_ZT, ldb, 0, 0, 2048, G, bid); }
            else if (d.sub == 2) { lda = DFF; ldb = DFF; S.init(3, a->ws + WS_ACT, nullptr, lda, a->ws + WS_WFOUT + (size_t)L * 1024 * DFF * 2, ldb, MTOK, 1024, DFF, G, bid); }
            else { lda = 1024; ldb = 1024; const unsigned char* w = d.sub == 0 ? a->ws + WS_WOA + (size_t)(L == 0 ? 0 : 1) * 1024 * 1024 * 2 : a->ws + WS_WOR;
                S.init(3, a->ws + WS_O, nullptr, lda, w, ldb, MTOK, 1024, 1024, G, bid); }
            pg8::gemm_phase_n128(lds, lda, ldb, S, E);
            if (d.sub == 3 && bid >= 128) { PH_TID; deferred_convert(a, 3, lds, (bid - 128) * NWAVES + wave, 128 * NWAVES); }
            if (d.sub == 2 && L < 3) { PH_TID; phase_sw(a, lds, L == 0 ? 0x0Cu : L == 1 ? 0x30u : 0xC0u, gw, ngw, tid, lane); }
        } break;
#endif
#if (PHMASK >> 6) & 1
        case T_FFN: {
            const int nidx = 2 * L + 1;
            GenSched S; S.init(0, a->ws + WS_H, nullptr, 1024, a->ws + WS_WFI + (size_t)L * 5632 * 1024 * 2, 1024, MTOK, 5632, 1024, G, bid);
            EpiFFN E{(bf16_t*)(a->ws + WS_ACT), (const float*)(a->ws + WS_SSP) + (size_t)nidx * 8192 * SSPN, (const float*)(a->ws + WS_SW) + sw_off(nidx), lds};
            pg8::gemm_phase(lds, 1024, 1024, S, E);
            if (bid >= 704 - 2 * G && L == 0) {
                GenSched S2; S2.init(2, a->ws + WS_WFO, nullptr, 1024, a->ws + WS_TC, 1024, 1024, 256, a->ph_hi > 0 ? 256 : 320, G, bid - (704 - 2 * G));
                EpiBf16 E2{(bf16_t*)(a->ws + WS_WCS), 1024};
                pg8::gemm_phase(lds, 1024, 1024, S2, E2); }
            if (bid >= 704 - 2 * G && L < 3) { PH_TID; deferred_convert(a, L, lds, (bid - (704 - 2 * G)) * NWAVES + wave, (3 * G - 704) * NWAVES); }
        } break;
#endif
#if (PHMASK >> 7) & 1
        case T_HIN: {
            { GenSched S; S.init(5, a->ws + WS_H, nullptr, 1024, a->ws + WS_WINR, 1024, MTOK, 4096, 1024, G, bid);
              EpiHgrn E{(bf16_t*)(a->ws + WS_GH), (bf16_t*)(a->ws + WS_QTF), (bf16_t*)(a->ws + WS_KTF), (bf16_t*)(a->ws + WS_QTB), (bf16_t*)(a->ws + WS_KTB), (bf16_t*)(a->ws + WS_KHTF), (bf16_t*)(a->ws + WS_KHTB),
                        (bf16_t*)(a->ws + WS_VT), (float*)(a->ws + WS_DDF), (float*)(a->ws + WS_DDB), (const float*)(a->ws + WS_LBV), (const float*)(a->ws + WS_SSP) + 2ull * 8192 * SSPN, (const float*)(a->ws + WS_SW) + sw_off(2), lds};
              pg8::gemm_phase(lds, 1024, 1024, S, E); }
            { GenSched S; S.init(6, a->ws + WS_H, nullptr, 1024, a->ws + WS_WINR, 1024, MTOK, 1024, 1024, G, bid);
              EpiG128 E{(bf16_t*)(a->ws + WS_GH), (const float*)(a->ws + WS_SSP) + 2ull * 8192 * SSPN, (const float*)(a->ws + WS_SW) + sw_off(2), lds};
              pg8::gemm_phase_n128(lds, 1024, 1024, S, E); }
        } break;
#endif
#if (PHMASK >> 8) & 1
        case T_SCAN: phase_scan(a, lds, G, bid); break;
#endif
#if (PHMASK >> 9) & 1
        case T_HFIN: { PH_TID; phase_hgrn_final(a, gw, ngw, lane); } break;
#endif
#if (PHMASK >> 10) & 1
        case T_F1: {
            GenSched S; S.init(0, a->ws + WS_WCS, nullptr, 1024, a->ws + WS_H, 1024, 2048, MTOK, 1024, G, bid);
            EpiFour1 E{(bf16_t*)(a->ws + WS_ZT), (const float*)(a->ws + WS_SSP) + 4ull * 8192 * SSPN, (const float*)(a->ws + WS_SW) + sw_off(4), lds};
            pg8::gemm_phase(lds, 1024, 1024, S, E);
        } break;
#endif
        default: { PH_TID; phase_final(a, gw, ngw, lane); } break;
        }
    }
}

extern "C" void kernel_launch(void* const* d_in, const int* in_sizes, int n_in, void* d_out, int out_size, void* d_ws, size_t ws_size, hipStream_t stream) {
    static int grid = 0;
    if (grid == 0) {
        if (n_in != 23 || out_size != 29360128 || ws_size < WS_END2) {
            fprintf(stderr, "kernel_launch: unexpected shapes: n_in %d out %d ws %zu (need >= %zu); nothing launched\n", n_in, out_size, ws_size, (size_t)WS_END); grid = -1; return; }
        int dev = 0, cus = 0, per_cu = 0;
        if (hipGetDevice(&dev) != hipSuccess || hipDeviceGetAttribute(&cus, hipDeviceAttributeMultiprocessorCount, dev) != hipSuccess) { fprintf(stderr, "kernel_launch: device query failed\n"); grid = -1; return; }
        if (hipFuncSetAttribute((const void*)fwd_megakernel, hipFuncAttributeMaxDynamicSharedMemorySize, LDS_BYTES) != hipSuccess) { fprintf(stderr, "kernel_launch: hipFuncSetAttribute failed\n"); grid = -1; return; }
        if (hipOccupancyMaxActiveBlocksPerMultiprocessor(&per_cu, (const void*)fwd_megakernel, NTHREADS, LDS_BYTES) != hipSuccess || per_cu < 1) {
            fprintf(stderr, "kernel_launch: occupancy query reports %d workgroups per CU; nothing launched\n", per_cu); (void)hipGetLastError(); grid = -1; return; }
        if (cus < 256) { fprintf(stderr, "kernel_launch: needs >= 256 CUs (have %d); nothing launched\n", cus); grid = -1; return; }
        grid = 256;
    }
    if (grid < 0) return;
    (void)hipMemsetAsync((char*)d_ws + WS_CTL, 0, CTL_BYTES, stream);
    Args a{};
    for (int i = 0; i < 23; ++i) a.in[i] = (const float*)d_in[i];
    a.out = (float*)d_out; a.ws = (unsigned char*)d_ws;
    a.lam_init0 = 0.2f; a.lam_init1 = (float)(0.8 - 0.6 * 0.40656965974059917);
    a.ph_lo = 0; a.ph_hi = NPH;
    hipLaunchKernelGGL(fwd_megakernel, dim3(grid), dim3(NTHREADS), LDS_BYTES, stream, a);
    const hipError_t le = hipPeekAtLastError();
    if (le != hipSuccess) fprintf(stderr, "kernel_launch: launch failed: %s\n", hipGetErrorName(le));
}
```

```cpp
#include <hip/hip_runtime.h>
#include <cstdio>
#include <cstdint>

#define LAS __attribute__((address_space(3)))
#define GAS __attribute__((address_space(1)))
typedef unsigned short bf16_t;
typedef short bf16x8 __attribute__((ext_vector_type(8)));
typedef short s16x4 __attribute__((ext_vector_type(4)));
typedef float f32x2 __attribute__((ext_vector_type(2)));
typedef float f32x4 __attribute__((ext_vector_type(4)));
typedef float f32x8 __attribute__((ext_vector_type(8)));
typedef float f32x16 __attribute__((ext_vector_type(16)));
typedef unsigned u32x2 __attribute__((ext_vector_type(2)));
typedef unsigned u32x4 __attribute__((ext_vector_type(4)));

constexpr int DM = 1024, MTOK = 8192, NCTX = 4096, DFF = 2816, NKV = 4096 + 4 * 1536;
constexpr float EPS = 1e-6f;
constexpr int NWAVES = 8, NTHREADS = 512;

constexpr size_t al256(size_t x) { return (x + 255) / 256 * 256; }
constexpr size_t WS_CTL = 0, CTL_BYTES = 65536;
constexpr size_t WS_MOD = WS_CTL + CTL_BYTES;
constexpr size_t WS_ROPE = WS_MOD + al256(4 * 5 * 6144 * 4);
constexpr size_t WS_LBV = WS_ROPE + 8192;
constexpr size_t WS_LAM = WS_LBV + 8192;
constexpr size_t WS_AN = WS_LAM + 256;
constexpr size_t WS_SW = WS_AN + 8 * 5 * 1024 * 4;
constexpr size_t WS_SSP = WS_SW + al256(35840 * 5 * 4);
constexpr int SSPN = 32;
constexpr size_t WS_TC = WS_SSP + 9ull * 8192 * SSPN * 4;
constexpr size_t WS_CS256 = WS_TC + 256 * 1024 * 2;
constexpr size_t WS_CS1024 = WS_CS256 + 256 * 2048 * 2;
constexpr size_t WS_WQKV = WS_CS1024 + 1024 * 2048 * 2;
constexpr size_t WS_WOA = WS_WQKV + 2ull * 3072 * 1024 * 2;
constexpr size_t WS_WINR = WS_WOA + 2ull * 1024 * 1024 * 2;
constexpr size_t WS_WOR = WS_WINR + 5120ull * 1024 * 2;
constexpr size_t WS_WFO = WS_WOR + 1024ull * 1024 * 2;
constexpr size_t WS_WCS = WS_WFO + 1024ull * 1024 * 2;
constexpr size_t WS_WFI = WS_WCS + 2048ull * 1024 * 2;
constexpr size_t WS_WFOUT = WS_WFI + 4ull * 5632 * 1024 * 2;
constexpr size_t WS_X = WS_WFOUT + 4ull * 1024 * 2816 * 2;
constexpr size_t WS_H = WS_X + 8192ull * 1024 * 4;
constexpr size_t WS_O = WS_H + 8192ull * 1024 * 2;
constexpr size_t WS_SCR = WS_O + 8192ull * 1024 * 2;
constexpr size_t SZ_TOK = 8192ull * 1024 * 2;
constexpr size_t WS_Q = WS_SCR, WS_KB = WS_Q + SZ_TOK, WS_VB = WS_KB + (size_t)NKV * 1024 * 2;
constexpr size_t WS_GH = WS_SCR, WS_QTF = WS_GH + SZ_TOK, WS_KTF = WS_QTF + SZ_TOK, WS_QTB = WS_KTF + SZ_TOK, WS_KTB = WS_QTB + SZ_TOK, WS_KHTF = WS_KTB + SZ_TOK, WS_KHTB = WS_KHTF + SZ_TOK,
                 WS_VT = WS_KHTB + SZ_TOK, WS_OF = WS_VT + SZ_TOK, WS_OB = WS_OF + SZ_TOK, WS_DDF = WS_OB + SZ_TOK, WS_DDB = WS_DDF + 512ull * 8 * 128 * 4;
constexpr size_t WS_ZT = WS_SCR;
constexpr size_t WS_ACT = WS_SCR;
constexpr size_t WS_END = WS_DDB + 512ull * 8 * 128 * 4;
constexpr size_t WS_END2 = WS_END;
__host__ __device__ constexpr int sw_n(int nidx) { return nidx == 0 || nidx == 6 ? 3072 : nidx == 2 ? 5120 : nidx == 4 ? 2048 : 5632; }
__host__ __device__ constexpr int sw_off(int nidx) { int o = 0; for (int i = 0; i < nidx; ++i) o += 5 * sw_n(i); return o; }

constexpr size_t OUT_YP = 0, OUT_YS = 4194304, OUT_NK = 8388608, OUT_NV = 16777216, OUT_NS = 25165824;

constexpr int RING_BYTES = 131072;
constexpr int LDSCTL_OFF = RING_BYTES, MISC_OFF = LDSCTL_OFF + 320, RSTD_OFF = LDSCTL_OFF + 1024;
constexpr int LDS_BYTES = 147456;

typedef __bf16 bf16x2_t __attribute__((ext_vector_type(2)));
__device__ __forceinline__ unsigned cvt_pk_bf16(float lo, float hi) { f32x2 v = {lo, hi}; bf16x2_t b = __builtin_convertvector(v, bf16x2_t); return __builtin_bit_cast(unsigned, b); }
__device__ __forceinline__ float bf2f(unsigned short b) { return __uint_as_float((unsigned)b << 16); }
__device__ __forceinline__ float bflo(unsigned w) { return __uint_as_float(w << 16); }
__device__ __forceinline__ float bfhi(unsigned w) { return __uint_as_float(w & 0xffff0000u); }
__device__ __forceinline__ float fast_rcp(float x) { return __builtin_amdgcn_rcpf(x); }
__device__ __forceinline__ float silu_f(float x) { return x * fast_rcp(1.f + __expf(-x)); }
__device__ __forceinline__ float sigmoid_f(float x) { return fast_rcp(1.f + __expf(-x)); }
__device__ __forceinline__ float wave_sum(float v) {
#pragma unroll
    for (int o = 1; o < 64; o <<= 1) v += __shfl_xor(v, o);
    return v;
}
__device__ __forceinline__ int tid_opaque() { int t = threadIdx.x; asm volatile("" : "+v"(t)); return t; }
__device__ __forceinline__ int cond_of_row(int r) { return r < NCTX ? 0 : 1 + ((r - NCTX) >> 10); }
#define LDS_WAIT() asm volatile("s_waitcnt lgkmcnt(0)" ::: "memory")
#define VM_WAIT() asm volatile("s_waitcnt vmcnt(0)" ::: "memory")

#define XB_TMO      128
#define XB_XCNT(j)  (256  + 64 * (j))
#define XB_XSUB(j)  (1280 + 64 * (j))
#define XB_XGEN(j)  (2304 + 64 * (j))
#define XB_TOP      3328
#define XB_TOPGEN   3392
#define XCD_BAR_WORDS 3456
#define XB_SPIN_CAP (1u << 22)
__device__ __forceinline__ unsigned xb_ld(unsigned* p)              { return __hip_atomic_load(p, __ATOMIC_RELAXED, __HIP_MEMORY_SCOPE_AGENT); }
__device__ __forceinline__ unsigned xb_add(unsigned* p, unsigned v) { return __hip_atomic_fetch_add(p, v, __ATOMIC_RELAXED, __HIP_MEMORY_SCOPE_AGENT); }
__device__ __forceinline__ unsigned xb_xcc_id() { return (unsigned)__builtin_amdgcn_s_getreg((3 << 11) | 20) & 0xFu; }
#define XB_SPIN(cond, bar) do { unsigned _sp = 0; while (cond) { __builtin_amdgcn_s_sleep(1); \
    if ((++_sp & 255u) == 0u) { if (xb_ld(&(bar)[XB_TMO])) break; if (_sp > XB_SPIN_CAP) { atomicAdd(&(bar)[XB_TMO], 1u); break; } } } } while (0)
struct XcdBarrier { unsigned* bar; unsigned x; volatile LAS unsigned* st; };
__device__ __forceinline__ XcdBarrier xcd_barrier_post(unsigned* bar, volatile LAS unsigned* st) {
    XcdBarrier b; b.bar = bar; b.x = xb_xcc_id(); b.st = st;
    if (threadIdx.x == 0) (void)xb_add(&bar[XB_XCNT(b.x)], 1u);
    return b;
}
__device__ __forceinline__ void xcd_barrier_complete(unsigned* bar, unsigned x, unsigned& nloc, unsigned& nx) {
    const unsigned G = gridDim.x * gridDim.y * gridDim.z;
    unsigned sum, cnt, mine, sp = 0u;
    for (;;) {
        sum = 0u; cnt = 0u; mine = 0u;
#pragma unroll
        for (unsigned j = 0; j < 16; ++j) { const unsigned c = xb_ld(&bar[XB_XCNT(j)]); sum += c; cnt += (c > 0u) ? 1u : 0u; mine = (j == x) ? c : mine; }
        if (sum == G) break;
        __builtin_amdgcn_s_sleep(1);
        if ((++sp & 255u) == 0u) { if (xb_ld(&bar[XB_TMO])) break; if (sp > XB_SPIN_CAP) { atomicAdd(&bar[XB_TMO], 1u); break; } }
    }
    nloc = mine > 0u ? mine : 1u; nx = cnt > 0u ? cnt : 1u;
}
__device__ __forceinline__ void xcd_barrier(const XcdBarrier& b) {
    asm volatile("s_waitcnt vmcnt(0)" ::: "memory");
    __syncthreads();
    if (threadIdx.x == 0) {
        unsigned* bar = b.bar;
        __builtin_amdgcn_s_waitcnt(0);
        unsigned nloc = b.st[0], nx = b.st[1];
        if (nloc == 0u) { xcd_barrier_complete(bar, b.x, nloc, nx); b.st[0] = nloc; b.st[1] = nx; }
        const unsigned old = xb_add(&bar[XB_XSUB(b.x)], 1u);
        const unsigned gen = old / nloc;
        if (old + 1u == (gen + 1u) * nloc) {
            __builtin_amdgcn_fence(__ATOMIC_RELEASE, "agent");
            asm volatile("s_waitcnt vmcnt(0)" ::: "memory");
            const unsigned og = xb_add(&bar[XB_TOP], 1u);
            const unsigned tg = og / nx;
            asm volatile("buffer_inv sc1" ::: "memory");
            if (og + 1u == (tg + 1u) * nx) xb_add(&bar[XB_TOPGEN], 1u);
            else XB_SPIN(xb_ld(&bar[XB_TOPGEN]) == tg, bar);
            xb_add(&bar[XB_XGEN(b.x)], 1u);
            asm volatile("s_waitcnt vmcnt(0)" ::: "memory");
        } else {
            asm volatile("buffer_inv sc1" ::: "memory");
            XB_SPIN(xb_ld(&bar[XB_XGEN(b.x)]) == gen, bar);
            asm volatile("s_waitcnt vmcnt(0)" ::: "memory");
        }
    }
    __syncthreads();
}

namespace pg8 {
constexpr int BM = 256, BK = 64, HALF = 128, HTB = HALF * BK * 2, NXCD = 8, WGM = 8;
__host__ __device__ __forceinline__ int lds_byte(int r, int c) { const int st = (r >> 4) * 2 + (c >> 5), rr = r & 15, cc = c & 31, ob = rr * 64 + cc * 2; return st * 1024 + (ob ^ (((ob >> 9) & 1) << 5)); }
__host__ __device__ __forceinline__ int perm32(int rho) { const int n = rho >> 4, i = rho & 15; return 8 * (i >> 2) + 4 * n + (i & 3); }
__host__ __device__ __forceinline__ void stage_rc(int b, int& R, int& C) { const int st = b / 1024, sb = b % 1024, swz = sb ^ (((sb >> 9) & 1) << 5); R = (st >> 1) * 16 + swz / 64; C = (st & 1) * 32 + (swz % 64) / 2; }

struct GUnit { const char* A; const char* B; int nt; int row0; int col0; int aux; };

template <class Epi, class Sched>
__device__ __forceinline__ void gemm_phase(LAS unsigned char* lds, const int lda, const int ldb, const Sched& S, const Epi& E) {
    const int tid = tid_opaque(), wid = __builtin_amdgcn_readfirstlane(tid >> 6), lane = tid & 63, wr = wid >> 2, wc = wid & 3, fr = lane & 15, fq = lane >> 4;
    unsigned voffA[2], voffB[2];
#pragma unroll
    for (int i = 0; i < 2; ++i) { int R, C; stage_rc(tid * 16 + i * 8192, R, C); const int Rb = Epi::PERM ? ((R & ~31) + perm32(R & 31)) : R; voffA[i] = (unsigned)(R * lda + C) * 2u; voffB[i] = (unsigned)(Rb * ldb + C) * 2u; }
    const size_t kstep = (size_t)(BK * 2);
    const size_t hstepA = (size_t)HALF * lda * 2, hstepB = (size_t)HALF * ldb * 2;
    const unsigned ldsw = (unsigned)wid * 1024u;
    const int aoff = lds_byte(wr * 64 + fr, fq * 8), boff = lds_byte(wc * 32 + fr, fq * 8);
#define PG8_SA(b, h) (((b) * 2 + (h)) * HTB)
#define PG8_SB(b, h) ((4 + (b) * 2 + (h)) * HTB)
#define PG8_STAGE(bufoff, gbase, voff) do { _Pragma("unroll") for (int _i = 0; _i < 2; ++_i) \
        __builtin_amdgcn_global_load_lds((const unsigned*)((const char*)(gbase) + (voff)[_i]), (LAS unsigned*)(lds + (bufoff) + ldsw + _i * 8192), 16, 0, 0); } while (0)
#define PG8_LDA(dst, b, h) do { _Pragma("unroll") for (int m = 0; m < 4; ++m) _Pragma("unroll") for (int k = 0; k < 2; ++k) dst[m][k] = *(const LAS bf16x8*)(lds + PG8_SA(b, h) + aoff + m * 2048 + k * 1024); } while (0)
#define PG8_LDB(dst, b, h) do { _Pragma("unroll") for (int n = 0; n < 2; ++n) _Pragma("unroll") for (int k = 0; k < 2; ++k) dst[n][k] = *(const LAS bf16x8*)(lds + PG8_SB(b, h) + boff + n * 2048 + k * 1024); } while (0)
#define PG8_MMA(ai, bj, At, Bt) do { __builtin_amdgcn_s_setprio(1); _Pragma("unroll") for (int m = 0; m < 4; ++m) _Pragma("unroll") for (int n = 0; n < 2; ++n) _Pragma("unroll") for (int k = 0; k < 2; ++k) \
        acc[ai][bj][m][n] = __builtin_amdgcn_mfma_f32_16x16x32_bf16(Bt[n][k], At[m][k], acc[ai][bj][m][n], 0, 0, 0); __builtin_amdgcn_s_setprio(0); } while (0)
#define PG8_WAIT_V(n) asm volatile("s_waitcnt vmcnt(" #n ")" ::: "memory")
#define PG8_WAIT_L(n) asm volatile("s_waitcnt lgkmcnt(" #n ")" ::: "memory")
#define PG8_BAR __builtin_amdgcn_s_barrier()
#define PG8_SCHED __builtin_amdgcn_sched_barrier(0)
    GUnit cur, nxt; int ui = 0;
    if (!S.next(0, cur)) return;
    E.prepare(S, lds, tid);
    f32x4 acc[2][2][4][2];
#pragma unroll
    for (int a = 0; a < 2; ++a)
#pragma unroll
        for (int b = 0; b < 2; ++b)
#pragma unroll
            for (int m = 0; m < 4; ++m)
#pragma unroll
                for (int n = 0; n < 2; ++n) acc[a][b][m][n] = (f32x4){0.f, 0.f, 0.f, 0.f};
    bf16x8 At[4][2], B0[2][2], B1[2][2];
    const char* cA = cur.A; const char* cB = cur.B;
    PG8_STAGE(PG8_SB(0, 0), cB, voffB); PG8_STAGE(PG8_SB(0, 1), cB + hstepB, voffB); PG8_STAGE(PG8_SA(0, 0), cA, voffA); PG8_STAGE(PG8_SA(0, 1), cA + hstepA, voffA);
    if (wr == 1) PG8_BAR;
    PG8_WAIT_V(2); PG8_BAR;
    PG8_STAGE(PG8_SB(1, 0), cB + kstep, voffB); PG8_STAGE(PG8_SA(1, 0), cA + kstep, voffA); PG8_STAGE(PG8_SB(1, 1), cB + hstepB + kstep, voffB);
    PG8_WAIT_V(6); PG8_BAR;
    for (;;) {
        const bool has_next = S.next(ui + 1, nxt);
        const char* nA = has_next ? nxt.A : cA; const char* nB = has_next ? nxt.B : cB;
        const int nt = cur.nt;
        for (int t = 0; t < nt; t += 2) {
            const bool last = (t == nt - 2);
            const char* a1 = cA + (size_t)(t + 1) * kstep;
            const char* a2 = last ? nA : cA + (size_t)(t + 2) * kstep; const char* b2 = last ? nB : cB + (size_t)(t + 2) * kstep;
            const char* a3 = a2 + kstep; const char* b3 = b2 + kstep;
            PG8_LDB(B0, 0, 0); PG8_LDB(B1, 0, 1); PG8_SCHED; PG8_LDA(At, 0, 0); PG8_STAGE(PG8_SA(1, 1), a1 + hstepA, voffA);
            PG8_WAIT_V(8); PG8_WAIT_L(0); PG8_BAR; PG8_MMA(0, 0, At, B0); PG8_MMA(0, 1, At, B1); PG8_BAR; PG8_SCHED;
            PG8_LDA(At, 0, 1); PG8_STAGE(PG8_SB(0, 0), b2, voffB); PG8_STAGE(PG8_SB(0, 1), b2 + hstepB, voffB); PG8_STAGE(PG8_SA(0, 0), a2, voffA);
            PG8_WAIT_V(8); PG8_WAIT_L(0); PG8_BAR; PG8_MMA(1, 0, At, B0); PG8_MMA(1, 1, At, B1); PG8_BAR; PG8_SCHED;
            PG8_LDB(B0, 1, 0); PG8_LDB(B1, 1, 1); PG8_SCHED; PG8_LDA(At, 1, 0); PG8_STAGE(PG8_SA(0, 1), a2 + hstepA, voffA);
            PG8_WAIT_V(8); PG8_WAIT_L(0); PG8_BAR; PG8_MMA(0, 0, At, B0); PG8_MMA(0, 1, At, B1); PG8_BAR; PG8_SCHED;
            PG8_LDA(At, 1, 1); PG8_STAGE(PG8_SB(1, 0), b3, voffB); PG8_STAGE(PG8_SB(1, 1), b3 + hstepB, voffB); PG8_STAGE(PG8_SA(1, 0), a3, voffA);
            PG8_WAIT_V(8); PG8_WAIT_L(0); PG8_BAR; PG8_MMA(1, 0, At, B0); PG8_MMA(1, 1, At, B1); PG8_BAR; PG8_SCHED;
        }
        if (wr == 0) PG8_BAR;
        E(acc, cur, ui, wr, wc, fr, fq);
        if (!has_next) break;
#pragma unroll
        for (int a = 0; a < 2; ++a)
#pragma unroll
            for (int b = 0; b < 2; ++b)
#pragma unroll
                for (int m = 0; m < 4; ++m)
#pragma unroll
                    for (int n = 0; n < 2; ++n) acc[a][b][m][n] = (f32x4){0.f, 0.f, 0.f, 0.f};
        cur = nxt; cA = nA; cB = nB; ++ui;
        if (wr == 1) PG8_BAR;
    }
    PG8_WAIT_V(0);
    PG8_BAR;
#undef PG8_SA
#undef PG8_SB
#undef PG8_STAGE
#undef PG8_LDA
#undef PG8_LDB
#undef PG8_MMA
#undef PG8_WAIT_V
#undef PG8_WAIT_L
#undef PG8_BAR
#undef PG8_SCHED
}

template <class Epi, class Sched>
__device__ __forceinline__ void gemm_phase_n128(LAS unsigned char* lds, const int lda, const int ldb, const Sched& S, const Epi& E) {
    const int tid = tid_opaque(), wid = __builtin_amdgcn_readfirstlane(tid >> 6), lane = tid & 63, wr = wid >> 2, wc = wid & 3, fr = lane & 15, fq = lane >> 4;
    unsigned voffA[2], voffB[2];
#pragma unroll
    for (int i = 0; i < 2; ++i) { int R, C; stage_rc(tid * 16 + i * 8192, R, C); const int Rb = Epi::PERM ? ((R & ~31) + perm32(R & 31)) : R; voffA[i] = (unsigned)(R * lda + C) * 2u; voffB[i] = (unsigned)(Rb * ldb + C) * 2u; }
    const size_t kstep = (size_t)(BK * 2);
    const size_t hstepA = (size_t)HALF * lda * 2;
    const unsigned ldsw = (unsigned)wid * 1024u;
    const int aoff = lds_byte(wr * 64 + fr, fq * 8), boff = lds_byte(wc * 32 + fr, fq * 8);
#define N1_SA(b, h) (((b) * 2 + (h)) * HTB)
#define N1_SB(b) ((4 + (b)) * HTB)
#define N1_STAGE(bufoff, gbase, voff) do { _Pragma("unroll") for (int _i = 0; _i < 2; ++_i) \
        __builtin_amdgcn_global_load_lds((const unsigned*)((const char*)(gbase) + (voff)[_i]), (LAS unsigned*)(lds + (bufoff) + ldsw + _i * 8192), 16, 0, 0); } while (0)
#define N1_LDA(dst, b, h) do { _Pragma("unroll") for (int m = 0; m < 4; ++m) _Pragma("unroll") for (int k = 0; k < 2; ++k) dst[m][k] = *(const LAS bf16x8*)(lds + N1_SA(b, h) + aoff + m * 2048 + k * 1024); } while (0)
#define N1_LDB(dst, b) do { _Pragma("unroll") for (int n = 0; n < 2; ++n) _Pragma("unroll") for (int k = 0; k < 2; ++k) dst[n][k] = *(const LAS bf16x8*)(lds + N1_SB(b) + boff + n * 2048 + k * 1024); } while (0)
#define N1_MMA(ai, At, Bt) do { __builtin_amdgcn_s_setprio(1); _Pragma("unroll") for (int m = 0; m < 4; ++m) _Pragma("unroll") for (int n = 0; n < 2; ++n) _Pragma("unroll") for (int k = 0; k < 2; ++k) \
        acc[ai][m][n] = __builtin_amdgcn_mfma_f32_16x16x32_bf16(Bt[n][k], At[m][k], acc[ai][m][n], 0, 0, 0); __builtin_amdgcn_s_setprio(0); } while (0)
#define N1_WAIT_V(n) asm volatile("s_waitcnt vmcnt(" #n ")" ::: "memory")
#define N1_WAIT_L(n) asm volatile("s_waitcnt lgkmcnt(" #n ")" ::: "memory")
#define N1_BAR __builtin_amdgcn_s_barrier()
#define N1_SCHED __builtin_amdgcn_sched_barrier(0)
    GUnit cur, nxt; int ui = 0;
    if (!S.next(0, cur)) return;
    E.prepare(S, lds, tid);
    f32x4 acc[2][4][2];
#pragma unroll
    for (int x = 0; x < 2; ++x)
#pragma unroll
        for (int m = 0; m < 4; ++m)
#pragma unroll
            for (int n = 0; n < 2; ++n) acc[x][m][n] = (f32x4){0.f, 0.f, 0.f, 0.f};
    bf16x8 At[4][2], B0[2][2];
    const char* cA = cur.A; const char* cB = cur.B;
    N1_STAGE(N1_SB(0), cB, voffB); N1_STAGE(N1_SA(0, 0), cA, voffA); N1_STAGE(N1_SA(0, 1), cA + hstepA, voffA);
    if (wr == 1) N1_BAR;
    N1_WAIT_V(0); N1_BAR;
    N1_STAGE(N1_SB(1), cB + kstep, voffB); N1_STAGE(N1_SA(1, 0), cA + kstep, voffA);
    N1_BAR;
    for (;;) {
        const bool has_next = S.next(ui + 1, nxt);
        const char* nA = has_next ? nxt.A : cA; const char* nB = has_next ? nxt.B : cB;
        const int nt = cur.nt;
        for (int t = 0; t < nt; t += 2) {
            const bool last = (t == nt - 2);
            const char* a1 = cA + (size_t)(t + 1) * kstep;
            const char* a2 = last ? nA : cA + (size_t)(t + 2) * kstep; const char* b2 = last ? nB : cB + (size_t)(t + 2) * kstep;
            const char* a3 = a2 + kstep; const char* b3 = b2 + kstep;
            N1_LDB(B0, 0); N1_SCHED; N1_LDA(At, 0, 0); N1_STAGE(N1_SA(1, 1), a1 + hstepA, voffA);
            N1_WAIT_V(6); N1_WAIT_L(0); N1_BAR; N1_MMA(0, At, B0); N1_BAR; N1_SCHED;
            N1_LDA(At, 0, 1); N1_STAGE(N1_SA(0, 0), a2, voffA); N1_STAGE(N1_SB(0), b2, voffB);
            N1_WAIT_V(6); N1_WAIT_L(0); N1_BAR; N1_MMA(1, At, B0); N1_BAR; N1_SCHED;
            N1_LDB(B0, 1); N1_SCHED; N1_LDA(At, 1, 0); N1_STAGE(N1_SA(0, 1), a2 + hstepA, voffA);
            N1_WAIT_V(6); N1_WAIT_L(0); N1_BAR; N1_MMA(0, At, B0); N1_BAR; N1_SCHED;
            N1_LDA(At, 1, 1); N1_STAGE(N1_SA(1, 0), a3, voffA); N1_STAGE(N1_SB(1), b3, voffB);
            N1_WAIT_V(6); N1_WAIT_L(0); N1_BAR; N1_MMA(1, At, B0); N1_BAR; N1_SCHED;
        }
        if (wr == 0) N1_BAR;
        E(acc, cur, ui, wr, wc, fr, fq);
        if (!has_next) break;
#pragma unroll
        for (int x = 0; x < 2; ++x)
#pragma unroll
            for (int m = 0; m < 4; ++m)
#pragma unroll
                for (int n = 0; n < 2; ++n) acc[x][m][n] = (f32x4){0.f, 0.f, 0.f, 0.f};
        cur = nxt; cA = nA; cB = nB; ++ui;
        if (wr == 1) N1_BAR;
    }
    N1_WAIT_V(0);
    N1_BAR;
#undef N1_SA
#undef N1_SB
#undef N1_STAGE
#undef N1_LDA
#undef N1_LDB
#undef N1_MMA
#undef N1_WAIT_V
#undef N1_WAIT_L
#undef N1_BAR
#undef N1_SCHED
}
}
using pg8::GUnit;
typedef f32x4 AccT[2][2][4][2];
typedef f32x4 AccH[2][4][2];

template <class Sched> __device__ __forceinline__ void prep_rstd(LAS unsigned char* lds, const float* ssp, const Sched& S, bool cols, int tid) {
    LAS float* R = (LAS float*)(lds + RSTD_OFF);
    if (tid < 256) {
        f32x4 p[3][8]; bool ok[3];
#pragma unroll
        for (int i = 0; i < 3; ++i) { GUnit u; ok[i] = S.next(i, u);
            if (ok[i]) { const f32x4* q = (const f32x4*)(ssp + (size_t)((cols ? u.col0 : u.row0) + tid) * SSPN);
#pragma unroll
                for (int k = 0; k < 8; ++k) p[i][k] = q[k]; } }
#pragma unroll
        for (int i = 0; i < 3; ++i) if (ok[i]) { const f32x4 s4 = ((p[i][0] + p[i][1]) + (p[i][2] + p[i][3])) + ((p[i][4] + p[i][5]) + (p[i][6] + p[i][7]));
            R[i * 256 + tid] = rsqrtf(((s4[0] + s4[1]) + (s4[2] + s4[3])) * (1.f / 1024.f) + EPS); }
    }
    LDS_WAIT(); __builtin_amdgcn_s_barrier(); asm volatile("" ::: "memory");
}
struct EpiQKV {
    bf16_t* Q; bf16_t* KB; bf16_t* VB; float* nk; float* nv; const float* ropec; const float* ropes; const float* ssp; const float* sw; LAS unsigned char* lds;
    static constexpr bool PERM = false;
    template <class Sched> __device__ __forceinline__ void prepare(const Sched& S, LAS unsigned char* l, int tid) const { prep_rstd(l, ssp, S, false, tid); }
    __device__ __forceinline__ void operator()(const AccT& acc, const GUnit& u, int ui, int wr, int wc, int fr, int fq) const {
        const LAS float* R = (const LAS float*)(lds + RSTD_OFF) + ui * 256;
        const int sec = u.col0 >> 10;
        const bool lat = u.row0 >= NCTX;
        const int cbase = (u.col0 & 1023) + wc * 32 + 4 * fq;
        const float* swc = sw + cond_of_row(u.row0) * 3072 + u.col0 + wc * 32 + 4 * fq;
        f32x4 sv[2][2];
#pragma unroll
        for (int bj = 0; bj < 2; ++bj)
#pragma unroll
            for (int n = 0; n < 2; ++n) sv[bj][n] = *(const f32x4*)(swc + bj * 128 + n * 16);
#pragma unroll
        for (int ai = 0; ai < 2; ++ai)
#pragma unroll
            for (int m = 0; m < 4; ++m) {
                const int rl = ai * 128 + wr * 64 + m * 16 + fr, r = u.row0 + rl;
                const float rs = R[rl];
                int t = 0, kvrow = r; size_t orow = 0;
                if (lat) { const int rr = r - NCTX; t = rr & 1023; kvrow = NCTX + (rr >> 10) * 1536 + 512 + t; }
                else { const int b = r >> 8; orow = ((size_t)(b * 2) * 256 + (r & 255)) * 1024; }
                f32x4 cs = {1.f, 1.f, 1.f, 1.f}, sn = {0.f, 0.f, 0.f, 0.f};
                if (lat && sec < 2) { const int pos = (wc & 1) ? (t & 63) : (t >> 6); cs = *(const f32x4*)(ropec + pos * 16 + 4 * fq); sn = *(const f32x4*)(ropes + pos * 16 + 4 * fq); }
#pragma unroll
                for (int bj = 0; bj < 2; ++bj) {
                    f32x4 x1 = acc[ai][bj][m][0] * rs + sv[bj][0], x2 = acc[ai][bj][m][1] * rs + sv[bj][1];
                    const int c = cbase + bj * 128;
                    if (sec < 2) { const f32x4 y1 = x1 * cs - x2 * sn, y2 = x2 * cs + x1 * sn; x1 = y1; x2 = y2; }
                    u32x4 w; w.x = cvt_pk_bf16(x1[0], x1[1]); w.y = cvt_pk_bf16(x1[2], x1[3]); w.z = cvt_pk_bf16(x2[0], x2[1]); w.w = cvt_pk_bf16(x2[2], x2[3]);
                    const int c8 = c + 4 * fq;
                    if (sec == 0) *(u32x4*)(Q + (size_t)r * 1024 + c8) = w;
                    else {
                        *(u32x4*)((sec == 1 ? KB : VB) + (size_t)kvrow * 1024 + c8) = w;
                        if (!lat) { if (sec == 1) { float* o = nk + orow + c; *(f32x4*)o = x1; *(f32x4*)(o + 16) = x2; }
                                    else { float* o = nv + orow + c8; *(f32x4*)o = x1; *(f32x4*)(o + 4) = x2; } }
                    }
                }
            }
    }
};
struct EpiQKV128 {
    bf16_t* Q; bf16_t* KB; bf16_t* VB; float* nk; float* nv; const float* ropec; const float* ropes; const float* ssp; const float* sw; LAS unsigned char* lds;
    static constexpr bool PERM = false;
    template <class Sched> __device__ __forceinline__ void prepare(const Sched& S, LAS unsigned char* l, int tid) const { prep_rstd(l, ssp, S, false, tid); }
    __device__ __forceinline__ void operator()(const AccH& acc, const GUnit& u, int ui, int wr, int wc, int fr, int fq) const {
        const LAS float* R = (const LAS float*)(lds + RSTD_OFF) + ui * 256;
        const int sec = u.col0 >> 10;
        const bool lat = u.row0 >= NCTX;
        const int c = (u.col0 & 1023) + wc * 32 + 4 * fq;
        const float* swc = sw + cond_of_row(u.row0) * 3072 + u.col0 + wc * 32 + 4 * fq;
        const f32x4 sv0 = *(const f32x4*)swc, sv1 = *(const f32x4*)(swc + 16);
#pragma unroll
        for (int ai = 0; ai < 2; ++ai)
#pragma unroll
            for (int m = 0; m < 4; ++m) {
                const int rl = ai * 128 + wr * 64 + m * 16 + fr, r = u.row0 + rl;
                const float rs = R[rl];
                int t = 0, kvrow = r; size_t orow = 0;
                if (lat) { const int rr = r - NCTX; t = rr & 1023; kvrow = NCTX + (rr >> 10) * 1536 + 512 + t; }
                else { const int b = r >> 8; orow = ((size_t)(b * 2) * 256 + (r & 255)) * 1024; }
                f32x4 cs = {1.f, 1.f, 1.f, 1.f}, sn = {0.f, 0.f, 0.f, 0.f};
                if (lat && sec < 2) { const int pos = (wc & 1) ? (t & 63) : (t >> 6); cs = *(const f32x4*)(ropec + pos * 16 + 4 * fq); sn = *(const f32x4*)(ropes + pos * 16 + 4 * fq); }
                f32x4 x1 = acc[ai][m][0] * rs + sv0, x2 = acc[ai][m][1] * rs + sv1;
                if (sec < 2) { const f32x4 y1 = x1 * cs - x2 * sn, y2 = x2 * cs + x1 * sn; x1 = y1; x2 = y2; }
                u32x4 w; w.x = cvt_pk_bf16(x1[0], x1[1]); w.y = cvt_pk_bf16(x1[2], x1[3]); w.z = cvt_pk_bf16(x2[0], x2[1]); w.w = cvt_pk_bf16(x2[2], x2[3]);
                const int c8 = c + 4 * fq;
                if (sec == 0) *(u32x4*)(Q + (size_t)r * 1024 + c8) = w;
                else {
                    *(u32x4*)((sec == 1 ? KB : VB) + (size_t)kvrow * 1024 + c8) = w;
                    if (!lat) { if (sec == 1) { float* o = nk + orow + c; *(f32x4*)o = x1; *(f32x4*)(o + 16) = x2; }
                                else { float* o = nv + orow + c8; *(f32x4*)o = x1; *(f32x4*)(o + 4) = x2; } }
                }
            }
    }
};
struct EpiResid {
    float* X; const float* gate; const float* an; bf16_t* XA; float* ssp;
    static constexpr bool PERM = true;
    template <class Sched> __device__ __forceinline__ void prepare(const Sched&, LAS unsigned char*, int) const {}
    __device__ __forceinline__ void operator()(const AccT& acc, const GUnit& u, int ui, int wr, int wc, int fr, int fq) const {
        const int cbase = u.col0 + wc * 32 + 8 * fq;
        const int cnd = cond_of_row(u.row0);
        const float* g = gate + cnd * 6144;
        f32x4 gv[2][2];
#pragma unroll
        for (int bj = 0; bj < 2; ++bj)
#pragma unroll
            for (int n = 0; n < 2; ++n) gv[bj][n] = *(const f32x4*)(g + cbase + bj * 128 + n * 4);
        const float* anc = an + cnd * 1024 + cbase;
        const int slot = (u.col0 >> 8) * 4 + wc;
#pragma unroll
        for (int ai = 0; ai < 2; ++ai) {
#pragma unroll
            for (int mp = 0; mp < 2; ++mp) {
            f32x4 xo[2][2][2];
#pragma unroll
            for (int m2 = 0; m2 < 2; ++m2)
#pragma unroll
                for (int bj = 0; bj < 2; ++bj)
#pragma unroll
                    for (int n = 0; n < 2; ++n) xo[m2][bj][n] = *(const f32x4*)(X + (size_t)(u.row0 + ai * 128 + wr * 64 + (mp * 2 + m2) * 16 + fr) * 1024 + cbase + bj * 128 + n * 4);
#pragma unroll
            for (int m2 = 0; m2 < 2; ++m2) {
                const int m = mp * 2 + m2;
                const size_t ro = (size_t)(u.row0 + ai * 128 + wr * 64 + m * 16 + fr);
                float ss = 0.f;
#pragma unroll
                for (int bj = 0; bj < 2; ++bj) {
                    const f32x4 x0 = xo[m2][bj][0] + gv[bj][0] * acc[ai][bj][m][0], x1 = xo[m2][bj][1] + gv[bj][1] * acc[ai][bj][m][1];
                    *(f32x4*)(X + ro * 1024 + cbase + bj * 128) = x0; *(f32x4*)(X + ro * 1024 + cbase + bj * 128 + 4) = x1;
                    ss += ((x0[0] * x0[0] + x0[1] * x0[1]) + (x0[2] * x0[2] + x0[3] * x0[3])) + ((x1[0] * x1[0] + x1[1] * x1[1]) + (x1[2] * x1[2] + x1[3] * x1[3]));
                    if (an) { const f32x4 y0 = x0 * *(const f32x4*)(anc + bj * 128), y1 = x1 * *(const f32x4*)(anc + bj * 128 + 4); u32x4 w; w.x = cvt_pk_bf16(y0[0], y0[1]); w.y = cvt_pk_bf16(y0[2], y0[3]); w.z = cvt_pk_bf16(y1[0], y1[1]); w.w = cvt_pk_bf16(y1[2], y1[3]);
                        *(u32x4*)(XA + ro * 1024 + cbase + bj * 128) = w; }
                }
                ss += __shfl_xor(ss, 16); ss += __shfl_xor(ss, 32);
                if (fq == 0) ssp[ro * SSPN + slot] = ss;
            }
            }
            asm volatile("" ::: "memory");
        }
    }
};
struct EpiResid128 {
    bf16_t* X; const float* gate; const float* an; bf16_t* XA; float* ssp;
    static constexpr bool PERM = true;
    template <class Sched> __device__ __forceinline__ void prepare(const Sched&, LAS unsigned char*, int) const {}
    __device__ __forceinline__ void operator()(const AccH& acc, const GUnit& u, int ui, int wr, int wc, int fr, int fq) const {
        const int cbase = u.col0 + wc * 32 + 8 * fq;
        const int cnd = cond_of_row(u.row0);
        const float* g = gate + cnd * 6144;
        const f32x4 gv0 = *(const f32x4*)(g + cbase), gv1 = *(const f32x4*)(g + cbase + 4);
        f32x4 av0 = {0.f, 0.f, 0.f, 0.f}, av1 = av0;
        if (an) { av0 = *(const f32x4*)(an + cnd * 1024 + cbase); av1 = *(const f32x4*)(an + cnd * 1024 + cbase + 4); }
        const int slot = (u.col0 >> 7) * 4 + wc;
        u32x4 xo[2][4];
#pragma unroll
        for (int ai = 0; ai < 2; ++ai)
#pragma unroll
            for (int m = 0; m < 4; ++m) xo[ai][m] = *(const u32x4*)(X + (size_t)(u.row0 + ai * 128 + wr * 64 + m * 16 + fr) * 1024 + cbase);
#pragma unroll
        for (int ai = 0; ai < 2; ++ai)
#pragma unroll
            for (int m = 0; m < 4; ++m) {
                const size_t ro = (size_t)(u.row0 + ai * 128 + wr * 64 + m * 16 + fr);
                const u32x4 xw = xo[ai][m];
                const f32x4 xa = {bflo(xw.x), bfhi(xw.x), bflo(xw.y), bfhi(xw.y)}, xb = {bflo(xw.z), bfhi(xw.z), bflo(xw.w), bfhi(xw.w)};
                const f32x4 x0 = xa + gv0 * acc[ai][m][0], x1 = xb + gv1 * acc[ai][m][1];
                { u32x4 w; w.x = cvt_pk_bf16(x0[0], x0[1]); w.y = cvt_pk_bf16(x0[2], x0[3]); w.z = cvt_pk_bf16(x1[0], x1[1]); w.w = cvt_pk_bf16(x1[2], x1[3]); *(u32x4*)(X + ro * 1024 + cbase) = w; }
                float ss = ((x0[0] * x0[0] + x0[1] * x0[1]) + (x0[2] * x0[2] + x0[3] * x0[3])) + ((x1[0] * x1[0] + x1[1] * x1[1]) + (x1[2] * x1[2] + x1[3] * x1[3]));
                if (an) { const f32x4 y0 = x0 * av0, y1 = x1 * av1; u32x4 w; w.x = cvt_pk_bf16(y0[0], y0[1]); w.y = cvt_pk_bf16(y0[2], y0[3]); w.z = cvt_pk_bf16(y1[0], y1[1]); w.w = cvt_pk_bf16(y1[2], y1[3]);
                    *(u32x4*)(XA + ro * 1024 + cbase) = w; }
                ss += __shfl_xor(ss, 16); ss += __shfl_xor(ss, 32);
                if (fq == 0) ssp[ro * SSPN + slot] = ss;
            }
    }
};
struct EpiG128 {
    bf16_t* GH; const float* ssp; const float* sw; LAS unsigned char* lds;
    static constexpr bool PERM = true;
    template <class Sched> __device__ __forceinline__ void prepare(const Sched& S, LAS unsigned char* l, int tid) const { prep_rstd(l, ssp, S, false, tid); }
    __device__ __forceinline__ void operator()(const AccH& acc, const GUnit& u, int ui, int wr, int wc, int fr, int fq) const {
        const LAS float* R = (const LAS float*)(lds + RSTD_OFF) + ui * 256;
        const float* swc = sw + cond_of_row(u.row0) * 5120 + u.col0 + wc * 32 + 8 * fq;
        const f32x4 sv0 = *(const f32x4*)swc, sv1 = *(const f32x4*)(swc + 4);
        const int cbase = (u.col0 - 4096) + wc * 32 + 8 * fq;
#pragma unroll
        for (int ai = 0; ai < 2; ++ai)
#pragma unroll
            for (int m = 0; m < 4; ++m) {
                const int rl = ai * 128 + wr * 64 + m * 16 + fr; const float rs = R[rl];
                const f32x4 v0 = acc[ai][m][0] * rs + sv0, v1 = acc[ai][m][1] * rs + sv1;
                u32x4 w; w.x = cvt_pk_bf16(silu_f(v0[0]), silu_f(v0[1])); w.y = cvt_pk_bf16(silu_f(v0[2]), silu_f(v0[3])); w.z = cvt_pk_bf16(silu_f(v1[0]), silu_f(v1[1])); w.w = cvt_pk_bf16(silu_f(v1[2]), silu_f(v1[3]));
                *(u32x4*)(GH + (size_t)(u.row0 + rl) * 1024 + cbase) = w;
            }
    }
};
struct EpiFFN {
    bf16_t* ACT; const float* ssp; const float* sw; LAS unsigned char* lds;
    static constexpr bool PERM = true;
    template <class Sched> __device__ __forceinline__ void prepare(const Sched& S, LAS unsigned char* l, int tid) const { prep_rstd(l, ssp, S, false, tid); }
    __device__ __forceinline__ void operator()(const AccT& acc, const GUnit& u, int ui, int wr, int wc, int fr, int fq) const {
        const LAS float* R = (const LAS float*)(lds + RSTD_OFF) + ui * 256;
        const int abase = (u.col0 >> 1) + wc * 32 + 8 * fq;
        const float* swc = sw + cond_of_row(u.row0) * 5632 + u.col0 + wc * 32 + 8 * fq;
        f32x4 sv[2][2];
#pragma unroll
        for (int bj = 0; bj < 2; ++bj)
#pragma unroll
            for (int n = 0; n < 2; ++n) sv[bj][n] = *(const f32x4*)(swc + bj * 128 + n * 4);
#pragma unroll
        for (int ai = 0; ai < 2; ++ai)
#pragma unroll
            for (int m = 0; m < 4; ++m) {
                const int rl = ai * 128 + wr * 64 + m * 16 + fr;
                const float rs = R[rl];
                u32x4 w;
#pragma unroll
                for (int n = 0; n < 2; ++n) {
                    const f32x4 g = acc[ai][0][m][n] * rs + sv[0][n], up = acc[ai][1][m][n] * rs + sv[1][n];
                    w[2 * n] = cvt_pk_bf16(silu_f(g[0]) * up[0], silu_f(g[1]) * up[1]); w[2 * n + 1] = cvt_pk_bf16(silu_f(g[2]) * up[2], silu_f(g[3]) * up[3]);
                }
                *(u32x4*)(ACT + (size_t)(u.row0 + rl) * DFF + abase) = w;
            }
    }
};
__device__ __forceinline__ void quad_transpose(f32x4& v, int qi) {
#define QT_X1(x) __int_as_float(__builtin_amdgcn_update_dpp(0, __float_as_int(x), 0xB1, 0xF, 0xF, true))
#define QT_X2(x) __int_as_float(__builtin_amdgcn_update_dpp(0, __float_as_int(x), 0x4E, 0xF, 0xF, true))
    const bool o1 = qi & 1, o2 = qi & 2;
    { const float t0 = o1 ? v[0] : v[1], t1 = o1 ? v[2] : v[3]; const float r0 = QT_X1(t0), r1 = QT_X1(t1);
      if (o1) { v[0] = r0; v[2] = r1; } else { v[1] = r0; v[3] = r1; } }
    { const float t0 = o2 ? v[0] : v[2], t1 = o2 ? v[1] : v[3]; const float r0 = QT_X2(t0), r1 = QT_X2(t1);
      if (o2) { v[0] = r0; v[1] = r1; } else { v[2] = r0; v[3] = r1; } }
#undef QT_X1
#undef QT_X2
}
__device__ __forceinline__ void quad_transpose_pk(unsigned& p0, unsigned& p1, int qi) {
    const unsigned sel = (qi & 1) ? 0x03020706u : 0x05040100u;
    const unsigned n0 = (unsigned)__builtin_amdgcn_update_dpp(0, (int)p0, 0xB1, 0xF, 0xF, true), n1 = (unsigned)__builtin_amdgcn_update_dpp(0, (int)p1, 0xB1, 0xF, 0xF, true);
    const unsigned a0 = __builtin_amdgcn_perm(n0, p0, sel), a1 = __builtin_amdgcn_perm(n1, p1, sel);
    const bool hi2 = qi & 2;
    const unsigned send = hi2 ? a0 : a1;
    const unsigned recv = (unsigned)__builtin_amdgcn_update_dpp(0, (int)send, 0x4E, 0xF, 0xF, true);
    p0 = hi2 ? recv : a0; p1 = hi2 ? a1 : recv;
}
#define DPP_BC(x, N) __int_as_float(__builtin_amdgcn_update_dpp(0, __float_as_int(x), 0x150 + (N), 0xF, 0xF, true))
#define DPPM_SHR(x, N) __int_as_float(__builtin_amdgcn_update_dpp(0x3f800000, __float_as_int(x), 0x110 + (N), 0xF, 0xF, false))
#define DPPM_SHL(x, N) __int_as_float(__builtin_amdgcn_update_dpp(0x3f800000, __float_as_int(x), 0x100 + (N), 0xF, 0xF, false))
#define DPP_SHR(x, N) __int_as_float(__builtin_amdgcn_update_dpp(0, __float_as_int(x), 0x110 + (N), 0xF, 0xF, true))
#define DPP_SHL(x, N) __int_as_float(__builtin_amdgcn_update_dpp(0, __float_as_int(x), 0x100 + (N), 0xF, 0xF, true))
struct EpiHgrn {
    bf16_t* GH; bf16_t* QTF; bf16_t* KTF; bf16_t* QTB; bf16_t* KTB; bf16_t* KHTF; bf16_t* KHTB; bf16_t* VT; float* DDF; float* DDB; const float* lbv; const float* ssp; const float* sw; LAS unsigned char* lds;
    static constexpr bool PERM = false;
    template <class Sched> __device__ __forceinline__ void prepare(const Sched& S, LAS unsigned char* l, int tid) const { prep_rstd(l, ssp, S, false, tid); }
    __device__ __forceinline__ void operator()(const AccT& acc, const GUnit& u, int ui, int wr, int wc, int fr, int fq) const {
        const LAS float* R = (const LAS float*)(lds + RSTD_OFF) + ui * 256;
        const int t = u.col0 >> 8;
        const float* swc = sw + cond_of_row(u.row0) * 5120 + u.col0 + wc * 32 + 4 * fq;
        f32x4 sv[2][2];
#pragma unroll
        for (int bj = 0; bj < 2; ++bj)
#pragma unroll
            for (int n = 0; n < 2; ++n) sv[bj][n] = *(const f32x4*)(swc + bj * 128 + n * 16);
        if (t >= 16) {
            const int cbase = (u.col0 - 4096) + wc * 32 + 4 * fq;
#pragma unroll
            for (int ai = 0; ai < 2; ++ai)
#pragma unroll
                for (int m = 0; m < 4; ++m) {
                    const int rl = ai * 128 + wr * 64 + m * 16 + fr; const float rs = R[rl];
#pragma unroll
                    for (int bj = 0; bj < 2; ++bj)
#pragma unroll
                        for (int n = 0; n < 2; ++n) { const f32x4 v = acc[ai][bj][m][n] * rs + sv[bj][n];
                            u32x2 w; w.x = cvt_pk_bf16(silu_f(v[0]), silu_f(v[1])); w.y = cvt_pk_bf16(silu_f(v[2]), silu_f(v[3]));
                            *(u32x2*)(GH + (size_t)(u.row0 + rl) * 1024 + cbase + bj * 128 + n * 16) = w; }
                }
            return;
        }
        const int h = t >> 1, kk = (t & 1) * 64 + wc * 16 + 4 * fq, chg = t * 64 + wc * 16 + 4 * fq;
        const f32x4 lb0 = *(const f32x4*)(lbv + chg), lb1 = *(const f32x4*)(lbv + 1024 + chg);
        const int lane = fq * 16 + fr;
#pragma unroll 1
        for (int am = 0; am < 8; ++am) {
            const int ai = am >> 2, m = am & 3;
            f32x4 aq, av, azf, azb;
            switch (am) {
#define HG_CASE(I) case I: aq = acc[(I) >> 2][0][(I) & 3][0]; av = acc[(I) >> 2][0][(I) & 3][1]; azf = acc[(I) >> 2][1][(I) & 3][0]; azb = acc[(I) >> 2][1][(I) & 3][1]; break;
                HG_CASE(0) HG_CASE(1) HG_CASE(2) HG_CASE(3) HG_CASE(4) HG_CASE(5) HG_CASE(6) default: aq = acc[1][0][3][0]; av = acc[1][0][3][1]; azf = acc[1][1][3][0]; azb = acc[1][1][3][1]; break;
#undef HG_CASE
            }
            const int rl = ai * 128 + wr * 64 + m * 16 + fr; const float rs = R[rl];
            const int tok = u.row0 + rl; const size_t cg = (size_t)((tok >> 4) * 8 + h);
            const f32x4 q4 = aq * rs + sv[0][0], v4 = av * rs + sv[0][1], zf = azf * rs + sv[1][0], zb = azb * rs + sv[1][1];
            f32x4 q, kf, kb, bf, bb;
#pragma unroll
            for (int j = 0; j < 4; ++j) { q[j] = silu_f(q4[j]);
                const float ff = lb0[j] + (1.f - lb0[j]) * sigmoid_f(zf[j]), fb = lb1[j] + (1.f - lb1[j]) * sigmoid_f(zb[j]);
                kf[j] = 1.f - ff; kb[j] = 1.f - fb; bf[j] = ff; bb[j] = fb; }
#define HG_SCAN(DIR, X) asm volatile("s_nop 1\n" \
                HG_SC4(DIR, 1) HG_SC4(DIR, 2) HG_SC4(DIR, 4) HG_SC4(DIR, 8) : "+v"(X[0]), "+v"(X[1]), "+v"(X[2]), "+v"(X[3]))
#define HG_SC1(DIR, N, R) "v_mul_f32_dpp " R ", " R ", " R " " DIR ":" #N " row_mask:0xf bank_mask:0xf\n"
#define HG_SC4(DIR, N) HG_SC1(DIR, N, "%0") HG_SC1(DIR, N, "%1") HG_SC1(DIR, N, "%2") HG_SC1(DIR, N, "%3")
            { float x[4] = {bf[0], bf[1], bf[2], bf[3]}; HG_SCAN("row_shr", x); bf[0] = x[0]; bf[1] = x[1]; bf[2] = x[2]; bf[3] = x[3]; }
            { float y[4] = {bb[0], bb[1], bb[2], bb[3]}; HG_SCAN("row_shl", y); bb[0] = y[0]; bb[1] = y[1]; bb[2] = y[2]; bb[3] = y[3]; }
#undef HG_SCAN
#undef HG_SC1
#undef HG_SC4
            f32x4 qtf, ktf, khf, ddf, qtb, ktb, khb, ddb;
#pragma unroll
            for (int j = 0; j < 4; ++j) {
                const float ef = bf[j], eif = fast_rcp(ef), eb = bb[j], eib = fast_rcp(eb);
                ddf[j] = DPP_BC(ef, 15); ddb[j] = DPP_BC(eb, 0);
                qtf[j] = q[j] * ef; ktf[j] = kf[j] * eif; khf[j] = ktf[j] * ddf[j];
                qtb[j] = q[j] * eb; ktb[j] = kb[j] * eib; khb[j] = ktb[j] * ddb[j]; }
            bf16_t* rec = QTF + ((size_t)(tok * 8 + h) * 32 + (kk >> 2)) * 16;
            { u32x4 w; w.x = cvt_pk_bf16(qtf[0], qtf[1]); w.y = cvt_pk_bf16(qtf[2], qtf[3]); w.z = cvt_pk_bf16(ktf[0], ktf[1]); w.w = cvt_pk_bf16(ktf[2], ktf[3]); *(u32x4*)rec = w; }
            { u32x4 w; w.x = cvt_pk_bf16(qtb[0], qtb[1]); w.y = cvt_pk_bf16(qtb[2], qtb[3]); w.z = cvt_pk_bf16(ktb[0], ktb[1]); w.w = cvt_pk_bf16(ktb[2], ktb[3]); *(u32x4*)(rec + 8) = w; }
            const size_t to = (cg * 128 + kk + (fr & 3)) * 16 + (fr & ~3);
            { unsigned w0 = cvt_pk_bf16(khf[0], khf[1]), w1 = cvt_pk_bf16(khf[2], khf[3]); quad_transpose_pk(w0, w1, fr & 3); u32x2 w; w.x = w0; w.y = w1; *(u32x2*)(KHTF + to) = w; }
            { unsigned w0 = cvt_pk_bf16(khb[0], khb[1]), w1 = cvt_pk_bf16(khb[2], khb[3]); quad_transpose_pk(w0, w1, fr & 3); u32x2 w; w.x = w0; w.y = w1; *(u32x2*)(KHTB + to) = w; }
            { unsigned w0 = cvt_pk_bf16(v4[0], v4[1]), w1 = cvt_pk_bf16(v4[2], v4[3]); quad_transpose_pk(w0, w1, fr & 3); u32x2 w; w.x = w0; w.y = w1; *(u32x2*)(VT + to) = w; }
            if (fr == 15) *(f32x4*)(DDF + cg * 128 + kk) = ddf;
            if (fr == 0) *(f32x4*)(DDB + cg * 128 + kk) = ddb;
        }
    }
};
struct EpiFour1 {
    bf16_t* ZT; const float* ssp; const float* sw; LAS unsigned char* lds;
    static constexpr bool PERM = true;
    template <class Sched> __device__ __forceinline__ void prepare(const Sched& S, LAS unsigned char* l, int tid) const { prep_rstd(l, ssp, S, true, tid); }
    __device__ __forceinline__ void operator()(const AccT& acc, const GUnit& u, int ui, int wr, int wc, int fr, int fq) const {
        const LAS float* R = (const LAS float*)(lds + RSTD_OFF) + ui * 256;
        const int cs = u.row0 >> 10;
        const float* swc = sw + cond_of_row(u.col0) * 2048 + u.row0 + wr * 64 + fr;
#pragma unroll
        for (int bj = 0; bj < 2; ++bj) {
            const int tl = bj * 128 + wc * 32 + 8 * fq, tok = u.col0 + tl;
            const f32x4 rs0 = *(const LAS f32x4*)(R + tl), rs1 = *(const LAS f32x4*)(R + tl + 4);
            int off;
            if (tok < NCTX) off = (tok >> 8) * 512 + cs * 256 + (tok & 255);
            else { const int tt = tok - NCTX; off = 8192 + (tt >> 10) * 2048 + cs * 1024 + (tt & 1023); }
#pragma unroll
            for (int ai = 0; ai < 2; ++ai)
#pragma unroll
                for (int m = 0; m < 4; ++m) {
                    const int nrow = (u.row0 & 1023) + ai * 128 + wr * 64 + m * 16 + fr;
                    const float sh = swc[ai * 128 + m * 16];
                    const f32x4 v0 = acc[ai][bj][m][0] * rs0 + sh, v1 = acc[ai][bj][m][1] * rs1 + sh;
                    u32x4 w; w.x = cvt_pk_bf16(v0[0], v0[1]); w.y = cvt_pk_bf16(v0[2], v0[3]); w.z = cvt_pk_bf16(v1[0], v1[1]); w.w = cvt_pk_bf16(v1[2], v1[3]);
                    *(u32x4*)(ZT + (size_t)nrow * 16384 + off) = w;
                }
        }
    }
};
struct EpiBf16 {
    bf16_t* O; int ldc;
    static constexpr bool PERM = false;
    template <class Sched> __device__ __forceinline__ void prepare(const Sched&, LAS unsigned char*, int) const {}
    __device__ __forceinline__ void operator()(const AccT& acc, const GUnit& u, int ui, int wr, int wc, int fr, int fq) const {
        bf16_t* base = O + (size_t)u.aux;
        const int cbase = u.col0 + wc * 32 + 4 * fq;
#pragma unroll
        for (int ai = 0; ai < 2; ++ai)
#pragma unroll
            for (int m = 0; m < 4; ++m) {
                bf16_t* pr = base + (size_t)(u.row0 + ai * 128 + wr * 64 + m * 16 + fr) * ldc + cbase;
#pragma unroll
                for (int bj = 0; bj < 2; ++bj)
#pragma unroll
                    for (int n = 0; n < 2; ++n) { const f32x4 v = acc[ai][bj][m][n]; u32x2 w; w.x = cvt_pk_bf16(v[0], v[1]); w.y = cvt_pk_bf16(v[2], v[3]); *(u32x2*)(pr + bj * 128 + n * 16) = w; }
            }
    }
};
struct GenSched {
    const char* A; const char* A2; const char* B; int lda, ldb, nM, nN, nwg, G, c, nt, mode;
    __device__ __forceinline__ void init(int mode_, const void* A_, const void* A2_, int lda_, const void* B_, int ldb_, int M, int N, int K, int G_, int c_) {
        mode = mode_; A = (const char*)A_; A2 = (const char*)A2_; B = (const char*)B_; lda = lda_; ldb = ldb_; nM = M / 256; nN = N / 256; nwg = (mode_ == 0 || mode_ == 7 || mode_ == 8) ? nM * nN : mode_ == 1 ? 128 : mode_ == 2 ? 32 : mode_ == 5 ? 512 : 256; G = G_; c = c_; nt = K / 64; }
    __device__ __forceinline__ bool next(int i, GUnit& u) const {
        const int L = i * G + c; if (L >= nwg) return false;
        u.aux = 0;
        if (mode == 0 || mode == 7 || mode == 8) {
            if (mode == 7 && i > 0) return false;
            int half = 0; int wgid = L; if (mode == 8) { if (i > 0) return false; half = L & 1; wgid = 256 + (L >> 1); if (wgid >= nM * nN) return false; } { const int q = nwg / 8, r = nwg % 8, xcd = wgid % 8, off = wgid / 8; wgid = (xcd < r ? xcd * (q + 1) : r * (q + 1) + (xcd - r) * q) + off; }
            const int nig = 8 * nN, gid = wgid / nig, fm = gid * 8, gsz = (nM - fm) < 8 ? (nM - fm) : 8;
            const int pm = fm + ((wgid % nig) % gsz), pn = (wgid % nig) / gsz;
            u.A = A + (size_t)pm * 256 * lda * 2; u.B = B + (size_t)(pn * 256 + half * 128) * ldb * 2; u.nt = nt; u.row0 = pm * 256; u.col0 = pn * 256 + half * 128;
        } else if (mode == 1) {
            if (L < 64) { const int b = L >> 4, pm = (L >> 2) & 3, pn = L & 3;
                u.A = A + (size_t)pm * 256 * 2048 * 2; u.B = B + ((size_t)pn * 256 * 16384 + 8192 + b * 2048) * 2; u.nt = 32; u.row0 = NCTX + b * 1024 + pm * 256; u.col0 = pn * 256; }
            else { const int l = L - 64, b = l >> 2, pn = l & 3;
                u.A = A2; u.B = B + ((size_t)pn * 256 * 16384 + b * 512) * 2; u.nt = 8; u.row0 = b * 256; u.col0 = pn * 256; }
        } else if (mode == 5) {
            int wgid = L; { const int xcd = wgid % 8, off = wgid / 8; wgid = xcd * 64 + off; }
            const int gid = wgid >> 7, r = wgid & 127, pm = gid * 8 + (r & 7), pn = r >> 3;
            u.A = A + (size_t)pm * 256 * lda * 2; u.B = B + (size_t)pn * 256 * ldb * 2; u.nt = nt; u.row0 = pm * 256; u.col0 = pn * 256;
        } else if (mode == 6) {
            const int wgid = (L & 7) * 32 + (L >> 3), pm = wgid >> 3, pn = wgid & 7;
            u.A = A + (size_t)pm * 256 * lda * 2; u.B = B + (size_t)(4096 + pn * 128) * ldb * 2; u.nt = nt; u.row0 = pm * 256; u.col0 = 4096 + pn * 128;
        } else if (mode == 3) {
            const int wgid = (L & 7) * 32 + (L >> 3), pm = wgid >> 3, pn = wgid & 7;
            u.A = A + (size_t)pm * 256 * lda * 2; u.B = B + (size_t)pn * 128 * ldb * 2; u.nt = nt; u.row0 = pm * 256; u.col0 = pn * 128;
        } else if (mode == 4) {
            if (L < 128) { const int b = L >> 5, pm = (L >> 3) & 3, pn = L & 7;
                u.A = A + (size_t)pm * 256 * 2048 * 2; u.B = B + ((size_t)pn * 128 * 16384 + 8192 + b * 2048) * 2; u.nt = 32; u.row0 = NCTX + b * 1024 + pm * 256; u.col0 = pn * 128; }
            else { const int l = L - 128, b = l >> 3, pn = l & 7;
                u.A = A2; u.B = B + ((size_t)pn * 128 * 16384 + b * 512) * 2; u.nt = 8; u.row0 = b * 256; u.col0 = pn * 128; }
        } else {
            const int g = L >> 3, cs = (L >> 2) & 1, pm = L & 3;
            u.A = A + ((size_t)pm * 256 * 1024 + g * 256) * 2; u.B = B + (size_t)cs * 256 * 2; u.nt = nt;
            u.row0 = pm * 256; u.col0 = 0; u.aux = cs * 1024 * 1024 + g * 256;
        }
        return true;
    }
};
struct Args {
    const float* in[23];
    float* out; unsigned char* ws;
    int ph_lo, ph_hi; float lam_init0, lam_init1; int pad0, pad1;
};
typedef const __attribute__((address_space(4))) Args* ArgP;
enum { I_XP = 0, I_XS, I_CK, I_CV, I_ST, I_C, I_CCTX, I_WADA, I_BADA, I_GMIX, I_GFFN, I_WQKV, I_LAM, I_GSUB, I_WOA, I_WINR, I_LBL, I_GOUT, I_WOR, I_WFOUR, I_WFI, I_WFO, I_GFIN };

__device__ __forceinline__ void tr_load(const float* W, int N, int item, int lane, f32x4 (&v)[8]) {
    const int nblk = N / 32, kb = item / nblk, nb = item % nblk;
    const float* src = W + (size_t)(64 * kb + 8 * (lane >> 3)) * N + 32 * nb + (lane & 7) * 4;
#pragma unroll
    for (int i = 0; i < 8; ++i) v[i] = __builtin_nontemporal_load((const f32x4*)(src + (size_t)i * N));
}
template <class RowMap>
__device__ __forceinline__ void tr_finish(const f32x4 (&v)[8], int K, int N, bf16_t* WT, const RowMap& rowmap, int item, int lane) {
    const int nblk = N / 32, kb = item / nblk, nb = item % nblk, k0 = 64 * kb + 8 * (lane >> 3), n0 = 32 * nb + (lane & 7) * 4;
#pragma unroll
    for (int j = 0; j < 4; ++j) {
        u32x4 o; o.x = cvt_pk_bf16(v[0][j], v[1][j]); o.y = cvt_pk_bf16(v[2][j], v[3][j]); o.z = cvt_pk_bf16(v[4][j], v[5][j]); o.w = cvt_pk_bf16(v[6][j], v[7][j]);
        *(u32x4*)(WT + (size_t)rowmap(n0 + j) * K + k0) = o; }
}
template <class RowMap>
__device__ __forceinline__ void transpose_item(const float* W, int K, int N, bf16_t* WT, const RowMap& rowmap, LAS float* scr, int item, int lane) {
    f32x4 v[8]; tr_load(W, N, item, lane, v); tr_finish(v, K, N, WT, rowmap, item, lane);
}
struct RowHin { __device__ __forceinline__ int operator()(int s) const { const int sec = s >> 10, ch = s & 1023; if (sec == 2) return 4096 + ch;
    const int t = ch >> 6, cl = ch & 63, bj = sec >= 3 ? 1 : 0, n = (sec == 1 || sec == 4) ? 1 : 0; return 256 * t + 128 * bj + 32 * (cl >> 4) + 16 * n + (cl & 15); } };
struct RowQKV { __device__ __forceinline__ int operator()(int s) const { if (s < 2048) return s; const int p = s & 31; return (s & ~31) + 16 * ((p >> 2) & 1) + 4 * (p >> 3) + (p & 3); } };
struct RowId { __device__ __forceinline__ int operator()(int n) const { return n; } };
struct RowFFN { __device__ __forceinline__ int operator()(int s) const { const int n = s >= DFF ? 1 : 0, a = s - n * DFF; return 256 * (a >> 7) + 128 * n + (a & 127); } };

__device__ __forceinline__ void cache_convert(ArgP a, int j, int gw, int ngw, int lane) {
    bf16_t* KB = (bf16_t*)(a->ws + WS_KB); bf16_t* VB = (bf16_t*)(a->ws + WS_VB);
    for (int it = gw; it < 2 * 4 * 512; it += ngw) {
        const int kv = it >> 11, r = it & 2047, b = r >> 9, s = r & 511;
        const float* src = a->in[kv ? I_CV : I_CK] + ((size_t)(b * 2 + j) * 512 + s) * 1024;
        bf16_t* dst = (kv ? VB : KB) + (size_t)(NCTX + b * 1536 + s) * 1024;
#pragma unroll
        for (int q = 0; q < 2; ++q) { const f32x8 v = *(const f32x8*)(src + q * 512 + lane * 8);
            u32x4 w; w.x = cvt_pk_bf16(v[0], v[1]); w.y = cvt_pk_bf16(v[2], v[3]); w.z = cvt_pk_bf16(v[4], v[5]); w.w = cvt_pk_bf16(v[6], v[7]);
            if (kv) *(u32x4*)(dst + q * 512 + lane * 8) = w;
            else { const int d0 = q * 512 + lane * 8, p0 = d0 & 31, n = p0 >> 4, f0 = (p0 & 15) >> 2;
                bf16_t* g = dst + (d0 & ~31);
                u32x2 lo, hi; lo.x = w.x; lo.y = w.y; hi.x = w.z; hi.y = w.w;
                *(u32x2*)(g + 8 * f0 + 4 * n) = lo; *(u32x2*)(g + 8 * (f0 + 1) + 4 * n) = hi; } }
    }
}

__device__ __forceinline__ void phase_ada(ArgP a, LAS unsigned char* lds, int it0, int it1, int step) {
    const int tid = tid_opaque(), lane = tid & 63, wave = __builtin_amdgcn_readfirstlane(tid >> 6);
    {
        LAS float* SC = (LAS float*)lds;
        LAS float* RED = (LAS float*)(lds + 20480);
        for (int i = tid; i < 5 * 1024; i += NTHREADS) { const int cnd = i >> 10, k = i & 1023; const float x = cnd == 0 ? a->in[I_CCTX][k] : a->in[I_C][(cnd - 1) * 1024 + k]; SC[i] = silu_f(x); }
        __syncthreads();
        float* mod = (float*)(a->ws + WS_MOD);
        for (int it = it0; it < it1; it += step) {
            const int l = it / 48, cg = it % 48;
            const int kh = lane >> 5, c4 = (lane & 31) * 4;
            const float* w = a->in[I_WADA] + (size_t)l * 1024 * 6144 + (size_t)(wave * 128 + 64 * kh) * 6144 + cg * 128 + c4;
            f32x4 acc[5];
#pragma unroll
            for (int c = 0; c < 5; ++c) acc[c] = (f32x4){0.f, 0.f, 0.f, 0.f};
#pragma unroll 1
            for (int k0 = 0; k0 < 64; k0 += 16) {
                f32x4 wv[16];
#pragma unroll
                for (int kk = 0; kk < 16; ++kk) wv[kk] = __builtin_nontemporal_load((const f32x4*)(w + (size_t)(k0 + kk) * 6144));
#pragma unroll
                for (int c = 0; c < 5; ++c) {
#pragma unroll
                    for (int k4 = 0; k4 < 4; ++k4) { const f32x4 sc = *(const LAS f32x4*)(SC + c * 1024 + wave * 128 + 64 * kh + k0 + 4 * k4);
                        acc[c] += sc[0] * wv[4 * k4] + sc[1] * wv[4 * k4 + 1] + sc[2] * wv[4 * k4 + 2] + sc[3] * wv[4 * k4 + 3]; }
                }
            }
#pragma unroll
            for (int c = 0; c < 5; ++c) {
#pragma unroll
                for (int q = 0; q < 4; ++q) acc[c][q] += __shfl_xor(acc[c][q], 32);
                if (kh == 0) *(LAS f32x4*)(RED + (wave * 5 + c) * 128 + c4) = acc[c]; }
            __syncthreads();
            for (int i = tid; i < 5 * 128; i += NTHREADS) { const int c = i >> 7, col = i & 127; float s = 0.f;
#pragma unroll
                for (int wv2 = 0; wv2 < 8; ++wv2) s += RED[(wv2 * 5 + c) * 128 + col];
                const float mv = s + a->in[I_BADA][l * 6144 + cg * 128 + col];
                mod[(size_t)(l * 5 + c) * 6144 + cg * 128 + col] = mv;
                if (l == 3 && ((cg >> 3) == 1 || (cg >> 3) == 4)) { const int wh = (cg >> 3) == 4, k = (cg & 7) * 128 + col;
                    ((float*)(a->ws + WS_AN))[(size_t)(6 + wh) * 5120 + c * 1024 + k] = a->in[wh ? I_GFFN : I_GMIX][3 * 1024 + k] * (1.f + mv); } }
            __syncthreads();
        }
    }
}

__device__ __forceinline__ void deferred_convert(ArgP a, int set, LAS unsigned char* lds, int widx, int nw);
__device__ __forceinline__ void phase_prologue(ArgP a, LAS unsigned char* lds, int G, int bid) {
    const int tid = tid_opaque(), lane = tid & 63, wave = __builtin_amdgcn_readfirstlane(tid >> 6);
    const int gw = bid * NWAVES + wave, ngw = G * NWAVES, gt = bid * NTHREADS + tid, ngt = G * NTHREADS;
    phase_ada(a, lds, bid, 3 * 48, G);
    if (bid >= 3 * 48) deferred_convert(a, 5, lds, (bid - 3 * 48) * NWAVES + wave, (G - 3 * 48) * NWAVES);
    deferred_convert(a, 6, lds, gw, ngw);
    {
        float* ropec = (float*)(a->ws + WS_ROPE); float* ropes = ropec + 1024;
        for (int i = gt; i < 1024; i += ngt) { const int pos = i >> 4, q = i & 15;
            float inv = (q & 3) == 0 ? 1.f : (q & 3) == 1 ? 0.56234132519f : (q & 3) == 2 ? 0.31622776602f : 0.17782794100f;
            inv *= (q >> 2) == 0 ? 1.f : (q >> 2) == 1 ? 0.1f : (q >> 2) == 2 ? 0.01f : 0.001f;
            const float ap = (float)pos * inv * 0.31830988618f;
            ropec[i] = cospif(ap); ropes[i] = sinpif(ap); }
        bf16_t* TC = (bf16_t*)(a->ws + WS_TC);
        for (int i = gt; i < 256 * 512; i += ngt) { const int c = i >> 9, k = i & 511, d = k & 255; const float ang = (float)((c * d) & 255) * (1.f / 128.f);
            const float v = (k < 256 ? cospif(ang) : sinpif(ang)) * 0.0625f; TC[c * 1024 + k] = (bf16_t)(cvt_pk_bf16(v, 0.f) & 0xffff); }
        bf16_t* C2 = (bf16_t*)(a->ws + WS_CS256);
        for (int i = gt; i < 256 * 512; i += ngt) { const int p = i >> 9, k = i & 511, t = k & 255; const float ang = (float)((p * t) & 255) * (1.f / 128.f);
            const float v = (k < 256 ? cospif(ang) : -sinpif(ang)) * 0.0625f; C2[p * 2048 + k] = (bf16_t)(cvt_pk_bf16(v, 0.f) & 0xffff); }
        bf16_t* C1 = (bf16_t*)(a->ws + WS_CS1024);
        for (int i = gt; i < 1024 * 2048; i += ngt) { const int p = i >> 11, k = i & 2047, t = k & 1023; const float ang = (float)((p * t) & 1023) * (1.f / 512.f);
            const float v = (k < 1024 ? cospif(ang) : -sinpif(ang)) * 0.03125f; C1[i] = (bf16_t)(cvt_pk_bf16(v, 0.f) & 0xffff); }
        float* lbv = (float*)(a->ws + WS_LBV);
        for (int i = gt; i < 2048; i += ngt) { const int d = i >> 10, k = i & 1023; const float* lg = a->in[I_LBL] + (size_t)d * 4096 + k;
            const float l0 = lg[0], l1 = lg[1024], l2 = lg[2048], l3 = lg[3072]; const float mx = fmaxf(fmaxf(l0, l1), fmaxf(l2, l3));
            const float e0 = __expf(l0 - mx), e1 = __expf(l1 - mx), e2 = __expf(l2 - mx), e3 = __expf(l3 - mx); lbv[i] = e1 / (e0 + e1 + e2 + e3); }
        if (gw < 2) { const int j = gw; const float* lp = a->in[I_LAM] + j * 256;
            float s1 = wave_sum(lp[lane] * lp[64 + lane]), s2 = wave_sum(lp[128 + lane] * lp[192 + lane]);
            if (lane == 0) ((float*)(a->ws + WS_LAM))[j] = __expf(s1) - __expf(s2) + (j == 0 ? a->lam_init0 : a->lam_init1); }
    }
    cache_convert(a, 0, gw, ngw, lane);
}

struct TrJob { const float* W; bf16_t* WT; int K, N, map, item; };
__device__ __forceinline__ bool tr_decode(ArgP a, int set, int it, TrJob& j) {
    constexpr int I_FI = 16 * 176, I_FO = 44 * 32, I_R = 16 * 160, I_O = 16 * 32, I_Q = 16 * 96;
    if (set == 3) {
        if (it < I_Q) { j.W = a->in[I_WQKV] + (size_t)1024 * 3072; j.WT = (bf16_t*)(a->ws + WS_WQKV) + (size_t)3072 * 1024; j.K = 1024; j.N = 3072; j.map = 3; j.item = it; return true; }
        it -= I_Q; if (it >= I_O) return false;
        j.W = a->in[I_WOA] + (size_t)1024 * 1024; j.WT = (bf16_t*)(a->ws + WS_WOA) + (size_t)1024 * 1024; j.K = 1024; j.N = 1024; j.map = 1; j.item = it; return true;
    }
    if (set == 6) {
        if (it < I_Q) { j.W = a->in[I_WQKV]; j.WT = (bf16_t*)(a->ws + WS_WQKV); j.K = 1024; j.N = 3072; j.map = 3; j.item = it; return true; }
        it -= I_Q;
        if (it < I_O) { j.W = a->in[I_WOA]; j.WT = (bf16_t*)(a->ws + WS_WOA); j.K = 1024; j.N = 1024; j.map = 1; j.item = it; return true; }
        it -= I_O;
        if (it < I_O) { j.W = a->in[I_WFOUR]; j.WT = (bf16_t*)(a->ws + WS_WFO); j.K = 1024; j.N = 1024; j.map = 1; j.item = it; return true; }
        it -= I_O;
        if (it < I_FI) { j.W = a->in[I_WFI]; j.WT = (bf16_t*)(a->ws + WS_WFI); j.K = 1024; j.N = 5632; j.map = 0; j.item = it; return true; }
        it -= I_FI; if (it >= I_FO) return false;
        j.W = a->in[I_WFO]; j.WT = (bf16_t*)(a->ws + WS_WFOUT); j.K = DFF; j.N = 1024; j.map = 1; j.item = it; return true;
    }
    if (set == 5) {
        if (it < I_R) { j.W = a->in[I_WINR]; j.WT = (bf16_t*)(a->ws + WS_WINR); j.K = 1024; j.N = 5120; j.map = 2; j.item = it; return true; }
        it -= I_R; if (it >= I_O) return false;
        j.W = a->in[I_WOR]; j.WT = (bf16_t*)(a->ws + WS_WOR); j.K = 1024; j.N = 1024; j.map = 1; j.item = it; return true;
    }
    const int l = set + 1;
    if (it < I_FI) { j.W = a->in[I_WFI] + (size_t)l * 1024 * 5632; j.WT = (bf16_t*)(a->ws + WS_WFI) + (size_t)l * 5632 * 1024; j.K = 1024; j.N = 5632; j.map = 0; j.item = it; return true; }
    it -= I_FI;
    if (it < I_FO) { j.W = a->in[I_WFO] + (size_t)l * DFF * 1024; j.WT = (bf16_t*)(a->ws + WS_WFOUT) + (size_t)l * 1024 * DFF; j.K = DFF; j.N = 1024; j.map = 1; j.item = it; return true; }
    return false;
}
__device__ __forceinline__ void deferred_convert(ArgP a, int set, LAS unsigned char* lds, int widx, int nw) {
    const int tid = tid_opaque(), lane = tid & 63, wave = __builtin_amdgcn_readfirstlane(tid >> 6);
    LAS float* scr = (LAS float*)(lds + wave * 16384);
    const int ni = set == 6 ? 16 * 96 + 2 * 16 * 32 + 16 * 176 + 44 * 32 : set == 5 ? 16 * 160 + 16 * 32 : set == 3 ? 16 * 96 + 16 * 32 : 16 * 176 + 44 * 32;
#define FW_FIN(v, j, ok) do { if (ok) { if (j.map == 0) tr_finish(v, j.K, j.N, j.WT, RowFFN(), j.item, lane); else if (j.map == 1) tr_finish(v, j.K, j.N, j.WT, RowId(), j.item, lane); \
        else if (j.map == 2) tr_finish(v, j.K, j.N, j.WT, RowHin(), j.item, lane); else tr_finish(v, j.K, j.N, j.WT, RowQKV(), j.item, lane); } } while (0)
    for (int it = widx; it < ni; it += 5 * nw) {
        f32x4 v0[8], v1[8], v2[8], v3[8], v4[8]; TrJob j0, j1, j2, j3, j4;
        const bool k0 = tr_decode(a, set, it, j0), k1 = tr_decode(a, set, it + nw, j1), k2 = tr_decode(a, set, it + 2 * nw, j2);
        const bool k3 = tr_decode(a, set, it + 3 * nw, j3), k4 = tr_decode(a, set, it + 4 * nw, j4);
        if (k0) tr_load(j0.W, j0.N, j0.item, lane, v0); if (k1) tr_load(j1.W, j1.N, j1.item, lane, v1); if (k2) tr_load(j2.W, j2.N, j2.item, lane, v2);
        if (k3) tr_load(j3.W, j3.N, j3.item, lane, v3); if (k4) tr_load(j4.W, j4.N, j4.item, lane, v4);
        FW_FIN(v0, j0, k0); FW_FIN(v1, j1, k1); FW_FIN(v2, j2, k2); FW_FIN(v3, j3, k3); FW_FIN(v4, j4, k4);
    }
#undef FW_FIN
}

__device__ __forceinline__ void phase_first_norm(ArgP a, int gw, int ngw, int lane) {
    bf16_t* X = (bf16_t*)(a->ws + WS_X); bf16_t* XA = (bf16_t*)(a->ws + WS_H); float* ssp = (float*)(a->ws + WS_SSP);
    const float* mod = (const float*)(a->ws + WS_MOD); const float* gm = a->in[I_GMIX];
    for (int r = gw; r < MTOK; r += ngw) {
        const float* xr = r < NCTX ? a->in[I_XP] + (size_t)r * 1024 : a->in[I_XS] + (size_t)(r - NCTX) * 1024;
        const float* sc = mod + (size_t)cond_of_row(r) * 6144 + 1024;
        float s = 0.f;
#pragma unroll
        for (int j = 0; j < 4; ++j) {
            const int c = j * 256 + lane * 4;
            const f32x4 v = *(const f32x4*)(xr + c); s += (v.x * v.x + v.y * v.y) + (v.z * v.z + v.w * v.w);
            const f32x4 y = v * (*(const f32x4*)(gm + c) * (1.f + *(const f32x4*)(sc + c)));
            u32x2 w; w.x = cvt_pk_bf16(y[0], y[1]); w.y = cvt_pk_bf16(y[2], y[3]);
            *(u32x2*)(XA + (size_t)r * 1024 + c) = w; { u32x2 xw; xw.x = cvt_pk_bf16(v[0], v[1]); xw.y = cvt_pk_bf16(v[2], v[3]); *(u32x2*)(X + (size_t)r * 1024 + c) = xw; }
        }
        s = wave_sum(s);
        if (lane < SSPN) ssp[(size_t)r * SSPN + lane] = lane == 0 ? s : 0.f;
    }
}
__device__ __forceinline__ void phase_final(ArgP a, int gw, int ngw, int lane) {
    const bf16_t* X = (const bf16_t*)(a->ws + WS_X); const float* g = a->in[I_GFIN]; const float* ssp = (const float*)(a->ws + WS_SSP) + 8ull * 8192 * SSPN;
    for (int r = gw; r < MTOK; r += ngw) {
        const bf16_t* xr = X + (size_t)r * 1024;
        float s = lane < SSPN ? ssp[(size_t)r * SSPN + lane] : 0.f;
        const float rstd = rsqrtf(wave_sum(s) * (1.f / 1024.f) + EPS);
#pragma unroll
        for (int j = 0; j < 4; ++j) { const int c = j * 256 + lane * 4; const u32x2 xw = *(const u32x2*)(xr + c); const f32x4 xv = {bflo(xw.x), bfhi(xw.x), bflo(xw.y), bfhi(xw.y)};
            *(f32x4*)(a->out + (size_t)r * 1024 + c) = xv * rstd * *(const f32x4*)(g + c); }
    }
}
__device__ __forceinline__ void phase_an(ArgP a, int gt, int ngt) {
    float* an = (float*)(a->ws + WS_AN); const float* mod = (const float*)(a->ws + WS_MOD);
    for (int i = gt; i < 6 * 5 * 1024; i += ngt) {   const int nidx = i / 5120, c = (i / 1024) % 5, k = i & 1023, l = nidx >> 1, wh = nidx & 1;
        an[i] = a->in[wh ? I_GFFN : I_GMIX][l * 1024 + k] * (1.f + mod[(size_t)(l * 5 + c) * 6144 + (wh ? 4 : 1) * 1024 + k]); }
}
__device__ __forceinline__ void phase_sw(ArgP a, LAS unsigned char* lds, unsigned mask, int gw, int ngw, int tid, int lane) {
    LAS float* SH = (LAS float*)lds;
    const float* mod = (const float*)(a->ws + WS_MOD); float* swb = (float*)(a->ws + WS_SW);
    for (int nidx = 0; nidx < 8; ++nidx) {
        if (!((mask >> nidx) & 1)) continue;
        const int l = nidx >> 1, wh = nidx & 1, N = sw_n(nidx);
        const bf16_t* W = nidx == 0 ? (const bf16_t*)(a->ws + WS_WQKV) : nidx == 6 ? (const bf16_t*)(a->ws + WS_WQKV) + 3072ull * 1024 : nidx == 2 ? (const bf16_t*)(a->ws + WS_WINR)
                        : nidx == 4 ? (const bf16_t*)(a->ws + WS_WCS) : (const bf16_t*)(a->ws + WS_WFI) + (size_t)l * 5632 * 1024;
        __syncthreads();
        for (int i = tid; i < 5 * 1024; i += NTHREADS) SH[i] = mod[(size_t)(l * 5 + (i >> 10)) * 6144 + (wh ? 3 : 0) * 1024 + (i & 1023)];
        __syncthreads();
        float* sw = swb + sw_off(nidx);
        for (int n0 = gw; n0 < N; n0 += 4 * ngw) {
            u32x4 wa[4], wb[4];
#pragma unroll
            for (int q = 0; q < 4; ++q) { const int n = n0 + q * ngw;
                if (n < N) { wa[q] = *(const u32x4*)(W + (size_t)n * 1024 + lane * 8); wb[q] = *(const u32x4*)(W + (size_t)n * 1024 + 512 + lane * 8); } }
#pragma unroll
            for (int q = 0; q < 4; ++q) { const int n = n0 + q * ngw;
                if (n < N) {
                    const u32x4 w0 = wa[q], w1 = wb[q];
                    float wf[16];
#pragma unroll
                    for (int i = 0; i < 4; ++i) { wf[2 * i] = bflo(w0[i]); wf[2 * i + 1] = bfhi(w0[i]); wf[8 + 2 * i] = bflo(w1[i]); wf[8 + 2 * i + 1] = bfhi(w1[i]); }
                    float acc[5];
#pragma unroll
                    for (int c = 0; c < 5; ++c) {
                        const f32x4 s0 = *(const LAS f32x4*)(SH + c * 1024 + lane * 8), s1 = *(const LAS f32x4*)(SH + c * 1024 + lane * 8 + 4);
                        const f32x4 s2 = *(const LAS f32x4*)(SH + c * 1024 + 512 + lane * 8), s3 = *(const LAS f32x4*)(SH + c * 1024 + 512 + lane * 8 + 4);
                        float t = 0.f;
#pragma unroll
                        for (int i = 0; i < 4; ++i) t += wf[i] * s0[i] + wf[4 + i] * s1[i] + wf[8 + i] * s2[i] + wf[12 + i] * s3[i];
                        acc[c] = wave_sum(t);
                    }
                    if (lane < 5) sw[(size_t)lane * N + n] = lane == 0 ? acc[0] : lane == 1 ? acc[1] : lane == 2 ? acc[2] : lane == 3 ? acc[3] : acc[4];
                } }
        }
    }
    __syncthreads();
}
__device__ __forceinline__ void phase_hgrn_final(ArgP a, int gw, int ngw, int lane) {
    const bf16_t* OF = (const bf16_t*)(a->ws + WS_OF); const bf16_t* OB = (const bf16_t*)(a->ws + WS_OB); const bf16_t* GH = (const bf16_t*)(a->ws + WS_GH);
    bf16_t* O = (bf16_t*)(a->ws + WS_O); const float* go = a->in[I_GOUT];
    for (int r = gw; r < MTOK; r += ngw) {
        const size_t off = (size_t)r * 1024 + lane * 16;
        u32x4 f0 = *(const u32x4*)(OF + off), f1 = *(const u32x4*)(OF + off + 8), b0 = *(const u32x4*)(OB + off), b1 = *(const u32x4*)(OB + off + 8);
        u32x4 g0 = *(const u32x4*)(GH + off), g1 = *(const u32x4*)(GH + off + 8);
        float o[16], gt[16];
#pragma unroll
        for (int i = 0; i < 4; ++i) { o[2 * i] = bflo(f0[i]) + bflo(b0[i]); o[2 * i + 1] = bfhi(f0[i]) + bfhi(b0[i]); o[8 + 2 * i] = bflo(f1[i]) + bflo(b1[i]); o[8 + 2 * i + 1] = bfhi(f1[i]) + bfhi(b1[i]);
            gt[2 * i] = bflo(g0[i]); gt[2 * i + 1] = bfhi(g0[i]); gt[8 + 2 * i] = bflo(g1[i]); gt[8 + 2 * i + 1] = bfhi(g1[i]); }
        float s = 0.f;
#pragma unroll
        for (int i = 0; i < 16; ++i) s += o[i] * o[i];
        s += __shfl_xor(s, 1); s += __shfl_xor(s, 2); s += __shfl_xor(s, 4);
        const float rstd = rsqrtf(s * (1.f / 128.f) + EPS);
        const int vc = (lane & 7) * 16;
        u32x4 w0, w1;
#pragma unroll
        for (int i = 0; i < 4; ++i) {
            w0[i] = cvt_pk_bf16(o[2 * i] * rstd * go[vc + 2 * i] * gt[2 * i], o[2 * i + 1] * rstd * go[vc + 2 * i + 1] * gt[2 * i + 1]);
            w1[i] = cvt_pk_bf16(o[8 + 2 * i] * rstd * go[vc + 8 + 2 * i] * gt[8 + 2 * i], o[8 + 2 * i + 1] * rstd * go[vc + 8 + 2 * i + 1] * gt[8 + 2 * i + 1]); }
        *(u32x4*)(O + off) = w0; *(u32x4*)(O + off + 8) = w1;
    }
}

namespace att {
constexpr int KVBLK = 64, LDQ = 1024;
constexpr float SCALE = 0.125f, THR = 8.f;
constexpr size_t SHM_V = KVBLK * 128 * 2, SHM_K = KVBLK * 128 * 2;
#define KSWZ(row, colB) ((row) * 256 + ((colB) ^ (((row) & 7) << 4)))
#define SBAR() __builtin_amdgcn_sched_barrier(0)
__device__ __forceinline__ int crow(int r, int hi) { return (r & 3) + 8 * (r >> 2) + 4 * hi; }
__device__ __forceinline__ unsigned cvtpk(float lo, float hi) { unsigned r; asm volatile("v_cvt_pk_bf16_f32 %0, %1, %2" : "=v"(r) : "v"(lo), "v"(hi)); return r; }
__device__ __forceinline__ void partialSM(f32x16& p0, f32x16& p1, float& m_reg, float& mn, float& alpha) {
  constexpr float C = SCALE * 1.4426950408889634f;
  float pmax = p0[0];
#pragma unroll
  for (int r = 1; r < 16; ++r) pmax = fmaxf(pmax, p0[r]);
#pragma unroll
  for (int r = 0; r < 16; ++r) pmax = fmaxf(pmax, p1[r]);
  { auto rr = __builtin_amdgcn_permlane32_swap(__float_as_uint(pmax), __float_as_uint(pmax), false, false);
    pmax = fmaxf(__uint_as_float(rr[0]), __uint_as_float(rr[1])); }
  if (__builtin_expect(__all(pmax - m_reg <= THR / SCALE), 1)) { mn = m_reg; alpha = 1.f; }
  else { mn = fmaxf(m_reg, pmax); alpha = __builtin_amdgcn_exp2f((m_reg - mn) * C); m_reg = mn; }
  float mnC = -mn * C;
#pragma unroll
  for (int r = 0; r < 16; ++r) p0[r] = fmaf(p0[r], C, mnC);
#pragma unroll
  for (int r = 0; r < 16; ++r) p1[r] = fmaf(p1[r], C, mnC);
#pragma unroll
  for (int r = 0; r < 16; ++r) p0[r] = __builtin_amdgcn_exp2f(p0[r]);
}
__device__ __forceinline__ void finishSM(f32x16& p0, f32x16& p1, float alpha, float& l_reg, bf16x8& pa0, bf16x8& pa1, bf16x8& pa2, bf16x8& pa3) {
#pragma unroll
  for (int r = 0; r < 16; ++r) p1[r] = __builtin_amdgcn_exp2f(p1[r]);
  float ps = 0;
#pragma unroll
  for (int r = 0; r < 16; ++r) ps += p0[r];
#pragma unroll
  for (int r = 0; r < 16; ++r) ps += p1[r];
  { auto rr = __builtin_amdgcn_permlane32_swap(__float_as_uint(ps), __float_as_uint(ps), false, false);
    ps = __uint_as_float(rr[0]) + __uint_as_float(rr[1]); }
  l_reg = l_reg * alpha + ps;
#define PK4(P, BASE, OUT) do { unsigned a0 = cvtpk(P[BASE + 0], P[BASE + 1]), a1 = cvtpk(P[BASE + 2], P[BASE + 3]);   \
    unsigned b0 = cvtpk(P[BASE + 4], P[BASE + 5]), b1 = cvtpk(P[BASE + 6], P[BASE + 7]);                              \
    auto r0 = __builtin_amdgcn_permlane32_swap(a0, b0, false, false); auto r1 = __builtin_amdgcn_permlane32_swap(a1, b1, false, false); \
    u32x4 w = {r0[0], r1[0], r0[1], r1[1]}; OUT = *reinterpret_cast<bf16x8*>(&w); } while (0)
  PK4(p0, 0, pa0); PK4(p0, 8, pa1); PK4(p1, 0, pa2); PK4(p1, 8, pa3);
#undef PK4
}
__device__ __forceinline__ void qkt(f32x16& p0, f32x16& p1, const bf16_t* Ks, const bf16x8* qr, int r32, int hi, int cc) {
  p0 = f32x16{}; p1 = f32x16{};
#pragma unroll
  for (int d0 = 0; d0 < 4; ++d0) { int cb = (cc * 64 + d0 * 16 + hi * 8) * 2;
    bf16x8 b0 = *reinterpret_cast<const bf16x8*>((const char*)Ks + KSWZ(r32, cb));
    bf16x8 b1 = *reinterpret_cast<const bf16x8*>((const char*)Ks + KSWZ(32 + r32, cb));
    p0 = __builtin_amdgcn_mfma_f32_32x32x16_bf16(b0, qr[d0], p0, 0, 0, 0);
    p1 = __builtin_amdgcn_mfma_f32_32x32x16_bf16(b1, qr[d0], p1, 0, 0, 0); }
}
__device__ __forceinline__ int v_st(int k, int c) { const int kk = (k & ~0xC) | ((k & 4) << 1) | ((k & 8) >> 1); return ((kk >> 3) * 4 + (c >> 5)) * 512 + ((kk & 7) * 32 + (c & 31)) * 2; }
__device__ __forceinline__ int v_rd_base(int lane) { return ((lane & 3) << 3) | (((lane >> 2) & 3) << 6) | (((lane >> 4) & 1) << 5) | (((lane >> 5) & 1) << 8); }
constexpr int v_rd_off(int d0, int ks, int half) { return d0 * 512 + ks * 4096 + half * 2048; }
template <int OFF> __device__ __forceinline__ s16x4 tr_read(int vb) {
  s16x4 r; asm volatile("ds_read_b64_tr_b16 %0, %1 offset:%2" : "=&v"(r) : "v"(vb), "i"(OFF) : "memory"); return r;
}
template <int D0> __device__ __forceinline__ void pv_one(f32x16& od, int vb, bf16x8 pa0, bf16x8 pa1, bf16x8 pa2, bf16x8 pa3) {
  const s16x4 l0 = tr_read<v_rd_off(D0, 0, 0)>(vb), h0 = tr_read<v_rd_off(D0, 0, 1)>(vb), l1 = tr_read<v_rd_off(D0, 1, 0)>(vb), h1 = tr_read<v_rd_off(D0, 1, 1)>(vb);
  const s16x4 l2 = tr_read<v_rd_off(D0, 2, 0)>(vb), h2 = tr_read<v_rd_off(D0, 2, 1)>(vb), l3 = tr_read<v_rd_off(D0, 3, 0)>(vb), h3 = tr_read<v_rd_off(D0, 3, 1)>(vb);
  asm volatile("s_waitcnt lgkmcnt(0)" ::: "memory"); SBAR();
#define PK(L, H) (bf16x8){L[0], L[1], L[2], L[3], H[0], H[1], H[2], H[3]}
  od = __builtin_amdgcn_mfma_f32_32x32x16_bf16(pa0, PK(l0, h0), od, 0, 0, 0);
  od = __builtin_amdgcn_mfma_f32_32x32x16_bf16(pa1, PK(l1, h1), od, 0, 0, 0);
  od = __builtin_amdgcn_mfma_f32_32x32x16_bf16(pa2, PK(l2, h2), od, 0, 0, 0);
  od = __builtin_amdgcn_mfma_f32_32x32x16_bf16(pa3, PK(l3, h3), od, 0, 0, 0);
#undef PK
}
__device__ __forceinline__ void pv_d0(f32x16* o, int vb, bf16x8 pa0, bf16x8 pa1, bf16x8 pa2, bf16x8 pa3) {
  pv_one<0>(o[0], vb, pa0, pa1, pa2, pa3); pv_one<1>(o[1], vb, pa0, pa1, pa2, pa3); pv_one<2>(o[2], vb, pa0, pa1, pa2, pa3); pv_one<3>(o[3], vb, pa0, pa1, pa2, pa3);
}
__device__ __forceinline__ void diff_attn_unit(const bf16_t* __restrict__ Qb, const bf16_t* __restrict__ Kh, const bf16_t* __restrict__ Vh, bf16_t* __restrict__ Ob,
                                               int seq, char* lds, float lam, const float* __restrict__ gsub, float oscale) {
  const int tid = tid_opaque(), wid = tid >> 6, lane = tid & 63, r32 = lane & 31, hi = lane >> 5;
  const int qblk = wid >> 1, cc = wid & 1;
  bf16_t* V_lds = (bf16_t*)lds; bf16_t* K_lds = (bf16_t*)(lds + 2 * SHM_V);
  float* ws = (float*)(lds + 2 * SHM_V + 2 * SHM_K) + wid * 64; float* li_l = ws; float* al_l = ws + 32;
  float m_reg = -1e30f, l_reg = 0; f32x16 o[4] = {}; bf16x8 qr[4];
  const bf16_t* Qw = Qb + (long)(qblk * 32 + r32) * LDQ + cc * 64 + hi * 8;
#pragma unroll
  for (int d0 = 0; d0 < 4; ++d0) qr[d0] = *reinterpret_cast<const bf16x8*>(Qw + d0 * 16);
  const int sr = tid >> 4, sc = (tid & 15) * 8, vst0 = v_st(sr, sc), vst1 = v_st(32 + sr, sc);
  const int vb0 = (int)(uintptr_t)V_lds + v_rd_base(lane);
  struct { bf16x8 vs0, vs1, ks0, ks1; } sr_[2];
#define SLOAD(i, k0) do { sr_[i].vs0 = *reinterpret_cast<const bf16x8*>(&Vh[(long)((k0) + sr) * LDQ + sc]); sr_[i].vs1 = *reinterpret_cast<const bf16x8*>(&Vh[(long)((k0) + 32 + sr) * LDQ + sc]); \
    sr_[i].ks0 = *reinterpret_cast<const bf16x8*>(&Kh[(long)((k0) + sr) * LDQ + sc]); sr_[i].ks1 = *reinterpret_cast<const bf16x8*>(&Kh[(long)((k0) + 32 + sr) * LDQ + sc]); } while (0)
#define SWRITE(b, i) do { *(bf16x8*)((char*)V_lds + (b) * SHM_V + vst0) = sr_[i].vs0;          \
    *(bf16x8*)((char*)V_lds + (b) * SHM_V + vst1) = sr_[i].vs1; int kc = sc * 2;               \
    *(bf16x8*)((char*)K_lds + (b) * SHM_K + KSWZ(sr, kc)) = sr_[i].ks0;                       \
    *(bf16x8*)((char*)K_lds + (b) * SHM_K + KSWZ(32 + sr, kc)) = sr_[i].ks1; } while (0)
#define SWAIT() asm volatile("s_waitcnt vmcnt(4)" ::: "memory")
#define RESC(a) do { if (__any((a) < 1.f)) { if (hi == 0) al_l[r32] = (a); asm volatile("s_waitcnt lgkmcnt(0)" ::: "memory"); \
    _Pragma("unroll") for (int d = 0; d < 4; ++d) _Pragma("unroll") for (int r = 0; r < 16; ++r) o[d][r] *= al_l[crow(r, hi)]; } } while (0)
  f32x16 pA0, pA1, pB0, pB1; float mnA, mnB, alA, alB; bf16x8 pa0, pa1, pa2, pa3; const int NT = seq / KVBLK;
  constexpr int SE = 0, SO = 1;
  SLOAD(SE, 0); asm volatile("s_waitcnt vmcnt(0)" ::: "memory"); SWRITE(0, SE); __syncthreads();
  qkt(pA0, pA1, K_lds, qr, r32, hi, cc); partialSM(pA0, pA1, m_reg, mnA, alA);
  SLOAD(SO, KVBLK); if (2 < NT) SLOAD(SE, 2 * KVBLK);
  SWAIT(); SWRITE(1, SO); __syncthreads();
  for (int j = 1; j + 1 < NT; j += 2) {
    SBAR(); qkt(pB0, pB1, (bf16_t*)((char*)K_lds + SHM_K), qr, r32, hi, cc);
    finishSM(pA0, pA1, alA, l_reg, pa0, pa1, pa2, pa3); SBAR();
    SLOAD(SO, (j + 2) * KVBLK); SBAR();
    pv_d0(o, vb0, pa0, pa1, pa2, pa3); partialSM(pB0, pB1, m_reg, mnB, alB);
    __syncthreads(); SWAIT(); SWRITE(0, SE);
    RESC(alB); __syncthreads();
    SBAR(); qkt(pA0, pA1, K_lds, qr, r32, hi, cc);
    finishSM(pB0, pB1, alB, l_reg, pa0, pa1, pa2, pa3); SBAR();
    if (j + 3 < NT) SLOAD(SE, (j + 3) * KVBLK); SBAR();
    pv_d0(o, vb0 + (int)SHM_V, pa0, pa1, pa2, pa3); partialSM(pA0, pA1, m_reg, mnA, alA);
    __syncthreads(); SWAIT(); SWRITE(1, SO);
    RESC(alA); __syncthreads();
  }
  SBAR(); qkt(pB0, pB1, (bf16_t*)((char*)K_lds + SHM_K), qr, r32, hi, cc);
  finishSM(pA0, pA1, alA, l_reg, pa0, pa1, pa2, pa3); SBAR();
  pv_d0(o, vb0, pa0, pa1, pa2, pa3); partialSM(pB0, pB1, m_reg, mnB, alB);
  __syncthreads(); RESC(alB);
  finishSM(pB0, pB1, alB, l_reg, pa0, pa1, pa2, pa3); SBAR();
  pv_d0(o, vb0 + (int)SHM_V, pa0, pa1, pa2, pa3);
  if (hi == 0) li_l[r32] = l_reg; asm volatile("s_waitcnt lgkmcnt(0)" ::: "memory");
  float rli[16];
#pragma unroll
  for (int r = 0; r < 16; ++r) rli[r] = __builtin_amdgcn_rcpf(li_l[crow(r, hi)]);
  __syncthreads();
  float* xch = (float*)lds + qblk * (32 * 128);
  if (cc == 1) {
#pragma unroll
    for (int r = 0; r < 16; ++r)
#pragma unroll
      for (int d0 = 0; d0 < 4; ++d0) xch[crow(r, hi) * 128 + d0 * 32 + r32] = lam * o[d0][r] * rli[r];
  }
  __syncthreads();
  if (cc == 0) {
    float gs[4];
#pragma unroll
    for (int d0 = 0; d0 < 4; ++d0) gs[d0] = gsub[d0 * 32 + r32] * oscale;
#pragma unroll
    for (int r = 0; r < 16; ++r) {
      float ss = 0.f;
#pragma unroll
      for (int d0 = 0; d0 < 4; ++d0) { const float v = o[d0][r] * rli[r] - xch[crow(r, hi) * 128 + d0 * 32 + r32]; o[d0][r] = v; ss += v * v; }
      ss += __shfl_xor(ss, 1); ss += __shfl_xor(ss, 2); ss += __shfl_xor(ss, 4); ss += __shfl_xor(ss, 8); ss += __shfl_xor(ss, 16);
      const float rs = rsqrtf(ss * (1.f / 128.f) + EPS);
      bf16_t* orow = Ob + (long)(qblk * 32 + crow(r, hi)) * LDQ;
#pragma unroll
      for (int d0 = 0; d0 < 4; ++d0) orow[d0 * 32 + r32] = (bf16_t)(cvtpk(o[d0][r] * rs * gs[d0], 0.f) & 0xffff);
    }
  }
  __syncthreads();
#undef SLOAD
#undef SWRITE
#undef SWAIT
#undef RESC
}
#undef KSWZ
#undef SBAR
constexpr int LDS_NEED = 2 * SHM_V + 2 * SHM_K + 8 * 64 * 4;
}

__device__ __forceinline__ void phase_attn(ArgP a, int j, char* lds, int G, int bid) {
    const bf16_t* Q = (const bf16_t*)(a->ws + WS_Q); const bf16_t* KB = (const bf16_t*)(a->ws + WS_KB); const bf16_t* VB = (const bf16_t*)(a->ws + WS_VB);
    bf16_t* O = (bf16_t*)(a->ws + WS_O);
    const float lam = ((const float*)(a->ws + WS_LAM))[j];
    const float oscale = 1.f - (j == 0 ? a->lam_init0 : a->lam_init1);
    const float* gsub = a->in[I_GSUB] + j * 128;
    for (int u0 = bid; u0 < 512; u0 += G) {
        const int u = (u0 & 256) + (u0 & 7) * 32 + ((u0 & 255) >> 3);
        int qrow, krow, seq, h;
        if (u < 256) { const int b = u >> 6; h = (u >> 3) & 7; const int qb = u & 7; qrow = NCTX + b * 1024 + qb * 128; krow = NCTX + b * 1536; seq = 1536; }
        else { const int v = u - 256, b = v >> 4; h = (v >> 1) & 7; const int qb = v & 1; qrow = b * 256 + qb * 128; krow = b * 256; seq = 256; }
        att::diff_attn_unit(Q + (size_t)qrow * 1024 + h * 128, KB + (size_t)krow * 1024 + h * 128, VB + (size_t)krow * 1024 + h * 128, O + (size_t)qrow * 1024 + h * 128,
                            seq, lds, lam, gsub, oscale);
    }
}

namespace hg {
constexpr int QT_OFF = 0, KT_OFF = 64 * 272, KHT_OFF = 2 * 64 * 272, VT_OFF = KHT_OFF + 128 * 144, DD_OFF = VT_OFF + 128 * 144, LDS_NEED = DD_OFF + 4 * 128 * 4;
__device__ __forceinline__ s16x4 pk4(f32x4 v) { u32x2 w; w.x = cvt_pk_bf16(v[0], v[1]); w.y = cvt_pk_bf16(v[2], v[3]); return __builtin_bit_cast(s16x4, w); }
struct Stage { u32x4 qk[4], kh[2], v[2], d; };
__device__ __forceinline__ void scan_unit(int tok0, int n, int h, int dir, int vbase, int nwv, const bf16_t* __restrict__ QK, const bf16_t* __restrict__ KHT, const bf16_t* __restrict__ VT,
                                          const float* __restrict__ DD, const float* __restrict__ s0, float* __restrict__ sout, bf16_t* __restrict__ Od, LAS unsigned char* lds) {
    const int tid = tid_opaque(), lane = tid & 63, wv = __builtin_amdgcn_readfirstlane(tid >> 6), l15 = lane & 15, g = lane >> 4;
    const bool act = wv < nwv;
    const int vc = vbase + 16 * wv + l15;
    f32x4 S[8];
#pragma unroll
    for (int i = 0; i < 8; ++i) {
        if (s0 && act) {
#pragma unroll
            for (int r = 0; r < 4; ++r) S[i][r] = s0[(size_t)(16 * i + 4 * g + r) * 128 + vc]; }
        else S[i] = (f32x4){0.f, 0.f, 0.f, 0.f};
    }
    const int nms = n >> 6;
    Stage st;
#define HG_LOAD(msn) do { const int tb_ = tok0 + (msn) * 64; \
        _Pragma("unroll") for (int i_ = 0; i_ < 4; ++i_) { const int p_ = tid + 512 * i_; \
            st.qk[i_] = *(const u32x4*)(QK + ((size_t)((tb_ + (p_ >> 5)) * 8 + h) * 32 + (p_ & 31)) * 16 + dir * 8); } \
        _Pragma("unroll") for (int i_ = 0; i_ < 2; ++i_) { const int p_ = tid + 512 * i_; \
            const size_t to_ = ((size_t)(((tb_ >> 4) + (p_ >> 8)) * 8 + h) * 128 + ((p_ & 255) >> 1)) * 16 + (p_ & 1) * 8; st.kh[i_] = *(const u32x4*)(KHT + to_); st.v[i_] = *(const u32x4*)(VT + to_); } \
        if (tid < 128) st.d = *(const u32x4*)(DD + (size_t)(((tb_ >> 4) + (tid >> 5)) * 8 + h) * 128 + (tid & 31) * 4); } while (0)
#define HG_STORE() do { \
        _Pragma("unroll") for (int i_ = 0; i_ < 4; ++i_) { const int p_ = tid + 512 * i_; u32x2 lo_, hi_; lo_.x = st.qk[i_].x; lo_.y = st.qk[i_].y; hi_.x = st.qk[i_].z; hi_.y = st.qk[i_].w; \
            *(LAS u32x2*)(lds + QT_OFF + (p_ >> 5) * 272 + (p_ & 31) * 8) = lo_; *(LAS u32x2*)(lds + KT_OFF + (p_ >> 5) * 272 + (p_ & 31) * 8) = hi_; } \
        _Pragma("unroll") for (int i_ = 0; i_ < 2; ++i_) { const int p_ = tid + 512 * i_; \
            const int lo2_ = ((p_ & 255) >> 1) * 144 + ((p_ >> 8) * 16 + (p_ & 1) * 8) * 2; *(LAS u32x4*)(lds + KHT_OFF + lo2_) = st.kh[i_]; *(LAS u32x4*)(lds + VT_OFF + lo2_) = st.v[i_]; } \
        if (tid < 128) *(LAS u32x4*)(lds + DD_OFF + ((tid >> 5) * 128 + (tid & 31) * 4) * 4) = st.d; } while (0)
    HG_LOAD(dir ? nms - 1 : 0);
    HG_STORE();
    __syncthreads();
    for (int ms = 0; ms < nms; ++ms) {
        const int msn = dir ? nms - 1 - ms : ms;
        if (ms + 1 < nms) HG_LOAD(dir ? msn - 1 : msn + 1);
        __builtin_amdgcn_sched_barrier(0);
        if (act) {
        s16x4 xb[4];
#pragma unroll
        for (int cp = 0; cp < 4; cp += 2) {
            bf16x8 ka[2][4], qb[2][4];
#pragma unroll
            for (int q = 0; q < 2; ++q)
#pragma unroll
                for (int kk = 0; kk < 4; ++kk) {
                    ka[q][kk] = *(const LAS bf16x8*)(lds + KT_OFF + ((cp + q) * 16 + l15) * 272 + kk * 64 + g * 16);
                    qb[q][kk] = *(const LAS bf16x8*)(lds + QT_OFF + ((cp + q) * 16 + l15) * 272 + kk * 64 + g * 16); }
            __builtin_amdgcn_sched_barrier(0);
            f32x4 X0 = {0.f, 0.f, 0.f, 0.f}, X1 = {0.f, 0.f, 0.f, 0.f};
#pragma unroll
            for (int kk = 0; kk < 4; ++kk) { X0 = __builtin_amdgcn_mfma_f32_16x16x32_bf16(ka[0][kk], qb[0][kk], X0, 0, 0, 0); X1 = __builtin_amdgcn_mfma_f32_16x16x32_bf16(ka[1][kk], qb[1][kk], X1, 0, 0, 0); }
#pragma unroll
            for (int r = 0; r < 4; ++r) if (dir ? (4 * g + r < l15) : (4 * g + r > l15)) { X0[r] = 0.f; X1[r] = 0.f; }
            xb[cp] = pk4(X0); xb[cp + 1] = pk4(X1);
            __builtin_amdgcn_sched_barrier(0);
        }
        f32x4 dvA[8], dvB[8]; s16x4 kaA[8], kaB[8], vbA, vbB;
#define HG_OPS(c_, DV, KA, VB) do { VB = *(const LAS s16x4*)(lds + VT_OFF + vc * 144 + ((c_) * 16 + 4 * g) * 2); \
            _Pragma("unroll") for (int i_ = 0; i_ < 8; ++i_) { DV[i_] = *(const LAS f32x4*)(lds + DD_OFF + ((c_) * 128 + 16 * i_ + 4 * g) * 4); \
                KA[i_] = *(const LAS s16x4*)(lds + KHT_OFF + (16 * i_ + l15) * 144 + ((c_) * 16 + 4 * g) * 2); } } while (0)
#define HG_CHUNK(c_, XB, DV, KA, VB) do { \
            f32x4 o0_ = {0.f, 0.f, 0.f, 0.f}, o1_ = {0.f, 0.f, 0.f, 0.f}; s16x4 sb_[8], qa_[8]; \
            _Pragma("unroll") for (int i_ = 0; i_ < 8; ++i_) { sb_[i_] = pk4(S[i_]); qa_[i_] = *(const LAS s16x4*)(lds + QT_OFF + ((c_) * 16 + l15) * 272 + (16 * i_ + 4 * g) * 2); } \
            _Pragma("unroll") for (int i_ = 0; i_ < 8; ++i_) S[i_] = __builtin_amdgcn_mfma_f32_16x16x16bf16_1k(KA[i_], VB, S[i_] * DV[i_], 0, 0, 0); \
            _Pragma("unroll") for (int i_ = 0; i_ < 8; i_ += 2) { o0_ = __builtin_amdgcn_mfma_f32_16x16x16bf16_1k(qa_[i_], sb_[i_], o0_, 0, 0, 0); o1_ = __builtin_amdgcn_mfma_f32_16x16x16bf16_1k(qa_[i_ + 1], sb_[i_ + 1], o1_, 0, 0, 0); } \
            o0_ = __builtin_amdgcn_mfma_f32_16x16x16bf16_1k(XB, VB, o0_, 0, 0, 0); \
            const f32x4 o_ = o0_ + o1_; \
            _Pragma("unroll") for (int r_ = 0; r_ < 4; ++r_) Od[(size_t)(tok0 + msn * 64 + (c_) * 16 + 4 * g + r_) * 1024 + h * 128 + vc] = (bf16_t)(cvt_pk_bf16(o_[r_], 0.f) & 0xffff); } while (0)
        const int c0 = dir ? 3 : 0, cs = dir ? -1 : 1;
        HG_OPS(c0, dvA, kaA, vbA); __builtin_amdgcn_sched_barrier(0);
        HG_OPS(c0 + cs, dvB, kaB, vbB); __builtin_amdgcn_sched_barrier(0);
        { const s16x4 x0 = dir ? xb[3] : xb[0]; HG_CHUNK(c0, x0, dvA, kaA, vbA); } __builtin_amdgcn_sched_barrier(0);
        HG_OPS(c0 + 2 * cs, dvA, kaA, vbA); __builtin_amdgcn_sched_barrier(0);
        { const s16x4 x1 = dir ? xb[2] : xb[1]; HG_CHUNK(c0 + cs, x1, dvB, kaB, vbB); } __builtin_amdgcn_sched_barrier(0);
        HG_OPS(c0 + 3 * cs, dvB, kaB, vbB); __builtin_amdgcn_sched_barrier(0);
        { const s16x4 x2 = dir ? xb[1] : xb[2]; HG_CHUNK(c0 + 2 * cs, x2, dvA, kaA, vbA); } __builtin_amdgcn_sched_barrier(0);
        { const s16x4 x3 = dir ? xb[0] : xb[3]; HG_CHUNK(c0 + 3 * cs, x3, dvB, kaB, vbB); }
#undef HG_OPS
#undef HG_CHUNK
        }
        __syncthreads();
        if (ms + 1 < nms) { HG_STORE(); }
        __syncthreads();
    }
#undef HG_LOAD
#undef HG_STORE
    if (sout && act) {
#pragma unroll
        for (int i = 0; i < 8; ++i)
#pragma unroll
            for (int r = 0; r < 4; ++r) sout[(size_t)(16 * i + 4 * g + r) * 128 + vc] = S[i][r];
    }
}
}

__device__ __forceinline__ void phase_scan(ArgP a, LAS unsigned char* lds, int G, int bid) {
    for (int i = 0;; ++i) {
        const int u0 = i * G + ((i & 1) ? (G - 1 - bid) : bid);
        if (u0 >= 384) break;
        const int u = (u0 & ~127) + (u0 & 7) * 16 + ((u0 & 127) >> 3);
        int tok0, n, h, dir, vbase = 0, nwv = 8; const float* s0 = nullptr; float* sout = nullptr;
        if (u < 128) { const int b = u >> 5; h = (u >> 2) & 7; dir = (u >> 1) & 1; vbase = (u & 1) * 64; nwv = 4; tok0 = NCTX + b * 1024; n = 1024; s0 = a->in[I_ST] + ((size_t)(b * 2 + dir) * 8 + h) * 16384; }
        else { const int v = u - 128, b = v >> 4; h = (v >> 1) & 7; dir = v & 1; tok0 = b * 256; n = 256; sout = a->out + OUT_NS + ((size_t)(b * 2 + dir) * 8 + h) * 16384; }
        hg::scan_unit(tok0, n, h, dir, vbase, nwv, (const bf16_t*)(a->ws + WS_QTF), (const bf16_t*)(a->ws + (dir ? WS_KHTB : WS_KHTF)),
                      (const bf16_t*)(a->ws + WS_VT), (const float*)(a->ws + (dir ? WS_DDB : WS_DDF)), s0, sout, (bf16_t*)(a->ws + (dir ? WS_OB : WS_OF)), lds);
    }
}

#ifndef PHMASK
#define PHMASK 0xFFFF
#endif
#ifndef REPMASK
#define REPMASK 0
#endif
#ifndef XBAR
#define XBAR 0
#endif
enum PhType { T_PRO = 0, T_NORM, T_QKV, T_ATTN, T_RES, T_FFN, T_HIN, T_SCAN, T_HFIN, T_F1, T_FINAL, T_FOLD };
struct PhDesc { int type, layer, sub; };
constexpr int NPH = 23;
__device__ __forceinline__ PhDesc phase_desc(int p) {
    switch (p) {
        case 0: return {T_PRO, 0, 0};
        case 1: return {T_FOLD, 0, 0};
        case 2: return {T_QKV, 0, 0}; case 3: return {T_ATTN, 0, 0}; case 4: return {T_RES, 0, 0}; case 5: return {T_FFN, 0, 0}; case 6: return {T_RES, 0, 2};
        case 7: return {T_HIN, 1, 0}; case 8: return {T_SCAN, 1, 0}; case 9: return {T_HFIN, 1, 0}; case 10: return {T_RES, 1, 1}; case 11: return {T_FFN, 1, 0}; case 12: return {T_RES, 1, 2};
        case 13: return {T_F1, 2, 0}; case 14: return {T_RES, 2, 3}; case 15: return {T_FFN, 2, 0}; case 16: return {T_RES, 2, 2};
        case 17: return {T_QKV, 3, 1}; case 18: return {T_ATTN, 3, 1}; case 19: return {T_RES, 3, 0}; case 20: return {T_FFN, 3, 0}; case 21: return {T_RES, 3, 2};
        default: return {T_FINAL, 0, 0};
    }
}

__global__ void __launch_bounds__(NTHREADS, 2) fwd_megakernel(Args a_unused) {
    extern __shared__ __attribute__((aligned(16))) unsigned char lds_raw[];
    LAS unsigned char* lds = (LAS unsigned char*)lds_raw;
    constexpr int G = 256; const int bid = blockIdx.x;
    ArgP a = (ArgP)__builtin_amdgcn_kernarg_segment_ptr();
    for (int u = threadIdx.x; u < (LDS_BYTES - LDSCTL_OFF) / 4; u += NTHREADS) ((LAS unsigned*)(lds + LDSCTL_OFF))[u] = 0u;
    __syncthreads();
    volatile LAS unsigned* MISC = (volatile LAS unsigned*)(lds + MISC_OFF);
    XcdBarrier bar = xcd_barrier_post((unsigned*)(a->ws + WS_CTL), MISC + 8);

    const int nrun = a->ph_hi < NPH ? a->ph_hi + 1 : NPH;
#if REPMASK
    for (int pj = 2 * a->ph_lo; pj < 2 * nrun; ++pj) {
        const int pi = pj >> 1, rep = pj & 1;
        const int ph = pi < a->ph_hi ? pi : NPH - 1;
        const PhDesc d = phase_desc(ph);
        if (rep && !((REPMASK >> d.type) & 1)) continue;
        if (pj > 2 * a->ph_lo) xcd_barrier(bar);
#else
    for (int pi = a->ph_lo; pi < nrun; ++pi) {
        const int rep = 0;
        const int ph = pi < a->ph_hi ? pi : NPH - 1;
        const PhDesc d = phase_desc(ph);
        if (pi > a->ph_lo) xcd_barrier(bar);
#endif
        for (int xb = 0; xb < XBAR; ++xb) xcd_barrier(bar);
#define PH_TID const int tid = tid_opaque(), lane = tid & 63, wave = __builtin_amdgcn_readfirstlane(tid >> 6), gw = bid * NWAVES + wave, ngw = G * NWAVES; (void)lane; (void)gw; (void)ngw
        asm volatile("" : "+s"(a));
        const int L = d.layer;
        switch (d.type) {
#if (PHMASK >> 0) & 1
        case T_PRO: phase_prologue(a, lds, G, bid);
            if (a->ph_hi < NPH) { PH_TID; for (size_t i = (size_t)bid * NTHREADS + tid; i < 29360128 / 4; i += (size_t)G * NTHREADS) ((f32x4*)a->out)[i] = (f32x4){0.f, 0.f, 0.f, 0.f}; }
            break;
#endif
#if (PHMASK >> 1) & 1
        case T_FOLD: {
            PH_TID;
            phase_an(a, bid * NTHREADS + tid, G * NTHREADS);
            phase_sw(a, lds, 0x03, gw, ngw, tid, lane);
            phase_first_norm(a, gw, ngw, lane);
        } break;
#endif
#if (PHMASK >> 2) & 1
        case T_NORM: break;
#endif
#if (PHMASK >> 3) & 1
        case T_QKV: {
            const int j = d.sub, nidx = 2 * L;
            if (j == 1) { PH_TID; cache_convert(a, 1, gw, ngw, lane); }
            const float* sspn = (const float*)(a->ws + WS_SSP) + (size_t)nidx * 8192 * SSPN; const float* swn = (const float*)(a->ws + WS_SW) + sw_off(nidx);
            { GenSched S; S.init(7, a->ws + WS_H, nullptr, 1024, a->ws + WS_WQKV + (size_t)j * 3072 * 1024 * 2, 1024, MTOK, 3072, 1024, G, bid);
              EpiQKV E{(bf16_t*)(a->ws + WS_Q), (bf16_t*)(a->ws + WS_KB), (bf16_t*)(a->ws + WS_VB), a->out + OUT_NK + (size_t)j * 256 * 1024, a->out + OUT_NV + (size_t)j * 256 * 1024,
                       (const float*)(a->ws + WS_ROPE), (const float*)(a->ws + WS_ROPE) + 1024, sspn, swn, lds};
              pg8::gemm_phase(lds, 1024, 1024, S, E); }
            { GenSched S; S.init(8, a->ws + WS_H, nullptr, 1024, a->ws + WS_WQKV + (size_t)j * 3072 * 1024 * 2, 1024, MTOK, 3072, 1024, G, bid);
              EpiQKV128 E{(bf16_t*)(a->ws + WS_Q), (bf16_t*)(a->ws + WS_KB), (bf16_t*)(a->ws + WS_VB), a->out + OUT_NK + (size_t)j * 256 * 1024, a->out + OUT_NV + (size_t)j * 256 * 1024,
                          (const float*)(a->ws + WS_ROPE), (const float*)(a->ws + WS_ROPE) + 1024, sspn, swn, lds};
              pg8::gemm_phase_n128(lds, 1024, 1024, S, E); }
        } break;
#endif
#if (PHMASK >> 4) & 1
        case T_ATTN: phase_attn(a, d.sub, (char*)lds_raw, G, bid); break;
#endif
#if (PHMASK >> 5) & 1
        case T_RES: {
            const int nn = d.sub == 2 ? 2 * L + 2 : 2 * L + 1;
            EpiResid128 E{(bf16_t*)(a->ws + WS_X), (float*)(a->ws + WS_MOD) + (size_t)L * 5 * 6144 + (d.sub == 2 ? 5 : 2) * 1024,
                          nn < 8 ? (const float*)(a->ws + WS_AN) + nn * 5120 : nullptr, (bf16_t*)(a->ws + WS_H), (float*)(a->ws + WS_SSP) + (size_t)nn * 8192 * SSPN};
            GenSched S; int lda, ldb;
            if (d.sub == 3) { lda = 2048; ldb = 16384; S.init(4, a->ws + WS_CS1024, a->ws + WS_CS256, lda, a->ws + WS_ZT, ldb, 0, 0, 2048, G, bid); }
            else if (d.sub == 2) { lda = DFF; ldb = DFF; S.init(3, a->ws + WS_ACT, nullptr, lda, a->ws + WS_WFOUT + (size_t)L * 1024 * DFF * 2, ldb, MTOK, 1024, DFF, G, bid); }
            else { lda = 1024; ldb = 1024; const unsigned char* w = d.sub == 0 ? a->ws + WS_WOA + (size_t)(L == 0 ? 0 : 1) * 1024 * 1024 * 2 : a->ws + WS_WOR;
                S.init(3, a->ws + WS_O, nullptr, lda, w, ldb, MTOK, 1024, 1024, G, bid); }
            pg8::gemm_phase_n128(lds, lda, ldb, S, E);
            if (d.sub == 3 && bid >= 128) { phase_ada(a, lds, 3 * 48 + (bid - 128), 4 * 48, 128); }
            if (d.sub == 3 && bid >= 128) { PH_TID; deferred_convert(a, 3, lds, (bid - 128) * NWAVES + wave, 128 * NWAVES); }
            if (d.sub == 2 && L < 3) { PH_TID; phase_sw(a, lds, L == 0 ? 0x0Cu : L == 1 ? 0x30u : 0xC0u, gw, ngw, tid, lane); }
        } break;
#endif
#if (PHMASK >> 6) & 1
        case T_FFN: {
            const int nidx = 2 * L + 1;
            GenSched S; S.init(0, a->ws + WS_H, nullptr, 1024, a->ws + WS_WFI + (size_t)L * 5632 * 1024 * 2, 1024, MTOK, 5632, 1024, G, bid);
            EpiFFN E{(bf16_t*)(a->ws + WS_ACT), (const float*)(a->ws + WS_SSP) + (size_t)nidx * 8192 * SSPN, (const float*)(a->ws + WS_SW) + sw_off(nidx), lds};
            pg8::gemm_phase(lds, 1024, 1024, S, E);
            if (bid >= 704 - 2 * G && L == 0) {
                GenSched S2; S2.init(2, a->ws + WS_WFO, nullptr, 1024, a->ws + WS_TC, 1024, 1024, 256, a->ph_hi > 0 ? 256 : 320, G, bid - (704 - 2 * G));
                EpiBf16 E2{(bf16_t*)(a->ws + WS_WCS), 1024};
                pg8::gemm_phase(lds, 1024, 1024, S2, E2); }
            if (bid >= 704 - 2 * G && L < 3) { PH_TID; deferred_convert(a, L, lds, (bid - (704 - 2 * G)) * NWAVES + wave, (3 * G - 704) * NWAVES); }
        } break;
#endif
#if (PHMASK >> 7) & 1
        case T_HIN: {
            { GenSched S; S.init(5, a->ws + WS_H, nullptr, 1024, a->ws + WS_WINR, 1024, MTOK, 4096, 1024, G, bid);
              EpiHgrn E{(bf16_t*)(a->ws + WS_GH), (bf16_t*)(a->ws + WS_QTF), (bf16_t*)(a->ws + WS_KTF), (bf16_t*)(a->ws + WS_QTB), (bf16_t*)(a->ws + WS_KTB), (bf16_t*)(a->ws + WS_KHTF), (bf16_t*)(a->ws + WS_KHTB),
                        (bf16_t*)(a->ws + WS_VT), (float*)(a->ws + WS_DDF), (float*)(a->ws + WS_DDB), (const float*)(a->ws + WS_LBV), (const float*)(a->ws + WS_SSP) + 2ull * 8192 * SSPN, (const float*)(a->ws + WS_SW) + sw_off(2), lds};
              pg8::gemm_phase(lds, 1024, 1024, S, E); }
            { GenSched S; S.init(6, a->ws + WS_H, nullptr, 1024, a->ws + WS_WINR, 1024, MTOK, 1024, 1024, G, bid);
              EpiG128 E{(bf16_t*)(a->ws + WS_GH), (const float*)(a->ws + WS_SSP) + 2ull * 8192 * SSPN, (const float*)(a->ws + WS_SW) + sw_off(2), lds};
              pg8::gemm_phase_n128(lds, 1024, 1024, S, E); }
        } break;
#endif
#if (PHMASK >> 8) & 1
        case T_SCAN: phase_scan(a, lds, G, bid); break;
#endif
#if (PHMASK >> 9) & 1
        case T_HFIN: { PH_TID; phase_hgrn_final(a, gw, ngw, lane); } break;
#endif
#if (PHMASK >> 10) & 1
        case T_F1: {
            GenSched S; S.init(0, a->ws + WS_WCS, nullptr, 1024, a->ws + WS_H, 1024, 2048, MTOK, 1024, G, bid);
            EpiFour1 E{(bf16_t*)(a->ws + WS_ZT), (const float*)(a->ws + WS_SSP) + 4ull * 8192 * SSPN, (const float*)(a->ws + WS_SW) + sw_off(4), lds};
            pg8::gemm_phase(lds, 1024, 1024, S, E);
        } break;
#endif
        default: { PH_TID; phase_final(a, gw, ngw, lane); } break;
        }
    }
}

extern "C" void kernel_launch(void* const* d_in, const int* in_sizes, int n_in, void* d_out, int out_size, void* d_ws, size_t ws_size, hipStream_t stream) {
    static int grid = 0;
    if (grid == 0) {
        if (n_in != 23 || out_size != 29360128 || ws_size < WS_END2) {
            fprintf(stderr, "kernel_launch: unexpected shapes: n_in %d out %d ws %zu (need >= %zu); nothing launched\n", n_in, out_size, ws_size, (size_t)WS_END); grid = -1; return; }
        int dev = 0, cus = 0, per_cu = 0;
        if (hipGetDevice(&dev) != hipSuccess || hipDeviceGetAttribute(&cus, hipDeviceAttributeMultiprocessorCount, dev) != hipSuccess) { fprintf(stderr, "kernel_launch: device query failed\n"); grid = -1; return; }
        if (hipFuncSetAttribute((const void*)fwd_megakernel, hipFuncAttributeMaxDynamicSharedMemorySize, LDS_BYTES) != hipSuccess) { fprintf(stderr, "kernel_launch: hipFuncSetAttribute failed\n"); grid = -1; return; }
        if (hipOccupancyMaxActiveBlocksPerMultiprocessor(&per_cu, (const void*)fwd_megakernel, NTHREADS, LDS_BYTES) != hipSuccess || per_cu < 1) {
            fprintf(stderr, "kernel_launch: occupancy query reports %d workgroups per CU; nothing launched\n", per_cu); (void)hipGetLastError(); grid = -1; return; }
        if (cus < 256) { fprintf(stderr, "kernel_launch: needs >= 256 CUs (have %d); nothing launched\n", cus); grid = -1; return; }
        grid = 256;
    }
    if (grid < 0) return;
    (void)hipMemsetAsync((char*)d_ws + WS_CTL, 0, CTL_BYTES, stream);
    Args a{};
    for (int i = 0; i < 23; ++i) a.in[i] = (const float*)d_in[i];
    a.out = (float*)d_out; a.ws = (unsigned char*)d_ws;
    a.lam_init0 = 0.2f; a.lam_init1 = (float)(0.8 - 0.6 * 0.40656965974059917);
    a.ph_lo = 0; a.ph_hi = NPH;
    hipLaunchKernelGGL(fwd_megakernel, dim3(grid), dim3(NTHREADS), LDS_BYTES, stream, a);
    const hipError_t le = hipPeekAtLastError();
    if (le != hipSuccess) fprintf(stderr, "kernel_launch: launch failed: %s\n", hipGetErrorName(le));
}
```
